# Optimizing an MI355X kernel written in HIP

```python
import math
import jax
import jax.numpy as jnp
from jax import lax
import numpy as np

D_MODEL = 1024
BATCH = 4
SEQ = 8192
DEPTH = 2

MIX_WIDTH = D_MODEL
LRU_WIDTH = D_MODEL // 4
LRU_BLOCK_W = 64
LRU_BLOCKS = LRU_WIDTH // LRU_BLOCK_W
CONV_W = 4
LRU_C = 8.0
S5_WIDTH = D_MODEL // 4
S5_GROUP_W = 16
S5_GROUPS = S5_WIDTH // S5_GROUP_W
S5_STATE = 64
HEAD_DIM = 64
ATTN_WIDTH = MIX_WIDTH - LRU_WIDTH - S5_WIDTH
N_ATTN_HEADS = ATTN_WIDTH // HEAD_DIM
Q_BLOCK = 128
O_LRU_X = 0
O_LRU_G = O_LRU_X + LRU_WIDTH
O_S5 = O_LRU_G + LRU_WIDTH
O_Q = O_S5 + S5_WIDTH
O_K = O_Q + ATTN_WIDTH
O_V = O_K + ATTN_WIDTH
O_F = O_V + ATTN_WIDTH
IN_COLS = O_F + N_ATTN_HEADS
N_EXPERTS = 32
TOP_K = 4
D_FF = D_MODEL
SWIGLU_LIMIT = 7.0
SWIGLU_ALPHA = 1.702
MOE_BLOCK = 128
N_MOD = 6
RMS_EPS = 1e-6

kernel_name = 'hybrid_lru_s5_fox_moe_block'


def rms_norm(x, g):
    xf = x.astype(jnp.float32)
    y = xf * lax.rsqrt(jnp.mean(xf * xf, axis=-1, keepdims=True) + RMS_EPS)
    return (y * g.astype(jnp.float32)).astype(x.dtype)


def causal_conv(x, w, b):
    T = x.shape[1]
    xp = jnp.pad(x, ((0, 0), (CONV_W - 1, 0), (0, 0)))
    y = b
    for j in range(CONV_W):
        y = y + xp[:, j:j + T] * w[j]
    return y


def _linear_combine(e1, e2):
    a1, b1 = e1
    a2, b2 = e2
    return a1 * a2, a2 * b1 + b2


def _complex_combine(e1, e2):
    ar1, ai1, br1, bi1 = e1
    ar2, ai2, br2, bi2 = e2
    return (ar2 * ar1 - ai2 * ai1,
            ar2 * ai1 + ai2 * ar1,
            ar2 * br1 - ai2 * bi1 + br2,
            ar2 * bi1 + ai2 * br1 + bi2)


def rg_lru(x, w_a, b_a, w_x, b_x, lam):
    Bsz, T, C = x.shape
    xf = x.astype(jnp.float32)
    xh = xf.reshape(Bsz, T, LRU_BLOCKS, LRU_BLOCK_W)
    r = jax.nn.sigmoid(jnp.einsum('bthi,hij->bthj', xh, w_a.astype(jnp.float32)).reshape(Bsz, T, C) + b_a)
    i = jax.nn.sigmoid(jnp.einsum('bthi,hij->bthj', xh, w_x.astype(jnp.float32)).reshape(Bsz, T, C) + b_x)
    log_a = -LRU_C * r * jax.nn.softplus(-lam.astype(jnp.float32))
    a = jnp.exp(log_a)
    u = xf * i * jnp.sqrt(-jnp.expm1(2.0 * log_a))
    _, h = lax.associative_scan(_linear_combine, (a, u), axis=1)
    return h.astype(x.dtype)


def s5_mixer(u, a_re, a_im, b_re, b_im, c_re, c_im, d, log_dt, glu_w, glu_b):
    Bsz, T, C = u.shape
    f32 = jnp.float32
    uf = u.astype(f32).reshape(Bsz, T, S5_GROUPS, S5_GROUP_W)
    a_re = a_re.astype(f32)
    a_im = a_im.astype(f32)
    dt = jnp.exp(log_dt.astype(f32))[:, None]
    mag = jnp.exp(a_re * dt)
    abar_re = mag * jnp.cos(a_im * dt)
    abar_im = mag * jnp.sin(a_im * dt)
    den = a_re * a_re + a_im * a_im
    num_re = abar_re - 1.0
    k_re = (num_re * a_re + abar_im * a_im) / den
    k_im = (abar_im * a_re - num_re * a_im) / den
    b_re = b_re.astype(f32)
    b_im = b_im.astype(f32)
    bbar_re = k_re[..., None] * b_re - k_im[..., None] * b_im
    bbar_im = k_re[..., None] * b_im + k_im[..., None] * b_re
    bu_re = jnp.einsum('btgc,gpc->btgp', uf, bbar_re)
    bu_im = jnp.einsum('btgc,gpc->btgp', uf, bbar_im)
    ar = jnp.broadcast_to(abar_re, bu_re.shape)
    ai = jnp.broadcast_to(abar_im, bu_im.shape)
    _, _, xr, xi = lax.associative_scan(_complex_combine, (ar, ai, bu_re, bu_im), axis=1)
    y = (jnp.einsum('btgp,gcp->btgc', xr, c_re.astype(f32))
         - jnp.einsum('btgp,gcp->btgc', xi, c_im.astype(f32)))
    y = y.reshape(Bsz, T, C) + d.astype(f32) * uf.reshape(Bsz, T, C)
    y = jax.nn.gelu(y)
    y = y * jax.nn.sigmoid(y @ glu_w.astype(f32) + glu_b.astype(f32))
    return y.astype(u.dtype)


def forgetting_attention(q, k, v, log_f):
    Bsz, T, H, Dh = q.shape
    nq = T // Q_BLOCK
    F = jnp.cumsum(log_f, axis=1)
    FT = jnp.transpose(F, (0, 2, 1))
    q_blocks = jnp.swapaxes(q.reshape(Bsz, nq, Q_BLOCK, H, Dh), 0, 1)
    F_blocks = jnp.moveaxis(FT.reshape(Bsz, H, nq, Q_BLOCK), 2, 0)
    k_pos = jnp.arange(T)
    scale = HEAD_DIM ** -0.5

    def block(args):
        qi, Fi, bi = args
        s = jnp.einsum('bqhd,bkhd->bhqk', qi, k, preferred_element_type=jnp.float32) * scale
        s = s + Fi[..., :, None] - FT[:, :, None, :]
        q_pos = bi * Q_BLOCK + jnp.arange(Q_BLOCK)
        s = jnp.where(k_pos[None, :] <= q_pos[:, None], s, -jnp.inf)
        p = jax.nn.softmax(s, axis=-1)
        return jnp.einsum('bhqk,bkhd->bqhd', p.astype(v.dtype), v)

    out = lax.map(block, (q_blocks, F_blocks, jnp.arange(nq)))
    return jnp.swapaxes(out, 0, 1).reshape(Bsz, T, H * Dh)


def token_mix(h, w_in, conv_w, conv_b, lru_wa, lru_ba, lru_wx, lru_bx, lru_lambda,
              s5_a_re, s5_a_im, s5_b_re, s5_b_im, s5_c_re, s5_c_im, s5_d, s5_log_dt,
              s5_glu_w, s5_glu_b, fox_fb, gn_lru, gn_s5, gn_attn, w_out):
    Bsz, T, _ = h.shape
    p = h @ w_in
    xr = causal_conv(p[..., O_LRU_X:O_LRU_G], conv_w, conv_b)
    y_lru = rg_lru(xr, lru_wa, lru_ba, lru_wx, lru_bx, lru_lambda) * jax.nn.gelu(p[..., O_LRU_G:O_S5])
    y_s5 = s5_mixer(p[..., O_S5:O_Q], s5_a_re, s5_a_im, s5_b_re, s5_b_im, s5_c_re, s5_c_im,
                    s5_d, s5_log_dt, s5_glu_w, s5_glu_b)
    q = p[..., O_Q:O_K].reshape(Bsz, T, N_ATTN_HEADS, HEAD_DIM)
    k = p[..., O_K:O_V].reshape(Bsz, T, N_ATTN_HEADS, HEAD_DIM)
    v = p[..., O_V:O_F].reshape(Bsz, T, N_ATTN_HEADS, HEAD_DIM)
    log_f = jax.nn.log_sigmoid((p[..., O_F:IN_COLS] + fox_fb).astype(jnp.float32))
    y_att = forgetting_attention(q, k, v, log_f)
    y = jnp.concatenate([rms_norm(y_lru, gn_lru), rms_norm(y_s5, gn_s5), rms_norm(y_att, gn_attn)], axis=-1)
    return y @ w_out


def moe_ffn(h, router_w, router_b, w_gu, b_gu, w_dn, b_dn):
    N, D = h.shape
    NK = N * TOP_K
    n_blocks = -(-NK // MOE_BLOCK) + N_EXPERTS
    logits = (h @ router_w + router_b).astype(jnp.float32)
    top_vals, top_idx = lax.top_k(logits, TOP_K)
    gates = jax.nn.softmax(top_vals, axis=-1).astype(h.dtype)
    flat_e = top_idx.reshape(-1)
    flat_tok = jnp.arange(NK, dtype=jnp.int32) // TOP_K
    order = jnp.argsort(flat_e)
    sorted_e = flat_e[order]
    counts = jnp.bincount(flat_e, length=N_EXPERTS)
    starts = jnp.cumsum(counts) - counts
    padded = (counts + MOE_BLOCK - 1) // MOE_BLOCK * MOE_BLOCK
    pad_ends = jnp.cumsum(padded)
    pad_starts = pad_ends - padded
    dest = pad_starts[sorted_e] + jnp.arange(NK) - starts[sorted_e]
    buf_tok = jnp.zeros((n_blocks * MOE_BLOCK,), jnp.int32).at[dest].set(flat_tok[order])
    block_e = jnp.minimum(jnp.searchsorted(pad_ends, jnp.arange(n_blocks) * MOE_BLOCK, side='right'),
                          N_EXPERTS - 1)
    xb = h[buf_tok].reshape(n_blocks, MOE_BLOCK, D)

    def expert_block(args):
        xe, e = args
        gu = xe @ w_gu[e] + b_gu[e]
        g = jnp.minimum(gu[:, :D_FF], SWIGLU_LIMIT)
        up = jnp.clip(gu[:, D_FF:], -SWIGLU_LIMIT, SWIGLU_LIMIT)
        return ((up + 1.0) * (g * jax.nn.sigmoid(SWIGLU_ALPHA * g))) @ w_dn[e] + b_dn[e]

    yb = lax.map(expert_block, (xb, block_e)).reshape(n_blocks * MOE_BLOCK, D)
    y_sorted = yb[dest]
    y_assign = jnp.zeros_like(y_sorted).at[order].set(y_sorted).reshape(N, TOP_K, D)
    return jnp.einsum('nk,nkd->nd', gates, y_assign)


def setup_inputs(seed: int = 0) -> dict:
    key = jax.random.key(seed)
    keys = list(jax.random.split(key, 40))

    def nrm(shape, std):
        return std * jax.random.normal(keys.pop(), shape, jnp.float32)

    def uni(shape, lo, hi):
        return jax.random.uniform(keys.pop(), shape, jnp.float32, lo, hi)

    L = DEPTH
    n = jnp.arange(S5_STATE, dtype=jnp.float32)
    a0 = uni((L, LRU_WIDTH), 0.9, 0.999)
    s = a0 ** (1.0 / LRU_C)
    return {
        'x': nrm((BATCH, SEQ, D_MODEL), 1.0),
        'c': nrm((BATCH, D_MODEL), 1.0),
        'ada_w': nrm((L, D_MODEL, N_MOD * D_MODEL), 0.5 * D_MODEL ** -0.5),
        'ada_b': nrm((L, N_MOD * D_MODEL), 0.02),
        'pre_mix_g': 1.0 + nrm((L, D_MODEL), 0.1),
        'w_in': nrm((L, D_MODEL, IN_COLS), D_MODEL ** -0.5),
        'conv_w': nrm((L, CONV_W, LRU_WIDTH), CONV_W ** -0.5),
        'conv_b': nrm((L, LRU_WIDTH), 0.01),
        'lru_wa': nrm((L, LRU_BLOCKS, LRU_BLOCK_W, LRU_BLOCK_W), LRU_BLOCK_W ** -0.5),
        'lru_ba': nrm((L, LRU_WIDTH), 0.01),
        'lru_wx': nrm((L, LRU_BLOCKS, LRU_BLOCK_W, LRU_BLOCK_W), LRU_BLOCK_W ** -0.5),
        'lru_bx': nrm((L, LRU_WIDTH), 0.01),
        'lru_lambda': jnp.log(s) - jnp.log1p(-s),
        's5_a_re': -0.5 + nrm((L, S5_GROUPS, S5_STATE), 0.01),
        's5_a_im': jnp.pi * n + nrm((L, S5_GROUPS, S5_STATE), 0.01),
        's5_b_re': nrm((L, S5_GROUPS, S5_STATE, S5_GROUP_W), (2 * S5_GROUP_W) ** -0.5),
        's5_b_im': nrm((L, S5_GROUPS, S5_STATE, S5_GROUP_W), (2 * S5_GROUP_W) ** -0.5),
        's5_c_re': nrm((L, S5_GROUPS, S5_GROUP_W, S5_STATE), 0.5),
        's5_c_im': nrm((L, S5_GROUPS, S5_GROUP_W, S5_STATE), 0.5),
        's5_d': nrm((L, S5_WIDTH), 0.5),
        's5_log_dt': uni((L, S5_GROUPS), math.log(1e-3), math.log(1e-1)),
        's5_glu_w': nrm((L, S5_WIDTH, S5_WIDTH), S5_WIDTH ** -0.5),
        's5_glu_b': nrm((L, S5_WIDTH), 0.01),
        'fox_fb': 3.0 + nrm((L, N_ATTN_HEADS), 0.5),
        'gn_lru': 1.0 + nrm((L, LRU_WIDTH), 0.1),
        'gn_s5': 1.0 + nrm((L, S5_WIDTH), 0.1),
        'gn_attn': 1.0 + nrm((L, ATTN_WIDTH), 0.1),
        'w_out': nrm((L, MIX_WIDTH, D_MODEL), MIX_WIDTH ** -0.5),
        'post_mix_g': 1.0 + nrm((L, D_MODEL), 0.1),
        'pre_ffn_g': 1.0 + nrm((L, D_MODEL), 0.1),
        'router_w': nrm((L, D_MODEL, N_EXPERTS), D_MODEL ** -0.5),
        'router_b': nrm((L, N_EXPERTS), 0.01),
        'w_gu': nrm((L, N_EXPERTS, D_MODEL, 2 * D_FF), D_MODEL ** -0.5),
        'b_gu': nrm((L, N_EXPERTS, 2 * D_FF), 0.01),
        'w_dn': nrm((L, N_EXPERTS, D_FF, D_MODEL), D_FF ** -0.5),
        'b_dn': nrm((L, N_EXPERTS, D_MODEL), 0.01),
        'post_ffn_g': 1.0 + nrm((L, D_MODEL), 0.1),
    }


def reference(x, c, ada_w, ada_b, pre_mix_g, w_in, conv_w, conv_b, lru_wa, lru_ba, lru_wx, lru_bx,
              lru_lambda, s5_a_re, s5_a_im, s5_b_re, s5_b_im, s5_c_re, s5_c_im, s5_d, s5_log_dt,
              s5_glu_w, s5_glu_b, fox_fb, gn_lru, gn_s5, gn_attn, w_out, post_mix_g, pre_ffn_g,
              router_w, router_b, w_gu, b_gu, w_dn, b_dn, post_ffn_g):
    Bsz, T, D = x.shape
    for l in range(DEPTH):
        mod = (jax.nn.silu(c) @ ada_w[l] + ada_b[l]).reshape(Bsz, N_MOD, 1, D)
        shift_m, scale_m, gate_m = mod[:, 0], mod[:, 1], mod[:, 2]
        shift_f, scale_f, gate_f = mod[:, 3], mod[:, 4], mod[:, 5]
        h = rms_norm(x, pre_mix_g[l]) * (1.0 + scale_m) + shift_m
        y = token_mix(h, w_in[l], conv_w[l], conv_b[l], lru_wa[l], lru_ba[l], lru_wx[l], lru_bx[l],
                      lru_lambda[l], s5_a_re[l], s5_a_im[l], s5_b_re[l], s5_b_im[l], s5_c_re[l],
                      s5_c_im[l], s5_d[l], s5_log_dt[l], s5_glu_w[l], s5_glu_b[l], fox_fb[l],
                      gn_lru[l], gn_s5[l], gn_attn[l], w_out[l])
        x = x + gate_m * rms_norm(y, post_mix_g[l])
        h = rms_norm(x, pre_ffn_g[l]) * (1.0 + scale_f) + shift_f
        y = moe_ffn(h.reshape(Bsz * T, D), router_w[l], router_b[l], w_gu[l], b_gu[l],
                    w_dn[l], b_dn[l]).reshape(Bsz, T, D)
        x = x + gate_f * rms_norm(y, post_ffn_g[l])
    return x
```

```cpp
#include <hip/hip_runtime.h>
#include <stdint.h>
#include <stdio.h>

#define LAS __attribute__((address_space(3)))
typedef unsigned short bf16_t;
typedef short bf16x8 __attribute__((ext_vector_type(8)));
typedef float f32x4 __attribute__((ext_vector_type(4)));
typedef unsigned u32x4 __attribute__((ext_vector_type(4)));
typedef unsigned u32x2 __attribute__((ext_vector_type(2)));

constexpr int NB = 4, T = 8192, D = 1024, M = NB * T, NL = 2;
constexpr int INC = 2312, NP = 2560;
constexpr int C_LX = 0, C_LG = 256, C_S5 = 512, C_Q = 768, C_K = 1280, C_V = 1792, C_F = 2304;
constexpr int NH = 8, HD = 64, NE = 32, TOPK = 4, DFF = 1024;
constexpr int RP = M * TOPK + NE * 256;
constexpr float C2 = 0.125f * 1.4426950408889634f;
constexpr float LOG2E = 1.4426950408889634f;
constexpr float RMS_EPS = 1e-6f;
constexpr int NTHREADS = 512, NWAVES = 8;

enum { I_X = 0, I_C, I_ADAW, I_ADAB, I_PREMIXG, I_WIN, I_CONVW, I_CONVB, I_LRUWA, I_LRUBA, I_LRUWX, I_LRUBX, I_LAMBDA, I_S5ARE, I_S5AIM, I_S5BRE, I_S5BIM,
       I_S5CRE, I_S5CIM, I_S5D, I_S5LOGDT, I_GLUW, I_GLUB, I_FOXFB, I_GNLRU, I_GNS5, I_GNATT, I_WOUT, I_POSTMIXG, I_PREFFNG, I_ROUTW, I_ROUTB, I_WGU, I_BGU,
       I_WDN, I_BDN, I_POSTFFNG, N_IN };

constexpr size_t MiB = 1u << 20;
constexpr size_t WS_CTL = 0;
constexpr size_t WS_MOD = 1 * MiB;
constexpr size_t WS_MISC = 2 * MiB;
constexpr size_t WS_FC2 = 6 * MiB;
constexpr size_t WS_WIN = 8 * MiB;
constexpr size_t WS_WOUT = 18 * MiB;
constexpr size_t WS_WGU = 22 * MiB;
constexpr size_t WS_WDN = 278 * MiB;
constexpr size_t WS_HB = 406 * MiB;
constexpr size_t WS_PB = 470 * MiB;
constexpr size_t WS_YL = 630 * MiB;
constexpr size_t WS_YS0 = 662 * MiB;
constexpr size_t WS_OA = 694 * MiB;
constexpr size_t WS_YC = 758 * MiB;
constexpr size_t WS_Y = 822 * MiB;
constexpr size_t WS_XS = 950 * MiB;
constexpr size_t WS_H1 = 1222 * MiB;
constexpr size_t WS_YR = 1494 * MiB;
constexpr size_t WS_END = 1766 * MiB;
constexpr size_t MS_TOPI = 0, MS_TOPG = 512 * 1024, MS_RANK = 1024 * 1024, MS_POS = 1536 * 1024, MS_HIST = 2048 * 1024, MS_TILEE = 2048 * 1024 + 64 * 1024;
constexpr int CW_NT = 8;

struct Prm { const float* in[N_IN]; float* out; unsigned char* ws; };

__device__ __forceinline__ unsigned f2bf(float f) { unsigned u = __builtin_bit_cast(unsigned, f); return (u + 0x7fffu + ((u >> 16) & 1u)) >> 16; }
__device__ __forceinline__ unsigned pk2(float lo, float hi) { return f2bf(lo) | (f2bf(hi) << 16); }
__device__ __forceinline__ float bf2f(unsigned v) { return __builtin_bit_cast(float, v << 16); }
__device__ __forceinline__ float bflo(unsigned w) { return __builtin_bit_cast(float, w << 16); }
__device__ __forceinline__ float bfhi(unsigned w) { return __builtin_bit_cast(float, w & 0xffff0000u); }
__device__ __forceinline__ float wave_sum(float v) {
#pragma unroll
    for (int o = 1; o < 64; o <<= 1) v += __shfl_xor(v, o);
    return v;
}
__device__ __forceinline__ float sigmoidf_(float x) { return 1.f / (1.f + __expf(-x)); }
__device__ __forceinline__ float gelu_tanh(float x) { const float u = 0.7978845608028654f * (x + 0.044715f * x * x * x); return x * sigmoidf_(2.f * u); }

__device__ __forceinline__ void tr_item(const float* W, int ldw, int nvalid, int k0, int n0, bf16_t* dst, float scale, LAS float* scr, int lane) {
    const int nn = n0 + (lane & 31); const bool ok = nn < nvalid;
#pragma unroll 8
    for (int i = 0; i < 32; ++i) { const int kk = 2 * i + (lane >> 5); scr[kk * 33 + (lane & 31)] = ok ? W[(size_t)(k0 + kk) * ldw + nn] * scale : 0.f; }
    asm volatile("s_waitcnt lgkmcnt(0)" ::: "memory");
    const int c = lane & 7;
#pragma unroll
    for (int j = 0; j < 4; ++j) { const int n = (lane >> 3) + 8 * j; const LAS float* s = scr + (8 * c) * 33 + n;
        u32x4 o; o.x = pk2(s[0 * 33], s[1 * 33]); o.y = pk2(s[2 * 33], s[3 * 33]); o.z = pk2(s[4 * 33], s[5 * 33]); o.w = pk2(s[6 * 33], s[7 * 33]);
        *(u32x4*)(dst + (size_t)n * 1024 + k0 + 8 * c) = o; }
    asm volatile("s_waitcnt lgkmcnt(0)" ::: "memory");
}

__device__ __forceinline__ void ph_prologue(const Prm& p, LAS unsigned char* lds, int wg, int nwg) {
    const int tid = threadIdx.x, lane = tid & 63, wave = tid >> 6;
    {
        LAS float* sc = (LAS float*)lds; LAS float* red = sc + 4096;
        const float* c = p.in[I_C];
        for (int i = tid; i < 4096; i += NTHREADS) { const float v = c[i]; sc[i] = v / (1.f + __expf(-v)); }
        __syncthreads();
        float* MOD = (float*)(p.ws + WS_MOD);
        for (int it = wg; it < 2 * 96; it += nwg) {
            const int l = it / 96, n0 = (it % 96) * 64, kg = tid >> 6, nl = tid & 63;
            const float* W = p.in[I_ADAW] + (size_t)l * 1024 * 6144 + n0 + nl;
            float a0 = 0.f, a1 = 0.f, a2 = 0.f, a3 = 0.f;
            for (int k = kg; k < 1024; k += 8) { const float w = W[(size_t)k * 6144]; a0 += sc[k] * w; a1 += sc[1024 + k] * w; a2 += sc[2048 + k] * w; a3 += sc[3072 + k] * w; }
            red[(kg * 4 + 0) * 64 + nl] = a0; red[(kg * 4 + 1) * 64 + nl] = a1; red[(kg * 4 + 2) * 64 + nl] = a2; red[(kg * 4 + 3) * 64 + nl] = a3;
            __syncthreads();
            if (tid < 256) { const int b = tid >> 6; float s = 0.f;
#pragma unroll
                for (int g = 0; g < 8; ++g) s += red[(g * 4 + b) * 64 + nl];
                MOD[(size_t)(l * 4 + b) * 6144 + n0 + nl] = s + p.in[I_ADAB][l * 6144 + n0 + nl]; }
            __syncthreads();
        }
    }
    {
        LAS float* scr = (LAS float*)lds + wave * (64 * 33);
        const int gw = wave * nwg + wg, NGW = nwg * NWAVES;
        constexpr int I_IN = 16 * 80, I_OUT = 16 * 32, I_GU = 16 * 64, I_DN = 16 * 32;
        constexpr int TOT = 2 * I_IN + 2 * I_OUT + 64 * I_GU + 64 * I_DN;
        for (int it = gw; it < TOT; it += NGW) {
            int r = it;
            if (r < 2 * I_IN) { const int l = r / I_IN, q = r % I_IN, kb = q / 80, nb = q % 80, n0 = nb * 32;
                const float sc = (n0 >= C_Q && n0 < C_K) ? C2 : 1.f;
                tr_item(p.in[I_WIN] + (size_t)l * 1024 * INC, INC, INC, kb * 64, n0, (bf16_t*)(p.ws + WS_WIN) + ((size_t)l * NP + n0) * 1024, sc, scr, lane); continue; }
            r -= 2 * I_IN;
            if (r < 2 * I_OUT) { const int l = r / I_OUT, q = r % I_OUT, kb = q / 32, nb = q % 32, n0 = nb * 32;
                tr_item(p.in[I_WOUT] + (size_t)l * 1024 * 1024, 1024, 1024, kb * 64, n0, (bf16_t*)(p.ws + WS_WOUT) + ((size_t)l * 1024 + n0) * 1024, 1.f, scr, lane); continue; }
            r -= 2 * I_OUT;
            if (r < 64 * I_GU) { const int le = r / I_GU, q = r % I_GU, kb = q / 64, nb = q % 64, n0 = nb * 32;
                const int s = n0 / 1024, rr = n0 % 1024, j = rr / 128, cc = rr % 128, drow = 256 * j + 128 * s + cc;
                tr_item(p.in[I_WGU] + (size_t)le * 1024 * 2048, 2048, 2048, kb * 64, n0, (bf16_t*)(p.ws + WS_WGU) + ((size_t)le * 2048 + drow) * 1024, 1.f, scr, lane); continue; }
            r -= 64 * I_GU;
            { const int le = r / I_DN, q = r % I_DN, kb = q / 32, nb = q % 32, n0 = nb * 32;
                tr_item(p.in[I_WDN] + (size_t)le * 1024 * 1024, 1024, 1024, kb * 64, n0, (bf16_t*)(p.ws + WS_WDN) + ((size_t)le * 1024 + n0) * 1024, 1.f, scr, lane); }
        }
    }
}

__device__ __forceinline__ void ph_norm1(const Prm& p, int l, int wg, int nwg) {
    const int tid = threadIdx.x, lane = tid & 63, wave = tid >> 6;
    const float* X = (l == 0) ? p.in[I_X] : p.out;
    const float* MOD = (const float*)(p.ws + WS_MOD);
    bf16_t* HB = (bf16_t*)(p.ws + WS_HB);
    const float* g = p.in[I_PREMIXG] + l * 1024;
    for (int m = wg * NWAVES + wave; m < M; m += nwg * NWAVES) {
        const int b = m / T;
        const float* shift = MOD + (size_t)(l * 4 + b) * 6144 + 0 * 1024; const float* scale = shift + 1024;
        f32x4 v[4]; float ss = 0.f;
#pragma unroll
        for (int j = 0; j < 4; ++j) { v[j] = *(const f32x4*)(X + (size_t)m * 1024 + 4 * lane + 256 * j); ss += (v[j].x * v[j].x + v[j].y * v[j].y) + (v[j].z * v[j].z + v[j].w * v[j].w); }
        const float rstd = 1.f / sqrtf(wave_sum(ss) * (1.f / 1024.f) + RMS_EPS);
#pragma unroll
        for (int j = 0; j < 4; ++j) { const int c = 4 * lane + 256 * j; const f32x4 gg = *(const f32x4*)(g + c), sc = *(const f32x4*)(scale + c), sh = *(const f32x4*)(shift + c);
            const f32x4 h = v[j] * rstd * gg * (sc + 1.f) + sh;
            u32x2 o; o.x = pk2(h.x, h.y); o.y = pk2(h.z, h.w); *(u32x2*)(HB + (size_t)m * 1024 + c) = o; }
    }
}

template <class Epi>
__device__ __forceinline__ void sg_unit(const bf16_t* A, int lda, const bf16_t* Bt, int ldb, int K, const Epi& E) {
    const int tid = threadIdx.x, lane = tid & 63, wave = tid >> 6, wr = wave >> 2, wc = wave & 3, fr = lane & 15, fq = lane >> 4;
    f32x4 acc[4][4];
#pragma unroll
    for (int m = 0; m < 4; ++m)
#pragma unroll
        for (int n = 0; n < 4; ++n) acc[m][n] = (f32x4){0.f, 0.f, 0.f, 0.f};
    const bf16_t* ap = A + (size_t)(wr * 64 + fr) * lda + 8 * fq;
    const bf16_t* bp = Bt + (size_t)(wc * 32 + fr) * ldb + 8 * fq;
    for (int k0 = 0; k0 < K; k0 += 32) {
        bf16x8 a[4], b[4];
#pragma unroll
        for (int m = 0; m < 4; ++m) a[m] = *(const bf16x8*)(ap + (size_t)(m * 16) * lda + k0);
#pragma unroll
        for (int n = 0; n < 4; ++n) b[n] = *(const bf16x8*)(bp + (size_t)((n >> 1) * 128 + (n & 1) * 16) * ldb + k0);
#pragma unroll
        for (int m = 0; m < 4; ++m)
#pragma unroll
            for (int n = 0; n < 4; ++n) acc[m][n] = __builtin_amdgcn_mfma_f32_16x16x32_bf16(a[m], b[n], acc[m][n], 0, 0, 0);
    }
#pragma unroll
    for (int m = 0; m < 4; ++m)
#pragma unroll
        for (int n = 0; n < 2; ++n)
#pragma unroll
            for (int r = 0; r < 4; ++r) E(wr * 64 + m * 16 + 4 * fq + r, wc * 32 + n * 16 + fr, acc[m][n][r], acc[m][n + 2][r]);
}

struct EpiStoreBf16 { bf16_t* C; int ldc;
    __device__ __forceinline__ void operator()(int r, int ca, float va, float vb) const { C[(size_t)r * ldc + ca] = (bf16_t)f2bf(va); C[(size_t)r * ldc + ca + 128] = (bf16_t)f2bf(vb); } };
struct EpiStoreF32 { float* C; int ldc;
    __device__ __forceinline__ void operator()(int r, int ca, float va, float vb) const { C[(size_t)r * ldc + ca] = va; C[(size_t)r * ldc + ca + 128] = vb; } };
struct EpiSwiglu { bf16_t* C; const float* bg; const float* bu;
    __device__ __forceinline__ void operator()(int r, int ca, float va, float vb) const {
        const float g = fminf(va + bg[ca], 7.f); const float u = fminf(fmaxf(vb + bu[ca], -7.f), 7.f);
        C[(size_t)r * 1024 + ca] = (bf16_t)f2bf((u + 1.f) * (g * sigmoidf_(1.702f * g))); } };
struct EpiBiasBf16 { bf16_t* C; const float* bias;
    __device__ __forceinline__ void operator()(int r, int ca, float va, float vb) const { C[(size_t)r * 1024 + ca] = (bf16_t)f2bf(va + bias[ca]); C[(size_t)r * 1024 + ca + 128] = (bf16_t)f2bf(vb + bias[ca + 128]); } };

__device__ __forceinline__ void ph_gemm_in(const Prm& p, int l, int wg, int nwg) {
    const bf16_t* HB = (const bf16_t*)(p.ws + WS_HB); const bf16_t* W = (const bf16_t*)(p.ws + WS_WIN) + (size_t)l * NP * 1024; bf16_t* PB = (bf16_t*)(p.ws + WS_PB);
    for (int u = wg; u < (M / 128) * (NP / 256); u += nwg) { const int pm = u / (NP / 256), pn = u % (NP / 256);
        EpiStoreBf16 E{PB + (size_t)pm * 128 * NP + pn * 256, NP};
        sg_unit(HB + (size_t)pm * 128 * 1024, 1024, W + (size_t)pn * 256 * 1024, 1024, 1024, E); }
}
__device__ __forceinline__ void ph_gemm_out(const Prm& p, int l, int wg, int nwg) {
    const bf16_t* YC = (const bf16_t*)(p.ws + WS_YC); const bf16_t* W = (const bf16_t*)(p.ws + WS_WOUT) + (size_t)l * 1024 * 1024; float* Y = (float*)(p.ws + WS_Y);
    for (int u = wg; u < (M / 128) * 4; u += nwg) { const int pm = u / 4, pn = u % 4;
        EpiStoreF32 E{Y + (size_t)pm * 128 * 1024 + pn * 256, 1024};
        sg_unit(YC + (size_t)pm * 128 * 1024, 1024, W + (size_t)pn * 256 * 1024, 1024, 1024, E); }
}
__device__ __forceinline__ void ph_gemm1(const Prm& p, int l, int wg, int nwg) {
    const bf16_t* XS = (const bf16_t*)(p.ws + WS_XS); bf16_t* H1 = (bf16_t*)(p.ws + WS_H1);
    const int nt = ((const int*)(p.ws + WS_CTL))[CW_NT]; const int* TILE_E = (const int*)(p.ws + WS_MISC + MS_TILEE);
    for (int u = wg; u < nt * 2 * 8; u += nwg) { const int rt = u / 8, j = u % 8, e = TILE_E[rt >> 1];
        const bf16_t* W = (const bf16_t*)(p.ws + WS_WGU) + ((size_t)(l * NE + e) * 2048 + j * 256) * 1024;
        const float* bg = p.in[I_BGU] + (size_t)(l * NE + e) * 2048 + j * 128;
        EpiSwiglu E{H1 + (size_t)rt * 128 * 1024 + j * 128, bg, bg + 1024};
        sg_unit(XS + (size_t)rt * 128 * 1024, 1024, W, 1024, 1024, E); }
}
__device__ __forceinline__ void ph_gemm2(const Prm& p, int l, int wg, int nwg) {
    const bf16_t* H1 = (const bf16_t*)(p.ws + WS_H1); bf16_t* YR = (bf16_t*)(p.ws + WS_YR);
    const int nt = ((const int*)(p.ws + WS_CTL))[CW_NT]; const int* TILE_E = (const int*)(p.ws + WS_MISC + MS_TILEE);
    for (int u = wg; u < nt * 2 * 4; u += nwg) { const int rt = u / 4, pn = u % 4, e = TILE_E[rt >> 1];
        const bf16_t* W = (const bf16_t*)(p.ws + WS_WDN) + ((size_t)(l * NE + e) * 1024 + pn * 256) * 1024;
        EpiBiasBf16 E{YR + (size_t)rt * 128 * 1024 + pn * 256, p.in[I_BDN] + (size_t)(l * NE + e) * 1024 + pn * 256};
        sg_unit(H1 + (size_t)rt * 128 * 1024, 1024, W, 1024, 1024, E); }
}

__device__ __forceinline__ void lru_wave(const Prm& p, int l, int b, int blk, int lane, LAS float* wl) {
    const bf16_t* PB = (const bf16_t*)(p.ws + WS_PB); float* YL = (float*)(p.ws + WS_YL);
    const int ch = blk * 64 + lane;
    for (int i = 0; i < 64; ++i) { wl[i * 64 + lane] = p.in[I_LRUWA][((size_t)(l * 4 + blk) * 64 + i) * 64 + lane]; wl[4096 + i * 64 + lane] = p.in[I_LRUWX][((size_t)(l * 4 + blk) * 64 + i) * 64 + lane]; }
    asm volatile("s_waitcnt lgkmcnt(0)" ::: "memory");
    const float ba = p.in[I_LRUBA][l * 256 + ch], bx = p.in[I_LRUBX][l * 256 + ch];
    const float lam = p.in[I_LAMBDA][l * 256 + ch]; const float sp = log1pf(expf(-lam));
    const float cw0 = p.in[I_CONVW][(l * 4 + 0) * 256 + ch], cw1 = p.in[I_CONVW][(l * 4 + 1) * 256 + ch], cw2 = p.in[I_CONVW][(l * 4 + 2) * 256 + ch], cw3 = p.in[I_CONVW][(l * 4 + 3) * 256 + ch];
    const float cb = p.in[I_CONVB][l * 256 + ch];
    float x1 = 0.f, x2 = 0.f, x3 = 0.f, h = 0.f;
    for (int t = 0; t < T; ++t) {
        const size_t row = (size_t)(b * T + t) * NP; const float xin = bf2f(PB[row + C_LX + ch]), gin = bf2f(PB[row + C_LG + ch]);
        const float xr = cb + cw0 * x3 + cw1 * x2 + cw2 * x1 + cw3 * xin;
        x3 = x2; x2 = x1; x1 = xin;
        float ra = ba, ri = bx;
#pragma unroll 8
        for (int i = 0; i < 64; ++i) { const float xi = __builtin_bit_cast(float, __builtin_amdgcn_readlane(__builtin_bit_cast(int, xr), i)); ra += xi * wl[i * 64 + lane]; ri += xi * wl[4096 + i * 64 + lane]; }
        const float r = sigmoidf_(ra), ig = sigmoidf_(ri);
        const float log_a = -8.f * r * sp; const float a = __expf(log_a); const float mult = sqrtf(-expm1f(2.f * log_a));
        h = a * h + xr * ig * mult;
        YL[(size_t)(b * T + t) * 256 + ch] = h * gelu_tanh(gin);
    }
}
__device__ __forceinline__ void s5_wave(const Prm& p, int l, int b, int g, int lane) {
    const bf16_t* PB = (const bf16_t*)(p.ws + WS_PB); float* YS0 = (float*)(p.ws + WS_YS0);
    const int pi = lane;
    const float are = p.in[I_S5ARE][(l * 16 + g) * 64 + pi], aim = p.in[I_S5AIM][(l * 16 + g) * 64 + pi];
    const float dt = expf(p.in[I_S5LOGDT][l * 16 + g]);
    const float mag = expf(are * dt); const float th = aim * dt * 0.3183098861837907f; const float abr = mag * cospif(th), abi = mag * sinpif(th);
    const float den = are * are + aim * aim, nre = abr - 1.f;
    const float kre = (nre * are + abi * aim) / den, kim = (abi * are - nre * aim) / den;
    float bre[16], bim[16], cre[16], cim[16];
#pragma unroll
    for (int c = 0; c < 16; ++c) { const float br = p.in[I_S5BRE][((size_t)(l * 16 + g) * 64 + pi) * 16 + c], bi = p.in[I_S5BIM][((size_t)(l * 16 + g) * 64 + pi) * 16 + c];
        bre[c] = kre * br - kim * bi; bim[c] = kre * bi + kim * br;
        cre[c] = p.in[I_S5CRE][((size_t)(l * 16 + g) * 16 + c) * 64 + pi]; cim[c] = p.in[I_S5CIM][((size_t)(l * 16 + g) * 16 + c) * 64 + pi]; }
    const float dd = p.in[I_S5D][l * 256 + g * 16 + (lane & 15)];
    float xr = 0.f, xi = 0.f;
    for (int t = 0; t < T; ++t) {
        const size_t row = (size_t)(b * T + t);
        const float uv = bf2f(PB[row * NP + C_S5 + g * 16 + (lane & 15)]);
        float bur = 0.f, bui = 0.f;
#pragma unroll
        for (int c = 0; c < 16; ++c) { const float uc = __builtin_bit_cast(float, __builtin_amdgcn_readlane(__builtin_bit_cast(int, uv), c)); bur += uc * bre[c]; bui += uc * bim[c]; }
        const float nr = abr * xr - abi * xi + bur, ni = abr * xi + abi * xr + bui; xr = nr; xi = ni;
        float mine = 0.f;
#pragma unroll
        for (int c = 0; c < 16; ++c) { const float y = wave_sum(cre[c] * xr - cim[c] * xi); mine = ((lane & 15) == c) ? y : mine; }
        if (lane < 16) { const float y = mine + dd * uv; YS0[row * 256 + g * 16 + lane] = gelu_tanh(y); }
    }
}
__device__ __forceinline__ void fcum_wave(const Prm& p, int l, int b, int hh, int lane) {
    const bf16_t* PB = (const bf16_t*)(p.ws + WS_PB); float* FC2 = (float*)(p.ws + WS_FC2);
    const float fb = p.in[I_FOXFB][l * 8 + hh];
    float run = 0.f;
    for (int t = lane * 128; t < lane * 128 + 128; ++t) { const float z = bf2f(PB[(size_t)(b * T + t) * NP + C_F + hh]) + fb;
        run += -(fmaxf(-z, 0.f) + log1pf(expf(-fabsf(z)))); }
    float incl = run;
#pragma unroll
    for (int o = 1; o < 64; o <<= 1) { const float v = __shfl_up(incl, o); if (lane >= o) incl += v; }
    float acc = incl - run;
    for (int t = lane * 128; t < lane * 128 + 128; ++t) { const float z = bf2f(PB[(size_t)(b * T + t) * NP + C_F + hh]) + fb;
        acc += -(fmaxf(-z, 0.f) + log1pf(expf(-fabsf(z)))); FC2[(size_t)(b * 8 + hh) * T + t] = acc * LOG2E; }
}
__device__ __forceinline__ void ph_scan(const Prm& p, int l, LAS unsigned char* lds, int wg, int nwg) {
    const int tid = threadIdx.x, lane = tid & 63, wave = tid >> 6;
    if (wave == 0) { for (int it = wg; it < 16; it += nwg) lru_wave(p, l, it >> 2, it & 3, lane, (LAS float*)lds); }
    else { for (int it = (wave - 1) * nwg + wg; it < 96; it += nwg * (NWAVES - 1)) {
        if (it < 64) s5_wave(p, l, it >> 4, it & 15, lane);
        else fcum_wave(p, l, (it - 64) >> 3, (it - 64) & 7, lane); } }
}

__device__ __forceinline__ void ph_attn(const Prm& p, int l, LAS unsigned char* lds, int wg, int nwg) {
    const int tid = threadIdx.x, hf = tid & 1;
    const bf16_t* PB = (const bf16_t*)(p.ws + WS_PB); const float* FC2 = (const float*)(p.ws + WS_FC2); float* OA = (float*)(p.ws + WS_OA);
    LAS float* Ks = (LAS float*)lds; LAS float* Vs = Ks + 32 * 64; LAS float* Fk = Vs + 32 * 64;
    for (int it = wg; it < NB * NH * 32; it += nwg) {
        const int b = it >> 8, hh = (it >> 5) & 7, qc = 31 - (it & 31);
        const int i = qc * 256 + (tid >> 1); const size_t row = (size_t)(b * T + i);
        float q[32], o[32];
#pragma unroll
        for (int d = 0; d < 32; d += 2) { const unsigned w = *(const unsigned*)(PB + row * NP + C_Q + hh * 64 + hf * 32 + d); q[d] = bflo(w); q[d + 1] = bfhi(w); }
#pragma unroll
        for (int d = 0; d < 32; ++d) o[d] = 0.f;
        const float Fq = FC2[(size_t)(b * 8 + hh) * T + i];
        float mrun = -1e30f, lrun = 0.f;
        for (int j0 = 0; j0 < (qc + 1) * 256; j0 += 32) {
            __syncthreads();
            { const int key = tid >> 4, d4 = (tid & 15) * 4; const size_t kr = (size_t)(b * T + j0 + key) * NP;
              const u32x2 kw = *(const u32x2*)(PB + kr + C_K + hh * 64 + d4), vw = *(const u32x2*)(PB + kr + C_V + hh * 64 + d4);
              Ks[key * 64 + d4] = bflo(kw.x); Ks[key * 64 + d4 + 1] = bfhi(kw.x); Ks[key * 64 + d4 + 2] = bflo(kw.y); Ks[key * 64 + d4 + 3] = bfhi(kw.y);
              Vs[key * 64 + d4] = bflo(vw.x); Vs[key * 64 + d4 + 1] = bfhi(vw.x); Vs[key * 64 + d4 + 2] = bflo(vw.y); Vs[key * 64 + d4 + 3] = bfhi(vw.y);
              if (tid < 32) Fk[tid] = FC2[(size_t)(b * 8 + hh) * T + j0 + tid]; }
            __syncthreads();
            if (j0 > i) continue;
#pragma unroll 1
            for (int jj = 0; jj < 32; ++jj) {
                if (j0 + jj > i) break;
                float dot = 0.f;
#pragma unroll
                for (int d = 0; d < 32; d += 4) { const f32x4 kv = *(const LAS f32x4*)(Ks + jj * 64 + hf * 32 + d); dot += q[d] * kv.x + q[d + 1] * kv.y + q[d + 2] * kv.z + q[d + 3] * kv.w; }
                dot += __shfl_xor(dot, 1);
                const float sv = dot + Fq - Fk[jj];
                const float mnew = fmaxf(mrun, sv); const float scl = exp2f(mrun - mnew); const float pj = exp2f(sv - mnew); mrun = mnew; lrun = lrun * scl + pj;
#pragma unroll
                for (int d = 0; d < 32; d += 4) { const f32x4 vv = *(const LAS f32x4*)(Vs + jj * 64 + hf * 32 + d);
                    o[d] = o[d] * scl + pj * vv.x; o[d + 1] = o[d + 1] * scl + pj * vv.y; o[d + 2] = o[d + 2] * scl + pj * vv.z; o[d + 3] = o[d + 3] * scl + pj * vv.w; }
            }
        }
        const float inv = 1.f / lrun;
#pragma unroll
        for (int d = 0; d < 32; d += 4) *(f32x4*)(OA + row * 512 + hh * 64 + hf * 32 + d) = (f32x4){o[d] * inv, o[d + 1] * inv, o[d + 2] * inv, o[d + 3] * inv};
    }
}

__device__ __forceinline__ void ph_fin(const Prm& p, int l, LAS unsigned char* lds, int wg, int nwg) {
    const int tid = threadIdx.x, lane = tid & 63, wave = tid >> 6;
    const float* YL = (const float*)(p.ws + WS_YL); const float* YS0 = (const float*)(p.ws + WS_YS0); const float* OA = (const float*)(p.ws + WS_OA); bf16_t* YC = (bf16_t*)(p.ws + WS_YC);
    LAS float* ys = (LAS float*)lds;
    LAS float* yo = ys + 32 * 256;
    const float* GW = p.in[I_GLUW] + (size_t)l * 256 * 256; const float* GB = p.in[I_GLUB] + l * 256;
    for (int it = wg; it < M / 32; it += nwg) {
        const int m0 = it * 32;
        __syncthreads();
        for (int i = tid; i < 32 * 256; i += NTHREADS) ys[i] = YS0[(size_t)m0 * 256 + i];
        __syncthreads();
        { const int j = tid & 255, half = tid >> 8; float z[16];
#pragma unroll
          for (int t = 0; t < 16; ++t) z[t] = GB[j];
          for (int i = 0; i < 256; ++i) { const float w = GW[i * 256 + j];
#pragma unroll
              for (int t = 0; t < 16; ++t) z[t] += ys[(half * 16 + t) * 256 + i] * w; }
#pragma unroll
          for (int t = 0; t < 16; ++t) { const float y = ys[(half * 16 + t) * 256 + j]; yo[(half * 16 + t) * 256 + j] = y * sigmoidf_(z[t]); } }
        __syncthreads();
        for (int r = wave; r < 32; r += NWAVES) { const size_t m = (size_t)(m0 + r);
            { const f32x4 v = *(const f32x4*)(YL + m * 256 + 4 * lane); const float rs = 1.f / sqrtf(wave_sum(v.x * v.x + v.y * v.y + v.z * v.z + v.w * v.w) * (1.f / 256.f) + RMS_EPS);
              const f32x4 g = *(const f32x4*)(p.in[I_GNLRU] + l * 256 + 4 * lane); u32x2 o; o.x = pk2(v.x * rs * g.x, v.y * rs * g.y); o.y = pk2(v.z * rs * g.z, v.w * rs * g.w); *(u32x2*)(YC + m * 1024 + 4 * lane) = o; }
            { const f32x4 v = *(const LAS f32x4*)(yo + r * 256 + 4 * lane); const float rs = 1.f / sqrtf(wave_sum(v.x * v.x + v.y * v.y + v.z * v.z + v.w * v.w) * (1.f / 256.f) + RMS_EPS);
              const f32x4 g = *(const f32x4*)(p.in[I_GNS5] + l * 256 + 4 * lane); u32x2 o; o.x = pk2(v.x * rs * g.x, v.y * rs * g.y); o.y = pk2(v.z * rs * g.z, v.w * rs * g.w); *(u32x2*)(YC + m * 1024 + 256 + 4 * lane) = o; }
            { const f32x4 v0 = *(const f32x4*)(OA + m * 512 + 4 * lane), v1 = *(const f32x4*)(OA + m * 512 + 256 + 4 * lane);
              const float rs = 1.f / sqrtf(wave_sum((v0.x * v0.x + v0.y * v0.y + v0.z * v0.z + v0.w * v0.w) + (v1.x * v1.x + v1.y * v1.y + v1.z * v1.z + v1.w * v1.w)) * (1.f / 512.f) + RMS_EPS);
              const f32x4 g0 = *(const f32x4*)(p.in[I_GNATT] + l * 512 + 4 * lane), g1 = *(const f32x4*)(p.in[I_GNATT] + l * 512 + 256 + 4 * lane);
              u32x2 o; o.x = pk2(v0.x * rs * g0.x, v0.y * rs * g0.y); o.y = pk2(v0.z * rs * g0.z, v0.w * rs * g0.w); *(u32x2*)(YC + m * 1024 + 512 + 4 * lane) = o;
              o.x = pk2(v1.x * rs * g1.x, v1.y * rs * g1.y); o.y = pk2(v1.z * rs * g1.z, v1.w * rs * g1.w); *(u32x2*)(YC + m * 1024 + 768 + 4 * lane) = o; }
        }
    }
}

__device__ __forceinline__ void ph_row(const Prm& p, int l, LAS unsigned char* lds, int wg, int nwg) {
    const int tid = threadIdx.x, lane = tid & 63, wave = tid >> 6;
    const int R = M / nwg;
    const float* Xin = (l == 0) ? p.in[I_X] : p.out; float* X = p.out; const float* Y = (const float*)(p.ws + WS_Y);
    const float* MOD = (const float*)(p.ws + WS_MOD); bf16_t* HB = (bf16_t*)(p.ws + WS_HB);
    int* TOPI = (int*)(p.ws + WS_MISC + MS_TOPI); float* TOPG = (float*)(p.ws + WS_MISC + MS_TOPG); int* RANK = (int*)(p.ws + WS_MISC + MS_RANK); int* HIST = (int*)(p.ws + WS_MISC + MS_HIST);
    LAS int* etab = (LAS int*)lds;
    const float* RW = p.in[I_ROUTW] + (size_t)l * 1024 * 32; const float* RB = p.in[I_ROUTB] + l * 32;
    for (int r = wave; r < R; r += NWAVES) {
        const size_t m = (size_t)wg * R + r; const int b = (int)(m / T);
        const float* mod = MOD + (size_t)(l * 4 + b) * 6144;
        f32x4 y[4], x[4]; float ss = 0.f;
#pragma unroll
        for (int j = 0; j < 4; ++j) { y[j] = *(const f32x4*)(Y + m * 1024 + 4 * lane + 256 * j); ss += (y[j].x * y[j].x + y[j].y * y[j].y) + (y[j].z * y[j].z + y[j].w * y[j].w); }
        const float rstd = 1.f / sqrtf(wave_sum(ss) * (1.f / 1024.f) + RMS_EPS);
        float s2 = 0.f;
#pragma unroll
        for (int j = 0; j < 4; ++j) { const int c = 4 * lane + 256 * j; const f32x4 g = *(const f32x4*)(p.in[I_POSTMIXG] + l * 1024 + c), gate = *(const f32x4*)(mod + 2 * 1024 + c);
            x[j] = *(const f32x4*)(Xin + m * 1024 + c) + gate * (y[j] * rstd * g); *(f32x4*)(X + m * 1024 + c) = x[j];
            s2 += (x[j].x * x[j].x + x[j].y * x[j].y) + (x[j].z * x[j].z + x[j].w * x[j].w); }
        const float rstd2 = 1.f / sqrtf(wave_sum(s2) * (1.f / 1024.f) + RMS_EPS);
        float lg[32];
#pragma unroll
        for (int e = 0; e < 32; ++e) lg[e] = 0.f;
#pragma unroll
        for (int j = 0; j < 4; ++j) { const int c = 4 * lane + 256 * j; const f32x4 g = *(const f32x4*)(p.in[I_PREFFNG] + l * 1024 + c), sc = *(const f32x4*)(mod + 4 * 1024 + c), sh = *(const f32x4*)(mod + 3 * 1024 + c);
            const f32x4 h = x[j] * rstd2 * g * (sc + 1.f) + sh;
            u32x2 o; o.x = pk2(h.x, h.y); o.y = pk2(h.z, h.w); *(u32x2*)(HB + m * 1024 + c) = o;
#pragma unroll
            for (int q = 0; q < 4; ++q) { const float hv = h[q]; const float* wr = RW + (size_t)(c + q) * 32;
#pragma unroll
                for (int e = 0; e < 32; e += 4) { const f32x4 w = *(const f32x4*)(wr + e); lg[e] += hv * w.x; lg[e + 1] += hv * w.y; lg[e + 2] += hv * w.z; lg[e + 3] += hv * w.w; } } }
        float mine = -3e38f;
#pragma unroll
        for (int e = 0; e < 32; ++e) { const float s = wave_sum(lg[e]) + RB[e]; mine = (lane == e) ? s : mine; }
        float tv[4]; int ti[4];
#pragma unroll
        for (int k = 0; k < 4; ++k) { float mx = mine;
#pragma unroll
            for (int o = 1; o < 64; o <<= 1) mx = fmaxf(mx, __shfl_xor(mx, o));
            const unsigned long long bal = __ballot(mine == mx && lane < 32); const int idx = __ffsll((long long)bal) - 1;
            tv[k] = mx; ti[k] = idx; if (lane == idx) mine = -3e38f; }
        const float e1 = __expf(tv[1] - tv[0]), e2 = __expf(tv[2] - tv[0]), e3 = __expf(tv[3] - tv[0]); const float inv = 1.f / (1.f + e1 + e2 + e3);
        if (lane < 4) { const int id = (lane == 0) ? ti[0] : (lane == 1) ? ti[1] : (lane == 2) ? ti[2] : ti[3]; const float gv = ((lane == 0) ? 1.f : (lane == 1) ? e1 : (lane == 2) ? e2 : e3) * inv;
            TOPI[m * 4 + lane] = id; TOPG[m * 4 + lane] = gv; etab[r * 4 + lane] = id; }
    }
    __syncthreads();
    const int NEn = R * 4;
    if (tid < NEn) { const int e = etab[tid]; int rk = 0; for (int j = 0; j < tid; ++j) rk += (etab[j] == e) ? 1 : 0; RANK[(size_t)wg * NEn + tid] = rk; }
    if (tid < 32) { int c = 0; for (int j = 0; j < NEn; ++j) c += (etab[j] == tid) ? 1 : 0; HIST[wg * 32 + tid] = c; }
    __syncthreads();
}

__device__ __forceinline__ void ph_offs(const Prm& p, int l, LAS unsigned char* lds, int wg, int nwg) {
    const int tid = threadIdx.x, lane = tid & 63, wave = tid >> 6;
    const int R = M / nwg, NEn = R * 4;
    const int* TOPI = (const int*)(p.ws + WS_MISC + MS_TOPI); const int* RANK = (const int*)(p.ws + WS_MISC + MS_RANK); const int* HIST = (const int*)(p.ws + WS_MISC + MS_HIST);
    int* POS = (int*)(p.ws + WS_MISC + MS_POS); int* TILE_E = (int*)(p.ws + WS_MISC + MS_TILEE); int* CTL = (int*)(p.ws + WS_CTL);
    const bf16_t* HB = (const bf16_t*)(p.ws + WS_HB); bf16_t* XS = (bf16_t*)(p.ws + WS_XS);
    LAS int* tot = (LAS int*)lds; LAS int* mine = tot + 32; LAS int* base = mine + 32; LAS int* ptab = base + 32;
    __syncthreads();
    if (tid < 32) { int t = 0, mb = 0; for (int w = 0; w < nwg; ++w) { const int c = HIST[w * 32 + tid]; t += c; mb += (w < wg) ? c : 0; } tot[tid] = t; mine[tid] = mb; }
    __syncthreads();
    if (tid == 0) { int run = 0; for (int e = 0; e < 32; ++e) { const int pad = (tot[e] + 255) / 256 * 256; base[e] = run + mine[e];
            if (wg == 0) for (int t = run / 256; t < (run + pad) / 256; ++t) TILE_E[t] = e;
            run += pad; }
        if (wg == 0) CTL[CW_NT] = run / 256; }
    __syncthreads();
    if (tid < NEn) { const size_t idx = (size_t)wg * NEn + tid; const int pos = base[TOPI[idx]] + RANK[idx]; POS[idx] = pos; ptab[tid] = pos; }
    __syncthreads();
    for (int i = wave; i < NEn; i += NWAVES) { const size_t m = (size_t)wg * R + (i >> 2); const int pos = ptab[i];
        const u32x4* src = (const u32x4*)(HB + m * 1024); u32x4* dst = (u32x4*)(XS + (size_t)pos * 1024);
        dst[lane] = src[lane]; dst[lane + 64] = src[lane + 64]; }
}

__device__ __forceinline__ void ph_comb(const Prm& p, int l, int wg, int nwg) {
    const int tid = threadIdx.x, lane = tid & 63, wave = tid >> 6;
    const bf16_t* YR = (const bf16_t*)(p.ws + WS_YR); const int* POS = (const int*)(p.ws + WS_MISC + MS_POS); const float* TOPG = (const float*)(p.ws + WS_MISC + MS_TOPG);
    const float* MOD = (const float*)(p.ws + WS_MOD); float* X = p.out;
    for (int m = wg * NWAVES + wave; m < M; m += nwg * NWAVES) {
        const int b = m / T; const float* gate = MOD + (size_t)(l * 4 + b) * 6144 + 5 * 1024;
        float y[16];
#pragma unroll
        for (int i = 0; i < 16; ++i) y[i] = 0.f;
#pragma unroll
        for (int k = 0; k < 4; ++k) { const int pos = POS[(size_t)m * 4 + k]; const float gv = TOPG[(size_t)m * 4 + k];
            const u32x4 a = *(const u32x4*)(YR + (size_t)pos * 1024 + 8 * lane), c = *(const u32x4*)(YR + (size_t)pos * 1024 + 512 + 8 * lane);
            y[0] += gv * bflo(a.x); y[1] += gv * bfhi(a.x); y[2] += gv * bflo(a.y); y[3] += gv * bfhi(a.y); y[4] += gv * bflo(a.z); y[5] += gv * bfhi(a.z); y[6] += gv * bflo(a.w); y[7] += gv * bfhi(a.w);
            y[8] += gv * bflo(c.x); y[9] += gv * bfhi(c.x); y[10] += gv * bflo(c.y); y[11] += gv * bfhi(c.y); y[12] += gv * bflo(c.z); y[13] += gv * bfhi(c.z); y[14] += gv * bflo(c.w); y[15] += gv * bfhi(c.w); }
        float ss = 0.f;
#pragma unroll
        for (int i = 0; i < 16; ++i) ss += y[i] * y[i];
        const float rstd = 1.f / sqrtf(wave_sum(ss) * (1.f / 1024.f) + RMS_EPS);
#pragma unroll
        for (int hf = 0; hf < 2; ++hf) { const int c0 = hf * 512 + 8 * lane;
#pragma unroll
            for (int q = 0; q < 2; ++q) { const int c = c0 + 4 * q; const f32x4 g = *(const f32x4*)(p.in[I_POSTFFNG] + l * 1024 + c), gt = *(const f32x4*)(gate + c); f32x4 xv = *(const f32x4*)(X + (size_t)m * 1024 + c);
                xv.x += gt.x * (y[hf * 8 + 4 * q + 0] * rstd * g.x); xv.y += gt.y * (y[hf * 8 + 4 * q + 1] * rstd * g.y); xv.z += gt.z * (y[hf * 8 + 4 * q + 2] * rstd * g.z); xv.w += gt.w * (y[hf * 8 + 4 * q + 3] * rstd * g.w);
                *(f32x4*)(X + (size_t)m * 1024 + c) = xv; } }
    }
}

enum { PH_PRO = 0, PH_NORM1, PH_GEMM_IN, PH_SCAN, PH_ATTN, PH_FIN, PH_GEMM_OUT, PH_ROW, PH_OFFS, PH_GEMM1, PH_GEMM2, PH_COMB };
constexpr int LDS_BYTES = 98304;

template <int PH> __global__ void __launch_bounds__(NTHREADS, 2) k_phase(Prm p, int l) {
    extern __shared__ __attribute__((aligned(16))) unsigned char lds_raw[];
    LAS unsigned char* lds = (LAS unsigned char*)lds_raw;
    const int wg = blockIdx.x, nwg = gridDim.x;
    if (PH == PH_PRO) ph_prologue(p, lds, wg, nwg);
    if (PH == PH_NORM1) ph_norm1(p, l, wg, nwg);
    if (PH == PH_GEMM_IN) ph_gemm_in(p, l, wg, nwg);
    if (PH == PH_SCAN) ph_scan(p, l, lds, wg, nwg);
    if (PH == PH_ATTN) ph_attn(p, l, lds, wg, nwg);
    if (PH == PH_FIN) ph_fin(p, l, lds, wg, nwg);
    if (PH == PH_GEMM_OUT) ph_gemm_out(p, l, wg, nwg);
    if (PH == PH_ROW) ph_row(p, l, lds, wg, nwg);
    if (PH == PH_OFFS) ph_offs(p, l, lds, wg, nwg);
    if (PH == PH_GEMM1) ph_gemm1(p, l, wg, nwg);
    if (PH == PH_GEMM2) ph_gemm2(p, l, wg, nwg);
    if (PH == PH_COMB) ph_comb(p, l, wg, nwg);
}

template <int PH> static void launch(const Prm& p, int l, hipStream_t stream) {
    static bool attr = false;
    if (!attr) { (void)hipFuncSetAttribute((const void*)k_phase<PH>, hipFuncAttributeMaxDynamicSharedMemorySize, LDS_BYTES); attr = true; }
    hipLaunchKernelGGL(k_phase<PH>, dim3(256), dim3(NTHREADS), LDS_BYTES, stream, p, l);
}

extern "C" void kernel_launch(void* const* d_in, const int* in_sizes, int n_in, void* d_out, int out_size, void* d_ws, size_t ws_size, hipStream_t stream) {
    if (n_in != N_IN || out_size != M * D || ws_size < WS_END) { fprintf(stderr, "kernel_launch: unexpected shapes: n_in %d out %d ws %zu (need %zu)\n", n_in, out_size, ws_size, (size_t)WS_END); return; }
    Prm p{};
    for (int i = 0; i < N_IN; ++i) p.in[i] = (const float*)d_in[i];
    p.out = (float*)d_out; p.ws = (unsigned char*)d_ws;
    (void)hipMemsetAsync((char*)d_ws + WS_CTL, 0, 1 * MiB, stream);
    launch<PH_PRO>(p, 0, stream);
    for (int l = 0; l < NL; ++l) {
        launch<PH_NORM1>(p, l, stream);
        launch<PH_GEMM_IN>(p, l, stream);
        launch<PH_SCAN>(p, l, stream);
        launch<PH_ATTN>(p, l, stream);
        launch<PH_FIN>(p, l, stream);
        launch<PH_GEMM_OUT>(p, l, stream);
        launch<PH_ROW>(p, l, stream);
        launch<PH_OFFS>(p, l, stream);
        launch<PH_GEMM1>(p, l, stream);
        launch<PH_GEMM2>(p, l, stream);
        launch<PH_COMB>(p, l, stream);
    }
}
```

```cpp
#include <hip/hip_runtime.h>
#include <stdint.h>
#include <stdio.h>

#define LAS __attribute__((address_space(3)))
typedef unsigned short bf16_t;
typedef short bf16x8 __attribute__((ext_vector_type(8)));
typedef float f32x4 __attribute__((ext_vector_type(4)));
typedef unsigned u32x4 __attribute__((ext_vector_type(4)));
typedef unsigned u32x2 __attribute__((ext_vector_type(2)));

constexpr int NB = 4, T = 8192, D = 1024, M = NB * T, NL = 2;
constexpr int INC = 2312, NP = 2560;
constexpr int C_LX = 0, C_LG = 256, C_S5 = 512, C_Q = 768, C_K = 1280, C_V = 1792, C_F = 2304;
constexpr int NH = 8, HD = 64, NE = 32, TOPK = 4, DFF = 1024;
constexpr int RP = M * TOPK + NE * 256;
constexpr float C2 = 0.125f * 1.4426950408889634f;
constexpr float LOG2E = 1.4426950408889634f;
constexpr float RMS_EPS = 1e-6f;
constexpr int NTHREADS = 512, NWAVES = 8;
#ifndef FAST_ATTN
#define FAST_ATTN 1
#endif
#ifndef YR_FP8
#define YR_FP8 1
#endif
#ifndef F8_ALLV
#define F8_ALLV 1
#endif
#ifndef EXPERT_FP8
#define EXPERT_FP8 1
#endif

enum { I_X = 0, I_C, I_ADAW, I_ADAB, I_PREMIXG, I_WIN, I_CONVW, I_CONVB, I_LRUWA, I_LRUBA, I_LRUWX, I_LRUBX, I_LAMBDA, I_S5ARE, I_S5AIM, I_S5BRE, I_S5BIM,
       I_S5CRE, I_S5CIM, I_S5D, I_S5LOGDT, I_GLUW, I_GLUB, I_FOXFB, I_GNLRU, I_GNS5, I_GNATT, I_WOUT, I_POSTMIXG, I_PREFFNG, I_ROUTW, I_ROUTB, I_WGU, I_BGU,
       I_WDN, I_BDN, I_POSTFFNG, N_IN };

constexpr size_t MiB = 1u << 20;
constexpr size_t WS_CTL = 0;
constexpr size_t WS_MOD = 1 * MiB;
constexpr size_t WS_MISC = 2 * MiB;
constexpr size_t WS_FC2 = 6 * MiB;
constexpr size_t WS_WIN = 8 * MiB;
constexpr size_t WS_WOUT = 18 * MiB;
constexpr size_t WS_WGU = 22 * MiB;
constexpr size_t WS_WDN = 278 * MiB;
constexpr size_t WS_HB = 406 * MiB;
constexpr size_t WS_PB = 470 * MiB;
constexpr size_t WS_YL = 630 * MiB;
constexpr size_t WS_YS0 = 662 * MiB;
constexpr size_t WS_OA = 694 * MiB;
constexpr size_t WS_AGG = WS_OA;
constexpr size_t WS_XEND = WS_OA + 2 * MiB;
constexpr size_t WS_GLUW = WS_OA + 8 * MiB;
constexpr size_t WS_X4END = WS_OA + 7 * MiB;
constexpr size_t WS_S5T = WS_OA + 10 * MiB;
constexpr size_t WS_LRUW = WS_OA + 9 * MiB;
constexpr size_t WS_YC = 758 * MiB;
constexpr size_t WS_Y = 822 * MiB;
constexpr size_t WS_XS = 950 * MiB;
constexpr size_t WS_XB = WS_XS;
constexpr size_t WS_H1 = 1222 * MiB;
constexpr size_t WS_YR = 1494 * MiB;
constexpr size_t WS_END = 1766 * MiB;
constexpr size_t MS_ROWTOK = 2560 * 1024;
constexpr size_t MS_TOPI = 0, MS_TOPG = 512 * 1024, MS_RANK = 1024 * 1024, MS_POS = 1536 * 1024, MS_HIST = 2048 * 1024, MS_TILEE = 2048 * 1024 + 64 * 1024;
constexpr int CW_NT = 8;
constexpr int CW_QN = 16384, CW_KT = 32768;
constexpr int CW_NRM = 8192;

struct Prm { const float* in[N_IN]; float* out; unsigned char* ws; };
__device__ __forceinline__ int fresh_tid() { int t = threadIdx.x; asm volatile("" : "+v"(t)); return t; }
typedef const __attribute__((address_space(4))) Prm* PrmP;
__device__ __forceinline__ PrmP prm_fresh() { PrmP q = (PrmP)__builtin_amdgcn_kernarg_segment_ptr(); asm volatile("" : "+s"(q)); return q; }

typedef float f32x2h_ __attribute__((ext_vector_type(2))); typedef __bf16 bf16x2h_ __attribute__((ext_vector_type(2)));
__device__ __forceinline__ unsigned pk2(float lo, float hi) { const f32x2h_ v = {lo, hi}; return __builtin_bit_cast(unsigned, __builtin_convertvector(v, bf16x2h_)); }
__device__ __forceinline__ unsigned f2bf(float f) { return pk2(f, 0.f) & 0xffffu; }
__device__ __forceinline__ float bf2f(unsigned v) { return __builtin_bit_cast(float, v << 16); }
__device__ __forceinline__ float bflo(unsigned w) { return __builtin_bit_cast(float, w << 16); }
__device__ __forceinline__ float bfhi(unsigned w) { return __builtin_bit_cast(float, w & 0xffff0000u); }
__device__ __forceinline__ float wave_sum(float v) {
#pragma unroll
    for (int o = 1; o < 64; o <<= 1) v += __shfl_xor(v, o);
    return v;
}
__device__ __forceinline__ float sigmoidf_(float x) { return __builtin_amdgcn_rcpf(1.f + __expf(-x)); }
__device__ __forceinline__ float gelu_tanh(float x) { const float u = 0.7978845608028654f * (x + 0.044715f * x * x * x); return x * sigmoidf_(2.f * u); }

__device__ __forceinline__ void tr_item(const float* W, int ldw, int nvalid, int k0, int n0, bf16_t* dst, float scale, LAS float* scr, int lane, int ldd = 1024) {
    const int nn = n0 + (lane & 31); const bool ok = nn < nvalid;
#pragma unroll 8
    for (int i = 0; i < 32; ++i) { const int kk = 2 * i + (lane >> 5); scr[kk * 33 + (lane & 31)] = ok ? W[(size_t)(k0 + kk) * ldw + nn] * scale : 0.f; }
    asm volatile("s_waitcnt lgkmcnt(0)" ::: "memory");
    const int c = lane & 7;
#pragma unroll
    for (int j = 0; j < 4; ++j) { const int n = (lane >> 3) + 8 * j; const LAS float* s = scr + (8 * c) * 33 + n;
        u32x4 o; o.x = pk2(s[0 * 33], s[1 * 33]); o.y = pk2(s[2 * 33], s[3 * 33]); o.z = pk2(s[4 * 33], s[5 * 33]); o.w = pk2(s[6 * 33], s[7 * 33]);
        *(u32x4*)(dst + (size_t)n * ldd + k0 + 8 * c) = o; }
    asm volatile("s_waitcnt lgkmcnt(0)" ::: "memory");
}

__device__ __forceinline__ unsigned pk4_fp8(float a, float b, float c, float d) { int w = __builtin_amdgcn_cvt_pk_fp8_f32(a, b, 0, false); w = __builtin_amdgcn_cvt_pk_fp8_f32(c, d, w, true); return (unsigned)w; }
__device__ __forceinline__ void tr_item8w(const float* W, int ldw, int k0, int n0, unsigned char* dst, float scale, LAS float* scr, int lane) {
#pragma unroll 1
    for (int hh = 0; hh < 2; ++hh) { f32x4 v[8];
#pragma unroll
      for (int i = 0; i < 8; ++i) v[i] = *(const f32x4*)(W + (size_t)(k0 + hh * 32 + (lane >> 4) + 4 * i) * ldw + n0 + 4 * (lane & 15));
#pragma unroll
      for (int i = 0; i < 8; ++i) { LAS float* d = scr + (hh * 32 + (lane >> 4) + 4 * i) * 65 + 4 * (lane & 15); d[0] = v[i].x * scale; d[1] = v[i].y * scale; d[2] = v[i].z * scale; d[3] = v[i].w * scale; } }
    asm volatile("s_waitcnt lgkmcnt(0)" ::: "memory");
    const int kq = lane & 3;
#pragma unroll
    for (int j = 0; j < 4; ++j) { const int n = (lane >> 2) + 16 * j; const LAS float* s = scr + (16 * kq) * 65 + n;
        u32x4 o; o.x = pk4_fp8(s[0 * 65], s[1 * 65], s[2 * 65], s[3 * 65]); o.y = pk4_fp8(s[4 * 65], s[5 * 65], s[6 * 65], s[7 * 65]);
        o.z = pk4_fp8(s[8 * 65], s[9 * 65], s[10 * 65], s[11 * 65]); o.w = pk4_fp8(s[12 * 65], s[13 * 65], s[14 * 65], s[15 * 65]);
        *(u32x4*)(dst + (size_t)n * 1024 + k0 + 16 * kq) = o; }
    asm volatile("s_waitcnt lgkmcnt(0)" ::: "memory");
}
__device__ __forceinline__ void ph_prologue(PrmP p, LAS unsigned char* lds, int wg, int nwg) {
    const int tid = fresh_tid(), lane = tid & 63, wave = tid >> 6;
    {
        LAS float* sc = (LAS float*)lds; LAS float* red = sc + 4096;
        const float* c = p->in[I_C];
        for (int i = tid; i < 4096; i += NTHREADS) { const float v = c[i]; sc[i] = v / (1.f + __expf(-v)); }
        __syncthreads();
        float* MOD = (float*)(p->ws + WS_MOD);
        for (int it = wg; it < 2 * 96; it += nwg) {
            const int l = it / 96, n0 = (it % 96) * 64, kg = tid >> 6, nl = tid & 63;
            const float* W = p->in[I_ADAW] + (size_t)l * 1024 * 6144 + n0 + nl;
            float a0 = 0.f, a1 = 0.f, a2 = 0.f, a3 = 0.f;
            for (int k0 = kg; k0 < 1024; k0 += 8 * 16) { float w[16];
#pragma unroll
                for (int q = 0; q < 16; ++q) w[q] = W[(size_t)(k0 + 8 * q) * 6144];
#pragma unroll
                for (int q = 0; q < 16; ++q) { const int k = k0 + 8 * q; a0 += sc[k] * w[q]; a1 += sc[1024 + k] * w[q]; a2 += sc[2048 + k] * w[q]; a3 += sc[3072 + k] * w[q]; } }
            red[(kg * 4 + 0) * 64 + nl] = a0; red[(kg * 4 + 1) * 64 + nl] = a1; red[(kg * 4 + 2) * 64 + nl] = a2; red[(kg * 4 + 3) * 64 + nl] = a3;
            __syncthreads();
            if (tid < 256) { const int b = tid >> 6; float s = 0.f;
#pragma unroll
                for (int g = 0; g < 8; ++g) s += red[(g * 4 + b) * 64 + nl];
                MOD[(size_t)(l * 4 + b) * 6144 + n0 + nl] = s + p->in[I_ADAB][l * 6144 + n0 + nl]; }
            __syncthreads();
        }
    }
    {
        LAS float* scr = (LAS float*)lds + wave * (64 * 65);
        const int gw = wave * nwg + wg, NGW = nwg * NWAVES;
        constexpr int I_IN = 16 * 80, I_OUT = 16 * 32, I_GU = EXPERT_FP8 ? 16 * 32 : 16 * 64, I_DN = EXPERT_FP8 ? 16 * 16 : 16 * 32;
        constexpr int I_GLU = 4 * 8;
        constexpr int I_LRU = 4 * 2 * 2;
        constexpr int TOT = 2 * I_IN + 2 * I_OUT + 64 * I_GU + 64 * I_DN + 2 * I_GLU + 2 * I_LRU;
        for (int it = gw; it < TOT; it += NGW) {
            int r = it;
            if (r < 2 * I_IN) { const int l = r / I_IN, q = r % I_IN, kb = q / 80, nb = q % 80, n0 = nb * 32;
                const float sc = (n0 >= C_Q && n0 < C_K) ? C2 : 1.f;
                tr_item(p->in[I_WIN] + (size_t)l * 1024 * INC, INC, INC, kb * 64, n0, (bf16_t*)(p->ws + WS_WIN) + ((size_t)l * NP + n0) * 1024, sc, scr, lane); continue; }
            r -= 2 * I_IN;
            if (r < 2 * I_OUT) { const int l = r / I_OUT, q = r % I_OUT, kb = q / 32, nb = q % 32, n0 = nb * 32;
                tr_item(p->in[I_WOUT] + (size_t)l * 1024 * 1024, 1024, 1024, kb * 64, n0, (bf16_t*)(p->ws + WS_WOUT) + ((size_t)l * 1024 + n0) * 1024, 1.f, scr, lane); continue; }
            r -= 2 * I_OUT;
            if (r < 64 * I_GU) { const int le = r / I_GU, q = r % I_GU, NBK = EXPERT_FP8 ? 32 : 64, kb = q / NBK, nb = q % NBK, n0 = nb * (2048 / NBK);
                const int s = n0 / 1024, rr = n0 % 1024, j = rr / 128, cc = rr % 128, drow = 256 * j + 128 * s + cc;
                if (EXPERT_FP8) tr_item8w(p->in[I_WGU] + (size_t)le * 1024 * 2048, 2048, kb * 64, n0, p->ws + WS_WGU + ((size_t)le * 2048 + drow) * 1024, 64.f, scr, lane);
                else tr_item(p->in[I_WGU] + (size_t)le * 1024 * 2048, 2048, 2048, kb * 64, n0, (bf16_t*)(p->ws + WS_WGU) + ((size_t)le * 2048 + drow) * 1024, 1.f, scr, lane); continue; }
            r -= 64 * I_GU;
            if (r < 64 * I_DN) { const int le = r / I_DN, q = r % I_DN, NBK = EXPERT_FP8 ? 16 : 32, kb = q / NBK, nb = q % NBK, n0 = nb * (1024 / NBK);
                if (EXPERT_FP8) tr_item8w(p->in[I_WDN] + (size_t)le * 1024 * 1024, 1024, kb * 64, n0, p->ws + WS_WDN + ((size_t)le * 1024 + n0) * 1024, 64.f, scr, lane);
                else tr_item(p->in[I_WDN] + (size_t)le * 1024 * 1024, 1024, 1024, kb * 64, n0, (bf16_t*)(p->ws + WS_WDN) + ((size_t)le * 1024 + n0) * 1024, 1.f, scr, lane); continue; }
            r -= 64 * I_DN;
            if (r < 2 * I_GLU) { const int l = r / I_GLU, q = r % I_GLU, kb = q / 8, nb = q % 8, n0 = nb * 32;
                tr_item(p->in[I_GLUW] + (size_t)l * 256 * 256, 256, 256, kb * 64, n0, (bf16_t*)(p->ws + WS_GLUW) + ((size_t)l * 256 + n0) * 256, 1.f, scr, lane, 256); continue; }
            r -= 2 * I_GLU;
            { const int l = r / I_LRU, q = r % I_LRU, blk = q >> 2, gate = (q >> 1) & 1, n0 = (q & 1) * 32;
                tr_item(p->in[gate ? I_LRUWX : I_LRUWA] + (size_t)(l * 4 + blk) * 4096, 64, 64, 0, n0, (bf16_t*)(p->ws + WS_LRUW) + ((size_t)((l * 4 + blk) * 2 + gate) * 64 + n0) * 64, 1.f, scr, lane, 64); }
        }
    }
}

__device__ __forceinline__ void ph_norm1(PrmP p, int l, int wg, int nwg) {
    const int tid = fresh_tid(), lane = tid & 63, wave = tid >> 6;
    const float* X = (l == 0) ? p->in[I_X] : p->out;
    const float* MOD = (const float*)(p->ws + WS_MOD);
    bf16_t* HB = (bf16_t*)(p->ws + WS_HB);
    const float* g = p->in[I_PREMIXG] + l * 1024;
    for (int m = wg * NWAVES + wave; m < M; m += nwg * NWAVES) {
        const int b = m / T;
        const float* shift = MOD + (size_t)(l * 4 + b) * 6144 + 0 * 1024; const float* scale = shift + 1024;
        f32x4 v[4]; float ss = 0.f;
#pragma unroll
        for (int j = 0; j < 4; ++j) { v[j] = *(const f32x4*)(X + (size_t)m * 1024 + 4 * lane + 256 * j); ss += (v[j].x * v[j].x + v[j].y * v[j].y) + (v[j].z * v[j].z + v[j].w * v[j].w); }
        const float rstd = __builtin_amdgcn_rsqf(wave_sum(ss) * (1.f / 1024.f) + RMS_EPS);
#pragma unroll
        for (int j = 0; j < 4; ++j) { const int c = 4 * lane + 256 * j; const f32x4 gg = *(const f32x4*)(g + c), sc = *(const f32x4*)(scale + c), sh = *(const f32x4*)(shift + c);
            const f32x4 h = v[j] * rstd * gg * (sc + 1.f) + sh;
            u32x2 o; o.x = pk2(h.x, h.y); o.y = pk2(h.z, h.w); *(u32x2*)(HB + (size_t)m * 1024 + c) = o; }
    }
}

namespace pg8 {
#define PG8_LAS __attribute__((address_space(3)))
typedef unsigned short bf16_t;
typedef short bf16x8 __attribute__((ext_vector_type(8)));
typedef float f32x4 __attribute__((ext_vector_type(4)));
typedef unsigned u32x4 __attribute__((ext_vector_type(4)));
constexpr int BM = 256, BK = 64, HALF = 128, HTB = HALF * BK * 2  , STAGE_BYTES = 8 * HTB, NXCD = 8, WGM = 8;

__host__ __device__ __forceinline__ int lds_byte(int r, int c) { const int st = (r >> 4) * 2 + (c >> 5), rr = r & 15, cc = c & 31, ob = rr * 64 + cc * 2; return st * 1024 + (ob ^ (((ob >> 9) & 1) << 5)); }
__host__ __device__ __forceinline__ void stage_rc(int b, int& R, int& C) { const int st = b / 1024, sb = b % 1024, swz = sb ^ (((sb >> 9) & 1) << 5); R = (st >> 1) * 16 + swz / 64; C = (st & 1) * 32 + (swz % 64) / 2; }
__host__ __device__ __forceinline__ int perm32(int rho) { const int n = rho >> 4, i = rho & 15; return 8 * (i >> 2) + 4 * n + (i & 3); }

struct Unit { int pm, pn; };
struct Gemm { const bf16_t* A; const bf16_t* Bt; int M, N, K; const PG8_LAS unsigned short* rowtok = nullptr; };

struct StaticOrder {
    int nM, nN, nwg, G, c;
    __host__ __device__ void init(int M, int N, int G_, int c_) { nM = M / BM; nN = N / BM; nwg = nM * nN; G = G_; c = c_; }
    __host__ __device__ bool next(int i, Unit& u) const {
        const long L = (long)i * G + c; if (L >= nwg) return false;
        int wgid = (int)L; { const int q = nwg / NXCD, r = nwg % NXCD, xcd = wgid % NXCD, off = wgid / NXCD; wgid = (xcd < r ? xcd * (q + 1) : r * (q + 1) + (xcd - r) * q) + off; }
        const int nig = WGM * nN, gid = wgid / nig, fm = gid * WGM, gsz = (nM - fm) < WGM ? (nM - fm) : WGM;
        u.pm = fm + ((wgid % nig) % gsz); u.pn = (wgid % nig) / gsz; return true;
    }
    __device__ __forceinline__ void a_ready(const Unit&) const {}
    __device__ __forceinline__ void done(const Unit&) const {}
};


__device__ __forceinline__ unsigned cvt_pk_bf16(float lo, float hi) { unsigned r; asm volatile("v_cvt_pk_bf16_f32 %0, %1, %2" : "=v"(r) : "v"(lo), "v"(hi)); return r; }
struct EpiBf16Plain {
    static constexpr bool PERM = true, AFTER_DRAIN = false;
    bf16_t* O; int ldc;
    __device__ __forceinline__ void operator()(const f32x4 (&acc)[2][2][4][2], const Unit& u, int wr, int wc, int fr, int fq) const {
        const int row0 = u.pm * BM + wr * 64 + fr, col0 = u.pn * BM + wc * 32 + 8 * fq;
#pragma unroll
        for (int ai = 0; ai < 2; ++ai)
#pragma unroll
            for (int m = 0; m < 4; ++m) { bf16_t* rowp = O + (size_t)(row0 + ai * HALF + m * 16) * ldc + col0;
#pragma unroll
                for (int bj = 0; bj < 2; ++bj) { const f32x4 v0 = acc[ai][bj][m][0], v1 = acc[ai][bj][m][1];
                    u32x4 w; w.x = cvt_pk_bf16(v0[0], v0[1]); w.y = cvt_pk_bf16(v0[2], v0[3]); w.z = cvt_pk_bf16(v1[0], v1[1]); w.w = cvt_pk_bf16(v1[2], v1[3]);
                    *(u32x4*)(rowp + bj * HALF) = w; } }
    }
};
struct EpiSwiglu {
    static constexpr bool PERM = true, AFTER_DRAIN = false;
    bf16_t* H1; const float* bgu;
    __device__ __forceinline__ void operator()(const f32x4 (&acc)[2][2][4][2], const Unit& u, int wr, int wc, int fr, int fq) const {
        const int e = u.pn >> 3, j = u.pn & 7, row0 = u.pm * BM + wr * 64 + fr, lc0 = wc * 32 + 8 * fq;
        const float* bb = bgu + (size_t)e * 2048 + j * 128 + lc0;
        const f32x4 bg0 = *(const f32x4*)(bb), bg1 = *(const f32x4*)(bb + 4), bu0 = *(const f32x4*)(bb + 1024), bu1 = *(const f32x4*)(bb + 1028);
#pragma unroll
        for (int ai = 0; ai < 2; ++ai)
#pragma unroll
            for (int m = 0; m < 4; ++m) { float o[8];
#pragma unroll
                for (int n = 0; n < 2; ++n) { const f32x4 g4 = acc[ai][0][m][n] + (n ? bg1 : bg0), u4 = acc[ai][1][m][n] + (n ? bu1 : bu0);
#pragma unroll
                    for (int q = 0; q < 4; ++q) { const float g = fminf(g4[q], 7.f), up = fminf(fmaxf(u4[q], -7.f), 7.f);
                        o[4 * n + q] = (up + 1.f) * g * __builtin_amdgcn_rcpf(1.f + __builtin_amdgcn_exp2f(-1.702f * 1.4426950408889634f * g)); } }
                u32x4 w; w.x = cvt_pk_bf16(o[0], o[1]); w.y = cvt_pk_bf16(o[2], o[3]); w.z = cvt_pk_bf16(o[4], o[5]); w.w = cvt_pk_bf16(o[6], o[7]);
                *(u32x4*)(H1 + (size_t)(row0 + ai * HALF + m * 16) * 1024 + j * 128 + lc0) = w; }
    }
};
__device__ __forceinline__ unsigned pk4_fp8(float a, float b, float c, float d) { int w = __builtin_amdgcn_cvt_pk_fp8_f32(a, b, 0, false); w = __builtin_amdgcn_cvt_pk_fp8_f32(c, d, w, true); return (unsigned)w; }
struct EpiSwiglu8 {
    static constexpr bool PERM = true, AFTER_DRAIN = false;
    unsigned char* H1; const float* bgu;
    __device__ __forceinline__ void operator()(const f32x4 (&acc)[2][2][4][2], const Unit& u, int wr, int wc, int fr, int fq) const {
        const int e = u.pn >> 3, j = u.pn & 7, row0 = u.pm * BM + wr * 64 + fr, lc0 = wc * 32 + 8 * fq;
        const float* bb = bgu + (size_t)e * 2048 + j * 128 + lc0;
        const f32x4 bg0 = *(const f32x4*)(bb), bg1 = *(const f32x4*)(bb + 4), bu0 = *(const f32x4*)(bb + 1024), bu1 = *(const f32x4*)(bb + 1028);
#pragma unroll
        for (int ai = 0; ai < 2; ++ai)
#pragma unroll
            for (int m = 0; m < 4; ++m) { float o[8];
#pragma unroll
                for (int n = 0; n < 2; ++n) { const f32x4 g4 = acc[ai][0][m][n] + (n ? bg1 : bg0), u4 = acc[ai][1][m][n] + (n ? bu1 : bu0);
#pragma unroll
                    for (int q = 0; q < 4; ++q) { const float g = fminf(g4[q], 7.f), up = fminf(fmaxf(u4[q], -7.f), 7.f);
                        o[4 * n + q] = 2.f * (up + 1.f) * g * __builtin_amdgcn_rcpf(1.f + __builtin_amdgcn_exp2f(-1.702f * 1.4426950408889634f * g)); } }
                typedef unsigned u32x2_ __attribute__((ext_vector_type(2))); u32x2_ w; w.x = pk4_fp8(o[0], o[1], o[2], o[3]); w.y = pk4_fp8(o[4], o[5], o[6], o[7]);
                *(u32x2_*)(H1 + (size_t)(row0 + ai * HALF + m * 16) * 1024 + j * 128 + lc0) = w; }
    }
};
struct EpiDown {
    static constexpr bool PERM = true, AFTER_DRAIN = false;
    bf16_t* YR; const float* bdn;
    __device__ __forceinline__ void operator()(const f32x4 (&acc)[2][2][4][2], const Unit& u, int wr, int wc, int fr, int fq) const {
        const int e = u.pn >> 2, jn = u.pn & 3, row0 = u.pm * BM + wr * 64 + fr, col0 = jn * BM + wc * 32 + 8 * fq;
        f32x4 bv[2][2];
#pragma unroll
        for (int bj = 0; bj < 2; ++bj)
#pragma unroll
            for (int n = 0; n < 2; ++n) bv[bj][n] = *(const f32x4*)(bdn + (size_t)e * 1024 + col0 + bj * HALF + 4 * n);
#pragma unroll
        for (int ai = 0; ai < 2; ++ai)
#pragma unroll
            for (int m = 0; m < 4; ++m) { bf16_t* rowp = YR + (size_t)(row0 + ai * HALF + m * 16) * 1024 + col0;
#pragma unroll
                for (int bj = 0; bj < 2; ++bj) { const f32x4 v0 = acc[ai][bj][m][0] + bv[bj][0], v1 = acc[ai][bj][m][1] + bv[bj][1];
                    u32x4 w; w.x = cvt_pk_bf16(v0[0], v0[1]); w.y = cvt_pk_bf16(v0[2], v0[3]); w.z = cvt_pk_bf16(v1[0], v1[1]); w.w = cvt_pk_bf16(v1[2], v1[3]);
                    *(u32x4*)(rowp + bj * HALF) = w; } }
    }
};
struct EpiDown8 {
    static constexpr bool PERM = true, AFTER_DRAIN = false;
    unsigned char* YR; const float* bdn;
    __device__ __forceinline__ void operator()(const f32x4 (&acc)[2][2][4][2], const Unit& u, int wr, int wc, int fr, int fq) const {
        const int e = u.pn >> 2, jn = u.pn & 3, row0 = u.pm * BM + wr * 64 + fr, col0 = jn * BM + wc * 32 + 8 * fq;
        f32x4 bv[2][2];
#pragma unroll
        for (int bj = 0; bj < 2; ++bj)
#pragma unroll
            for (int n = 0; n < 2; ++n) bv[bj][n] = *(const f32x4*)(bdn + (size_t)e * 1024 + col0 + bj * HALF + 4 * n);
#pragma unroll
        for (int ai = 0; ai < 2; ++ai)
#pragma unroll
            for (int m = 0; m < 4; ++m) { unsigned char* rowp = YR + (size_t)(row0 + ai * HALF + m * 16) * 1024 + col0;
#pragma unroll
                for (int bj = 0; bj < 2; ++bj) { const f32x4 v0 = (acc[ai][bj][m][0] + bv[bj][0]) * 16.f, v1 = (acc[ai][bj][m][1] + bv[bj][1]) * 16.f;
                    typedef unsigned u32x2_ __attribute__((ext_vector_type(2))); u32x2_ w; w.x = pk4_fp8(v0[0], v0[1], v0[2], v0[3]); w.y = pk4_fp8(v1[0], v1[1], v1[2], v1[3]);
                    *(u32x2_*)(rowp + bj * HALF) = w; } }
    }
};
struct GroupOrder {
    int nt, nct, G, c; const PG8_LAS int* tile_e;
    __device__ __forceinline__ bool peek_pm(int i, int& rt) const { const int x = c & 7, j = c >> 3, rpg = 32 / nct, gi = i * 8 + x; rt = gi * rpg + j / nct; return G == 256 && rt < nt; }
    __device__ __forceinline__ bool next(int i, Unit& u) const {
        const int x = c & 7, j = c >> 3, rpg = 32 / nct, gi = i * 8 + x, rt = gi * rpg + j / nct, ct = j % nct;
        if (G != 256 || rt >= nt) return false;
        u.pm = rt; u.pn = tile_e[rt] * nct + ct; return true; }
    __device__ __forceinline__ void a_ready(const Unit&) const {}
    __device__ __forceinline__ void done(const Unit&) const {}
};

typedef int i32x8 __attribute__((ext_vector_type(8))); typedef int i32x4 __attribute__((ext_vector_type(4)));
__device__ __forceinline__ i32x8 cat8(bf16x8 lo, bf16x8 hi) { const i32x4 a = __builtin_bit_cast(i32x4, lo), b = __builtin_bit_cast(i32x4, hi); return __builtin_shufflevector(a, b, 0, 1, 2, 3, 4, 5, 6, 7); }
template <class Epi, class Sched, bool ALIGN_EPI = false, bool SP2 = false, int F8SCALE = 0, bool GATHER = false>
__device__ __forceinline__ void gemm_phase(PG8_LAS unsigned char* lds, const Gemm g, const Sched& S, const Epi& E) {
    const int tid = fresh_tid(), wid = __builtin_amdgcn_readfirstlane(tid >> 6), lane = tid & 63, wr = wid >> 2, wc = wid & 3, fr = lane & 15, fq = lane >> 4;
    const int K = g.K, nt = K / BK;
    unsigned voffA[2], voffB[2];
#pragma unroll
    for (int i = 0; i < 2; ++i) { int R, C; stage_rc(tid * 16 + i * 8192, R, C); const int Rb = Epi::PERM ? ((R & ~31) + perm32(R & 31)) : R;
        voffA[i] = GATHER ? (unsigned)((R << 16) | (C * 2)) : (unsigned)(R * K + C) * 2u; voffB[i] = (unsigned)(Rb * K + C) * 2u; }
    static_assert(!GATHER || SP2, "the gathered form is written for the SP2 loop");
    unsigned gA[2][2] = {{0u, 0u}, {0u, 0u}}, gN[2][2] = {{0u, 0u}, {0u, 0u}};
#define PG8_GLOOK(dst, unit) do { _Pragma("unroll") for (int h_ = 0; h_ < 2; ++h_) _Pragma("unroll") for (int i_ = 0; i_ < 2; ++i_) \
        dst[h_][i_] = (unsigned)g.rowtok[(unit) * BM + h_ * HALF + (int)(voffA[i_] >> 16)]; } while (0)
#define PG8_GOFF(dst, src) do { _Pragma("unroll") for (int h_ = 0; h_ < 2; ++h_) _Pragma("unroll") for (int i_ = 0; i_ < 2; ++i_) dst[h_][i_] = src[h_][i_] * (unsigned)(K * 2) + (voffA[i_] & 0xffffu); } while (0)
#define PG8_STAGE_A(bufoff, gbase, half, OFFS) do { if constexpr (GATHER) { _Pragma("unroll") for (int _i = 0; _i < 2; ++_i) \
        __builtin_amdgcn_global_load_lds((const unsigned*)((const char*)(gbase) + OFFS[half][_i]), (PG8_LAS unsigned*)(lds + (bufoff) + ldsw + _i * 8192), 16, 0, 0); } \
        else { PG8_STAGE(bufoff, (gbase) + (half) * hstep, voffA); } } while (0)
    const size_t kstep = (size_t)(BK * 2);
    const size_t hstep = (size_t)HALF * K * 2;
    const size_t tstep = 2 * hstep;
    const unsigned ldsw = (unsigned)wid * 1024u;
    const int aoff = lds_byte(wr * 64 + fr, fq * 8), boff = lds_byte(wc * 32 + fr, fq * 8);
#define PG8_SA(b, h) (((b) * 2 + (h)) * HTB)
#define PG8_SB(b, h) ((4 + (b) * 2 + (h)) * HTB)
#define PG8_STAGE(bufoff, gbase, voff) do { _Pragma("unroll") for (int _i = 0; _i < 2; ++_i) \
        __builtin_amdgcn_global_load_lds((const unsigned*)((const char*)(gbase) + (voff)[_i]), (PG8_LAS unsigned*)(lds + (bufoff) + ldsw + _i * 8192), 16, 0, 0); } while (0)
#define PG8_LDA(dst, b, h) do { _Pragma("unroll") for (int m = 0; m < 4; ++m) { const bf16x8 l0_ = *(const PG8_LAS bf16x8*)(lds + PG8_SA(b, h) + aoff + m * 2048), l1_ = *(const PG8_LAS bf16x8*)(lds + PG8_SA(b, h) + aoff + m * 2048 + 1024); \
        if constexpr (F8SCALE != 0) dst##8[m] = cat8(l0_, l1_); else { dst[m][0] = l0_; dst[m][1] = l1_; } } } while (0)
#define PG8_LDB(dst, b, h) do { _Pragma("unroll") for (int n = 0; n < 2; ++n) { const bf16x8 l0_ = *(const PG8_LAS bf16x8*)(lds + PG8_SB(b, h) + boff + n * 2048), l1_ = *(const PG8_LAS bf16x8*)(lds + PG8_SB(b, h) + boff + n * 2048 + 1024); \
        if constexpr (F8SCALE != 0) dst##8[n] = cat8(l0_, l1_); else { dst[n][0] = l0_; dst[n][1] = l1_; } } } while (0)
#define PG8_MMA(ai, bj, At, Bt) do { __builtin_amdgcn_s_setprio(1); _Pragma("unroll") for (int m = 0; m < 4; ++m) _Pragma("unroll") for (int n = 0; n < 2; ++n) { \
        if constexpr (F8SCALE != 0) { if (F8_ALLV || ((ai) == 1 && (bj) == 1)) asm volatile("v_mfma_scale_f32_16x16x128_f8f6f4 %0, %1, %2, %0, %3, %4 op_sel_hi:[0,0,0]" : "+v"(acc[ai][bj][m][n]) : "v"(Bt##8[n]), "v"(At##8[m]), "v"(f8sa), "v"(f8sb)); \
            else asm volatile("v_mfma_scale_f32_16x16x128_f8f6f4 %0, %1, %2, %0, %3, %4 op_sel_hi:[0,0,0]" : "+a"(acc[ai][bj][m][n]) : "v"(Bt##8[n]), "v"(At##8[m]), "v"(f8sa), "v"(f8sb)); } \
        else { _Pragma("unroll") for (int k = 0; k < 2; ++k) acc[ai][bj][m][n] = __builtin_amdgcn_mfma_f32_16x16x32_bf16(Bt[n][k], At[m][k], acc[ai][bj][m][n], 0, 0, 0); } } __builtin_amdgcn_s_setprio(0); } while (0)
#define PG8_WAIT_V(n) asm volatile("s_waitcnt vmcnt(" #n ")" ::: "memory")
#define PG8_WAIT_L(n) asm volatile("s_waitcnt lgkmcnt(" #n ")" ::: "memory")
#define PG8_BAR __builtin_amdgcn_s_barrier()
#define PG8_SCHED __builtin_amdgcn_sched_barrier(0)
    Unit cur, nxt; int ui = 0;
    if (!S.next(0, cur)) return;
    f32x4 acc[2][2][4][2];
#pragma unroll
    for (int a = 0; a < 2; ++a)
#pragma unroll
        for (int b = 0; b < 2; ++b)
#pragma unroll
            for (int m = 0; m < 4; ++m)
#pragma unroll
                for (int n = 0; n < 2; ++n) acc[a][b][m][n] = (f32x4){0.f, 0.f, 0.f, 0.f};
    bf16x8 At[4][2], B0[2][2], B1[2][2]; i32x8 At8[4], B08[2], B18[2];
    const int f8sa = F8SCALE * 0x01010101, f8sb = 0x7f7f7f7f;
    const char* cA = GATHER ? (const char*)g.A : (const char*)g.A + (size_t)cur.pm * tstep; const char* cB = (const char*)g.Bt + (size_t)cur.pn * tstep;
    if constexpr (GATHER) { PG8_GLOOK(gN, 0); PG8_GOFF(gA, gN); }
    S.a_ready(cur);
    if constexpr (SP2) {
        PG8_STAGE(PG8_SB(0, 0), cB, voffB); PG8_STAGE(PG8_SB(0, 1), cB + hstep, voffB); PG8_STAGE_A(PG8_SA(0, 0), cA, 0, gA); PG8_STAGE_A(PG8_SA(0, 1), cA, 1, gA);
        if (wr == 1) PG8_BAR;
        PG8_WAIT_V(2); PG8_BAR;
        PG8_STAGE(PG8_SB(1, 0), cB + kstep, voffB); PG8_STAGE_A(PG8_SA(1, 0), cA + kstep, 0, gA); PG8_STAGE(PG8_SB(1, 1), cB + hstep + kstep, voffB);
        PG8_WAIT_V(6); PG8_BAR;
    } else {
        PG8_STAGE(PG8_SB(0, 0), cB, voffB); PG8_STAGE(PG8_SA(0, 0), cA, voffA); PG8_STAGE(PG8_SB(0, 1), cB + hstep, voffB); PG8_STAGE(PG8_SA(0, 1), cA + hstep, voffA);
        if (wr == 1) PG8_BAR;
        PG8_WAIT_V(4); PG8_BAR;
        PG8_STAGE(PG8_SB(1, 0), cB + kstep, voffB); PG8_STAGE(PG8_SA(1, 0), cA + kstep, voffA); PG8_STAGE(PG8_SB(1, 1), cB + hstep + kstep, voffB);
        PG8_WAIT_V(6); PG8_BAR;
    }
    for (;;) {
        if constexpr (GATHER) { int rt_; if (S.peek_pm(ui + 1, rt_)) PG8_GLOOK(gN, ui + 1); }
        const bool has_next = S.next(ui + 1, nxt);
        const char* nA = (has_next && !GATHER) ? (const char*)g.A + (size_t)nxt.pm * tstep : cA; const char* nB = has_next ? (const char*)g.Bt + (size_t)nxt.pn * tstep : cB;
        for (int t = 0; t < nt; t += 2) {
            const bool last = (t == nt - 2);
            const char* a1 = cA + (size_t)(t + 1) * kstep;
            const char* a2 = last ? nA : cA + (size_t)(t + 2) * kstep; const char* b2 = last ? nB : cB + (size_t)(t + 2) * kstep;
            const char* a3 = a2 + kstep; const char* b3 = b2 + kstep;
            if (last && has_next) S.a_ready(nxt);
            unsigned o2[2][2] = {{gA[0][0], gA[0][1]}, {gA[1][0], gA[1][1]}};
            if constexpr (GATHER) { if (last) { asm volatile("" : "+v"(gN[0][0]), "+v"(gN[0][1]), "+v"(gN[1][0]), "+v"(gN[1][1]) :: "memory"); PG8_GOFF(o2, gN); } }
            if constexpr (SP2) {
            PG8_LDB(B0, 0, 0); PG8_LDB(B1, 0, 1); PG8_SCHED; PG8_LDA(At, 0, 0); PG8_STAGE_A(PG8_SA(1, 1), a1, 1, gA);
            PG8_WAIT_V(8); PG8_WAIT_L(0); PG8_BAR; PG8_MMA(0, 0, At, B0); PG8_MMA(0, 1, At, B1); PG8_BAR; PG8_SCHED;
            PG8_LDA(At, 0, 1); PG8_STAGE(PG8_SB(0, 0), b2, voffB); PG8_STAGE(PG8_SB(0, 1), b2 + hstep, voffB); PG8_STAGE_A(PG8_SA(0, 0), a2, 0, o2);
            PG8_WAIT_V(8); PG8_WAIT_L(0); PG8_BAR; PG8_MMA(1, 0, At, B0); PG8_MMA(1, 1, At, B1); PG8_BAR; PG8_SCHED;
            PG8_LDB(B0, 1, 0); PG8_LDB(B1, 1, 1); PG8_SCHED; PG8_LDA(At, 1, 0); PG8_STAGE_A(PG8_SA(0, 1), a2, 1, o2);
            PG8_WAIT_V(8); PG8_WAIT_L(0); PG8_BAR; PG8_MMA(0, 0, At, B0); PG8_MMA(0, 1, At, B1); PG8_BAR; PG8_SCHED;
            PG8_LDA(At, 1, 1); PG8_STAGE(PG8_SB(1, 0), b3, voffB); PG8_STAGE(PG8_SB(1, 1), b3 + hstep, voffB); PG8_STAGE_A(PG8_SA(1, 0), a3, 0, o2);
            PG8_WAIT_V(8); PG8_WAIT_L(0); PG8_BAR; PG8_MMA(1, 0, At, B0); PG8_MMA(1, 1, At, B1); PG8_BAR; PG8_SCHED;
            } else {
            PG8_LDB(B0, 0, 0); PG8_SCHED; PG8_LDA(At, 0, 0); PG8_STAGE(PG8_SA(1, 1), a1 + hstep, voffA);
            PG8_WAIT_L(8); PG8_BAR; PG8_WAIT_L(0); PG8_MMA(0, 0, At, B0); PG8_BAR; PG8_SCHED;
            PG8_LDB(B1, 0, 1); PG8_STAGE(PG8_SB(0, 0), b2, voffB);
            PG8_BAR; PG8_WAIT_L(0); PG8_MMA(0, 1, At, B1); PG8_BAR;
            PG8_LDA(At, 0, 1); PG8_STAGE(PG8_SA(0, 0), a2, voffA);
            PG8_BAR; PG8_WAIT_L(0); PG8_MMA(1, 0, At, B0); PG8_BAR; PG8_SCHED;
            PG8_STAGE(PG8_SB(0, 1), b2 + hstep, voffB);
            PG8_WAIT_V(6); PG8_BAR; PG8_MMA(1, 1, At, B1); PG8_BAR;
            PG8_LDB(B0, 1, 0); PG8_SCHED; PG8_LDA(At, 1, 0); PG8_STAGE(PG8_SA(0, 1), a2 + hstep, voffA);
            PG8_WAIT_L(8); PG8_BAR; PG8_WAIT_L(0); PG8_MMA(0, 0, At, B0); PG8_BAR; PG8_SCHED;
            PG8_LDB(B1, 1, 1); PG8_STAGE(PG8_SB(1, 0), b3, voffB);
            PG8_BAR; PG8_WAIT_L(0); PG8_MMA(0, 1, At, B1); PG8_BAR;
            PG8_LDA(At, 1, 1); PG8_STAGE(PG8_SA(1, 0), a3, voffA);
            PG8_BAR; PG8_WAIT_L(0); PG8_MMA(1, 0, At, B0); PG8_BAR; PG8_SCHED;
            PG8_STAGE(PG8_SB(1, 1), b3 + hstep, voffB);
            PG8_WAIT_V(6); PG8_BAR; PG8_MMA(1, 1, At, B1); PG8_BAR;
            }
        }
        if constexpr (ALIGN_EPI) { if (wr == 0) PG8_BAR; }
        if constexpr (!Epi::AFTER_DRAIN) { E(acc, cur, wr, wc, fr, fq); S.done(cur); }
        if (!has_next) break;
#pragma unroll
        for (int a = 0; a < 2; ++a)
#pragma unroll
            for (int b = 0; b < 2; ++b)
#pragma unroll
                for (int m = 0; m < 4; ++m)
#pragma unroll
                    for (int n = 0; n < 2; ++n) acc[a][b][m][n] = (f32x4){0.f, 0.f, 0.f, 0.f};
        cur = nxt; cA = nA; cB = nB; ++ui;
        if constexpr (GATHER) PG8_GOFF(gA, gN);
        if constexpr (ALIGN_EPI) { if (wr == 1) PG8_BAR; }
    }
    PG8_WAIT_V(0);
    if constexpr (!ALIGN_EPI) { if (wr == 0) PG8_BAR; }
    PG8_BAR;
    if constexpr (Epi::AFTER_DRAIN) { E.fused(acc, cur, wr, wc, fr, fq, lds, wid, lane); S.done(cur); }
#undef PG8_SA
#undef PG8_SB
#undef PG8_STAGE
#undef PG8_STAGE_A
#undef PG8_GLOOK
#undef PG8_GOFF
#undef PG8_LDA
#undef PG8_LDB
#undef PG8_MMA
#undef PG8_WAIT_V
#undef PG8_WAIT_L
#undef PG8_BAR
#undef PG8_SCHED
}
}

constexpr int GX_TILE = 133760, GX_ROWS = GX_TILE + 2240;
static_assert(GX_ROWS + 17 * 512 <= 147456 - 64, "grouped-GEMM LDS tables");
__device__ __forceinline__ void fg_gemm_in(PrmP p, int l, LAS unsigned char* lds, int wg, int nwg) {
    pg8::Gemm g{(const bf16_t*)(p->ws + WS_HB), (const bf16_t*)(p->ws + WS_WIN) + (size_t)l * NP * 1024, M, NP, 1024}; pg8::StaticOrder S; S.init(M, NP, nwg, wg);
    pg8::EpiBf16Plain E{(bf16_t*)(p->ws + WS_PB), NP};
    pg8::gemm_phase<pg8::EpiBf16Plain, pg8::StaticOrder, true, true>(lds, g, S, E);
}
__device__ __forceinline__ void fg_gemm_out(PrmP p, int l, LAS unsigned char* lds, int wg, int nwg) {
    pg8::Gemm g{(const bf16_t*)(p->ws + WS_YC), (const bf16_t*)(p->ws + WS_WOUT) + (size_t)l * 1024 * 1024, M, 1024, 1024}; pg8::StaticOrder S; S.init(M, 1024, nwg, wg);
    pg8::EpiBf16Plain E{(bf16_t*)(p->ws + WS_Y), 1024};
    pg8::gemm_phase<pg8::EpiBf16Plain, pg8::StaticOrder, true, true>(lds, g, S, E);
}
__device__ __forceinline__ void fg_gemm1(PrmP p, int l, LAS unsigned char* lds, int wg, int nwg) {
    const int nt = ((const int*)(p->ws + WS_CTL))[CW_NT];
    LAS int* tl = (LAS int*)(lds + GX_TILE); LAS unsigned short* rl = (LAS unsigned short*)(lds + GX_ROWS);
    pg8::GroupOrder S{nt, 8, nwg, wg, tl};
    { const int tid = fresh_tid(); const int* TE = (const int*)(p->ws + WS_MISC + MS_TILEE); const int* RT = (const int*)(p->ws + WS_MISC + MS_ROWTOK);
      __syncthreads();
      for (int i = tid; i < nt; i += NTHREADS) tl[i] = TE[i];
      { int rv[17];
#pragma unroll
        for (int ui = 0; ui < 17; ++ui) { int rt; rv[ui] = (S.peek_pm(ui, rt) && tid < 256) ? RT[rt * 256 + tid] : 0; }
#pragma unroll
        for (int ui = 0; ui < 17; ++ui) if (tid < 256) rl[ui * 256 + tid] = (unsigned short)rv[ui]; }
      __syncthreads(); }
    if (EXPERT_FP8) {
        pg8::Gemm g{(const bf16_t*)(p->ws + WS_HB), (const bf16_t*)(p->ws + WS_WGU + (size_t)l * NE * 2048 * 1024), RP, NE * 2048, 512, rl};
        pg8::EpiSwiglu8 E{p->ws + WS_H1, p->in[I_BGU] + (size_t)l * NE * 2048};
        pg8::gemm_phase<pg8::EpiSwiglu8, pg8::GroupOrder, true, true, 119, true>(lds, g, S, E);
    } else {
    pg8::Gemm g{(const bf16_t*)(p->ws + WS_XS), (const bf16_t*)(p->ws + WS_WGU) + (size_t)l * NE * 2048 * 1024, RP, NE * 2048, 1024};
    pg8::EpiSwiglu E{(bf16_t*)(p->ws + WS_H1), p->in[I_BGU] + (size_t)l * NE * 2048};
    pg8::gemm_phase<pg8::EpiSwiglu, pg8::GroupOrder, true, true>(lds, g, S, E);
    }
}
__device__ __forceinline__ void fg_gemm2(PrmP p, int l, LAS unsigned char* lds, int wg, int nwg) {
    const int nt = ((const int*)(p->ws + WS_CTL))[CW_NT];
    LAS int* tl = (LAS int*)(lds + GX_TILE);
    { const int tid = fresh_tid(); const int* TE = (const int*)(p->ws + WS_MISC + MS_TILEE); __syncthreads(); for (int i = tid; i < nt; i += NTHREADS) tl[i] = TE[i]; __syncthreads(); }
    pg8::GroupOrder S{nt, 4, nwg, wg, tl};
    pg8::EpiDown E{(bf16_t*)(p->ws + WS_YR), p->in[I_BDN] + (size_t)l * NE * 1024};
    if (EXPERT_FP8) {
        pg8::Gemm g{(const bf16_t*)(p->ws + WS_H1), (const bf16_t*)(p->ws + WS_WDN + (size_t)l * NE * 1024 * 1024), RP, NE * 1024, 512};
        if (YR_FP8) { pg8::EpiDown8 E8{p->ws + WS_YR, p->in[I_BDN] + (size_t)l * NE * 1024}; pg8::gemm_phase<pg8::EpiDown8, pg8::GroupOrder, true, true, 120>(lds, g, S, E8); }
        else pg8::gemm_phase<pg8::EpiDown, pg8::GroupOrder, true, true, 120>(lds, g, S, E);
    } else {
    pg8::Gemm g{(const bf16_t*)(p->ws + WS_H1), (const bf16_t*)(p->ws + WS_WDN) + (size_t)l * NE * 1024 * 1024, RP, NE * 1024, 1024};
    pg8::gemm_phase<pg8::EpiDown, pg8::GroupOrder, true, true>(lds, g, S, E);
    }
}

#include <hip/hip_bf16.h>
#include <cmath>
namespace attn_body {
using bf16=__hip_bfloat16;
using bf16x8=__attribute__((ext_vector_type(8)))short;
using s16x4=__attribute__((ext_vector_type(4)))short;
using f32x16=__attribute__((ext_vector_type(16)))float;
using u32x4=__attribute__((ext_vector_type(4)))unsigned;
constexpr int BATCH=4,NHEAD=8,SEQ=8192,D=64,DM=2560;
constexpr int NW=8,QBLK=32,QB=QBLK*NW,KVBLK=64,NQB=SEQ/QB;
constexpr int ATTN_PITCH=DM, ATTN_UNIT_ROWS=QB;
__device__ __forceinline__ int crow(int r,int hi){return (r&3)+8*(r>>2)+4*hi;}
#define SBAR() __builtin_amdgcn_sched_barrier(0)
__device__ __forceinline__ void cmask(f32x16&p0,f32x16&p1,int jb,int qrel,int hi){
  const float NEG=-INFINITY; int kb=64*jb+4*hi;
  #pragma unroll
  for(int r=0;r<16;++r){int kv=kb+(r&3)+8*(r>>2); if(kv>qrel)p0[r]=NEG; if(kv+32>qrel)p1[r]=NEG;}
}

constexpr int NSLOT=3, SLOTB=8192;
constexpr int LDS_K=0, LDS_V=NSLOT*SLOTB, LDS_WS=2*NSLOT*SLOTB, LDS_OST=LDS_WS+NW*64*4, LDS_BYTES=LDS_OST+NW*4096;
constexpr float C2=0.125f*1.4426950408889634f;
__device__ __forceinline__ void glds16(const void*gsrc,unsigned lds_dst){unsigned keep;
  asm volatile("s_mov_b32 %0, m0\n\ts_mov_b32 m0, %2\n\ts_nop 0\n\tglobal_load_lds_dwordx4 %1, off\n\ts_mov_b32 m0, %0":"=&s"(keep):"v"(gsrc),"s"(lds_dst):"memory");}
__device__ __forceinline__ float max3f(float a,float b,float c){float r;asm("v_max3_f32 %0, %1, %2, %3":"=v"(r):"v"(a),"v"(b),"v"(c));return r;}
__device__ __forceinline__ float max2f(float a,float b){float r;asm("v_max_f32_e32 %0, %1, %2":"=v"(r):"v"(a),"v"(b));return r;}
__device__ __forceinline__ float fadd_s(float a,float b){float r;asm("v_add_f32_e32 %0, %1, %2":"=v"(r):"v"(a),"v"(b));return r;}
__device__ __forceinline__ float fsub_s(float a,float b){float r;asm("v_sub_f32_e32 %0, %1, %2":"=v"(r):"v"(a),"v"(b));return r;}
typedef float f32x2_t __attribute__((ext_vector_type(2))); typedef __bf16 bf16x2_t __attribute__((ext_vector_type(2)));
__device__ __forceinline__ unsigned cvtpk_s(float lo,float hi){f32x2_t v={lo,hi};bf16x2_t b=__builtin_convertvector(v,bf16x2_t);return __builtin_bit_cast(unsigned,b);}
__device__ __forceinline__ unsigned f2bf(float f) { return pk2(f, 0.f) & 0xffffu; }
#define WAIT_BAR(N) asm volatile("s_waitcnt vmcnt(" #N ") lgkmcnt(0)\n\ts_barrier":::"memory")

typedef __attribute__((address_space(3))) const float* lds_fptr;
__device__ __forceinline__ void split3(float f,unsigned&hb,unsigned&mb,unsigned&lb){
  hb=__float_as_uint(f)&0xffff0000u; const float r1=f-__uint_as_float(hb); mb=__float_as_uint(r1)&0xffff0000u; const float r2=r1-__uint_as_float(mb); lb=__float_as_uint(r2)&0xffff0000u; }
__device__ __forceinline__ bf16x8 mk_kx(float fk,int hi){ unsigned hb,mb,lb; split3(-fk,hb,mb,lb);
  u32x4 w; w.x=0x3f803f80u; w.y=hi?0x00003f80u:(0x00003f80u|hb); w.z=hi?0u:((mb>>16)|lb); w.w=0u; return __builtin_bit_cast(bf16x8,w); }
__device__ __forceinline__ bf16x8 mk_qx(float fq,float mhat,int hi){ unsigned hb,mb,lb; split3(hi?-mhat:fq,hb,mb,lb);
  u32x4 w; w.x=(hb>>16)|mb; w.y=hi?(lb>>16):((lb>>16)|0x3f800000u); w.z=hi?0u:0x3f803f80u; w.w=0u; return __builtin_bit_cast(bf16x8,w); }
__device__ __forceinline__ void qkt(f32x16&p0,f32x16&p1,const char*Kslot,const bf16x8*qr,bf16x8 kxa,bf16x8 kxb,bf16x8 qx,int r32,int hi){
  const f32x16 zc=f32x16{};
  const char*kb=Kslot+hi*1024+r32*16;
  #pragma unroll
  for(int d0=0;d0<4;++d0){
    const bf16x8 b0=*reinterpret_cast<const bf16x8*>(kb+d0*2048);
    const bf16x8 b1=*reinterpret_cast<const bf16x8*>(kb+d0*2048+512);
    if(d0==0){p0=__builtin_amdgcn_mfma_f32_32x32x16_bf16(b0,qr[0],zc,0,0,0);p1=__builtin_amdgcn_mfma_f32_32x32x16_bf16(b1,qr[0],zc,0,0,0);}
    else{p0=__builtin_amdgcn_mfma_f32_32x32x16_bf16(b0,qr[d0],p0,0,0,0);p1=__builtin_amdgcn_mfma_f32_32x32x16_bf16(b1,qr[d0],p1,0,0,0);}}
  p0=__builtin_amdgcn_mfma_f32_32x32x16_bf16(kxa,qx,p0,0,0,0);p1=__builtin_amdgcn_mfma_f32_32x32x16_bf16(kxb,qx,p1,0,0,0);
}
typedef __attribute__((address_space(3))) const char* lds_cptr;
typedef short v4i16_t __attribute__((ext_vector_type(4)));
__device__ __forceinline__ void kload8(bf16x8*kf,lds_cptr kp){
  kf[0]=*(const __attribute__((address_space(3))) bf16x8*)(kp);      kf[1]=*(const __attribute__((address_space(3))) bf16x8*)(kp+512);
  kf[2]=*(const __attribute__((address_space(3))) bf16x8*)(kp+2048); kf[3]=*(const __attribute__((address_space(3))) bf16x8*)(kp+2560);
  kf[4]=*(const __attribute__((address_space(3))) bf16x8*)(kp+4096); kf[5]=*(const __attribute__((address_space(3))) bf16x8*)(kp+4608);
  kf[6]=*(const __attribute__((address_space(3))) bf16x8*)(kp+6144); kf[7]=*(const __attribute__((address_space(3))) bf16x8*)(kp+6656);
}
__device__ __forceinline__ void kload2(bf16x8*kf,lds_cptr kp,int j){ kf[2*j]=*(const __attribute__((address_space(3))) bf16x8*)(kp+j*2048); kf[2*j+1]=*(const __attribute__((address_space(3))) bf16x8*)(kp+j*2048+512); }
__device__ __forceinline__ s16x4 vtr(lds_cptr p){ return __builtin_bit_cast(s16x4,__builtin_amdgcn_ds_read_tr16_b64_v4i16((__attribute__((address_space(3))) v4i16_t*)p)); }
__device__ __forceinline__ float rowmax(const f32x16&p0,const f32x16&p1){
  float a=max3f(p0[0],p0[1],p1[0]),b=max3f(p0[2],p0[3],p1[1]);a=max3f(a,p1[2],p1[3]);
  #pragma unroll
  for(int r=4;r<16;r+=4){a=max3f(a,p0[r],p0[r+1]);b=max3f(b,p0[r+2],p0[r+3]);a=max3f(a,p1[r],p1[r+1]);b=max3f(b,p1[r+2],p1[r+3]);}
  const float m=max2f(a,b);
  auto rr=__builtin_amdgcn_permlane32_swap(__float_as_uint(m),__float_as_uint(m),false,false);
  return max2f(__uint_as_float(rr[0]),__uint_as_float(rr[1]));
}
__device__ __forceinline__ void pv(f32x16*o,int vb,bf16x8 pa0,bf16x8 pa1,bf16x8 pa2,bf16x8 pa3){
  #pragma unroll
  for(int d0=0;d0<2;++d0){s16x4 lo[4],hi[4];
    #pragma unroll
    for(int ks=0;ks<4;++ks){
      asm volatile("ds_read_b64_tr_b16 %0,%1 offset:%c2":"=&v"(lo[ks]):"v"(vb),"i"(d0*4096+ks*1024):"memory");
      asm volatile("ds_read_b64_tr_b16 %0,%1 offset:%c2":"=&v"(hi[ks]):"v"(vb),"i"(d0*4096+ks*1024+512):"memory");}
    asm volatile("s_waitcnt lgkmcnt(0)":::"memory");SBAR();
    #define PK(k) (bf16x8){lo[k][0],lo[k][1],lo[k][2],lo[k][3],hi[k][0],hi[k][1],hi[k][2],hi[k][3]}
    o[d0]=__builtin_amdgcn_mfma_f32_32x32x16_bf16(pa0,PK(0),o[d0],0,0,0);
    o[d0]=__builtin_amdgcn_mfma_f32_32x32x16_bf16(pa1,PK(1),o[d0],0,0,0);
    o[d0]=__builtin_amdgcn_mfma_f32_32x32x16_bf16(pa2,PK(2),o[d0],0,0,0);
    o[d0]=__builtin_amdgcn_mfma_f32_32x32x16_bf16(pa3,PK(3),o[d0],0,0,0);
    #undef PK
  }
}

#ifndef ATTN_STORE16
#define ATTN_STORE16(p,v) (*(u32x4*)(p)=(v))
#endif
template<int THRL> __device__ __forceinline__ void attn_unit(int b,int h,int qb,const bf16*Q,const bf16*__restrict__ K,const bf16*__restrict__ V,bf16*O,char*shm,lds_fptr F2s,int tstart,float kmx){
  const int tid=::fresh_tid(),lane=tid&63,r32=lane&31,hi=lane>>5; const int wid=__builtin_amdgcn_readfirstlane(tid>>6);
  const long rowbase=(long)b*SEQ; const int q0=qb*QB;
  const bf16*Qw=Q+(rowbase+q0+wid*QBLK)*DM+h*D;
  const bf16*Kh=K+(rowbase+(long)tstart*KVBLK)*DM+h*D,*Vh=V+(rowbase+(long)tstart*KVBLK)*DM+h*D; const lds_fptr F2k=F2s+tstart*KVBLK;
  const unsigned lds0=(unsigned)(uintptr_t)shm;
  float*wsf=(float*)(shm+LDS_WS)+wid*64;
  const bf16*ksrc=Kh+(long)lane*DM+wid*8;
  const bf16*vsrc=Vh+(long)(16*(wid&3)+(lane>>2))*DM+(wid>>2)*32+(lane&3)*8;
  const unsigned kdst=lds0+LDS_K+wid*1024, vdst=lds0+LDS_V+wid*1024;
  #define DMA_K(t,slot) glds16(ksrc+(long)(t)*KVBLK*DM,(unsigned)__builtin_amdgcn_readfirstlane(kdst+(slot)))
  #define DMA_V(t,slot) glds16(vsrc+(long)(t)*KVBLK*DM,(unsigned)__builtin_amdgcn_readfirstlane(vdst+(slot)))
  const int vb0=(int)(lds0+LDS_V)+((lane>>4)&1)*32+(lane&3)*8+(4*hi+((lane&15)>>2))*64;
  const char*Kbase=shm+LDS_K; bf16x8 kf[8];
  const lds_cptr shm3=(lds_cptr)shm; const lds_cptr kp0=shm3+LDS_K+hi*1024+r32*16; const lds_cptr vp0=shm3+LDS_V+((lane>>4)&1)*32+(lane&3)*8+(4*hi+((lane&15)>>2))*64;
  const int NT=(q0+QB)/KVBLK-tstart;
  DMA_K(0,0);DMA_V(0,0);DMA_K(1,SLOTB);
  bf16x8 qr[4];
  #pragma unroll
  for(int d0=0;d0<4;++d0)qr[d0]=*reinterpret_cast<const bf16x8*>(&Qw[(long)r32*DM+d0*16+hi*8]);
  float m0; { float qq=0.f;
    #pragma unroll
    for(int d0=0;d0<4;++d0){const u32x4 w_=__builtin_bit_cast(u32x4,qr[d0]);
      #pragma unroll
      for(int j_=0;j_<4;++j_){const float a_=__uint_as_float(w_[j_]<<16),b_=__uint_as_float(w_[j_]&0xffff0000u);qq+=a_*a_+b_*b_;}}
    qq+=__shfl_xor(qq,32); m0=sqrtf(qq)*kmx+1.f; }
  float l_reg=0.f;f32x16 o[2];o[0]=f32x16{};o[1]=f32x16{};const f32x16 zc=f32x16{};
  const float fq_=F2s[q0+wid*QBLK+r32]; const bf16x8 qx=mk_qx(fq_,m0,hi);
  const int qrel=wid*QBLK+r32;
  #define CMASK(P0,P1,t) do{int jb_=(t)-(NT-4); if(jb_>=0)cmask(P0,P1,jb_,qrel,hi);}while(0)
  #define START(P0,P1) do{ _Pragma("unroll") for(int r=0;r<16;++r)P0[r]=__builtin_amdgcn_exp2f(P0[r]); }while(0)
  #define RESC() do{}while(0)
  f32x16 pA0,pA1,pB0,pB1;
  int sl_prev=0,sl_cur=0,sl_next=SLOTB;
  #define ROT() do{sl_prev=sl_cur;sl_cur=sl_next;sl_next=(sl_next==(NSLOT-1)*SLOTB)?0:sl_next+SLOTB;}while(0)
  DMA_K(2,2*SLOTB);
  WAIT_BAR(3);
  qkt(pA0,pA1,Kbase,qr,mk_kx(F2k[r32],hi),mk_kx(F2k[32+r32],hi),qx,r32,hi);asm volatile("s_nop 15\n\ts_nop 7":"+v"(pA0),"+v"(pA1));CMASK(pA0,pA1,0);
  START(pA0,pA1);
  _Pragma("unroll") for(int r=0;r<16;++r)pA1[r]=__builtin_amdgcn_exp2f(pA1[r]);
  WAIT_BAR(0);
  DMA_K(3,0);DMA_V(1,SLOTB);
  ROT();
  kload8(kf,kp0+sl_cur);
  WAIT_BAR(2);
  s16x4 vlo[8],vhi[8]; u32x4 pw0,pw1,pw2,pw3;
  #define PKW(P,B) cvtpk_s(P[B],P[B+1])
  #define PAF(k) __builtin_bit_cast(bf16x8,pw##k)
  #define VFR(i) (bf16x8){vlo[i][0],vlo[i][1],vlo[i][2],vlo[i][3],vhi[i][0],vhi[i][1],vhi[i][2],vhi[i][3]}
  #define PIN(x) asm volatile("":"+v"(x))
  #define MX3(a,b,c) __builtin_fmaxf(__builtin_fmaxf((a),(b)),(c))
  #define GAPA(MF,A0,A1,A2,A3,W0,W1,PW) do{ MF; sacc+=A0; sacc+=A1; sacc+=A2; sacc+=A3; PIN(sacc); W0; W1; PIN(PW); SBAR(); }while(0)
  #define EX(v) __builtin_amdgcn_exp2f(v)
  #define GAPB(MF,X,B) do{ MF; X[B]=EX(X[B]); X[B+1]=EX(X[B+1]); X[B+2]=EX(X[B+2]); X[B+3]=EX(X[B+3]); PIN(X); SBAR(); }while(0)
  #define VRD(i) do{ vlo[i]=vtr(vp_+(((i)>>2)*4096+((i)&3)*1024)); vhi[i]=vtr(vp_+(((i)>>2)*4096+((i)&3)*1024+512)); }while(0)
  #define KRD(G,j) do{ if(G){ kload2(kf,kp0+sl_next,j); SBAR(); } }while(0)
  #define STEP(C0,C1,P0,P1,t,GK,GV,GL) do{ const float fka_=F2k[(t)*KVBLK+r32],fkb_=F2k[(t)*KVBLK+32+r32]; SBAR(); \
    const lds_cptr vp_=vp0+sl_prev; \
    VRD(0); SBAR(); float sacc=(P0[0]+P0[1]); \
    GAPA(C0=__builtin_amdgcn_mfma_f32_32x32x16_bf16(kf[0],qr[0],zc,0,0,0), P0[2],P0[3],P0[4],P0[5],     pw0[0]=PKW(P0,0), pw0[1]=PKW(P0,2), pw0); \
    VRD(4); SBAR(); GAPA(C1=__builtin_amdgcn_mfma_f32_32x32x16_bf16(kf[1],qr[0],zc,0,0,0), P0[6],P0[7],P0[8],P0[9],     pw0[2]=PKW(P0,4), pw0[3]=PKW(P0,6), pw0); \
    VRD(1); SBAR(); GAPA(C0=__builtin_amdgcn_mfma_f32_32x32x16_bf16(kf[2],qr[1],C0,0,0,0),   P0[10],P0[11],P0[12],P0[13], pw1[0]=PKW(P0,8), pw1[1]=PKW(P0,10), pw1); \
    VRD(5); SBAR(); GAPA(C1=__builtin_amdgcn_mfma_f32_32x32x16_bf16(kf[3],qr[1],C1,0,0,0),   P0[14],P0[15],P1[0],P1[1],   pw1[2]=PKW(P0,12),pw1[3]=PKW(P0,14), pw1); \
    VRD(2); SBAR(); GAPA(C0=__builtin_amdgcn_mfma_f32_32x32x16_bf16(kf[4],qr[2],C0,0,0,0),   P1[2],P1[3],P1[4],P1[5],     pw2[0]=PKW(P1,0), pw2[1]=PKW(P1,2), pw2); \
    VRD(6); SBAR(); GAPA(C1=__builtin_amdgcn_mfma_f32_32x32x16_bf16(kf[5],qr[2],C1,0,0,0),   P1[6],P1[7],P1[8],P1[9],     pw2[2]=PKW(P1,4), pw2[3]=PKW(P1,6), pw2); \
    VRD(3); SBAR(); GAPA(C0=__builtin_amdgcn_mfma_f32_32x32x16_bf16(kf[6],qr[3],C0,0,0,0),   P1[10],P1[11],P1[12],P1[13], pw3[0]=PKW(P1,8), pw3[1]=PKW(P1,10), pw3); \
    VRD(7); SBAR(); GAPA(C1=__builtin_amdgcn_mfma_f32_32x32x16_bf16(kf[7],qr[3],C1,0,0,0),   P1[14],P1[15],0.f,0.f,       pw3[2]=PKW(P1,12),pw3[3]=PKW(P1,14), pw3); \
    { C0=__builtin_amdgcn_mfma_f32_32x32x16_bf16(mk_kx(fka_,hi),qx,C0,0,0,0); SBAR(); C1=__builtin_amdgcn_mfma_f32_32x32x16_bf16(mk_kx(fkb_,hi),qx,C1,0,0,0); } \
    l_reg+=sacc; \
    if(GK){DMA_K((t)+3,sl_cur);} if(GV){DMA_V((t)+1,sl_next);} \
    CMASK(C0,C1,t); \
    SBAR(); \
    GAPB(o[0]=__builtin_amdgcn_mfma_f32_32x32x16_bf16(PAF(0),VFR(0),o[0],0,0,0), C0,0); \
    GAPB(o[1]=__builtin_amdgcn_mfma_f32_32x32x16_bf16(PAF(0),VFR(4),o[1],0,0,0), C0,4); \
    KRD(GL,0); GAPB(o[0]=__builtin_amdgcn_mfma_f32_32x32x16_bf16(PAF(1),VFR(1),o[0],0,0,0), C0,8); \
    KRD(GL,1); GAPB(o[1]=__builtin_amdgcn_mfma_f32_32x32x16_bf16(PAF(1),VFR(5),o[1],0,0,0), C0,12); \
    KRD(GL,2); GAPB(o[0]=__builtin_amdgcn_mfma_f32_32x32x16_bf16(PAF(2),VFR(2),o[0],0,0,0), C1,0); \
    KRD(GL,3); GAPB(o[1]=__builtin_amdgcn_mfma_f32_32x32x16_bf16(PAF(2),VFR(6),o[1],0,0,0), C1,4); \
    GAPB(o[0]=__builtin_amdgcn_mfma_f32_32x32x16_bf16(PAF(3),VFR(3),o[0],0,0,0), C1,8); \
    GAPB(o[1]=__builtin_amdgcn_mfma_f32_32x32x16_bf16(PAF(3),VFR(7),o[1],0,0,0), C1,12); \
    }while(0)
  int t=1;
  #undef CMASK
  #define CMASK(P0,P1,t) do{}while(0)
  for(;t+5<NT;t+=2){
    STEP(pB0,pB1,pA0,pA1,t,true,true,true);     WAIT_BAR(2); RESC(); ROT();
    STEP(pA0,pA1,pB0,pB1,t+1,true,true,true);   WAIT_BAR(2); RESC(); ROT();
  }
  #undef CMASK
  #define CMASK(P0,P1,t) do{int jb_=(t)-(NT-4); if(jb_>=0)cmask(P0,P1,jb_,qrel,hi);}while(0)
  #define ENDW(tt) do{ if((tt)+3<NT){WAIT_BAR(2);} else if((tt)+2<NT){WAIT_BAR(1);} else {WAIT_BAR(0);} }while(0)
  for(;t+1<NT;t+=2){
    STEP(pB0,pB1,pA0,pA1,t,(t+3<NT),(t+1<NT),(t+1<NT));       ENDW(t);   RESC(); ROT();
    STEP(pA0,pA1,pB0,pB1,t+1,(t+4<NT),(t+2<NT),(t+2<NT));     ENDW(t+1); RESC(); ROT();
  }
  STEP(pB0,pB1,pA0,pA1,NT-1,false,false,false); RESC();
  { float sacc=pB0[0]+pB0[1]; _Pragma("unroll") for(int r=2;r<16;++r)sacc+=pB0[r]; _Pragma("unroll") for(int r=0;r<16;++r)sacc+=pB1[r]; l_reg+=sacc;
    pw0=(u32x4){PKW(pB0,0),PKW(pB0,2),PKW(pB0,4),PKW(pB0,6)};pw1=(u32x4){PKW(pB0,8),PKW(pB0,10),PKW(pB0,12),PKW(pB0,14)};pw2=(u32x4){PKW(pB1,0),PKW(pB1,2),PKW(pB1,4),PKW(pB1,6)};pw3=(u32x4){PKW(pB1,8),PKW(pB1,10),PKW(pB1,12),PKW(pB1,14)};
    SBAR(); pv(o,vb0+sl_cur,PAF(0),PAF(1),PAF(2),PAF(3)); }
  #undef PKW
  #undef PAF
  #undef VFR
  #undef PIN
  #undef MX3
  #undef GAPA
  #undef GAPB
  #undef EX
  #undef VRD
  #undef KRD
  #undef STEP
  #undef ENDW
  {auto rr=__builtin_amdgcn_permlane32_swap(__float_as_uint(l_reg),__float_as_uint(l_reg),false,false);l_reg=__uint_as_float(rr[0])+__uint_as_float(rr[1]);}
  if(hi==0)wsf[32+r32]=l_reg;asm volatile("s_waitcnt lgkmcnt(0)":::"memory");
  float rli[16];
  #pragma unroll
  for(int r=0;r<16;++r)rli[r]=__builtin_amdgcn_rcpf(wsf[32+crow(r,hi)]);
  bf16*Ow=O+(rowbase+q0+wid*QBLK)*DM+h*D;
  { bf16*stg=(bf16*)(shm+LDS_OST)+wid*2048;
    #pragma unroll
    for(int r=0;r<16;++r){const int orow=crow(r,hi);
      #pragma unroll
      for(int d0=0;d0<2;++d0)stg[orow*64+d0*32+r32]=__float2bfloat16(o[d0][r]*rli[r]);}
    asm volatile("s_waitcnt lgkmcnt(0)":::"memory");
    #pragma unroll
    for(int i=0;i<4;++i){const int row=i*8+(lane>>3),ch=lane&7; const u32x4 v=*(const u32x4*)(stg+row*64+ch*8); ATTN_STORE16(Ow+(long)row*DM+ch*8,v);} }
  asm volatile("s_waitcnt lgkmcnt(0)\n\ts_barrier":::"memory");
  #undef DMA_K
  #undef DMA_V
  #undef CMASK
  #undef START
  #undef RESC
  #undef ROT
}
constexpr int ATTN_LDS_BYTES=LDS_BYTES;
#undef SBAR
#undef WAIT_BAR
}

constexpr int ATT_F2_OFF = 86016, ATT_SCN_OFF = ATT_F2_OFF + 32768;
static_assert(attn_body::ATTN_LDS_BYTES <= ATT_F2_OFF && ATT_SCN_OFF + 64 <= 131072, "attention LDS map");
__device__ __forceinline__ void f2_items(PrmP p, int l, LAS unsigned char* lds, int wg, int nwg) {
    const int tid = fresh_tid(), lane = tid & 63, wave = tid >> 6;
    LAS float* scn = (LAS float*)(lds + ATT_SCN_OFF);
    const bf16_t* PB = (const bf16_t*)(p->ws + WS_PB); float* F2G = (float*)(p->ws + WS_FC2);
    for (int bh = wg; bh < 32; bh += nwg) { const int b = bh >> 3, hh = bh & 7;
        const float fb = p->in[I_FOXFB][l * 8 + hh];
        float loc[16]; float run = 0.f;
#pragma unroll
        for (int i = 0; i < 16; ++i) { const float z = bf2f(PB[(size_t)(b * T + tid * 16 + i) * NP + C_F + hh]) + fb;
            run += -(fmaxf(-z, 0.f) + __logf(1.f + __expf(-fabsf(z)))) * LOG2E; loc[i] = run; }
        float incl = run;
#pragma unroll
        for (int o = 1; o < 64; o <<= 1) { const float v = __shfl_up(incl, o); if (lane >= o) incl += v; }
        __syncthreads();
        if (lane == 63) scn[wave] = incl;
        __syncthreads();
        float base = incl - run;
        for (int w = 0; w < wave; ++w) base += scn[w];
#pragma unroll
        for (int i = 0; i < 16; ++i) F2G[(size_t)bh * T + tid * 16 + i] = base + loc[i];
    }
}
__device__ __forceinline__ void fa_attn(PrmP p, int l, LAS unsigned char* lds, int wg, int nwg) {
    const int tid = fresh_tid();
    if (nwg != 256) return;
    LAS float* F2s = (LAS float*)(lds + ATT_F2_OFF);
    LAS int* work = (LAS int*)(lds + ATT_SCN_OFF); LAS int* tst = work + 1024; LAS int* mine = tst + 1024;
    const float* F2G = (const float*)(p->ws + WS_FC2);
    __syncthreads();
    const unsigned* CT = (const unsigned*)(p->ws + WS_CTL);
#pragma unroll
    for (int k = 0; k < 8; ++k) { const int i = tid + 512 * k; F2s[i] = F2G[(size_t)(i >> 7) * T + (i & 127) * 64 + 63];
        F2s[4096 + i] = sqrtf(__uint_as_float(__hip_atomic_load(CT + CW_KT + l * 4096 + i, __ATOMIC_RELAXED, __HIP_MEMORY_SCOPE_AGENT))); }
    __syncthreads();
#pragma unroll
    for (int k = 0; k < 2; ++k) { const int u = tid + 512 * k, bh = u >> 5, qb = u & 31;
        const unsigned* NRM = (const unsigned*)(p->ws + WS_CTL) + CW_NRM + (l * 32 + bh) * 2;
        const float qn = sqrtf(__uint_as_float(__hip_atomic_load(NRM, __ATOMIC_RELAXED, __HIP_MEMORY_SCOPE_AGENT))), kn = sqrtf(__uint_as_float(__hip_atomic_load(NRM + 1, __ATOMIC_RELAXED, __HIP_MEMORY_SCOPE_AGENT)));
        (void)qn; (void)kn;
        const float qI = sqrtf(__uint_as_float(__hip_atomic_load(CT + CW_QN + (l * 32 + bh) * 32 + qb, __ATOMIC_RELAXED, __HIP_MEMORY_SCOPE_AGENT)));
        const float kI = fmaxf(fmaxf(F2s[4096 + bh * 128 + 4 * qb], F2s[4096 + bh * 128 + 4 * qb + 1]), fmaxf(F2s[4096 + bh * 128 + 4 * qb + 2], F2s[4096 + bh * 128 + 4 * qb + 3]));
        const float base = F2G[(size_t)bh * T + qb * 256] + 160.f + qI * kI;
        int ts = 0; bool ok = true;
        for (int J = 0; J < 4 * qb; ++J) { ok = ok && (F2s[bh * 128 + J] > base + qI * F2s[4096 + bh * 128 + J]); ts = (ok && (J & 1)) ? J + 1 : ts; }
        tst[u] = ts; work[u] = 4 * (qb + 1) - ts; }
    if (tid < 4) mine[tid] = 0;
    __syncthreads();
    { const int ua = tid, ub = tid + 512; const int wa = work[ua], wb = work[ub]; int ra = 0, rb = 0;
      typedef int i32x4_ __attribute__((ext_vector_type(4)));
      const int ka = wa * 1024 + (1023 - ua), kb = wb * 1024 + (1023 - ub);
#pragma unroll 4
      for (int v = 0; v < 1024; v += 4) { const i32x4_ w4 = *(const LAS i32x4_*)(work + v);
#pragma unroll
          for (int q = 0; q < 4; ++q) { const int kv = w4[q] * 1024 + (1023 - (v + q)); ra += (kv > ka) ? 1 : 0; rb += (kv > kb) ? 1 : 0; } }
      const int t0 = wg, t1 = 511 - wg, t2 = 512 + wg, t3 = 1023 - wg;
      if (ra == t0) mine[0] = ua; if (ra == t1) mine[1] = ua; if (ra == t2) mine[2] = ua; if (ra == t3) mine[3] = ua;
      if (rb == t0) mine[0] = ub; if (rb == t1) mine[1] = ub; if (rb == t2) mine[2] = ub; if (rb == t3) mine[3] = ub; }
    __syncthreads();
    const unsigned* NRMB = (const unsigned*)(p->ws + WS_CTL) + CW_NRM + l * 64;
    attn_body::bf16* pb = (attn_body::bf16*)(p->ws + WS_PB);
#pragma unroll 1
    for (int k = 0; k < 4; ++k) { const int u = __builtin_amdgcn_readfirstlane(mine[k]), bh = u >> 5, qb = u & 31, ts_u = __builtin_amdgcn_readfirstlane(tst[u]);
        __syncthreads();
#pragma unroll
        for (int i = 0; i < 4; ++i) *(LAS f32x4*)(F2s + tid * 4 + 2048 * i) = *(const f32x4*)(F2G + (size_t)bh * T + tid * 4 + 2048 * i);
        __syncthreads();
        const float m0 = sqrtf(__uint_as_float(__hip_atomic_load(NRMB + bh * 2 + 1, __ATOMIC_RELAXED, __HIP_MEMORY_SCOPE_AGENT)));
        attn_body::attn_unit<8>(bh >> 3, bh & 7, qb, pb + C_Q, pb + C_K, pb + C_V, pb + C_Q, (char*)lds, (attn_body::lds_fptr)F2s, ts_u, m0);
    }
}

typedef float f32x16 __attribute__((ext_vector_type(16)));
struct S5M { float ar[2], ai[2], a16r[2], a16i[2]; bf16x8 bfr[4]; };
__device__ __forceinline__ int tau32(int i) { return 16 * ((i >> 2) & 1) + 4 * (i >> 3) + (i & 3); }
__device__ __forceinline__ void s5m_setup(PrmP p, int l, int g, int lane, S5M& c) {
    const int nl = lane & 31, hi = lane >> 5;
    const float dt = expf(p->in[I_S5LOGDT][l * 16 + g]);
    u32x4 fre[2], fim[2];
#pragma unroll
    for (int s = 0; s < 2; ++s) { const int pi = 32 * s + nl;
        const float are = p->in[I_S5ARE][(l * 16 + g) * 64 + pi], aim = p->in[I_S5AIM][(l * 16 + g) * 64 + pi];
        const float mag = expf(are * dt); const float th = aim * dt * 0.3183098861837907f; const float abr = mag * cospif(th), abi = mag * sinpif(th);
        const float den = are * are + aim * aim, nre = abr - 1.f;
        const float kre = (nre * are + abi * aim) / den, kim = (abi * are - nre * aim) / den;
        c.ar[s] = abr; c.ai[s] = abi;
        float pr = abr, pi_ = abi;
#pragma unroll
        for (int q = 0; q < 4; ++q) { const float nr = pr * pr - pi_ * pi_, ni = 2.f * pr * pi_; pr = nr; pi_ = ni; }
        c.a16r[s] = pr; c.a16i[s] = pi_;
        const float* brp = p->in[I_S5BRE] + ((size_t)(l * 16 + g) * 64 + pi) * 16 + 8 * hi; const float* bip = p->in[I_S5BIM] + ((size_t)(l * 16 + g) * 64 + pi) * 16 + 8 * hi;
        const f32x4 br0 = *(const f32x4*)brp, br1 = *(const f32x4*)(brp + 4), bi0 = *(const f32x4*)bip, bi1 = *(const f32x4*)(bip + 4);
        const f32x4 re0 = br0 * kre - bi0 * kim, re1 = br1 * kre - bi1 * kim, im0 = bi0 * kre + br0 * kim, im1 = bi1 * kre + br1 * kim;
        fre[s] = (u32x4){pk2(re0.x, re0.y), pk2(re0.z, re0.w), pk2(re1.x, re1.y), pk2(re1.z, re1.w)};
        fim[s] = (u32x4){pk2(im0.x, im0.y), pk2(im0.z, im0.w), pk2(im1.x, im1.y), pk2(im1.z, im1.w)}; }
    c.bfr[0] = __builtin_bit_cast(bf16x8, fre[0]); c.bfr[1] = __builtin_bit_cast(bf16x8, fre[1]); c.bfr[2] = __builtin_bit_cast(bf16x8, fim[0]); c.bfr[3] = __builtin_bit_cast(bf16x8, fim[1]);
}
__device__ __forceinline__ void s5m_cfrag(PrmP p, int l, int g, int lane, bf16x8 (&cmf)[8], bf16x8& dfr) {
    const int nl = lane & 31, hi = lane >> 5;
    const float* cre = p->in[I_S5CRE] + ((size_t)(l * 16 + g) * 16 + (nl & 15)) * 64; const float* cim = p->in[I_S5CIM] + ((size_t)(l * 16 + g) * 16 + (nl & 15)) * 64;
    const bool okc = nl < 16;
#pragma unroll
    for (int ks = 0; ks < 8; ++ks) { const int j0 = 4 * ks + 2 * hi; const float2 ra = *(const float2*)(cre + j0), rb2 = *(const float2*)(cre + 32 + j0), ia = *(const float2*)(cim + j0), ib = *(const float2*)(cim + 32 + j0);
        u32x4 w; w.x = pk2(ra.x, rb2.x); w.y = pk2(-ia.x, -ib.x); w.z = pk2(ra.y, rb2.y); w.w = pk2(-ia.y, -ib.y);
        if (!okc) w = (u32x4){0u, 0u, 0u, 0u}; cmf[ks] = __builtin_bit_cast(bf16x8, w); }
    const float dv = p->in[I_S5D][l * 256 + g * 16 + (nl & 15)]; const int jd = nl - 8 * hi;
    const unsigned db = f2bf(dv); u32x4 w = (u32x4){0u, 0u, 0u, 0u};
    if (okc && jd >= 0 && jd < 8) { const unsigned v = (jd & 1) ? (db << 16) : db; if ((jd >> 1) == 0) w.x = v; else if ((jd >> 1) == 1) w.y = v; else if ((jd >> 1) == 2) w.z = v; else w.w = v; }
    dfr = __builtin_bit_cast(bf16x8, w);
}
__device__ __forceinline__ void s5m_table_build(PrmP p, int l, int g, int lane) {
    S5M c; s5m_setup(p, l, g, lane, c); bf16x8 cmf[8]; bf16x8 dfr; s5m_cfrag(p, l, g, lane, cmf, dfr);
    u32x4* tb = (u32x4*)(p->ws + WS_S5T) + (size_t)(l * 16 + g) * 15 * 64 + lane;
    tb[0 * 64] = (u32x4){__float_as_uint(c.ar[0]), __float_as_uint(c.ar[1]), __float_as_uint(c.ai[0]), __float_as_uint(c.ai[1])};
    tb[1 * 64] = (u32x4){__float_as_uint(c.a16r[0]), __float_as_uint(c.a16r[1]), __float_as_uint(c.a16i[0]), __float_as_uint(c.a16i[1])};
#pragma unroll
    for (int q = 0; q < 4; ++q) tb[(2 + q) * 64] = __builtin_bit_cast(u32x4, c.bfr[q]);
#pragma unroll
    for (int q = 0; q < 8; ++q) tb[(6 + q) * 64] = __builtin_bit_cast(u32x4, cmf[q]);
    tb[14 * 64] = __builtin_bit_cast(u32x4, dfr);
}
__device__ __forceinline__ void s5m_load(PrmP p, int l, int g, int lane, S5M& c) {
    const u32x4* tb = (const u32x4*)(p->ws + WS_S5T) + (size_t)(l * 16 + g) * 15 * 64 + lane;
    const u32x4 a = tb[0], b = tb[64];
    c.ar[0] = __uint_as_float(a.x); c.ar[1] = __uint_as_float(a.y); c.ai[0] = __uint_as_float(a.z); c.ai[1] = __uint_as_float(a.w);
    c.a16r[0] = __uint_as_float(b.x); c.a16r[1] = __uint_as_float(b.y); c.a16i[0] = __uint_as_float(b.z); c.a16i[1] = __uint_as_float(b.w);
#pragma unroll
    for (int q = 0; q < 4; ++q) c.bfr[q] = __builtin_bit_cast(bf16x8, tb[(2 + q) * 64]);
}
__device__ __forceinline__ void s5m_load_c(PrmP p, int l, int g, int lane, bf16x8 (&cmf)[8], bf16x8& dfr) {
    const u32x4* tb = (const u32x4*)(p->ws + WS_S5T) + (size_t)(l * 16 + g) * 15 * 64 + lane;
#pragma unroll
    for (int q = 0; q < 8; ++q) cmf[q] = __builtin_bit_cast(bf16x8, tb[(6 + q) * 64]);
    dfr = __builtin_bit_cast(bf16x8, tb[14 * 64]);
}
__device__ __forceinline__ void s5m_bu(const bf16_t* PB, size_t rb, int tb, int g, int lane, const S5M& c, f32x16 (&bu)[4], bf16x8& ufrag) {
    const int i = lane & 31, hi = lane >> 5;
    ufrag = *(const bf16x8*)(PB + (rb + tb + tau32(i)) * NP + C_S5 + 16 * g + 8 * hi);
    const f32x16 z = f32x16{};
#pragma unroll
    for (int q = 0; q < 4; ++q) bu[q] = __builtin_amdgcn_mfma_f32_32x32x16_bf16(ufrag, c.bfr[q], z, 0, 0, 0);
}
__device__ __forceinline__ void s5m_tile_end(const S5M& c, const f32x16 (&bu)[4], float (&xr)[2], float (&xi)[2]) {
#pragma unroll
    for (int s = 0; s < 2; ++s) { float er = bu[s][0], ei = bu[2 + s][0];
#pragma unroll
        for (int r = 1; r < 16; ++r) { const float nr = c.ar[s] * er - c.ai[s] * ei + bu[s][r], ni = c.ar[s] * ei + c.ai[s] * er + bu[2 + s][r]; er = nr; ei = ni; }
        const float por = __shfl_xor(er, 32), poi = __shfl_xor(ei, 32);
        const bool hi = ::fresh_tid() & 32; const float elr = hi ? por : er, eli = hi ? poi : ei, ehr = hi ? er : por, ehi = hi ? ei : poi;
        const float t1r = c.a16r[s] * xr[s] - c.a16i[s] * xi[s] + elr, t1i = c.a16r[s] * xi[s] + c.a16i[s] * xr[s] + eli;
        xr[s] = c.a16r[s] * t1r - c.a16i[s] * t1i + ehr; xi[s] = c.a16r[s] * t1i + c.a16i[s] * t1r + ehi; }
}
__device__ __forceinline__ void fs_scan(PrmP p, int l, LAS unsigned char* lds, int wg, int nwg) {
    const int tid = fresh_tid(), lane = tid & 63, wave = tid >> 6;
    f2_items(p, l, lds, wg, nwg);
    const bf16_t* PB = (const bf16_t*)(p->ws + WS_PB);
    { bf16_t* HLOC = (bf16_t*)(p->ws + WS_YL); bf16_t* PCUM = (bf16_t*)(p->ws + WS_YS0); float* AGG = (float*)(p->ws + WS_AGG);
      LAS unsigned char* xa = lds + wave * 13312; LAS unsigned char* xf = xa + 4608;
      const int nl = lane & 31, hi = lane >> 5;
      for (int it = wave * nwg + wg; it < 2048; it += nwg * NWAVES) {
        const int b = it >> 9, c = (it >> 2) & 127, blk = it & 3; const size_t rb = (size_t)b * T; const int t0 = c * 64;
        const bf16_t* wt = (const bf16_t*)(p->ws + WS_LRUW) + (size_t)(l * 4 + blk) * 2 * 4096 + (size_t)nl * 64 + 8 * hi;
        const int chc = blk * 64 + lane;
        const float cw0 = p->in[I_CONVW][(l * 4 + 0) * 256 + chc], cw1 = p->in[I_CONVW][(l * 4 + 1) * 256 + chc], cw2 = p->in[I_CONVW][(l * 4 + 2) * 256 + chc], cw3 = p->in[I_CONVW][(l * 4 + 3) * 256 + chc], cb = p->in[I_CONVB][l * 256 + chc];
        float ba[2], bx[2], sp8[2];
#pragma unroll
        for (int s2 = 0; s2 < 2; ++s2) { const int ch = blk * 64 + 32 * s2 + nl; ba[s2] = p->in[I_LRUBA][l * 256 + ch]; bx[s2] = p->in[I_LRUBX][l * 256 + ch]; sp8[s2] = -8.f * log1pf(expf(-p->in[I_LAMBDA][l * 256 + ch])); }
        float x1 = (t0 >= 1) ? bf2f(PB[(rb + t0 - 1) * NP + C_LX + chc]) : 0.f, x2 = (t0 >= 2) ? bf2f(PB[(rb + t0 - 2) * NP + C_LX + chc]) : 0.f, x3 = (t0 >= 3) ? bf2f(PB[(rb + t0 - 3) * NP + C_LX + chc]) : 0.f;
        float hin[2] = {0.f, 0.f}, pin[2] = {1.f, 1.f};
#pragma unroll 1
        for (int mt = 0; mt < 2; ++mt) { const int tb = t0 + mt * 32;
#pragma unroll 1
            for (int th = 0; th < 32; th += 16) { float xin[16];
#pragma unroll
              for (int tt = 0; tt < 16; ++tt) xin[tt] = bf2f(PB[(rb + tb + th + tt) * NP + C_LX + chc]);
#pragma unroll
              for (int tt = 0; tt < 16; ++tt) { const float xr = cb + cw0 * x3 + cw1 * x2 + cw2 * x1 + cw3 * xin[tt]; x3 = x2; x2 = x1; x1 = xin[tt];
                  *(LAS bf16_t*)(xa + (th + tt) * 144 + lane * 2) = (bf16_t)f2bf(xr); *(LAS float*)(xf + (th + tt) * 272 + lane * 4) = xr; } }
            asm volatile("s_waitcnt lgkmcnt(0)" ::: "memory");
            f32x16 acc[4];
#pragma unroll
            for (int q = 0; q < 4; ++q) acc[q] = f32x16{};
#pragma unroll
            for (int ks = 0; ks < 4; ++ks) { const bf16x8 af = *(const LAS bf16x8*)(xa + tau32(nl) * 144 + (16 * ks + 8 * hi) * 2);
#pragma unroll
                for (int q = 0; q < 4; ++q) { const bf16x8 wfr = *(const bf16x8*)(wt + ((size_t)(q >> 1) * 64 + 32 * (q & 1)) * 64 + 16 * ks); acc[q] = __builtin_amdgcn_mfma_f32_32x32x16_bf16(af, wfr, acc[q], 0, 0, 0); } }
#pragma unroll
            for (int s2 = 0; s2 < 2; ++s2) { const int ch = blk * 64 + 32 * s2 + nl;
                float hl[16], pl[16]; float h = 0.f, P = 1.f;
#pragma unroll
                for (int r = 0; r < 16; ++r) { const float xr = *(const LAS float*)(xf + (16 * hi + r) * 272 + (32 * s2 + nl) * 4);
                    const float rg = sigmoidf_(acc[s2][r] + ba[s2]), ig = sigmoidf_(acc[2 + s2][r] + bx[s2]);
                    const float la = sp8[s2] * rg, a = __expf(la), x2a = 2.f * la;
                    const float om = (x2a > -0.125f) ? -x2a * (1.f + x2a * (0.5f + x2a * (0.16666667f + x2a * 0.041666668f))) : 1.f - a * a;
                    h = a * h + xr * ig * __builtin_amdgcn_sqrtf(om); P *= a; hl[r] = h; pl[r] = P; }
                const float h0e = __shfl(h, nl), p0e = __shfl(P, nl);
                const float hs = hi ? h0e + p0e * hin[s2] : hin[s2], ps = hi ? pin[s2] * p0e : pin[s2];
#pragma unroll
                for (int r = 0; r < 16; ++r) { const size_t m = rb + tb + 16 * hi + r; HLOC[m * 256 + ch] = (bf16_t)f2bf(hl[r] + pl[r] * hs); PCUM[m * 256 + ch] = (bf16_t)f2bf(pl[r] * ps); }
                const float he = hl[15] + pl[15] * hs, pe = pl[15] * ps;
                hin[s2] = __shfl(he, 32 + nl); pin[s2] = __shfl(pe, 32 + nl); }
            asm volatile("s_waitcnt lgkmcnt(0)" ::: "memory");
        }
        if (hi == 0) {
#pragma unroll
            for (int s2 = 0; s2 < 2; ++s2) { const int ch = blk * 64 + 32 * s2 + nl; AGG[((size_t)(b * 128 + c) * 2 + 0) * 256 + ch] = pin[s2]; AGG[((size_t)(b * 128 + c) * 2 + 1) * 256 + ch] = hin[s2]; } }
      }
    }
    { unsigned* NRM = (unsigned*)(p->ws + WS_CTL) + CW_NRM;
      for (int it = wg; it < M / 128; it += nwg) { const int b = it / (T / 128); float mq = 0.f, mk = 0.f;
#pragma unroll 1
        for (int r8 = 0; r8 < 2; ++r8) { u32x4 qwv[8], kwv[8];
#pragma unroll
          for (int q8 = 0; q8 < 8; ++q8) { const size_t m = (size_t)it * 128 + wave * 16 + r8 * 8 + q8; qwv[q8] = *(const u32x4*)(PB + m * NP + C_Q + 8 * lane); kwv[q8] = *(const u32x4*)(PB + m * NP + C_K + 8 * lane); }
#pragma unroll
          for (int q8 = 0; q8 < 8; ++q8) { const u32x4 qw = qwv[q8], kw = kwv[q8];
            float sq = bflo(qw.x) * bflo(qw.x) + bfhi(qw.x) * bfhi(qw.x) + bflo(qw.y) * bflo(qw.y) + bfhi(qw.y) * bfhi(qw.y) + bflo(qw.z) * bflo(qw.z) + bfhi(qw.z) * bfhi(qw.z) + bflo(qw.w) * bflo(qw.w) + bfhi(qw.w) * bfhi(qw.w);
            float sk = bflo(kw.x) * bflo(kw.x) + bfhi(kw.x) * bfhi(kw.x) + bflo(kw.y) * bflo(kw.y) + bfhi(kw.y) * bfhi(kw.y) + bflo(kw.z) * bflo(kw.z) + bfhi(kw.z) * bfhi(kw.z) + bflo(kw.w) * bflo(kw.w) + bfhi(kw.w) * bfhi(kw.w);
#pragma unroll
            for (int o = 1; o < 8; o <<= 1) { sq += __shfl_xor(sq, o); sk += __shfl_xor(sk, o); }
            mq = fmaxf(mq, sq); mk = fmaxf(mk, sk); } }
        if ((lane & 7) == 0) { const int hh = lane >> 3, bh = b * 8 + hh, il = it % (T / 128); atomicMax(NRM + (l * 32 + bh) * 2, __float_as_uint(mq)); atomicMax(NRM + (l * 32 + bh) * 2 + 1, __float_as_uint(mk));
            unsigned* CT = (unsigned*)(p->ws + WS_CTL); atomicMax(CT + CW_QN + (l * 32 + bh) * 32 + (il >> 1), __float_as_uint(mq)); atomicMax(CT + CW_KT + (l * 32 + bh) * 128 + il * 2 + (wave >> 2), __float_as_uint(mk)); } }
    }
    { float* XEND = (float*)(p->ws + WS_XEND);
      for (int it = wave * nwg + wg; it < 2048; it += nwg * NWAVES) {
        const int b = it >> 9, g = (it >> 5) & 15, cq = it & 31;
        S5M cf; s5m_load(p, l, g, lane, cf);
        float a64r[2], a64i[2], x4r[2] = {0.f, 0.f}, x4i[2] = {0.f, 0.f};
#pragma unroll
        for (int s2 = 0; s2 < 2; ++s2) { float pr = cf.a16r[s2], pi_ = cf.a16i[s2];
#pragma unroll
            for (int q = 0; q < 2; ++q) { const float nr = pr * pr - pi_ * pi_, ni = 2.f * pr * pi_; pr = nr; pi_ = ni; }
            a64r[s2] = pr; a64i[s2] = pi_; }
        bf16x8 ufs[8];
#pragma unroll
        for (int t8 = 0; t8 < 8; ++t8) ufs[t8] = *(const bf16x8*)(PB + ((size_t)b * T + cq * 256 + t8 * 32 + tau32(lane & 31)) * NP + C_S5 + 16 * g + 8 * (lane >> 5));
#pragma unroll
        for (int k = 0; k < 4; ++k) { const int c = cq * 4 + k; float xr[2] = {0.f, 0.f}, xi[2] = {0.f, 0.f};
#pragma unroll
            for (int mt = 0; mt < 2; ++mt) { f32x16 bu[4]; const f32x16 z = f32x16{};
#pragma unroll
                for (int q = 0; q < 4; ++q) bu[q] = __builtin_amdgcn_mfma_f32_32x32x16_bf16(ufs[2 * k + mt], cf.bfr[q], z, 0, 0, 0);
                s5m_tile_end(cf, bu, xr, xi); }
#pragma unroll
            for (int s2 = 0; s2 < 2; ++s2) { const float nr = a64r[s2] * x4r[s2] - a64i[s2] * x4i[s2] + xr[s2], ni = a64r[s2] * x4i[s2] + a64i[s2] * x4r[s2] + xi[s2]; x4r[s2] = nr; x4i[s2] = ni; }
            if (lane < 32) { float* xe = XEND + ((size_t)((b * 16 + g) * 128 + c) * 64) * 2;
                *(float2*)(xe + lane * 2) = make_float2(xr[0], xi[0]); *(float2*)(xe + (32 + lane) * 2) = make_float2(xr[1], xi[1]); } }
        if (lane < 32) { float* xe = (float*)(p->ws + WS_X4END) + ((size_t)((b * 16 + g) * 32 + cq) * 64) * 2;
            *(float2*)(xe + lane * 2) = make_float2(x4r[0], x4i[0]); *(float2*)(xe + (32 + lane) * 2) = make_float2(x4r[1], x4i[1]); }
      }
    }
}

constexpr int FIN_YSB = 0, FIN_XST = 34816, FIN_CAR = FIN_XST + 8 * 8704;
static_assert(64 * 264 * 2 <= FIN_XST && FIN_CAR + 1024 <= 131072, "finalize LDS map");
__device__ __forceinline__ void fs_fin(PrmP p, int l, LAS unsigned char* lds, int wg, int nwg) {
    const int tid = fresh_tid(), lane = tid & 63, wave = tid >> 6, fr = lane & 15, fq = lane >> 4, nl = lane & 31, hi = lane >> 5;
    const bf16_t* PB = (const bf16_t*)(p->ws + WS_PB); bf16_t* YC = (bf16_t*)(p->ws + WS_YC);
    const bf16_t* HLOC = (const bf16_t*)(p->ws + WS_YL); const bf16_t* PCUM = (const bf16_t*)(p->ws + WS_YS0); const float* AGG = (const float*)(p->ws + WS_AGG); const float* XEND = (const float*)(p->ws + WS_XEND);
    LAS bf16_t* ysb = (LAS bf16_t*)(lds + FIN_YSB); LAS unsigned char* xst = lds + FIN_XST + wave * 8704; LAS float* car = (LAS float*)(lds + FIN_CAR);
    for (int it = wg; it < NB * 128; it += nwg) {
        const int b = it >> 7, c = it & 127, t0 = c * 64; const size_t rb = (size_t)b * T;
        __syncthreads();
        if (tid < 256) { float cr = 0.f; const float* ag = AGG + (size_t)(b * 128) * 512 + (fresh_tid() & 255); int cc = 0;
            for (; cc + 8 <= c; cc += 8) { float A[8], H[8];
#pragma unroll
                for (int q = 0; q < 8; ++q) { A[q] = ag[(size_t)(cc + q) * 512]; H[q] = ag[(size_t)(cc + q) * 512 + 256]; }
#pragma unroll
                for (int q = 0; q < 8; ++q) cr = A[q] * cr + H[q]; }
            for (; cc < c; ++cc) cr = ag[(size_t)cc * 512] * cr + ag[(size_t)cc * 512 + 256];
            car[tid] = cr; }
#pragma unroll 1
        for (int gi = 0; gi < 2; ++gi) { const int g = wave + 8 * gi;
            S5M cf; s5m_load(p, l, g, lane, cf);
            bf16x8 cmf[8]; bf16x8 dfr; s5m_load_c(p, l, g, lane, cmf, dfr);
            float xr[2] = {0.f, 0.f}, xi[2] = {0.f, 0.f};
            { float a64r[2], a64i[2];
#pragma unroll
              for (int s = 0; s < 2; ++s) { float pr = cf.a16r[s], pi_ = cf.a16i[s];
#pragma unroll
                  for (int q = 0; q < 2; ++q) { const float nr = pr * pr - pi_ * pi_, ni = 2.f * pr * pi_; pr = nr; pi_ = ni; }
                  a64r[s] = pr; a64i[s] = pi_; }
              float a256r[2], a256i[2];
#pragma unroll
              for (int s = 0; s < 2; ++s) { float pr = a64r[s], pi_ = a64i[s];
#pragma unroll
                  for (int q = 0; q < 2; ++q) { const float nr = pr * pr - pi_ * pi_, ni = 2.f * pr * pi_; pr = nr; pi_ = ni; }
                  a256r[s] = pr; a256i[s] = pi_; }
              const float* x4 = (const float*)(p->ws + WS_X4END) + ((size_t)((b * 16 + g) * 32) * 64) * 2 + nl * 2;
              const int nb4 = c >> 2; int cb = 0;
              for (; cb + 4 <= nb4; cb += 4) { float2 e0[4], e1[4];
#pragma unroll
                  for (int q = 0; q < 4; ++q) { e0[q] = *(const float2*)(x4 + (size_t)(cb + q) * 128); e1[q] = *(const float2*)(x4 + (size_t)(cb + q) * 128 + 64); }
#pragma unroll
                  for (int q = 0; q < 4; ++q) {
                      float nr = a256r[0] * xr[0] - a256i[0] * xi[0] + e0[q].x, ni = a256r[0] * xi[0] + a256i[0] * xr[0] + e0[q].y; xr[0] = nr; xi[0] = ni;
                      nr = a256r[1] * xr[1] - a256i[1] * xi[1] + e1[q].x; ni = a256r[1] * xi[1] + a256i[1] * xr[1] + e1[q].y; xr[1] = nr; xi[1] = ni; } }
              for (; cb < nb4; ++cb) { const float2 e0 = *(const float2*)(x4 + (size_t)cb * 128), e1 = *(const float2*)(x4 + (size_t)cb * 128 + 64);
                  float nr = a256r[0] * xr[0] - a256i[0] * xi[0] + e0.x, ni = a256r[0] * xi[0] + a256i[0] * xr[0] + e0.y; xr[0] = nr; xi[0] = ni;
                  nr = a256r[1] * xr[1] - a256i[1] * xi[1] + e1.x; ni = a256r[1] * xi[1] + a256i[1] * xr[1] + e1.y; xr[1] = nr; xi[1] = ni; }
              const float* xe = XEND + ((size_t)((b * 16 + g) * 128) * 64) * 2 + nl * 2;
              for (int cc = nb4 * 4; cc < c; ++cc) { const float2 e0 = *(const float2*)(xe + (size_t)cc * 128), e1 = *(const float2*)(xe + (size_t)cc * 128 + 64);
                  float nr = a64r[0] * xr[0] - a64i[0] * xi[0] + e0.x, ni = a64r[0] * xi[0] + a64i[0] * xr[0] + e0.y; xr[0] = nr; xi[0] = ni;
                  nr = a64r[1] * xr[1] - a64i[1] * xi[1] + e1.x; ni = a64r[1] * xi[1] + a64i[1] * xr[1] + e1.y; xr[1] = nr; xi[1] = ni; } }
#pragma unroll 1
            for (int mt = 0; mt < 2; ++mt) {
                f32x16 bu[4]; bf16x8 uf; s5m_bu(PB, rb, t0 + mt * 32, g, lane, cf, bu, uf);
#pragma unroll
                for (int s = 0; s < 2; ++s) {
#pragma unroll
                    for (int r = 1; r < 16; ++r) { const float pr = bu[s][r - 1], pi_ = bu[2 + s][r - 1]; bu[s][r] += cf.ar[s] * pr - cf.ai[s] * pi_; bu[2 + s][r] += cf.ar[s] * pi_ + cf.ai[s] * pr; }
                    const float er = bu[s][15], ei = bu[2 + s][15];
                    const float por = __shfl_xor(er, 32), poi = __shfl_xor(ei, 32);
                    const float elr = hi ? por : er, eli = hi ? poi : ei, ehr = hi ? er : por, ehi = hi ? ei : poi;
                    const float t1r = cf.a16r[s] * xr[s] - cf.a16i[s] * xi[s] + elr, t1i = cf.a16r[s] * xi[s] + cf.a16i[s] * xr[s] + eli;
                    float wr = hi ? t1r : xr[s], wi = hi ? t1i : xi[s];
                    xr[s] = cf.a16r[s] * t1r - cf.a16i[s] * t1i + ehr; xi[s] = cf.a16r[s] * t1i + cf.a16i[s] * t1r + ehi;
#pragma unroll
                    for (int r = 0; r < 16; ++r) { const float nr = cf.ar[s] * wr - cf.ai[s] * wi, ni = cf.ar[s] * wi + cf.ai[s] * wr; wr = nr; wi = ni; bu[s][r] += wr; bu[2 + s][r] += wi; }
                }
#pragma unroll
                for (int r = 0; r < 16; ++r) { u32x2 w; w.x = pk2(bu[0][r], bu[1][r]); w.y = pk2(bu[2][r], bu[3][r]); *(LAS u32x2*)(xst + (16 * hi + r) * 272 + nl * 8) = w; }
                asm volatile("s_waitcnt lgkmcnt(0)" ::: "memory");
                f32x16 acc = __builtin_amdgcn_mfma_f32_32x32x16_bf16(uf, dfr, f32x16{}, 0, 0, 0);
#pragma unroll
                for (int ks = 0; ks < 8; ++ks) { const bf16x8 af = *(const LAS bf16x8*)(xst + tau32(nl) * 272 + (16 * ks + 8 * hi) * 2); acc = __builtin_amdgcn_mfma_f32_32x32x16_bf16(af, cmf[ks], acc, 0, 0, 0); }
                if (nl < 16) {
#pragma unroll
                    for (int r = 0; r < 16; ++r) ysb[(mt * 32 + 16 * hi + r) * 264 + g * 16 + nl] = (bf16_t)f2bf(gelu_tanh(acc[r])); }
                asm volatile("s_waitcnt lgkmcnt(0)" ::: "memory");
            }
        }
        __syncthreads();
        { const bf16_t* GW = (const bf16_t*)(p->ws + WS_GLUW) + (size_t)l * 65536;
          f32x4 acc[4][2];
#pragma unroll
          for (int m = 0; m < 4; ++m) { acc[m][0] = (f32x4){0.f, 0.f, 0.f, 0.f}; acc[m][1] = (f32x4){0.f, 0.f, 0.f, 0.f}; }
#pragma unroll 2
          for (int ks = 0; ks < 8; ++ks) { bf16x8 a[4], bb[2];
#pragma unroll
              for (int m = 0; m < 4; ++m) a[m] = *(const LAS bf16x8*)(ysb + (m * 16 + fr) * 264 + ks * 32 + 8 * fq);
#pragma unroll
              for (int n = 0; n < 2; ++n) bb[n] = *(const bf16x8*)(GW + (size_t)((2 * wave + n) * 16 + fr) * 256 + ks * 32 + 8 * fq);
#pragma unroll
              for (int m = 0; m < 4; ++m)
#pragma unroll
                  for (int n = 0; n < 2; ++n) acc[m][n] = __builtin_amdgcn_mfma_f32_16x16x32_bf16(a[m], bb[n], acc[m][n], 0, 0, 0); }
          __syncthreads();
#pragma unroll
          for (int n = 0; n < 2; ++n) { const int j = (2 * wave + n) * 16 + fr; const float gb = p->in[I_GLUB][l * 256 + j];
#pragma unroll
              for (int m = 0; m < 4; ++m)
#pragma unroll
                  for (int r = 0; r < 4; ++r) { const int tk = m * 16 + 4 * fq + r; const float y = bf2f(ysb[tk * 264 + j]); ysb[tk * 264 + j] = (bf16_t)f2bf(y * sigmoidf_(acc[m][n][r] + gb)); } }
        }
        __syncthreads();
        { const f32x4 ggl = *(const f32x4*)(p->in[I_GNLRU] + l * 256 + 4 * lane), ggs = *(const f32x4*)(p->in[I_GNS5] + l * 256 + 4 * lane);
          const f32x4 g0 = *(const f32x4*)(p->in[I_GNATT] + l * 512 + 8 * lane), g1 = *(const f32x4*)(p->in[I_GNATT] + l * 512 + 8 * lane + 4); const f32x4 cr = *(const LAS f32x4*)(car + 4 * lane);
#pragma unroll 1
          for (int rq = 0; rq < 2; ++rq) {
            u32x2 hw[4], pw[4], gw[4]; u32x4 ow[4];
#pragma unroll
            for (int q = 0; q < 4; ++q) { const size_t m = rb + t0 + wave + 8 * (4 * rq + q);
                hw[q] = *(const u32x2*)(HLOC + m * 256 + 4 * lane); pw[q] = *(const u32x2*)(PCUM + m * 256 + 4 * lane); gw[q] = *(const u32x2*)(PB + m * NP + C_LG + 4 * lane); ow[q] = *(const u32x4*)(PB + m * NP + C_Q + 8 * lane); }
#pragma unroll
            for (int q = 0; q < 4; ++q) { const int r = wave + 8 * (4 * rq + q); const size_t m = rb + t0 + r;
              { const f32x4 hl = (f32x4){bflo(hw[q].x), bfhi(hw[q].x), bflo(hw[q].y), bfhi(hw[q].y)}, pc = (f32x4){bflo(pw[q].x), bfhi(pw[q].x), bflo(pw[q].y), bfhi(pw[q].y)};
                f32x4 v; v.x = (hl.x + pc.x * cr.x) * gelu_tanh(bflo(gw[q].x)); v.y = (hl.y + pc.y * cr.y) * gelu_tanh(bfhi(gw[q].x)); v.z = (hl.z + pc.z * cr.z) * gelu_tanh(bflo(gw[q].y)); v.w = (hl.w + pc.w * cr.w) * gelu_tanh(bfhi(gw[q].y));
                const float rs = __builtin_amdgcn_rsqf(wave_sum(v.x * v.x + v.y * v.y + v.z * v.z + v.w * v.w) * (1.f / 256.f) + RMS_EPS);
                u32x2 o; o.x = pk2(v.x * rs * ggl.x, v.y * rs * ggl.y); o.y = pk2(v.z * rs * ggl.z, v.w * rs * ggl.w); *(u32x2*)(YC + m * 1024 + 4 * lane) = o; }
              { const u32x2 yw = *(const LAS u32x2*)(ysb + r * 264 + 4 * lane); const f32x4 v = (f32x4){bflo(yw.x), bfhi(yw.x), bflo(yw.y), bfhi(yw.y)};
                const float rs = __builtin_amdgcn_rsqf(wave_sum(v.x * v.x + v.y * v.y + v.z * v.z + v.w * v.w) * (1.f / 256.f) + RMS_EPS);
                u32x2 o; o.x = pk2(v.x * rs * ggs.x, v.y * rs * ggs.y); o.y = pk2(v.z * rs * ggs.z, v.w * rs * ggs.w); *(u32x2*)(YC + m * 1024 + 256 + 4 * lane) = o; }
              { const u32x4 w = ow[q];
                const float v[8] = {bflo(w.x), bfhi(w.x), bflo(w.y), bfhi(w.y), bflo(w.z), bfhi(w.z), bflo(w.w), bfhi(w.w)};
                float ss = 0.f;
#pragma unroll
                for (int i = 0; i < 8; ++i) ss += v[i] * v[i];
                const float rs = __builtin_amdgcn_rsqf(wave_sum(ss) * (1.f / 512.f) + RMS_EPS);
                u32x4 o; o.x = pk2(v[0] * rs * g0.x, v[1] * rs * g0.y); o.y = pk2(v[2] * rs * g0.z, v[3] * rs * g0.w); o.z = pk2(v[4] * rs * g1.x, v[5] * rs * g1.y); o.w = pk2(v[6] * rs * g1.z, v[7] * rs * g1.w);
                *(u32x4*)(YC + m * 1024 + 512 + 8 * lane) = o; } } } }
    }
}

constexpr int ROW_WT = 0, ROW_WT_LD = 1028, ROW_ETAB = 131584 + 64;
__device__ __forceinline__ void ph_row(PrmP p, int l, LAS unsigned char* lds, int wg, int nwg) {
    const int tid = fresh_tid(), lane = tid & 63, wave = tid >> 6;
    const int R = M / nwg;
    const float* Xin = p->in[I_X]; bf16_t* XB = (bf16_t*)(p->ws + WS_XB); const bf16_t* Y = (const bf16_t*)(p->ws + WS_Y);
    const float* MOD = (const float*)(p->ws + WS_MOD); bf16_t* HB = (bf16_t*)(p->ws + WS_HB);
    int* TOPI = (int*)(p->ws + WS_MISC + MS_TOPI); float* TOPG = (float*)(p->ws + WS_MISC + MS_TOPG); int* RANK = (int*)(p->ws + WS_MISC + MS_RANK); int* HIST = (int*)(p->ws + WS_MISC + MS_HIST);
    LAS int* etab = (LAS int*)(lds + ROW_ETAB);
    LAS float* wt = (LAS float*)(lds + ROW_WT);
    const float* RW = p->in[I_ROUTW] + (size_t)l * 1024 * 32; const float* RB = p->in[I_ROUTB] + l * 32;
    __syncthreads();
    { f32x4 wv[16];
#pragma unroll
      for (int k = 0; k < 16; ++k) wv[k] = *(const f32x4*)(RW + tid * 4 + 2048 * k);
#pragma unroll
      for (int k = 0; k < 16; ++k) { const int i = tid * 4 + 2048 * k, e = i & 31, d = i >> 5; wt[e * ROW_WT_LD + d] = wv[k].x; wt[(e + 1) * ROW_WT_LD + d] = wv[k].y; wt[(e + 2) * ROW_WT_LD + d] = wv[k].z; wt[(e + 3) * ROW_WT_LD + d] = wv[k].w; } }
    __syncthreads();
    const float rbias = RB[(lane >> 1) & 31];
    const int RPW = R / NWAVES; constexpr int NR = 2;
    u32x2 ywn[NR][4]; f32x4 xfn[NR][4]; u32x2 xbn[NR][4];
#define ROW_LOAD(r0_) do { _Pragma("unroll") for (int q = 0; q < NR; ++q) _Pragma("unroll") for (int j = 0; j < 4; ++j) { const size_t mm_ = (size_t)wg * R + (r0_) + q; const int c_ = 4 * lane + 256 * j; \
        ywn[q][j] = *(const u32x2*)(Y + mm_ * 1024 + c_); if (l == 0) xfn[q][j] = *(const f32x4*)(Xin + mm_ * 1024 + c_); else xbn[q][j] = *(const u32x2*)(XB + mm_ * 1024 + c_); } } while (0)
    ROW_LOAD(wave * RPW);
    for (int r0 = wave * RPW; r0 < (wave + 1) * RPW; r0 += NR) {
        const size_t m0 = (size_t)wg * R + r0; const int b = (int)(m0 / T);
        const float* mod = MOD + (size_t)(l * 4 + b) * 6144;
        u32x2 ywc[NR][4]; f32x4 xfc[NR][4];
#pragma unroll
        for (int q = 0; q < NR; ++q)
#pragma unroll
            for (int j = 0; j < 4; ++j) { ywc[q][j] = ywn[q][j]; if (l == 0) xfc[q][j] = xfn[q][j]; else xfc[q][j] = (f32x4){bflo(xbn[q][j].x), bfhi(xbn[q][j].x), bflo(xbn[q][j].y), bfhi(xbn[q][j].y)}; }
        if (r0 + NR < (wave + 1) * RPW) ROW_LOAD(r0 + NR);
        f32x4 h[NR][4];
        { f32x4 y[NR][4]; float ss[NR] = {};
#pragma unroll
          for (int q = 0; q < NR; ++q)
#pragma unroll
              for (int j = 0; j < 4; ++j) { const u32x2 yw = ywc[q][j]; y[q][j] = (f32x4){bflo(yw.x), bfhi(yw.x), bflo(yw.y), bfhi(yw.y)}; ss[q] += (y[q][j].x * y[q][j].x + y[q][j].y * y[q][j].y) + (y[q][j].z * y[q][j].z + y[q][j].w * y[q][j].w); }
          float rstd[NR], s2[NR] = {};
#pragma unroll
          for (int q = 0; q < NR; ++q) rstd[q] = __builtin_amdgcn_rsqf(wave_sum(ss[q]) * (1.f / 1024.f) + RMS_EPS);
#pragma unroll
          for (int j = 0; j < 4; ++j) { const int c = 4 * lane + 256 * j; const f32x4 g = *(const f32x4*)(p->in[I_POSTMIXG] + l * 1024 + c), gate = *(const f32x4*)(mod + 2 * 1024 + c);
#pragma unroll
              for (int q = 0; q < NR; ++q) { const f32x4 x0 = xfc[q][j];
                  const f32x4 x = x0 + gate * (y[q][j] * rstd[q] * g); { u32x2 xo; xo.x = pk2(x.x, x.y); xo.y = pk2(x.z, x.w); *(u32x2*)(XB + (m0 + q) * 1024 + c) = xo; } h[q][j] = x;
                  s2[q] += (x.x * x.x + x.y * x.y) + (x.z * x.z + x.w * x.w); } }
          float rstd2[NR];
#pragma unroll
          for (int q = 0; q < NR; ++q) rstd2[q] = __builtin_amdgcn_rsqf(wave_sum(s2[q]) * (1.f / 1024.f) + RMS_EPS);
#pragma unroll
          for (int j = 0; j < 4; ++j) { const int c = 4 * lane + 256 * j; const f32x4 g = *(const f32x4*)(p->in[I_PREFFNG] + l * 1024 + c), sc = *(const f32x4*)(mod + 4 * 1024 + c), sh = *(const f32x4*)(mod + 3 * 1024 + c);
#pragma unroll
              for (int q = 0; q < NR; ++q) { h[q][j] = h[q][j] * rstd2[q] * g * (sc + 1.f) + sh;
                  if (EXPERT_FP8) *(unsigned*)((unsigned char*)HB + (m0 + q) * 1024 + c) = pk4_fp8(4.f * h[q][j].x, 4.f * h[q][j].y, 4.f * h[q][j].z, 4.f * h[q][j].w);
                  else { u32x2 o; o.x = pk2(h[q][j].x, h[q][j].y); o.y = pk2(h[q][j].z, h[q][j].w); *(u32x2*)(HB + (m0 + q) * 1024 + c) = o; } } } }
        float v16[NR][16];
        const bool b5 = lane & 32;
#pragma unroll
        for (int i = 0; i < 16; ++i) { float lo[NR] = {}, hi[NR] = {};
#pragma unroll
            for (int j = 0; j < 4; ++j) { const f32x4 wl = *(const LAS f32x4*)(wt + i * ROW_WT_LD + 4 * lane + 256 * j), wh = *(const LAS f32x4*)(wt + (i + 16) * ROW_WT_LD + 4 * lane + 256 * j);
#pragma unroll
                for (int q = 0; q < NR; ++q) { lo[q] += h[q][j].x * wl.x + h[q][j].y * wl.y + h[q][j].z * wl.z + h[q][j].w * wl.w; hi[q] += h[q][j].x * wh.x + h[q][j].y * wh.y + h[q][j].z * wh.z + h[q][j].w * wh.w; } }
#pragma unroll
            for (int q = 0; q < NR; ++q) { const float rcv = __shfl_xor(b5 ? lo[q] : hi[q], 32); v16[q][i] = (b5 ? hi[q] : lo[q]) + rcv; } }
#pragma unroll
        for (int q = 0; q < NR; ++q) { const int r = r0 + q; const size_t m = m0 + q;
            float v8[8], v4[4], v2[2], mine;
            { const bool b4 = lane & 16, b3 = lane & 8, b2 = lane & 4, b1 = lane & 2;
#pragma unroll
              for (int i = 0; i < 8; ++i) { const float rcv = __shfl_xor(b4 ? v16[q][i] : v16[q][i + 8], 16); v8[i] = (b4 ? v16[q][i + 8] : v16[q][i]) + rcv; }
#pragma unroll
              for (int i = 0; i < 4; ++i) { const float rcv = __shfl_xor(b3 ? v8[i] : v8[i + 4], 8); v4[i] = (b3 ? v8[i + 4] : v8[i]) + rcv; }
#pragma unroll
              for (int i = 0; i < 2; ++i) { const float rcv = __shfl_xor(b2 ? v4[i] : v4[i + 2], 4); v2[i] = (b2 ? v4[i + 2] : v4[i]) + rcv; }
              { const float rcv = __shfl_xor(b1 ? v2[0] : v2[1], 2); mine = (b1 ? v2[1] : v2[0]) + rcv; }
              mine += __shfl_xor(mine, 1); }
            mine += rbias;
            if (lane & 1) mine = -3e38f;
            float tv[4]; int ti[4];
#pragma unroll
            for (int k = 0; k < 4; ++k) { float mx = mine;
#pragma unroll
                for (int o = 1; o < 64; o <<= 1) mx = fmaxf(mx, __shfl_xor(mx, o));
                const unsigned long long bal = __ballot(mine == mx && !(lane & 1)); const int wl_ = __ffsll((long long)bal) - 1;
                tv[k] = mx; ti[k] = wl_ >> 1; if (lane == wl_) mine = -3e38f; }
            const float e1 = __expf(tv[1] - tv[0]), e2 = __expf(tv[2] - tv[0]), e3 = __expf(tv[3] - tv[0]); const float inv = __builtin_amdgcn_rcpf(1.f + e1 + e2 + e3);
            if (lane < 4) { const int id = (lane == 0) ? ti[0] : (lane == 1) ? ti[1] : (lane == 2) ? ti[2] : ti[3]; const float gv = ((lane == 0) ? 1.f : (lane == 1) ? e1 : (lane == 2) ? e2 : e3) * inv;
                TOPI[m * 4 + lane] = id; TOPG[m * 4 + lane] = gv; etab[r * 4 + lane] = id; } }
    }
    __syncthreads();
    const int NEn = R * 4;
    if (NEn == NTHREADS) {
        LAS int* wcnt = etab + NTHREADS;
        const int e = etab[tid]; int myrank = 0;
#pragma unroll 4
        for (int q = 0; q < 32; ++q) { const unsigned long long mk = __ballot(e == q); if (e == q) myrank = __popcll(mk & ((1ull << lane) - 1ull)); if (lane == q) wcnt[wave * 32 + q] = __popcll(mk); }
        __syncthreads();
        int pre = 0; for (int w = 0; w < wave; ++w) pre += wcnt[w * 32 + e];
        RANK[(size_t)wg * NEn + tid] = pre + myrank;
        if (tid < 32) { int c = 0;
#pragma unroll
            for (int w = 0; w < NWAVES; ++w) c += wcnt[w * 32 + tid];
            HIST[wg * 32 + tid] = c; }
    } else {
    if (tid < NEn) { const int e = etab[tid]; int rk = 0; for (int j = 0; j < tid; ++j) rk += (etab[j] == e) ? 1 : 0; RANK[(size_t)wg * NEn + tid] = rk; }
    if (tid < 32) { int c = 0; for (int j = 0; j < NEn; ++j) c += (etab[j] == tid) ? 1 : 0; HIST[wg * 32 + tid] = c; }
    }
    __syncthreads();
}

__device__ __forceinline__ void ph_offs(PrmP p, int l, LAS unsigned char* lds, int wg, int nwg) {
    const int tid = fresh_tid(), lane = tid & 63, wave = tid >> 6;
    const int R = M / nwg, NEn = R * 4;
    const int* TOPI = (const int*)(p->ws + WS_MISC + MS_TOPI); const int* RANK = (const int*)(p->ws + WS_MISC + MS_RANK); const int* HIST = (const int*)(p->ws + WS_MISC + MS_HIST);
    int* POS = (int*)(p->ws + WS_MISC + MS_POS); int* TILE_E = (int*)(p->ws + WS_MISC + MS_TILEE); int* CTL = (int*)(p->ws + WS_CTL);
    const bf16_t* HB = (const bf16_t*)(p->ws + WS_HB); bf16_t* XS = (bf16_t*)(p->ws + WS_XS);
    LAS int* tot = (LAS int*)lds; LAS int* mine = tot + 32; LAS int* base = mine + 32; LAS int* ptab = base + 32;
    __syncthreads();
    { LAS int* part = ptab + 512;
      const int e = tid & 31, pt = tid >> 5, per = (nwg + 15) / 16; int t = 0, mb = 0;
      for (int w = pt * per; w < (pt + 1) * per && w < nwg; ++w) { const int c = HIST[w * 32 + e]; t += c; mb += (w < wg) ? c : 0; }
      part[(pt * 2 + 0) * 32 + e] = t; part[(pt * 2 + 1) * 32 + e] = mb;
      __syncthreads();
      if (tid < 32) { int ts = 0, ms = 0;
#pragma unroll
          for (int q = 0; q < 16; ++q) { ts += part[(q * 2 + 0) * 32 + tid]; ms += part[(q * 2 + 1) * 32 + tid]; }
          tot[tid] = ts; mine[tid] = ms; } }
    __syncthreads();
    if (tid == 0) { int run = 0; for (int e = 0; e < 32; ++e) { const int pad = (tot[e] + 255) / 256 * 256; base[e] = run + mine[e];
            if (wg == 0) for (int t = run / 256; t < (run + pad) / 256; ++t) TILE_E[t] = e;
            run += pad; }
        if (wg == 0) CTL[CW_NT] = run / 256; }
    __syncthreads();
    int* ROWTOK = (int*)(p->ws + WS_MISC + MS_ROWTOK);
    if (tid < NEn) { const size_t idx = (size_t)wg * NEn + tid; const int pos = base[TOPI[idx]] + RANK[idx]; POS[idx] = pos; ptab[tid] = pos; ROWTOK[pos] = (int)(idx >> 2); }
    if (wg < 32) { const int e = wg, st = base[e] - mine[e] + tot[e], en = base[e] - mine[e] + (tot[e] + 255) / 256 * 256; for (int r = st + tid; r < en; r += NTHREADS) ROWTOK[r] = 0; }
    __syncthreads();
    if (EXPERT_FP8) return;
    for (int r0 = wave * (R / NWAVES); r0 < (wave + 1) * (R / NWAVES); r0 += 4) {
        u32x4 va[4], vb[4];
        if (EXPERT_FP8) {
#pragma unroll
            for (int q = 0; q < 4; ++q) va[q] = ((const u32x4*)((const unsigned char*)HB + ((size_t)wg * R + r0 + q) * 1024))[lane];
#pragma unroll
            for (int q = 0; q < 4; ++q)
#pragma unroll
                for (int k = 0; k < 4; ++k) ((u32x4*)((unsigned char*)XS + (size_t)ptab[(r0 + q) * 4 + k] * 1024))[lane] = va[q];
        } else {
#pragma unroll
        for (int q = 0; q < 4; ++q) { const u32x4* src = (const u32x4*)(HB + ((size_t)wg * R + r0 + q) * 1024); va[q] = src[lane]; vb[q] = src[lane + 64]; }
#pragma unroll
        for (int q = 0; q < 4; ++q)
#pragma unroll
            for (int k = 0; k < 4; ++k) { u32x4* dst = (u32x4*)(XS + (size_t)ptab[(r0 + q) * 4 + k] * 1024); dst[lane] = va[q]; dst[lane + 64] = vb[q]; }
        }
    }
}

__device__ __forceinline__ void ph_comb(PrmP p, int l, int wg, int nwg) {
    const int tid = fresh_tid(), lane = tid & 63, wave = tid >> 6;
    const bf16_t* YR = (const bf16_t*)(p->ws + WS_YR); const int* POS = (const int*)(p->ws + WS_MISC + MS_POS); const float* TOPG = (const float*)(p->ws + WS_MISC + MS_TOPG);
    const float* MOD = (const float*)(p->ws + WS_MOD); float* X = p->out; bf16_t* XB = (bf16_t*)(p->ws + WS_XB);
    int posv = POS[(size_t)(wg * NWAVES + wave) * 4 + (lane & 3)]; float gvv = TOPG[(size_t)(wg * NWAVES + wave) * 4 + (lane & 3)];
    for (int m = wg * NWAVES + wave; m < M; m += nwg * NWAVES) {
        const int b = m / T; const float* gate = MOD + (size_t)(l * 4 + b) * 6144 + 5 * 1024;
        const int posc = posv; const float gvc = gvv;
        { const int mn = m + nwg * NWAVES; if (mn < M) { posv = POS[(size_t)mn * 4 + (lane & 3)]; gvv = TOPG[(size_t)mn * 4 + (lane & 3)]; } }
        float y[16];
#pragma unroll
        for (int i = 0; i < 16; ++i) y[i] = 0.f;
#pragma unroll
        for (int k = 0; k < 4; ++k) { const int pos = __builtin_amdgcn_readlane(posc, k); const float gv = __builtin_bit_cast(float, __builtin_amdgcn_readlane(__builtin_bit_cast(int, gvc), k));
            if (YR_FP8) { typedef float f32x2_ __attribute__((ext_vector_type(2))); const float g16 = gv * 0.0625f;
                const u32x2 a8 = *(const u32x2*)((const unsigned char*)YR + (size_t)pos * 1024 + 8 * lane), c8 = *(const u32x2*)((const unsigned char*)YR + (size_t)pos * 1024 + 512 + 8 * lane);
                const unsigned wv[4] = {a8.x, a8.y, c8.x, c8.y};
#pragma unroll
                for (int q = 0; q < 4; ++q) { const f32x2_ lo = __builtin_amdgcn_cvt_pk_f32_fp8((int)wv[q], false), hi = __builtin_amdgcn_cvt_pk_f32_fp8((int)wv[q], true);
                    y[4 * q + 0] += g16 * lo.x; y[4 * q + 1] += g16 * lo.y; y[4 * q + 2] += g16 * hi.x; y[4 * q + 3] += g16 * hi.y; }
            } else {
            const u32x4 a = *(const u32x4*)(YR + (size_t)pos * 1024 + 8 * lane), c = *(const u32x4*)(YR + (size_t)pos * 1024 + 512 + 8 * lane);
            y[0] += gv * bflo(a.x); y[1] += gv * bfhi(a.x); y[2] += gv * bflo(a.y); y[3] += gv * bfhi(a.y); y[4] += gv * bflo(a.z); y[5] += gv * bfhi(a.z); y[6] += gv * bflo(a.w); y[7] += gv * bfhi(a.w);
            y[8] += gv * bflo(c.x); y[9] += gv * bfhi(c.x); y[10] += gv * bflo(c.y); y[11] += gv * bfhi(c.y); y[12] += gv * bflo(c.z); y[13] += gv * bfhi(c.z); y[14] += gv * bflo(c.w); y[15] += gv * bfhi(c.w); } }
        float ss = 0.f;
#pragma unroll
        for (int i = 0; i < 16; ++i) ss += y[i] * y[i];
        const float rstd = __builtin_amdgcn_rsqf(wave_sum(ss) * (1.f / 1024.f) + RMS_EPS);
        float xs[16]; float s2 = 0.f;
#pragma unroll
        for (int hf = 0; hf < 2; ++hf) { const int c0 = hf * 512 + 8 * lane;
#pragma unroll
            for (int q = 0; q < 2; ++q) { const int c = c0 + 4 * q; const f32x4 g = *(const f32x4*)(p->in[I_POSTFFNG] + l * 1024 + c), gt = *(const f32x4*)(gate + c); const u32x2 xw = *(const u32x2*)(XB + (size_t)m * 1024 + c); f32x4 xv = (f32x4){bflo(xw.x), bfhi(xw.x), bflo(xw.y), bfhi(xw.y)};
                xv.x += gt.x * (y[hf * 8 + 4 * q + 0] * rstd * g.x); xv.y += gt.y * (y[hf * 8 + 4 * q + 1] * rstd * g.y); xv.z += gt.z * (y[hf * 8 + 4 * q + 2] * rstd * g.z); xv.w += gt.w * (y[hf * 8 + 4 * q + 3] * rstd * g.w);
                if (l + 1 < NL) { u32x2 xo; xo.x = pk2(xv.x, xv.y); xo.y = pk2(xv.z, xv.w); *(u32x2*)(XB + (size_t)m * 1024 + c) = xo; } else *(f32x4*)(X + (size_t)m * 1024 + c) = xv;
                xs[hf * 8 + 4 * q + 0] = xv.x; xs[hf * 8 + 4 * q + 1] = xv.y; xs[hf * 8 + 4 * q + 2] = xv.z; xs[hf * 8 + 4 * q + 3] = xv.w; s2 += (xv.x * xv.x + xv.y * xv.y) + (xv.z * xv.z + xv.w * xv.w); } }
        if (l + 1 < NL) {
            const float rs2 = __builtin_amdgcn_rsqf(wave_sum(s2) * (1.f / 1024.f) + RMS_EPS);
            const float* shift = MOD + (size_t)((l + 1) * 4 + b) * 6144; const float* scale = shift + 1024; const float* g2 = p->in[I_PREMIXG] + (l + 1) * 1024;
            bf16_t* HB = (bf16_t*)(p->ws + WS_HB);
#pragma unroll
            for (int hf = 0; hf < 2; ++hf) { const int c0 = hf * 512 + 8 * lane; float hv[8];
#pragma unroll
                for (int q = 0; q < 2; ++q) { const f32x4 gg = *(const f32x4*)(g2 + c0 + 4 * q), sc = *(const f32x4*)(scale + c0 + 4 * q), sh = *(const f32x4*)(shift + c0 + 4 * q);
                    hv[4 * q + 0] = xs[hf * 8 + 4 * q + 0] * rs2 * gg.x * (sc.x + 1.f) + sh.x; hv[4 * q + 1] = xs[hf * 8 + 4 * q + 1] * rs2 * gg.y * (sc.y + 1.f) + sh.y;
                    hv[4 * q + 2] = xs[hf * 8 + 4 * q + 2] * rs2 * gg.z * (sc.z + 1.f) + sh.z; hv[4 * q + 3] = xs[hf * 8 + 4 * q + 3] * rs2 * gg.w * (sc.w + 1.f) + sh.w; }
                u32x4 o; o.x = pk2(hv[0], hv[1]); o.y = pk2(hv[2], hv[3]); o.z = pk2(hv[4], hv[5]); o.w = pk2(hv[6], hv[7]);
                *(u32x4*)(HB + (size_t)m * 1024 + c0) = o; } }
    }
}

__device__ __forceinline__ void ph_tables(PrmP p, int wg, int nwg) {
    const int tid = fresh_tid(), lane = tid & 63, wave = tid >> 6;
    for (int it = wave * nwg + wg; it < NL * 16; it += nwg * NWAVES) s5m_table_build(p, it >> 4, it & 15, lane);
}

#define XB_TMO      128
#define XB_XCNT(j)  (256  + 64 * (j))
#define XB_XSUB(j)  (1280 + 64 * (j))
#define XB_XGEN(j)  (2304 + 64 * (j))
#define XB_TOP      3328
#define XB_TOPGEN   3392
#define XCD_BAR_WORDS 3456
#define XB_SPIN_CAP (1u << 22)

__device__ __forceinline__ unsigned xb_ld(unsigned* p)              { return __hip_atomic_load(p, __ATOMIC_RELAXED, __HIP_MEMORY_SCOPE_AGENT); }
__device__ __forceinline__ unsigned xb_add(unsigned* p, unsigned v) { return __hip_atomic_fetch_add(p, v, __ATOMIC_RELAXED, __HIP_MEMORY_SCOPE_AGENT); }
__device__ __forceinline__ unsigned xb_xcc_id() { return (unsigned)__builtin_amdgcn_s_getreg((3 << 11) | 20) & 0xFu; }
#define XB_SPIN(cond, bar) do { unsigned _sp = 0; while (cond) { __builtin_amdgcn_s_sleep(1); \
    if ((++_sp & 255u) == 0u) { if (xb_ld(&(bar)[XB_TMO])) break; if (_sp > XB_SPIN_CAP) { atomicAdd(&(bar)[XB_TMO], 1u); break; } } } } while (0)

struct XcdBarrier { unsigned* bar; unsigned x; volatile LAS unsigned* st; };

__device__ __forceinline__ XcdBarrier xcd_barrier_post(unsigned* bar, volatile LAS unsigned* st) {
    XcdBarrier b; b.bar = bar; b.x = xb_xcc_id(); b.st = st;
    if (threadIdx.x == 0) (void)xb_add(&bar[XB_XCNT(b.x)], 1u);
    return b;
}
__device__ __forceinline__ void xcd_barrier_complete(unsigned* bar, unsigned x, unsigned& nloc, unsigned& nx) {
    const unsigned G = gridDim.x * gridDim.y * gridDim.z;
    unsigned sum, cnt, mine, sp = 0u;
    for (;;) {
        sum = 0u; cnt = 0u; mine = 0u;
#pragma unroll
        for (unsigned j = 0; j < 16; ++j) { const unsigned c = xb_ld(&bar[XB_XCNT(j)]); sum += c; cnt += (c > 0u) ? 1u : 0u; mine = (j == x) ? c : mine; }
        if (sum == G) break;
        __builtin_amdgcn_s_sleep(1);
        if ((++sp & 255u) == 0u) { if (xb_ld(&bar[XB_TMO])) break; if (sp > XB_SPIN_CAP) { atomicAdd(&bar[XB_TMO], 1u); break; } }
    }
    nloc = mine > 0u ? mine : 1u; nx = cnt > 0u ? cnt : 1u;
}
__device__ __forceinline__ void xcd_barrier(const XcdBarrier& b) {
    asm volatile("s_waitcnt vmcnt(0)" ::: "memory");
    __syncthreads();
    if (threadIdx.x == 0) {
        unsigned* bar = b.bar;
        __builtin_amdgcn_s_waitcnt(0);
        unsigned nloc = b.st[0], nx = b.st[1];
        if (nloc == 0u) { xcd_barrier_complete(bar, b.x, nloc, nx); b.st[0] = nloc; b.st[1] = nx; }
        const unsigned old = xb_add(&bar[XB_XSUB(b.x)], 1u);
        const unsigned gen = old / nloc;
        if (old + 1u == (gen + 1u) * nloc) {
            __builtin_amdgcn_fence(__ATOMIC_RELEASE, "agent");
            asm volatile("s_waitcnt vmcnt(0)" ::: "memory");
            const unsigned og = xb_add(&bar[XB_TOP], 1u);
            const unsigned tg = og / nx;
            if (og + 1u == (tg + 1u) * nx) xb_add(&bar[XB_TOPGEN], 1u);
            else XB_SPIN(xb_ld(&bar[XB_TOPGEN]) == tg, bar);
            __builtin_amdgcn_fence(__ATOMIC_ACQUIRE, "agent");
            xb_add(&bar[XB_XGEN(b.x)], 1u);
            asm volatile("s_waitcnt vmcnt(0)" ::: "memory");
        } else {
            XB_SPIN(xb_ld(&bar[XB_XGEN(b.x)]) == gen, bar);
            __builtin_amdgcn_fence(__ATOMIC_ACQUIRE, "agent");
            asm volatile("s_waitcnt vmcnt(0)" ::: "memory");
        }
    }
    __syncthreads();
}

constexpr int LDS_BYTES = 147456;
constexpr int LDS_BAR_OFF = LDS_BYTES - 64;
constexpr int CW_BAR = 4096;

__global__ void __launch_bounds__(NTHREADS, 2) mk_fwd(Prm p_unused) {
    extern __shared__ __attribute__((aligned(16))) unsigned char lds_raw[];
    LAS unsigned char* lds = (LAS unsigned char*)lds_raw;
    const int wg = blockIdx.x, nwg = gridDim.x;
    if (threadIdx.x < 4) ((LAS unsigned*)(lds + LDS_BAR_OFF))[threadIdx.x] = 0u;
    __syncthreads();
    (void)xcd_barrier_post((unsigned*)(prm_fresh()->ws + WS_CTL) + CW_BAR, (volatile LAS unsigned*)(lds + LDS_BAR_OFF));
#define GRID_BAR() do { XcdBarrier b_; b_.bar = (unsigned*)(prm_fresh()->ws + WS_CTL) + CW_BAR; b_.x = xb_xcc_id(); b_.st = (volatile LAS unsigned*)(lds + LDS_BAR_OFF); xcd_barrier(b_); } while (0)
#ifndef REP_PHASE
#define REP_PHASE -1
#endif
#define PHASE(id, call) do { call; GRID_BAR(); if (REP_PHASE == (id)) { call; GRID_BAR(); } } while (0)
    PHASE(0, (ph_prologue(prm_fresh(), lds, wg, nwg), ph_tables(prm_fresh(), wg, nwg)));
#define MK_LAYER(l) do { \
        if ((l) == 0) PHASE(1, ph_norm1(prm_fresh(), l, wg, nwg));     \
        PHASE(2, fg_gemm_in(prm_fresh(), l, lds, wg, nwg)); \
        PHASE(3, fs_scan(prm_fresh(), l, lds, wg, nwg)); \
        fa_attn(prm_fresh(), l, lds, wg, nwg); GRID_BAR(); \
        PHASE(5, fs_fin(prm_fresh(), l, lds, wg, nwg)); \
        PHASE(6, fg_gemm_out(prm_fresh(), l, lds, wg, nwg)); \
        ph_row(prm_fresh(), l, lds, wg, nwg); GRID_BAR(); \
        PHASE(8, ph_offs(prm_fresh(), l, lds, wg, nwg)); \
        PHASE(9, fg_gemm1(prm_fresh(), l, lds, wg, nwg)); \
        PHASE(10, fg_gemm2(prm_fresh(), l, lds, wg, nwg)); \
        ph_comb(prm_fresh(), l, wg, nwg); GRID_BAR(); } while (0)
    MK_LAYER(0);
    MK_LAYER(1);
#undef MK_LAYER
}

extern "C" void kernel_launch(void* const* d_in, const int* in_sizes, int n_in, void* d_out, int out_size, void* d_ws, size_t ws_size, hipStream_t stream) {
    if (n_in != N_IN || out_size != M * D || ws_size < WS_END) { fprintf(stderr, "kernel_launch: unexpected shapes: n_in %d out %d ws %zu (need %zu)\n", n_in, out_size, ws_size, (size_t)WS_END); return; }
    Prm p{};
    for (int i = 0; i < N_IN; ++i) p.in[i] = (const float*)d_in[i];
    p.out = (float*)d_out; p.ws = (unsigned char*)d_ws;
    (void)hipMemsetAsync((char*)d_ws + WS_CTL, 0, 1 * MiB, stream);
    static int grid = 0;
    if (grid == 0) {
        int dev = 0, cus = 0, per_cu = 0;
        if (hipGetDevice(&dev) != hipSuccess || hipDeviceGetAttribute(&cus, hipDeviceAttributeMultiprocessorCount, dev) != hipSuccess) { fprintf(stderr, "kernel_launch: device query failed\n"); grid = -1; return; }
        if (hipFuncSetAttribute((const void*)mk_fwd, hipFuncAttributeMaxDynamicSharedMemorySize, LDS_BYTES) != hipSuccess) { fprintf(stderr, "kernel_launch: hipFuncSetAttribute failed\n"); grid = -1; return; }
        if (hipOccupancyMaxActiveBlocksPerMultiprocessor(&per_cu, (const void*)mk_fwd, NTHREADS, LDS_BYTES) != hipSuccess || per_cu < 1) fprintf(stderr, "kernel_launch: occupancy query reports %d\n", per_cu);
        (void)hipGetLastError();
        grid = 256;
        if (cus < 256) fprintf(stderr, "kernel_launch: %d CUs: 256 workgroups of 144 KiB LDS cannot all be resident\n", cus);
    }
    if (grid < 0) return;
    hipLaunchKernelGGL(mk_fwd, dim3(grid), dim3(NTHREADS), LDS_BYTES, stream, p);
}
```

```cpp
#include <hip/hip_runtime.h>
#include <stdint.h>
#include <stdio.h>

#define LAS __attribute__((address_space(3)))
typedef unsigned short bf16_t;
typedef short bf16x8 __attribute__((ext_vector_type(8)));
typedef float f32x4 __attribute__((ext_vector_type(4)));
typedef unsigned u32x4 __attribute__((ext_vector_type(4)));
typedef unsigned u32x2 __attribute__((ext_vector_type(2)));

constexpr int NB = 4, T = 8192, D = 1024, M = NB * T, NL = 2;
constexpr int INC = 2312, NP = 2560;
constexpr int C_LX = 0, C_LG = 256, C_S5 = 512, C_Q = 768, C_K = 1280, C_V = 1792, C_F = 2304;
constexpr int NH = 8, HD = 64, NE = 32, TOPK = 4, DFF = 1024;
constexpr int RP = M * TOPK + NE * 256;
constexpr float C2 = 0.125f * 1.4426950408889634f;
constexpr float LOG2E = 1.4426950408889634f;
constexpr float RMS_EPS = 1e-6f;
constexpr int NTHREADS = 512, NWAVES = 8;
#ifndef FAST_ATTN
#define FAST_ATTN 1
#endif
#ifndef YR_FP8
#define YR_FP8 1
#endif
#ifndef F8_ALLV
#define F8_ALLV 1
#endif
#ifndef EXPERT_FP8
#define EXPERT_FP8 1
#endif

enum { I_X = 0, I_C, I_ADAW, I_ADAB, I_PREMIXG, I_WIN, I_CONVW, I_CONVB, I_LRUWA, I_LRUBA, I_LRUWX, I_LRUBX, I_LAMBDA, I_S5ARE, I_S5AIM, I_S5BRE, I_S5BIM,
       I_S5CRE, I_S5CIM, I_S5D, I_S5LOGDT, I_GLUW, I_GLUB, I_FOXFB, I_GNLRU, I_GNS5, I_GNATT, I_WOUT, I_POSTMIXG, I_PREFFNG, I_ROUTW, I_ROUTB, I_WGU, I_BGU,
       I_WDN, I_BDN, I_POSTFFNG, N_IN };

constexpr size_t MiB = 1u << 20;
constexpr size_t WS_CTL = 0;
constexpr size_t WS_MOD = 1 * MiB;
constexpr size_t WS_MISC = 2 * MiB;
constexpr size_t WS_FC2 = 6 * MiB;
constexpr size_t WS_WIN = 8 * MiB;
constexpr size_t WS_WOUT = 18 * MiB;
constexpr size_t WS_WGU = 22 * MiB;
constexpr size_t WS_WDN = 278 * MiB;
constexpr size_t WS_HB = 406 * MiB;
constexpr size_t WS_PB = 470 * MiB;
constexpr size_t WS_YL = 630 * MiB;
constexpr size_t WS_YS0 = 662 * MiB;
constexpr size_t WS_OA = 694 * MiB;
constexpr size_t WS_AGG = WS_OA;
constexpr size_t WS_XEND = WS_OA + 2 * MiB;
constexpr size_t WS_GLUW = WS_OA + 8 * MiB;
constexpr size_t WS_X4END = WS_OA + 7 * MiB;
constexpr size_t WS_S5T = WS_OA + 10 * MiB;
constexpr size_t WS_LRUW = WS_OA + 9 * MiB;
constexpr size_t WS_YC = 758 * MiB;
constexpr size_t WS_Y = 822 * MiB;
constexpr size_t WS_XS = 950 * MiB;
constexpr size_t WS_XB = WS_XS;
constexpr size_t WS_H1 = 1222 * MiB;
constexpr size_t WS_YR = 1494 * MiB;
constexpr size_t WS_END = 1766 * MiB;
constexpr size_t MS_ROWTOK = 2560 * 1024;
constexpr size_t MS_TOPI = 0, MS_TOPG = 512 * 1024, MS_RANK = 1024 * 1024, MS_POS = 1536 * 1024, MS_HIST = 2048 * 1024, MS_TILEE = 2048 * 1024 + 64 * 1024;
constexpr int CW_NT = 8;
constexpr int CW_QN = 16384, CW_KT = 32768;
constexpr int CW_NRM = 8192;

struct Prm { const float* in[N_IN]; float* out; unsigned char* ws; };
__device__ __forceinline__ int fresh_tid() { int t = threadIdx.x; asm volatile("" : "+v"(t)); return t; }
typedef const __attribute__((address_space(4))) Prm* PrmP;
__device__ __forceinline__ PrmP prm_fresh() { PrmP q = (PrmP)__builtin_amdgcn_kernarg_segment_ptr(); asm volatile("" : "+s"(q)); return q; }

typedef float f32x2h_ __attribute__((ext_vector_type(2))); typedef __bf16 bf16x2h_ __attribute__((ext_vector_type(2)));
__device__ __forceinline__ unsigned pk2(float lo, float hi) { const f32x2h_ v = {lo, hi}; return __builtin_bit_cast(unsigned, __builtin_convertvector(v, bf16x2h_)); }
__device__ __forceinline__ unsigned f2bf(float f) { return pk2(f, 0.f) & 0xffffu; }
__device__ __forceinline__ float bf2f(unsigned v) { return __builtin_bit_cast(float, v << 16); }
__device__ __forceinline__ float bflo(unsigned w) { return __builtin_bit_cast(float, w << 16); }
__device__ __forceinline__ float bfhi(unsigned w) { return __builtin_bit_cast(float, w & 0xffff0000u); }
__device__ __forceinline__ float wave_sum(float v) {
#pragma unroll
    for (int o = 1; o < 64; o <<= 1) v += __shfl_xor(v, o);
    return v;
}
__device__ __forceinline__ float sigmoidf_(float x) { return __builtin_amdgcn_rcpf(1.f + __expf(-x)); }
__device__ __forceinline__ float gelu_tanh(float x) { const float u = 0.7978845608028654f * (x + 0.044715f * x * x * x); return x * sigmoidf_(2.f * u); }

__device__ __forceinline__ void tr_item(const float* W, int ldw, int nvalid, int k0, int n0, bf16_t* dst, float scale, LAS float* scr, int lane, int ldd = 1024) {
    const int nn = n0 + (lane & 31); const bool ok = nn < nvalid;
#pragma unroll 8
    for (int i = 0; i < 32; ++i) { const int kk = 2 * i + (lane >> 5); scr[kk * 33 + (lane & 31)] = ok ? W[(size_t)(k0 + kk) * ldw + nn] * scale : 0.f; }
    asm volatile("s_waitcnt lgkmcnt(0)" ::: "memory");
    const int c = lane & 7;
#pragma unroll
    for (int j = 0; j < 4; ++j) { const int n = (lane >> 3) + 8 * j; const LAS float* s = scr + (8 * c) * 33 + n;
        u32x4 o; o.x = pk2(s[0 * 33], s[1 * 33]); o.y = pk2(s[2 * 33], s[3 * 33]); o.z = pk2(s[4 * 33], s[5 * 33]); o.w = pk2(s[6 * 33], s[7 * 33]);
        *(u32x4*)(dst + (size_t)n * ldd + k0 + 8 * c) = o; }
    asm volatile("s_waitcnt lgkmcnt(0)" ::: "memory");
}

__device__ __forceinline__ unsigned pk4_fp8(float a, float b, float c, float d) { int w = __builtin_amdgcn_cvt_pk_fp8_f32(a, b, 0, false); w = __builtin_amdgcn_cvt_pk_fp8_f32(c, d, w, true); return (unsigned)w; }
__device__ __forceinline__ void tr_item8w(const float* W, int ldw, int k0, int n0, unsigned char* dst, float scale, LAS float* scr, int lane) {
#pragma unroll 1
    for (int hh = 0; hh < 2; ++hh) { f32x4 v[8];
#pragma unroll
      for (int i = 0; i < 8; ++i) v[i] = *(const f32x4*)(W + (size_t)(k0 + hh * 32 + (lane >> 4) + 4 * i) * ldw + n0 + 4 * (lane & 15));
#pragma unroll
      for (int i = 0; i < 8; ++i) { LAS float* d = scr + (hh * 32 + (lane >> 4) + 4 * i) * 65 + 4 * (lane & 15); d[0] = v[i].x * scale; d[1] = v[i].y * scale; d[2] = v[i].z * scale; d[3] = v[i].w * scale; } }
    asm volatile("s_waitcnt lgkmcnt(0)" ::: "memory");
    const int kq = lane & 3;
#pragma unroll
    for (int j = 0; j < 4; ++j) { const int n = (lane >> 2) + 16 * j; const LAS float* s = scr + (16 * kq) * 65 + n;
        u32x4 o; o.x = pk4_fp8(s[0 * 65], s[1 * 65], s[2 * 65], s[3 * 65]); o.y = pk4_fp8(s[4 * 65], s[5 * 65], s[6 * 65], s[7 * 65]);
        o.z = pk4_fp8(s[8 * 65], s[9 * 65], s[10 * 65], s[11 * 65]); o.w = pk4_fp8(s[12 * 65], s[13 * 65], s[14 * 65], s[15 * 65]);
        *(u32x4*)(dst + (size_t)n * 1024 + k0 + 16 * kq) = o; }
    asm volatile("s_waitcnt lgkmcnt(0)" ::: "memory");
}
#ifndef PRO_PROBE
#define PRO_PROBE 0
#endif
template <int MODE> __device__ __forceinline__ void ex_convert(PrmP p, LAS float* scr, int gw, int NGW, int lane) {
    constexpr int I_GU = 16 * 32, I_DN = 16 * 16, NEX = 64 * I_GU + 64 * I_DN;
#define EX_ITEM(r_, src_, dst_, ldw_) do { int r2_ = (r_); if (r2_ < 64 * I_GU) { const int le = r2_ >> 9, q = r2_ & 511, kb = q >> 5, n0 = (q & 31) * 64; \
        const int sx = n0 >> 10, rr = n0 & 1023, j = rr >> 7, cc = rr & 127, drow = 256 * j + 128 * sx + cc; \
        ldw_ = 2048; src_ = p->in[I_WGU] + (size_t)le * 1024 * 2048 + (size_t)(kb * 64) * 2048 + n0; dst_ = p->ws + (MODE == 2 ? WS_YR : WS_WGU) + ((size_t)le * 2048 + drow) * 1024 + kb * 64; } \
      else { r2_ -= 64 * I_GU; const int le = r2_ >> 8, q = r2_ & 255, kb = q >> 4, n0 = (q & 15) * 64; \
        ldw_ = 1024; src_ = p->in[I_WDN] + (size_t)le * 1024 * 1024 + (size_t)(kb * 64) * 1024 + n0; dst_ = p->ws + (MODE == 2 ? WS_YR + 128 * MiB : WS_WDN) + ((size_t)le * 1024 + n0) * 1024 + kb * 64; } } while (0)
#define EX_LOAD(src_, ldw_) do { _Pragma("unroll") for (int i = 0; i < 16; ++i) { if (MODE == 2) v[i] = (f32x4){(float)i, (float)lane, 1.f, 2.f}; else v[i] = *(const f32x4*)((src_) + (size_t)((lane >> 4) + 4 * i) * (ldw_) + 4 * (lane & 15)); } } while (0)
    int r = gw;
    if (r < NEX) {
        const float* src; unsigned char* dst; int ldw; f32x4 v[16];
        EX_ITEM(r, src, dst, ldw); EX_LOAD(src, ldw);
#pragma unroll 1
        for (;;) {
#pragma unroll
            for (int i = 0; i < 16; ++i) { LAS float* d = scr + ((lane >> 4) + 4 * i) * 65 + 4 * (lane & 15); d[0] = v[i].x * 64.f; d[1] = v[i].y * 64.f; d[2] = v[i].z * 64.f; d[3] = v[i].w * 64.f; }
            const int rn = r + NGW; const bool more = rn < NEX; unsigned char* dcur = dst;
            if (more) { EX_ITEM(rn, src, dst, ldw); EX_LOAD(src, ldw); }
            asm volatile("s_waitcnt lgkmcnt(0)" ::: "memory");
            const int kq = lane & 3;
#pragma unroll
            for (int j = 0; j < 4; ++j) { const int n = (lane >> 2) + 16 * j; const LAS float* sp = scr + (16 * kq) * 65 + n;
                u32x4 o; o.x = pk4_fp8(sp[0 * 65], sp[1 * 65], sp[2 * 65], sp[3 * 65]); o.y = pk4_fp8(sp[4 * 65], sp[5 * 65], sp[6 * 65], sp[7 * 65]);
                o.z = pk4_fp8(sp[8 * 65], sp[9 * 65], sp[10 * 65], sp[11 * 65]); o.w = pk4_fp8(sp[12 * 65], sp[13 * 65], sp[14 * 65], sp[15 * 65]);
                if (MODE != 1 || (o.x == 0x12345678u && o.y == 0x9abcdef0u && o.z == 0x0fedcba9u)) *(u32x4*)(dcur + (size_t)n * 1024 + 16 * kq) = o; }
            asm volatile("s_waitcnt lgkmcnt(0)" ::: "memory");
            if (!more) break;
            r = rn;
        }
    }
#undef EX_ITEM
#undef EX_LOAD
}
__device__ __forceinline__ void ph_prologue(PrmP p, LAS unsigned char* lds, int wg, int nwg) {
    const int tid = fresh_tid(), lane = tid & 63, wave = tid >> 6;
    {
        LAS float* sc = (LAS float*)lds; LAS float* red = sc + 4096;
        const float* c = p->in[I_C];
        for (int i = tid; i < 4096; i += NTHREADS) { const float v = c[i]; sc[i] = v / (1.f + __expf(-v)); }
        __syncthreads();
        float* MOD = (float*)(p->ws + WS_MOD);
        for (int it = wg; it < 2 * 96; it += nwg) {
            const int l = it / 96, n0 = (it % 96) * 64, kg = tid >> 6, nl = tid & 63;
            const float* W = p->in[I_ADAW] + (size_t)l * 1024 * 6144 + n0 + nl;
            float a0 = 0.f, a1 = 0.f, a2 = 0.f, a3 = 0.f;
            for (int k0 = kg; k0 < 1024; k0 += 8 * 16) { float w[16];
#pragma unroll
                for (int q = 0; q < 16; ++q) w[q] = W[(size_t)(k0 + 8 * q) * 6144];
#pragma unroll
                for (int q = 0; q < 16; ++q) { const int k = k0 + 8 * q; a0 += sc[k] * w[q]; a1 += sc[1024 + k] * w[q]; a2 += sc[2048 + k] * w[q]; a3 += sc[3072 + k] * w[q]; } }
            red[(kg * 4 + 0) * 64 + nl] = a0; red[(kg * 4 + 1) * 64 + nl] = a1; red[(kg * 4 + 2) * 64 + nl] = a2; red[(kg * 4 + 3) * 64 + nl] = a3;
            __syncthreads();
            if (tid < 256) { const int b = tid >> 6; float s = 0.f;
#pragma unroll
                for (int g = 0; g < 8; ++g) s += red[(g * 4 + b) * 64 + nl];
                MOD[(size_t)(l * 4 + b) * 6144 + n0 + nl] = s + p->in[I_ADAB][l * 6144 + n0 + nl]; }
            __syncthreads();
        }
    }
    {
        LAS float* scr = (LAS float*)lds + wave * (64 * 65);
        const int gw = wave * nwg + wg, NGW = nwg * NWAVES;
        constexpr int I_IN = 16 * 80, I_OUT = 16 * 32, I_GU = EXPERT_FP8 ? 16 * 32 : 16 * 64, I_DN = EXPERT_FP8 ? 16 * 16 : 16 * 32;
        constexpr int I_GLU = 4 * 8;
        constexpr int I_LRU = 4 * 2 * 2;
        constexpr int NGU = EXPERT_FP8 ? 0 : 64 * I_GU, NDN = EXPERT_FP8 ? 0 : 64 * I_DN;
        constexpr int TOT = 2 * I_IN + 2 * I_OUT + NGU + NDN + 2 * I_GLU + 2 * I_LRU;
        for (int it = gw; it < TOT; it += NGW) {
            int r = it;
            if (r < 2 * I_IN) { const int l = r / I_IN, q = r % I_IN, kb = q / 80, nb = q % 80, n0 = nb * 32;
                const float sc = (n0 >= C_Q && n0 < C_K) ? C2 : 1.f;
                tr_item(p->in[I_WIN] + (size_t)l * 1024 * INC, INC, INC, kb * 64, n0, (bf16_t*)(p->ws + WS_WIN) + ((size_t)l * NP + n0) * 1024, sc, scr, lane); continue; }
            r -= 2 * I_IN;
            if (r < 2 * I_OUT) { const int l = r / I_OUT, q = r % I_OUT, kb = q / 32, nb = q % 32, n0 = nb * 32;
                tr_item(p->in[I_WOUT] + (size_t)l * 1024 * 1024, 1024, 1024, kb * 64, n0, (bf16_t*)(p->ws + WS_WOUT) + ((size_t)l * 1024 + n0) * 1024, 1.f, scr, lane); continue; }
            r -= 2 * I_OUT;
            if (r < NGU) { const int le = r / I_GU, q = r % I_GU, NBK = EXPERT_FP8 ? 32 : 64, kb = q / NBK, nb = q % NBK, n0 = nb * (2048 / NBK);
                const int s = n0 / 1024, rr = n0 % 1024, j = rr / 128, cc = rr % 128, drow = 256 * j + 128 * s + cc;
                if (EXPERT_FP8) tr_item8w(p->in[I_WGU] + (size_t)le * 1024 * 2048, 2048, kb * 64, n0, p->ws + WS_WGU + ((size_t)le * 2048 + drow) * 1024, 64.f, scr, lane);
                else tr_item(p->in[I_WGU] + (size_t)le * 1024 * 2048, 2048, 2048, kb * 64, n0, (bf16_t*)(p->ws + WS_WGU) + ((size_t)le * 2048 + drow) * 1024, 1.f, scr, lane); continue; }
            r -= NGU;
            if (r < NDN) { const int le = r / I_DN, q = r % I_DN, NBK = EXPERT_FP8 ? 16 : 32, kb = q / NBK, nb = q % NBK, n0 = nb * (1024 / NBK);
                if (EXPERT_FP8) tr_item8w(p->in[I_WDN] + (size_t)le * 1024 * 1024, 1024, kb * 64, n0, p->ws + WS_WDN + ((size_t)le * 1024 + n0) * 1024, 64.f, scr, lane);
                else tr_item(p->in[I_WDN] + (size_t)le * 1024 * 1024, 1024, 1024, kb * 64, n0, (bf16_t*)(p->ws + WS_WDN) + ((size_t)le * 1024 + n0) * 1024, 1.f, scr, lane); continue; }
            r -= NDN;
            if (r < 2 * I_GLU) { const int l = r / I_GLU, q = r % I_GLU, kb = q / 8, nb = q % 8, n0 = nb * 32;
                tr_item(p->in[I_GLUW] + (size_t)l * 256 * 256, 256, 256, kb * 64, n0, (bf16_t*)(p->ws + WS_GLUW) + ((size_t)l * 256 + n0) * 256, 1.f, scr, lane, 256); continue; }
            r -= 2 * I_GLU;
            { const int l = r / I_LRU, q = r % I_LRU, blk = q >> 2, gate = (q >> 1) & 1, n0 = (q & 1) * 32;
                tr_item(p->in[gate ? I_LRUWX : I_LRUWA] + (size_t)(l * 4 + blk) * 4096, 64, 64, 0, n0, (bf16_t*)(p->ws + WS_LRUW) + ((size_t)((l * 4 + blk) * 2 + gate) * 64 + n0) * 64, 1.f, scr, lane, 64); }
        }
#if EXPERT_FP8
        ex_convert<0>(p, scr, gw, NGW, lane);
        if (PRO_PROBE == 1) ex_convert<1>(p, scr, gw, NGW, lane);
        if (PRO_PROBE == 2) ex_convert<2>(p, scr, gw, NGW, lane);
#endif
    }
}

__device__ __forceinline__ void ph_norm1(PrmP p, int l, int wg, int nwg) {
    const int tid = fresh_tid(), lane = tid & 63, wave = tid >> 6;
    const float* X = (l == 0) ? p->in[I_X] : p->out;
    const float* MOD = (const float*)(p->ws + WS_MOD);
    bf16_t* HB = (bf16_t*)(p->ws + WS_HB);
    const float* g = p->in[I_PREMIXG] + l * 1024;
    for (int m = wg * NWAVES + wave; m < M; m += nwg * NWAVES) {
        const int b = m / T;
        const float* shift = MOD + (size_t)(l * 4 + b) * 6144 + 0 * 1024; const float* scale = shift + 1024;
        f32x4 v[4]; float ss = 0.f;
#pragma unroll
        for (int j = 0; j < 4; ++j) { v[j] = *(const f32x4*)(X + (size_t)m * 1024 + 4 * lane + 256 * j); ss += (v[j].x * v[j].x + v[j].y * v[j].y) + (v[j].z * v[j].z + v[j].w * v[j].w); }
        const float rstd = __builtin_amdgcn_rsqf(wave_sum(ss) * (1.f / 1024.f) + RMS_EPS);
#pragma unroll
        for (int j = 0; j < 4; ++j) { const int c = 4 * lane + 256 * j; const f32x4 gg = *(const f32x4*)(g + c), sc = *(const f32x4*)(scale + c), sh = *(const f32x4*)(shift + c);
            const f32x4 h = v[j] * rstd * gg * (sc + 1.f) + sh;
            u32x2 o; o.x = pk2(h.x, h.y); o.y = pk2(h.z, h.w); *(u32x2*)(HB + (size_t)m * 1024 + c) = o; }
    }
}

namespace pg8 {
#define PG8_LAS __attribute__((address_space(3)))
typedef unsigned short bf16_t;
typedef short bf16x8 __attribute__((ext_vector_type(8)));
typedef float f32x4 __attribute__((ext_vector_type(4)));
typedef unsigned u32x4 __attribute__((ext_vector_type(4)));
constexpr int BM = 256, BK = 64, HALF = 128, HTB = HALF * BK * 2  , STAGE_BYTES = 8 * HTB, NXCD = 8, WGM = 8;

__host__ __device__ __forceinline__ int lds_byte(int r, int c) { const int st = (r >> 4) * 2 + (c >> 5), rr = r & 15, cc = c & 31, ob = rr * 64 + cc * 2; return st * 1024 + (ob ^ (((ob >> 9) & 1) << 5)); }
__host__ __device__ __forceinline__ void stage_rc(int b, int& R, int& C) { const int st = b / 1024, sb = b % 1024, swz = sb ^ (((sb >> 9) & 1) << 5); R = (st >> 1) * 16 + swz / 64; C = (st & 1) * 32 + (swz % 64) / 2; }
__host__ __device__ __forceinline__ int perm32(int rho) { const int n = rho >> 4, i = rho & 15; return 8 * (i >> 2) + 4 * n + (i & 3); }

struct Unit { int pm, pn; };
struct Gemm { const bf16_t* A; const bf16_t* Bt; int M, N, K; const PG8_LAS unsigned short* rowtok = nullptr; };

struct StaticOrder {
    int nM, nN, nwg, G, c;
    __host__ __device__ void init(int M, int N, int G_, int c_) { nM = M / BM; nN = N / BM; nwg = nM * nN; G = G_; c = c_; }
    __host__ __device__ bool next(int i, Unit& u) const {
        const long L = (long)i * G + c; if (L >= nwg) return false;
        int wgid = (int)L; { const int q = nwg / NXCD, r = nwg % NXCD, xcd = wgid % NXCD, off = wgid / NXCD; wgid = (xcd < r ? xcd * (q + 1) : r * (q + 1) + (xcd - r) * q) + off; }
        const int nig = WGM * nN, gid = wgid / nig, fm = gid * WGM, gsz = (nM - fm) < WGM ? (nM - fm) : WGM;
        u.pm = fm + ((wgid % nig) % gsz); u.pn = (wgid % nig) / gsz; return true;
    }
    __device__ __forceinline__ void a_ready(const Unit&) const {}
    __device__ __forceinline__ void done(const Unit&) const {}
};


__device__ __forceinline__ unsigned cvt_pk_bf16(float lo, float hi) { unsigned r; asm volatile("v_cvt_pk_bf16_f32 %0, %1, %2" : "=v"(r) : "v"(lo), "v"(hi)); return r; }
struct EpiBf16Plain {
    static constexpr bool PERM = true, AFTER_DRAIN = false;
    bf16_t* O; int ldc;
    __device__ __forceinline__ void operator()(const f32x4 (&acc)[2][2][4][2], const Unit& u, int wr, int wc, int fr, int fq) const {
        const int row0 = u.pm * BM + wr * 64 + fr, col0 = u.pn * BM + wc * 32 + 8 * fq;
#pragma unroll
        for (int ai = 0; ai < 2; ++ai)
#pragma unroll
            for (int m = 0; m < 4; ++m) { bf16_t* rowp = O + (size_t)(row0 + ai * HALF + m * 16) * ldc + col0;
#pragma unroll
                for (int bj = 0; bj < 2; ++bj) { const f32x4 v0 = acc[ai][bj][m][0], v1 = acc[ai][bj][m][1];
                    u32x4 w; w.x = cvt_pk_bf16(v0[0], v0[1]); w.y = cvt_pk_bf16(v0[2], v0[3]); w.z = cvt_pk_bf16(v1[0], v1[1]); w.w = cvt_pk_bf16(v1[2], v1[3]);
                    *(u32x4*)(rowp + bj * HALF) = w; } }
    }
};
struct EpiSwiglu {
    static constexpr bool PERM = true, AFTER_DRAIN = false;
    bf16_t* H1; const float* bgu;
    __device__ __forceinline__ void operator()(const f32x4 (&acc)[2][2][4][2], const Unit& u, int wr, int wc, int fr, int fq) const {
        const int e = u.pn >> 3, j = u.pn & 7, row0 = u.pm * BM + wr * 64 + fr, lc0 = wc * 32 + 8 * fq;
        const float* bb = bgu + (size_t)e * 2048 + j * 128 + lc0;
        const f32x4 bg0 = *(const f32x4*)(bb), bg1 = *(const f32x4*)(bb + 4), bu0 = *(const f32x4*)(bb + 1024), bu1 = *(const f32x4*)(bb + 1028);
#pragma unroll
        for (int ai = 0; ai < 2; ++ai)
#pragma unroll
            for (int m = 0; m < 4; ++m) { float o[8];
#pragma unroll
                for (int n = 0; n < 2; ++n) { const f32x4 g4 = acc[ai][0][m][n] + (n ? bg1 : bg0), u4 = acc[ai][1][m][n] + (n ? bu1 : bu0);
#pragma unroll
                    for (int q = 0; q < 4; ++q) { const float g = fminf(g4[q], 7.f), up = fminf(fmaxf(u4[q], -7.f), 7.f);
                        o[4 * n + q] = (up + 1.f) * g * __builtin_amdgcn_rcpf(1.f + __builtin_amdgcn_exp2f(-1.702f * 1.4426950408889634f * g)); } }
                u32x4 w; w.x = cvt_pk_bf16(o[0], o[1]); w.y = cvt_pk_bf16(o[2], o[3]); w.z = cvt_pk_bf16(o[4], o[5]); w.w = cvt_pk_bf16(o[6], o[7]);
                *(u32x4*)(H1 + (size_t)(row0 + ai * HALF + m * 16) * 1024 + j * 128 + lc0) = w; }
    }
};
__device__ __forceinline__ unsigned pk4_fp8(float a, float b, float c, float d) { int w = __builtin_amdgcn_cvt_pk_fp8_f32(a, b, 0, false); w = __builtin_amdgcn_cvt_pk_fp8_f32(c, d, w, true); return (unsigned)w; }
struct EpiSwiglu8 {
    static constexpr bool PERM = true, AFTER_DRAIN = false;
    unsigned char* H1; const float* bgu;
    __device__ __forceinline__ void operator()(const f32x4 (&acc)[2][2][4][2], const Unit& u, int wr, int wc, int fr, int fq) const {
        const int e = u.pn >> 3, j = u.pn & 7, row0 = u.pm * BM + wr * 64 + fr, lc0 = wc * 32 + 8 * fq;
        const float* bb = bgu + (size_t)e * 2048 + j * 128 + lc0;
        const f32x4 bg0 = *(const f32x4*)(bb), bg1 = *(const f32x4*)(bb + 4), bu0 = *(const f32x4*)(bb + 1024), bu1 = *(const f32x4*)(bb + 1028);
#pragma unroll
        for (int ai = 0; ai < 2; ++ai)
#pragma unroll
            for (int m = 0; m < 4; ++m) { float o[8];
#pragma unroll
                for (int n = 0; n < 2; ++n) { const f32x4 g4 = acc[ai][0][m][n] + (n ? bg1 : bg0), u4 = acc[ai][1][m][n] + (n ? bu1 : bu0);
#pragma unroll
                    for (int q = 0; q < 4; ++q) { const float g = fminf(g4[q], 7.f), up = fminf(fmaxf(u4[q], -7.f), 7.f);
                        o[4 * n + q] = 2.f * (up + 1.f) * g * __builtin_amdgcn_rcpf(1.f + __builtin_amdgcn_exp2f(-1.702f * 1.4426950408889634f * g)); } }
                typedef unsigned u32x2_ __attribute__((ext_vector_type(2))); u32x2_ w; w.x = pk4_fp8(o[0], o[1], o[2], o[3]); w.y = pk4_fp8(o[4], o[5], o[6], o[7]);
                *(u32x2_*)(H1 + (size_t)(row0 + ai * HALF + m * 16) * 1024 + j * 128 + lc0) = w; }
    }
};
struct EpiDown {
    static constexpr bool PERM = true, AFTER_DRAIN = false;
    bf16_t* YR; const float* bdn;
    __device__ __forceinline__ void operator()(const f32x4 (&acc)[2][2][4][2], const Unit& u, int wr, int wc, int fr, int fq) const {
        const int e = u.pn >> 2, jn = u.pn & 3, row0 = u.pm * BM + wr * 64 + fr, col0 = jn * BM + wc * 32 + 8 * fq;
        f32x4 bv[2][2];
#pragma unroll
        for (int bj = 0; bj < 2; ++bj)
#pragma unroll
            for (int n = 0; n < 2; ++n) bv[bj][n] = *(const f32x4*)(bdn + (size_t)e * 1024 + col0 + bj * HALF + 4 * n);
#pragma unroll
        for (int ai = 0; ai < 2; ++ai)
#pragma unroll
            for (int m = 0; m < 4; ++m) { bf16_t* rowp = YR + (size_t)(row0 + ai * HALF + m * 16) * 1024 + col0;
#pragma unroll
                for (int bj = 0; bj < 2; ++bj) { const f32x4 v0 = acc[ai][bj][m][0] + bv[bj][0], v1 = acc[ai][bj][m][1] + bv[bj][1];
                    u32x4 w; w.x = cvt_pk_bf16(v0[0], v0[1]); w.y = cvt_pk_bf16(v0[2], v0[3]); w.z = cvt_pk_bf16(v1[0], v1[1]); w.w = cvt_pk_bf16(v1[2], v1[3]);
                    *(u32x4*)(rowp + bj * HALF) = w; } }
    }
};
struct EpiDown8 {
    static constexpr bool PERM = true, AFTER_DRAIN = false;
    unsigned char* YR; const float* bdn;
    __device__ __forceinline__ void operator()(const f32x4 (&acc)[2][2][4][2], const Unit& u, int wr, int wc, int fr, int fq) const {
        const int e = u.pn >> 2, jn = u.pn & 3, row0 = u.pm * BM + wr * 64 + fr, col0 = jn * BM + wc * 32 + 8 * fq;
        f32x4 bv[2][2];
#pragma unroll
        for (int bj = 0; bj < 2; ++bj)
#pragma unroll
            for (int n = 0; n < 2; ++n) bv[bj][n] = *(const f32x4*)(bdn + (size_t)e * 1024 + col0 + bj * HALF + 4 * n);
#pragma unroll
        for (int ai = 0; ai < 2; ++ai)
#pragma unroll
            for (int m = 0; m < 4; ++m) { unsigned char* rowp = YR + (size_t)(row0 + ai * HALF + m * 16) * 1024 + col0;
#pragma unroll
                for (int bj = 0; bj < 2; ++bj) { const f32x4 v0 = (acc[ai][bj][m][0] + bv[bj][0]) * 16.f, v1 = (acc[ai][bj][m][1] + bv[bj][1]) * 16.f;
                    typedef unsigned u32x2_ __attribute__((ext_vector_type(2))); u32x2_ w; w.x = pk4_fp8(v0[0], v0[1], v0[2], v0[3]); w.y = pk4_fp8(v1[0], v1[1], v1[2], v1[3]);
                    *(u32x2_*)(rowp + bj * HALF) = w; } }
    }
};
struct GroupOrder {
    int nt, nct, G, c; const PG8_LAS int* tile_e;
    __device__ __forceinline__ bool peek_pm(int i, int& rt) const { const int x = c & 7, j = c >> 3, rpg = 32 / nct, gi = i * 8 + x; rt = gi * rpg + j / nct; return G == 256 && rt < nt; }
    __device__ __forceinline__ bool next(int i, Unit& u) const {
        const int x = c & 7, j = c >> 3, rpg = 32 / nct, gi = i * 8 + x, rt = gi * rpg + j / nct, ct = j % nct;
        if (G != 256 || rt >= nt) return false;
        u.pm = rt; u.pn = tile_e[rt] * nct + ct; return true; }
    __device__ __forceinline__ void a_ready(const Unit&) const {}
    __device__ __forceinline__ void done(const Unit&) const {}
};

typedef int i32x8 __attribute__((ext_vector_type(8))); typedef int i32x4 __attribute__((ext_vector_type(4)));
__device__ __forceinline__ i32x8 cat8(bf16x8 lo, bf16x8 hi) { const i32x4 a = __builtin_bit_cast(i32x4, lo), b = __builtin_bit_cast(i32x4, hi); return __builtin_shufflevector(a, b, 0, 1, 2, 3, 4, 5, 6, 7); }
template <class Epi, class Sched, bool ALIGN_EPI = false, bool SP2 = false, int F8SCALE = 0, bool GATHER = false>
__device__ __forceinline__ void gemm_phase(PG8_LAS unsigned char* lds, const Gemm g, const Sched& S, const Epi& E) {
    const int tid = fresh_tid(), wid = __builtin_amdgcn_readfirstlane(tid >> 6), lane = tid & 63, wr = wid >> 2, wc = wid & 3, fr = lane & 15, fq = lane >> 4;
    const int K = g.K, nt = K / BK;
    unsigned voffA[2], voffB[2];
#pragma unroll
    for (int i = 0; i < 2; ++i) { int R, C; stage_rc(tid * 16 + i * 8192, R, C); const int Rb = Epi::PERM ? ((R & ~31) + perm32(R & 31)) : R;
        voffA[i] = GATHER ? (unsigned)((R << 16) | (C * 2)) : (unsigned)(R * K + C) * 2u; voffB[i] = (unsigned)(Rb * K + C) * 2u; }
    static_assert(!GATHER || SP2, "the gathered form is written for the SP2 loop");
    unsigned gA[2][2] = {{0u, 0u}, {0u, 0u}}, gN[2][2] = {{0u, 0u}, {0u, 0u}};
#define PG8_GLOOK(dst, unit) do { _Pragma("unroll") for (int h_ = 0; h_ < 2; ++h_) _Pragma("unroll") for (int i_ = 0; i_ < 2; ++i_) \
        dst[h_][i_] = (unsigned)g.rowtok[(unit) * BM + h_ * HALF + (int)(voffA[i_] >> 16)]; } while (0)
#define PG8_GOFF(dst, src) do { _Pragma("unroll") for (int h_ = 0; h_ < 2; ++h_) _Pragma("unroll") for (int i_ = 0; i_ < 2; ++i_) dst[h_][i_] = src[h_][i_] * (unsigned)(K * 2) + (voffA[i_] & 0xffffu); } while (0)
#define PG8_STAGE_A(bufoff, gbase, half, OFFS) do { if constexpr (GATHER) { _Pragma("unroll") for (int _i = 0; _i < 2; ++_i) \
        __builtin_amdgcn_global_load_lds((const unsigned*)((const char*)(gbase) + OFFS[half][_i]), (PG8_LAS unsigned*)(lds + (bufoff) + ldsw + _i * 8192), 16, 0, 0); } \
        else { PG8_STAGE(bufoff, (gbase) + (half) * hstep, voffA); } } while (0)
    const size_t kstep = (size_t)(BK * 2);
    const size_t hstep = (size_t)HALF * K * 2;
    const size_t tstep = 2 * hstep;
    const unsigned ldsw = (unsigned)wid * 1024u;
    const int aoff = lds_byte(wr * 64 + fr, fq * 8), boff = lds_byte(wc * 32 + fr, fq * 8);
#define PG8_SA(b, h) (((b) * 2 + (h)) * HTB)
#define PG8_SB(b, h) ((4 + (b) * 2 + (h)) * HTB)
#define PG8_STAGE(bufoff, gbase, voff) do { _Pragma("unroll") for (int _i = 0; _i < 2; ++_i) \
        __builtin_amdgcn_global_load_lds((const unsigned*)((const char*)(gbase) + (voff)[_i]), (PG8_LAS unsigned*)(lds + (bufoff) + ldsw + _i * 8192), 16, 0, 0); } while (0)
#define PG8_LDA(dst, b, h) do { _Pragma("unroll") for (int m = 0; m < 4; ++m) { const bf16x8 l0_ = *(const PG8_LAS bf16x8*)(lds + PG8_SA(b, h) + aoff + m * 2048), l1_ = *(const PG8_LAS bf16x8*)(lds + PG8_SA(b, h) + aoff + m * 2048 + 1024); \
        if constexpr (F8SCALE != 0) dst##8[m] = cat8(l0_, l1_); else { dst[m][0] = l0_; dst[m][1] = l1_; } } } while (0)
#define PG8_LDB(dst, b, h) do { _Pragma("unroll") for (int n = 0; n < 2; ++n) { const bf16x8 l0_ = *(const PG8_LAS bf16x8*)(lds + PG8_SB(b, h) + boff + n * 2048), l1_ = *(const PG8_LAS bf16x8*)(lds + PG8_SB(b, h) + boff + n * 2048 + 1024); \
        if constexpr (F8SCALE != 0) dst##8[n] = cat8(l0_, l1_); else { dst[n][0] = l0_; dst[n][1] = l1_; } } } while (0)
#define PG8_MMA(ai, bj, At, Bt) do { __builtin_amdgcn_s_setprio(1); _Pragma("unroll") for (int m = 0; m < 4; ++m) _Pragma("unroll") for (int n = 0; n < 2; ++n) { \
        if constexpr (F8SCALE != 0) { if (F8_ALLV || ((ai) == 1 && (bj) == 1)) asm volatile("v_mfma_scale_f32_16x16x128_f8f6f4 %0, %1, %2, %0, %3, %4 op_sel_hi:[0,0,0]" : "+v"(acc[ai][bj][m][n]) : "v"(Bt##8[n]), "v"(At##8[m]), "v"(f8sa), "v"(f8sb)); \
            else asm volatile("v_mfma_scale_f32_16x16x128_f8f6f4 %0, %1, %2, %0, %3, %4 op_sel_hi:[0,0,0]" : "+a"(acc[ai][bj][m][n]) : "v"(Bt##8[n]), "v"(At##8[m]), "v"(f8sa), "v"(f8sb)); } \
        else { _Pragma("unroll") for (int k = 0; k < 2; ++k) acc[ai][bj][m][n] = __builtin_amdgcn_mfma_f32_16x16x32_bf16(Bt[n][k], At[m][k], acc[ai][bj][m][n], 0, 0, 0); } } __builtin_amdgcn_s_setprio(0); } while (0)
#define PG8_WAIT_V(n) asm volatile("s_waitcnt vmcnt(" #n ")" ::: "memory")
#define PG8_WAIT_L(n) asm volatile("s_waitcnt lgkmcnt(" #n ")" ::: "memory")
#define PG8_BAR __builtin_amdgcn_s_barrier()
#define PG8_SCHED __builtin_amdgcn_sched_barrier(0)
    Unit cur, nxt; int ui = 0;
    if (!S.next(0, cur)) return;
    f32x4 acc[2][2][4][2];
#pragma unroll
    for (int a = 0; a < 2; ++a)
#pragma unroll
        for (int b = 0; b < 2; ++b)
#pragma unroll
            for (int m = 0; m < 4; ++m)
#pragma unroll
                for (int n = 0; n < 2; ++n) acc[a][b][m][n] = (f32x4){0.f, 0.f, 0.f, 0.f};
    bf16x8 At[4][2], B0[2][2], B1[2][2]; i32x8 At8[4], B08[2], B18[2];
    const int f8sa = F8SCALE * 0x01010101, f8sb = 0x7f7f7f7f;
    const char* cA = GATHER ? (const char*)g.A : (const char*)g.A + (size_t)cur.pm * tstep; const char* cB = (const char*)g.Bt + (size_t)cur.pn * tstep;
    if constexpr (GATHER) { PG8_GLOOK(gN, 0); PG8_GOFF(gA, gN); }
    S.a_ready(cur);
    if constexpr (SP2) {
        PG8_STAGE(PG8_SB(0, 0), cB, voffB); PG8_STAGE(PG8_SB(0, 1), cB + hstep, voffB); PG8_STAGE_A(PG8_SA(0, 0), cA, 0, gA); PG8_STAGE_A(PG8_SA(0, 1), cA, 1, gA);
        if (wr == 1) PG8_BAR;
        PG8_WAIT_V(2); PG8_BAR;
        PG8_STAGE(PG8_SB(1, 0), cB + kstep, voffB); PG8_STAGE_A(PG8_SA(1, 0), cA + kstep, 0, gA); PG8_STAGE(PG8_SB(1, 1), cB + hstep + kstep, voffB);
        PG8_WAIT_V(6); PG8_BAR;
    } else {
        PG8_STAGE(PG8_SB(0, 0), cB, voffB); PG8_STAGE(PG8_SA(0, 0), cA, voffA); PG8_STAGE(PG8_SB(0, 1), cB + hstep, voffB); PG8_STAGE(PG8_SA(0, 1), cA + hstep, voffA);
        if (wr == 1) PG8_BAR;
        PG8_WAIT_V(4); PG8_BAR;
        PG8_STAGE(PG8_SB(1, 0), cB + kstep, voffB); PG8_STAGE(PG8_SA(1, 0), cA + kstep, voffA); PG8_STAGE(PG8_SB(1, 1), cB + hstep + kstep, voffB);
        PG8_WAIT_V(6); PG8_BAR;
    }
    for (;;) {
        if constexpr (GATHER) { int rt_; if (S.peek_pm(ui + 1, rt_)) PG8_GLOOK(gN, ui + 1); }
        const bool has_next = S.next(ui + 1, nxt);
        const char* nA = (has_next && !GATHER) ? (const char*)g.A + (size_t)nxt.pm * tstep : cA; const char* nB = has_next ? (const char*)g.Bt + (size_t)nxt.pn * tstep : cB;
        for (int t = 0; t < nt; t += 2) {
            const bool last = (t == nt - 2);
            const char* a1 = cA + (size_t)(t + 1) * kstep;
            const char* a2 = last ? nA : cA + (size_t)(t + 2) * kstep; const char* b2 = last ? nB : cB + (size_t)(t + 2) * kstep;
            const char* a3 = a2 + kstep; const char* b3 = b2 + kstep;
            if (last && has_next) S.a_ready(nxt);
            unsigned o2[2][2] = {{gA[0][0], gA[0][1]}, {gA[1][0], gA[1][1]}};
            if constexpr (GATHER) { if (last) { asm volatile("" : "+v"(gN[0][0]), "+v"(gN[0][1]), "+v"(gN[1][0]), "+v"(gN[1][1]) :: "memory"); PG8_GOFF(o2, gN); } }
            if constexpr (SP2) {
            PG8_LDB(B0, 0, 0); PG8_LDB(B1, 0, 1); PG8_SCHED; PG8_LDA(At, 0, 0); PG8_STAGE_A(PG8_SA(1, 1), a1, 1, gA);
            PG8_WAIT_V(8); PG8_WAIT_L(0); PG8_BAR; PG8_MMA(0, 0, At, B0); PG8_MMA(0, 1, At, B1); PG8_BAR; PG8_SCHED;
            PG8_LDA(At, 0, 1); PG8_STAGE(PG8_SB(0, 0), b2, voffB); PG8_STAGE(PG8_SB(0, 1), b2 + hstep, voffB); PG8_STAGE_A(PG8_SA(0, 0), a2, 0, o2);
            PG8_WAIT_V(8); PG8_WAIT_L(0); PG8_BAR; PG8_MMA(1, 0, At, B0); PG8_MMA(1, 1, At, B1); PG8_BAR; PG8_SCHED;
            PG8_LDB(B0, 1, 0); PG8_LDB(B1, 1, 1); PG8_SCHED; PG8_LDA(At, 1, 0); PG8_STAGE_A(PG8_SA(0, 1), a2, 1, o2);
            PG8_WAIT_V(8); PG8_WAIT_L(0); PG8_BAR; PG8_MMA(0, 0, At, B0); PG8_MMA(0, 1, At, B1); PG8_BAR; PG8_SCHED;
            PG8_LDA(At, 1, 1); PG8_STAGE(PG8_SB(1, 0), b3, voffB); PG8_STAGE(PG8_SB(1, 1), b3 + hstep, voffB); PG8_STAGE_A(PG8_SA(1, 0), a3, 0, o2);
            PG8_WAIT_V(8); PG8_WAIT_L(0); PG8_BAR; PG8_MMA(1, 0, At, B0); PG8_MMA(1, 1, At, B1); PG8_BAR; PG8_SCHED;
            } else {
            PG8_LDB(B0, 0, 0); PG8_SCHED; PG8_LDA(At, 0, 0); PG8_STAGE(PG8_SA(1, 1), a1 + hstep, voffA);
            PG8_WAIT_L(8); PG8_BAR; PG8_WAIT_L(0); PG8_MMA(0, 0, At, B0); PG8_BAR; PG8_SCHED;
            PG8_LDB(B1, 0, 1); PG8_STAGE(PG8_SB(0, 0), b2, voffB);
            PG8_BAR; PG8_WAIT_L(0); PG8_MMA(0, 1, At, B1); PG8_BAR;
            PG8_LDA(At, 0, 1); PG8_STAGE(PG8_SA(0, 0), a2, voffA);
            PG8_BAR; PG8_WAIT_L(0); PG8_MMA(1, 0, At, B0); PG8_BAR; PG8_SCHED;
            PG8_STAGE(PG8_SB(0, 1), b2 + hstep, voffB);
            PG8_WAIT_V(6); PG8_BAR; PG8_MMA(1, 1, At, B1); PG8_BAR;
            PG8_LDB(B0, 1, 0); PG8_SCHED; PG8_LDA(At, 1, 0); PG8_STAGE(PG8_SA(0, 1), a2 + hstep, voffA);
            PG8_WAIT_L(8); PG8_BAR; PG8_WAIT_L(0); PG8_MMA(0, 0, At, B0); PG8_BAR; PG8_SCHED;
            PG8_LDB(B1, 1, 1); PG8_STAGE(PG8_SB(1, 0), b3, voffB);
            PG8_BAR; PG8_WAIT_L(0); PG8_MMA(0, 1, At, B1); PG8_BAR;
            PG8_LDA(At, 1, 1); PG8_STAGE(PG8_SA(1, 0), a3, voffA);
            PG8_BAR; PG8_WAIT_L(0); PG8_MMA(1, 0, At, B0); PG8_BAR; PG8_SCHED;
            PG8_STAGE(PG8_SB(1, 1), b3 + hstep, voffB);
            PG8_WAIT_V(6); PG8_BAR; PG8_MMA(1, 1, At, B1); PG8_BAR;
            }
        }
        if constexpr (ALIGN_EPI) { if (wr == 0) PG8_BAR; }
        if constexpr (!Epi::AFTER_DRAIN) { E(acc, cur, wr, wc, fr, fq); S.done(cur); }
        if (!has_next) break;
#pragma unroll
        for (int a = 0; a < 2; ++a)
#pragma unroll
            for (int b = 0; b < 2; ++b)
#pragma unroll
                for (int m = 0; m < 4; ++m)
#pragma unroll
                    for (int n = 0; n < 2; ++n) acc[a][b][m][n] = (f32x4){0.f, 0.f, 0.f, 0.f};
        cur = nxt; cA = nA; cB = nB; ++ui;
        if constexpr (GATHER) PG8_GOFF(gA, gN);
        if constexpr (ALIGN_EPI) { if (wr == 1) PG8_BAR; }
    }
    PG8_WAIT_V(0);
    if constexpr (!ALIGN_EPI) { if (wr == 0) PG8_BAR; }
    PG8_BAR;
    if constexpr (Epi::AFTER_DRAIN) { E.fused(acc, cur, wr, wc, fr, fq, lds, wid, lane); S.done(cur); }
#undef PG8_SA
#undef PG8_SB
#undef PG8_STAGE
#undef PG8_STAGE_A
#undef PG8_GLOOK
#undef PG8_GOFF
#undef PG8_LDA
#undef PG8_LDB
#undef PG8_MMA
#undef PG8_WAIT_V
#undef PG8_WAIT_L
#undef PG8_BAR
#undef PG8_SCHED
}
}

constexpr int GX_TILE = 133760, GX_ROWS = GX_TILE + 2240;
static_assert(GX_ROWS + 17 * 512 <= 147456 - 64, "grouped-GEMM LDS tables");
__device__ __forceinline__ void fg_gemm_in(PrmP p, int l, LAS unsigned char* lds, int wg, int nwg) {
    pg8::Gemm g{(const bf16_t*)(p->ws + WS_HB), (const bf16_t*)(p->ws + WS_WIN) + (size_t)l * NP * 1024, M, NP, 1024}; pg8::StaticOrder S; S.init(M, NP, nwg, wg);
    pg8::EpiBf16Plain E{(bf16_t*)(p->ws + WS_PB), NP};
    pg8::gemm_phase<pg8::EpiBf16Plain, pg8::StaticOrder, true, true>(lds, g, S, E);
}
__device__ __forceinline__ void fg_gemm_out(PrmP p, int l, LAS unsigned char* lds, int wg, int nwg) {
    pg8::Gemm g{(const bf16_t*)(p->ws + WS_YC), (const bf16_t*)(p->ws + WS_WOUT) + (size_t)l * 1024 * 1024, M, 1024, 1024}; pg8::StaticOrder S; S.init(M, 1024, nwg, wg);
    pg8::EpiBf16Plain E{(bf16_t*)(p->ws + WS_Y), 1024};
    pg8::gemm_phase<pg8::EpiBf16Plain, pg8::StaticOrder, true, true>(lds, g, S, E);
}
__device__ __forceinline__ void fg_gemm1(PrmP p, int l, LAS unsigned char* lds, int wg, int nwg) {
    const int nt = ((const int*)(p->ws + WS_CTL))[CW_NT];
    LAS int* tl = (LAS int*)(lds + GX_TILE); LAS unsigned short* rl = (LAS unsigned short*)(lds + GX_ROWS);
    pg8::GroupOrder S{nt, 8, nwg, wg, tl};
    { const int tid = fresh_tid(); const int* TE = (const int*)(p->ws + WS_MISC + MS_TILEE); const int* RT = (const int*)(p->ws + WS_MISC + MS_ROWTOK);
      __syncthreads();
      for (int i = tid; i < nt; i += NTHREADS) tl[i] = TE[i];
      { int rv[17];
#pragma unroll
        for (int ui = 0; ui < 17; ++ui) { int rt; rv[ui] = (S.peek_pm(ui, rt) && tid < 256) ? RT[rt * 256 + tid] : 0; }
#pragma unroll
        for (int ui = 0; ui < 17; ++ui) if (tid < 256) rl[ui * 256 + tid] = (unsigned short)rv[ui]; }
      __syncthreads(); }
    if (EXPERT_FP8) {
        pg8::Gemm g{(const bf16_t*)(p->ws + WS_HB), (const bf16_t*)(p->ws + WS_WGU + (size_t)l * NE * 2048 * 1024), RP, NE * 2048, 512, rl};
        pg8::EpiSwiglu8 E{p->ws + WS_H1, p->in[I_BGU] + (size_t)l * NE * 2048};
        pg8::gemm_phase<pg8::EpiSwiglu8, pg8::GroupOrder, true, true, 119, true>(lds, g, S, E);
    } else {
    pg8::Gemm g{(const bf16_t*)(p->ws + WS_XS), (const bf16_t*)(p->ws + WS_WGU) + (size_t)l * NE * 2048 * 1024, RP, NE * 2048, 1024};
    pg8::EpiSwiglu E{(bf16_t*)(p->ws + WS_H1), p->in[I_BGU] + (size_t)l * NE * 2048};
    pg8::gemm_phase<pg8::EpiSwiglu, pg8::GroupOrder, true, true>(lds, g, S, E);
    }
}
__device__ __forceinline__ void fg_gemm2(PrmP p, int l, LAS unsigned char* lds, int wg, int nwg) {
    const int nt = ((const int*)(p->ws + WS_CTL))[CW_NT];
    LAS int* tl = (LAS int*)(lds + GX_TILE);
    { const int tid = fresh_tid(); const int* TE = (const int*)(p->ws + WS_MISC + MS_TILEE); __syncthreads(); for (int i = tid; i < nt; i += NTHREADS) tl[i] = TE[i]; __syncthreads(); }
    pg8::GroupOrder S{nt, 4, nwg, wg, tl};
    pg8::EpiDown E{(bf16_t*)(p->ws + WS_YR), p->in[I_BDN] + (size_t)l * NE * 1024};
    if (EXPERT_FP8) {
        pg8::Gemm g{(const bf16_t*)(p->ws + WS_H1), (const bf16_t*)(p->ws + WS_WDN + (size_t)l * NE * 1024 * 1024), RP, NE * 1024, 512};
        if (YR_FP8) { pg8::EpiDown8 E8{p->ws + WS_YR, p->in[I_BDN] + (size_t)l * NE * 1024}; pg8::gemm_phase<pg8::EpiDown8, pg8::GroupOrder, true, true, 120>(lds, g, S, E8); }
        else pg8::gemm_phase<pg8::EpiDown, pg8::GroupOrder, true, true, 120>(lds, g, S, E);
    } else {
    pg8::Gemm g{(const bf16_t*)(p->ws + WS_H1), (const bf16_t*)(p->ws + WS_WDN) + (size_t)l * NE * 1024 * 1024, RP, NE * 1024, 1024};
    pg8::gemm_phase<pg8::EpiDown, pg8::GroupOrder, true, true>(lds, g, S, E);
    }
}

#include <hip/hip_bf16.h>
#include <cmath>
namespace attn_body {
using bf16=__hip_bfloat16;
using bf16x8=__attribute__((ext_vector_type(8)))short;
using s16x4=__attribute__((ext_vector_type(4)))short;
using f32x16=__attribute__((ext_vector_type(16)))float;
using u32x4=__attribute__((ext_vector_type(4)))unsigned;
constexpr int BATCH=4,NHEAD=8,SEQ=8192,D=64,DM=2560;
constexpr int NW=8,QBLK=32,QB=QBLK*NW,KVBLK=64,NQB=SEQ/QB;
constexpr int ATTN_PITCH=DM, ATTN_UNIT_ROWS=QB;
__device__ __forceinline__ int crow(int r,int hi){return (r&3)+8*(r>>2)+4*hi;}
#define SBAR() __builtin_amdgcn_sched_barrier(0)
__device__ __forceinline__ void cmask(f32x16&p0,f32x16&p1,int jb,int qrel,int hi){
  const float NEG=-INFINITY; int kb=64*jb+4*hi;
  #pragma unroll
  for(int r=0;r<16;++r){int kv=kb+(r&3)+8*(r>>2); if(kv>qrel)p0[r]=NEG; if(kv+32>qrel)p1[r]=NEG;}
}

constexpr int NSLOT=3, SLOTB=8192;
constexpr int LDS_K=0, LDS_V=NSLOT*SLOTB, LDS_WS=2*NSLOT*SLOTB, LDS_OST=LDS_WS+NW*64*4, LDS_BYTES=LDS_OST+NW*4096;
constexpr float C2=0.125f*1.4426950408889634f;
__device__ __forceinline__ void glds16(const void*gsrc,unsigned lds_dst){unsigned keep;
  asm volatile("s_mov_b32 %0, m0\n\ts_mov_b32 m0, %2\n\ts_nop 0\n\tglobal_load_lds_dwordx4 %1, off\n\ts_mov_b32 m0, %0":"=&s"(keep):"v"(gsrc),"s"(lds_dst):"memory");}
__device__ __forceinline__ float max3f(float a,float b,float c){float r;asm("v_max3_f32 %0, %1, %2, %3":"=v"(r):"v"(a),"v"(b),"v"(c));return r;}
__device__ __forceinline__ float max2f(float a,float b){float r;asm("v_max_f32_e32 %0, %1, %2":"=v"(r):"v"(a),"v"(b));return r;}
__device__ __forceinline__ float fadd_s(float a,float b){float r;asm("v_add_f32_e32 %0, %1, %2":"=v"(r):"v"(a),"v"(b));return r;}
__device__ __forceinline__ float fsub_s(float a,float b){float r;asm("v_sub_f32_e32 %0, %1, %2":"=v"(r):"v"(a),"v"(b));return r;}
typedef float f32x2_t __attribute__((ext_vector_type(2))); typedef __bf16 bf16x2_t __attribute__((ext_vector_type(2)));
__device__ __forceinline__ unsigned cvtpk_s(float lo,float hi){f32x2_t v={lo,hi};bf16x2_t b=__builtin_convertvector(v,bf16x2_t);return __builtin_bit_cast(unsigned,b);}
__device__ __forceinline__ unsigned f2bf(float f) { return pk2(f, 0.f) & 0xffffu; }
#define WAIT_BAR(N) asm volatile("s_waitcnt vmcnt(" #N ") lgkmcnt(0)\n\ts_barrier":::"memory")

typedef __attribute__((address_space(3))) const float* lds_fptr;
__device__ __forceinline__ void split3(float f,unsigned&hb,unsigned&mb,unsigned&lb){
  hb=__float_as_uint(f)&0xffff0000u; const float r1=f-__uint_as_float(hb); mb=__float_as_uint(r1)&0xffff0000u; const float r2=r1-__uint_as_float(mb); lb=__float_as_uint(r2)&0xffff0000u; }
__device__ __forceinline__ bf16x8 mk_kx(float fk,int hi){ unsigned hb,mb,lb; split3(-fk,hb,mb,lb);
  u32x4 w; w.x=0x3f803f80u; w.y=hi?0x00003f80u:(0x00003f80u|hb); w.z=hi?0u:((mb>>16)|lb); w.w=0u; return __builtin_bit_cast(bf16x8,w); }
__device__ __forceinline__ bf16x8 mk_qx(float fq,float mhat,int hi){ unsigned hb,mb,lb; split3(hi?-mhat:fq,hb,mb,lb);
  u32x4 w; w.x=(hb>>16)|mb; w.y=hi?(lb>>16):((lb>>16)|0x3f800000u); w.z=hi?0u:0x3f803f80u; w.w=0u; return __builtin_bit_cast(bf16x8,w); }
__device__ __forceinline__ void qkt(f32x16&p0,f32x16&p1,const char*Kslot,const bf16x8*qr,bf16x8 kxa,bf16x8 kxb,bf16x8 qx,int r32,int hi){
  const f32x16 zc=f32x16{};
  const char*kb=Kslot+hi*1024+r32*16;
  #pragma unroll
  for(int d0=0;d0<4;++d0){
    const bf16x8 b0=*reinterpret_cast<const bf16x8*>(kb+d0*2048);
    const bf16x8 b1=*reinterpret_cast<const bf16x8*>(kb+d0*2048+512);
    if(d0==0){p0=__builtin_amdgcn_mfma_f32_32x32x16_bf16(b0,qr[0],zc,0,0,0);p1=__builtin_amdgcn_mfma_f32_32x32x16_bf16(b1,qr[0],zc,0,0,0);}
    else{p0=__builtin_amdgcn_mfma_f32_32x32x16_bf16(b0,qr[d0],p0,0,0,0);p1=__builtin_amdgcn_mfma_f32_32x32x16_bf16(b1,qr[d0],p1,0,0,0);}}
  p0=__builtin_amdgcn_mfma_f32_32x32x16_bf16(kxa,qx,p0,0,0,0);p1=__builtin_amdgcn_mfma_f32_32x32x16_bf16(kxb,qx,p1,0,0,0);
}
typedef __attribute__((address_space(3))) const char* lds_cptr;
typedef short v4i16_t __attribute__((ext_vector_type(4)));
__device__ __forceinline__ void kload8(bf16x8*kf,lds_cptr kp){
  kf[0]=*(const __attribute__((address_space(3))) bf16x8*)(kp);      kf[1]=*(const __attribute__((address_space(3))) bf16x8*)(kp+512);
  kf[2]=*(const __attribute__((address_space(3))) bf16x8*)(kp+2048); kf[3]=*(const __attribute__((address_space(3))) bf16x8*)(kp+2560);
  kf[4]=*(const __attribute__((address_space(3))) bf16x8*)(kp+4096); kf[5]=*(const __attribute__((address_space(3))) bf16x8*)(kp+4608);
  kf[6]=*(const __attribute__((address_space(3))) bf16x8*)(kp+6144); kf[7]=*(const __attribute__((address_space(3))) bf16x8*)(kp+6656);
}
__device__ __forceinline__ void kload2(bf16x8*kf,lds_cptr kp,int j){ kf[2*j]=*(const __attribute__((address_space(3))) bf16x8*)(kp+j*2048); kf[2*j+1]=*(const __attribute__((address_space(3))) bf16x8*)(kp+j*2048+512); }
__device__ __forceinline__ s16x4 vtr(lds_cptr p){ return __builtin_bit_cast(s16x4,__builtin_amdgcn_ds_read_tr16_b64_v4i16((__attribute__((address_space(3))) v4i16_t*)p)); }
__device__ __forceinline__ float rowmax(const f32x16&p0,const f32x16&p1){
  float a=max3f(p0[0],p0[1],p1[0]),b=max3f(p0[2],p0[3],p1[1]);a=max3f(a,p1[2],p1[3]);
  #pragma unroll
  for(int r=4;r<16;r+=4){a=max3f(a,p0[r],p0[r+1]);b=max3f(b,p0[r+2],p0[r+3]);a=max3f(a,p1[r],p1[r+1]);b=max3f(b,p1[r+2],p1[r+3]);}
  const float m=max2f(a,b);
  auto rr=__builtin_amdgcn_permlane32_swap(__float_as_uint(m),__float_as_uint(m),false,false);
  return max2f(__uint_as_float(rr[0]),__uint_as_float(rr[1]));
}
__device__ __forceinline__ void pv(f32x16*o,int vb,bf16x8 pa0,bf16x8 pa1,bf16x8 pa2,bf16x8 pa3){
  #pragma unroll
  for(int d0=0;d0<2;++d0){s16x4 lo[4],hi[4];
    #pragma unroll
    for(int ks=0;ks<4;++ks){
      asm volatile("ds_read_b64_tr_b16 %0,%1 offset:%c2":"=&v"(lo[ks]):"v"(vb),"i"(d0*4096+ks*1024):"memory");
      asm volatile("ds_read_b64_tr_b16 %0,%1 offset:%c2":"=&v"(hi[ks]):"v"(vb),"i"(d0*4096+ks*1024+512):"memory");}
    asm volatile("s_waitcnt lgkmcnt(0)":::"memory");SBAR();
    #define PK(k) (bf16x8){lo[k][0],lo[k][1],lo[k][2],lo[k][3],hi[k][0],hi[k][1],hi[k][2],hi[k][3]}
    o[d0]=__builtin_amdgcn_mfma_f32_32x32x16_bf16(pa0,PK(0),o[d0],0,0,0);
    o[d0]=__builtin_amdgcn_mfma_f32_32x32x16_bf16(pa1,PK(1),o[d0],0,0,0);
    o[d0]=__builtin_amdgcn_mfma_f32_32x32x16_bf16(pa2,PK(2),o[d0],0,0,0);
    o[d0]=__builtin_amdgcn_mfma_f32_32x32x16_bf16(pa3,PK(3),o[d0],0,0,0);
    #undef PK
  }
}

#ifndef ATTN_STORE16
#define ATTN_STORE16(p,v) (*(u32x4*)(p)=(v))
#endif
template<int THRL> __device__ __forceinline__ void attn_unit(int b,int h,int qb,const bf16*Q,const bf16*__restrict__ K,const bf16*__restrict__ V,bf16*O,char*shm,lds_fptr F2s,int tstart,float kmx){
  const int tid=::fresh_tid(),lane=tid&63,r32=lane&31,hi=lane>>5; const int wid=__builtin_amdgcn_readfirstlane(tid>>6);
  const long rowbase=(long)b*SEQ; const int q0=qb*QB;
  const bf16*Qw=Q+(rowbase+q0+wid*QBLK)*DM+h*D;
  const bf16*Kh=K+(rowbase+(long)tstart*KVBLK)*DM+h*D,*Vh=V+(rowbase+(long)tstart*KVBLK)*DM+h*D; const lds_fptr F2k=F2s+tstart*KVBLK;
  const unsigned lds0=(unsigned)(uintptr_t)shm;
  float*wsf=(float*)(shm+LDS_WS)+wid*64;
  const bf16*ksrc=Kh+(long)lane*DM+wid*8;
  const bf16*vsrc=Vh+(long)(16*(wid&3)+(lane>>2))*DM+(wid>>2)*32+(lane&3)*8;
  const unsigned kdst=lds0+LDS_K+wid*1024, vdst=lds0+LDS_V+wid*1024;
  #define DMA_K(t,slot) glds16(ksrc+(long)(t)*KVBLK*DM,(unsigned)__builtin_amdgcn_readfirstlane(kdst+(slot)))
  #define DMA_V(t,slot) glds16(vsrc+(long)(t)*KVBLK*DM,(unsigned)__builtin_amdgcn_readfirstlane(vdst+(slot)))
  const int vb0=(int)(lds0+LDS_V)+((lane>>4)&1)*32+(lane&3)*8+(4*hi+((lane&15)>>2))*64;
  const char*Kbase=shm+LDS_K; bf16x8 kf[8];
  const lds_cptr shm3=(lds_cptr)shm; const lds_cptr kp0=shm3+LDS_K+hi*1024+r32*16; const lds_cptr vp0=shm3+LDS_V+((lane>>4)&1)*32+(lane&3)*8+(4*hi+((lane&15)>>2))*64;
  const int NT=(q0+QB)/KVBLK-tstart;
  DMA_K(0,0);DMA_V(0,0);DMA_K(1,SLOTB);
  bf16x8 qr[4];
  #pragma unroll
  for(int d0=0;d0<4;++d0)qr[d0]=*reinterpret_cast<const bf16x8*>(&Qw[(long)r32*DM+d0*16+hi*8]);
  float m0; { float qq=0.f;
    #pragma unroll
    for(int d0=0;d0<4;++d0){const u32x4 w_=__builtin_bit_cast(u32x4,qr[d0]);
      #pragma unroll
      for(int j_=0;j_<4;++j_){const float a_=__uint_as_float(w_[j_]<<16),b_=__uint_as_float(w_[j_]&0xffff0000u);qq+=a_*a_+b_*b_;}}
    qq+=__shfl_xor(qq,32); m0=sqrtf(qq)*kmx+1.f; }
  float l_reg=0.f;f32x16 o[2];o[0]=f32x16{};o[1]=f32x16{};const f32x16 zc=f32x16{};
  const float fq_=F2s[q0+wid*QBLK+r32]; const bf16x8 qx=mk_qx(fq_,m0,hi);
  const int qrel=wid*QBLK+r32;
  #define CMASK(P0,P1,t) do{int jb_=(t)-(NT-4); if(jb_>=0)cmask(P0,P1,jb_,qrel,hi);}while(0)
  #define START(P0,P1) do{ _Pragma("unroll") for(int r=0;r<16;++r)P0[r]=__builtin_amdgcn_exp2f(P0[r]); }while(0)
  #define RESC() do{}while(0)
  f32x16 pA0,pA1,pB0,pB1;
  int sl_prev=0,sl_cur=0,sl_next=SLOTB;
  #define ROT() do{sl_prev=sl_cur;sl_cur=sl_next;sl_next=(sl_next==(NSLOT-1)*SLOTB)?0:sl_next+SLOTB;}while(0)
  DMA_K(2,2*SLOTB);
  WAIT_BAR(3);
  qkt(pA0,pA1,Kbase,qr,mk_kx(F2k[r32],hi),mk_kx(F2k[32+r32],hi),qx,r32,hi);asm volatile("s_nop 15\n\ts_nop 7":"+v"(pA0),"+v"(pA1));CMASK(pA0,pA1,0);
  START(pA0,pA1);
  _Pragma("unroll") for(int r=0;r<16;++r)pA1[r]=__builtin_amdgcn_exp2f(pA1[r]);
  WAIT_BAR(0);
  DMA_K(3,0);DMA_V(1,SLOTB);
  ROT();
  kload8(kf,kp0+sl_cur);
  WAIT_BAR(2);
  s16x4 vlo[8],vhi[8]; u32x4 pw0,pw1,pw2,pw3;
  #define PKW(P,B) cvtpk_s(P[B],P[B+1])
  #define PAF(k) __builtin_bit_cast(bf16x8,pw##k)
  #define VFR(i) (bf16x8){vlo[i][0],vlo[i][1],vlo[i][2],vlo[i][3],vhi[i][0],vhi[i][1],vhi[i][2],vhi[i][3]}
  #define PIN(x) asm volatile("":"+v"(x))
  #define MX3(a,b,c) __builtin_fmaxf(__builtin_fmaxf((a),(b)),(c))
  #define GAPA(MF,A0,A1,A2,A3,W0,W1,PW) do{ MF; sacc+=A0; sacc+=A1; sacc+=A2; sacc+=A3; PIN(sacc); W0; W1; PIN(PW); SBAR(); }while(0)
  #define EX(v) __builtin_amdgcn_exp2f(v)
  #define GAPB(MF,X,B) do{ MF; X[B]=EX(X[B]); X[B+1]=EX(X[B+1]); X[B+2]=EX(X[B+2]); X[B+3]=EX(X[B+3]); PIN(X); SBAR(); }while(0)
  #define VRD(i) do{ vlo[i]=vtr(vp_+(((i)>>2)*4096+((i)&3)*1024)); vhi[i]=vtr(vp_+(((i)>>2)*4096+((i)&3)*1024+512)); }while(0)
  #define KRD(G,j) do{ if(G){ kload2(kf,kp0+sl_next,j); SBAR(); } }while(0)
  #define STEP(C0,C1,P0,P1,t,GK,GV,GL) do{ const float fka_=F2k[(t)*KVBLK+r32],fkb_=F2k[(t)*KVBLK+32+r32]; SBAR(); \
    const lds_cptr vp_=vp0+sl_prev; \
    VRD(0); SBAR(); float sacc=(P0[0]+P0[1]); \
    GAPA(C0=__builtin_amdgcn_mfma_f32_32x32x16_bf16(kf[0],qr[0],zc,0,0,0), P0[2],P0[3],P0[4],P0[5],     pw0[0]=PKW(P0,0), pw0[1]=PKW(P0,2), pw0); \
    VRD(4); SBAR(); GAPA(C1=__builtin_amdgcn_mfma_f32_32x32x16_bf16(kf[1],qr[0],zc,0,0,0), P0[6],P0[7],P0[8],P0[9],     pw0[2]=PKW(P0,4), pw0[3]=PKW(P0,6), pw0); \
    VRD(1); SBAR(); GAPA(C0=__builtin_amdgcn_mfma_f32_32x32x16_bf16(kf[2],qr[1],C0,0,0,0),   P0[10],P0[11],P0[12],P0[13], pw1[0]=PKW(P0,8), pw1[1]=PKW(P0,10), pw1); \
    VRD(5); SBAR(); GAPA(C1=__builtin_amdgcn_mfma_f32_32x32x16_bf16(kf[3],qr[1],C1,0,0,0),   P0[14],P0[15],P1[0],P1[1],   pw1[2]=PKW(P0,12),pw1[3]=PKW(P0,14), pw1); \
    VRD(2); SBAR(); GAPA(C0=__builtin_amdgcn_mfma_f32_32x32x16_bf16(kf[4],qr[2],C0,0,0,0),   P1[2],P1[3],P1[4],P1[5],     pw2[0]=PKW(P1,0), pw2[1]=PKW(P1,2), pw2); \
    VRD(6); SBAR(); GAPA(C1=__builtin_amdgcn_mfma_f32_32x32x16_bf16(kf[5],qr[2],C1,0,0,0),   P1[6],P1[7],P1[8],P1[9],     pw2[2]=PKW(P1,4), pw2[3]=PKW(P1,6), pw2); \
    VRD(3); SBAR(); GAPA(C0=__builtin_amdgcn_mfma_f32_32x32x16_bf16(kf[6],qr[3],C0,0,0,0),   P1[10],P1[11],P1[12],P1[13], pw3[0]=PKW(P1,8), pw3[1]=PKW(P1,10), pw3); \
    VRD(7); SBAR(); GAPA(C1=__builtin_amdgcn_mfma_f32_32x32x16_bf16(kf[7],qr[3],C1,0,0,0),   P1[14],P1[15],0.f,0.f,       pw3[2]=PKW(P1,12),pw3[3]=PKW(P1,14), pw3); \
    { C0=__builtin_amdgcn_mfma_f32_32x32x16_bf16(mk_kx(fka_,hi),qx,C0,0,0,0); SBAR(); C1=__builtin_amdgcn_mfma_f32_32x32x16_bf16(mk_kx(fkb_,hi),qx,C1,0,0,0); } \
    l_reg+=sacc; \
    if(GK){DMA_K((t)+3,sl_cur);} if(GV){DMA_V((t)+1,sl_next);} \
    CMASK(C0,C1,t); \
    SBAR(); \
    GAPB(o[0]=__builtin_amdgcn_mfma_f32_32x32x16_bf16(PAF(0),VFR(0),o[0],0,0,0), C0,0); \
    GAPB(o[1]=__builtin_amdgcn_mfma_f32_32x32x16_bf16(PAF(0),VFR(4),o[1],0,0,0), C0,4); \
    KRD(GL,0); GAPB(o[0]=__builtin_amdgcn_mfma_f32_32x32x16_bf16(PAF(1),VFR(1),o[0],0,0,0), C0,8); \
    KRD(GL,1); GAPB(o[1]=__builtin_amdgcn_mfma_f32_32x32x16_bf16(PAF(1),VFR(5),o[1],0,0,0), C0,12); \
    KRD(GL,2); GAPB(o[0]=__builtin_amdgcn_mfma_f32_32x32x16_bf16(PAF(2),VFR(2),o[0],0,0,0), C1,0); \
    KRD(GL,3); GAPB(o[1]=__builtin_amdgcn_mfma_f32_32x32x16_bf16(PAF(2),VFR(6),o[1],0,0,0), C1,4); \
    GAPB(o[0]=__builtin_amdgcn_mfma_f32_32x32x16_bf16(PAF(3),VFR(3),o[0],0,0,0), C1,8); \
    GAPB(o[1]=__builtin_amdgcn_mfma_f32_32x32x16_bf16(PAF(3),VFR(7),o[1],0,0,0), C1,12); \
    }while(0)
  int t=1;
  #undef CMASK
  #define CMASK(P0,P1,t) do{}while(0)
  for(;t+5<NT;t+=2){
    STEP(pB0,pB1,pA0,pA1,t,true,true,true);     WAIT_BAR(2); RESC(); ROT();
    STEP(pA0,pA1,pB0,pB1,t+1,true,true,true);   WAIT_BAR(2); RESC(); ROT();
  }
  #undef CMASK
  #define CMASK(P0,P1,t) do{int jb_=(t)-(NT-4); if(jb_>=0)cmask(P0,P1,jb_,qrel,hi);}while(0)
  #define ENDW(tt) do{ if((tt)+3<NT){WAIT_BAR(2);} else if((tt)+2<NT){WAIT_BAR(1);} else {WAIT_BAR(0);} }while(0)
  for(;t+1<NT;t+=2){
    STEP(pB0,pB1,pA0,pA1,t,(t+3<NT),(t+1<NT),(t+1<NT));       ENDW(t);   RESC(); ROT();
    STEP(pA0,pA1,pB0,pB1,t+1,(t+4<NT),(t+2<NT),(t+2<NT));     ENDW(t+1); RESC(); ROT();
  }
  STEP(pB0,pB1,pA0,pA1,NT-1,false,false,false); RESC();
  { float sacc=pB0[0]+pB0[1]; _Pragma("unroll") for(int r=2;r<16;++r)sacc+=pB0[r]; _Pragma("unroll") for(int r=0;r<16;++r)sacc+=pB1[r]; l_reg+=sacc;
    pw0=(u32x4){PKW(pB0,0),PKW(pB0,2),PKW(pB0,4),PKW(pB0,6)};pw1=(u32x4){PKW(pB0,8),PKW(pB0,10),PKW(pB0,12),PKW(pB0,14)};pw2=(u32x4){PKW(pB1,0),PKW(pB1,2),PKW(pB1,4),PKW(pB1,6)};pw3=(u32x4){PKW(pB1,8),PKW(pB1,10),PKW(pB1,12),PKW(pB1,14)};
    SBAR(); pv(o,vb0+sl_cur,PAF(0),PAF(1),PAF(2),PAF(3)); }
  #undef PKW
  #undef PAF
  #undef VFR
  #undef PIN
  #undef MX3
  #undef GAPA
  #undef GAPB
  #undef EX
  #undef VRD
  #undef KRD
  #undef STEP
  #undef ENDW
  {auto rr=__builtin_amdgcn_permlane32_swap(__float_as_uint(l_reg),__float_as_uint(l_reg),false,false);l_reg=__uint_as_float(rr[0])+__uint_as_float(rr[1]);}
  if(hi==0)wsf[32+r32]=l_reg;asm volatile("s_waitcnt lgkmcnt(0)":::"memory");
  float rli[16];
  #pragma unroll
  for(int r=0;r<16;++r)rli[r]=__builtin_amdgcn_rcpf(wsf[32+crow(r,hi)]);
  bf16*Ow=O+(rowbase+q0+wid*QBLK)*DM+h*D;
  { bf16*stg=(bf16*)(shm+LDS_OST)+wid*2048;
    #pragma unroll
    for(int r=0;r<16;++r){const int orow=crow(r,hi);
      #pragma unroll
      for(int d0=0;d0<2;++d0)stg[orow*64+d0*32+r32]=__float2bfloat16(o[d0][r]*rli[r]);}
    asm volatile("s_waitcnt lgkmcnt(0)":::"memory");
    #pragma unroll
    for(int i=0;i<4;++i){const int row=i*8+(lane>>3),ch=lane&7; const u32x4 v=*(const u32x4*)(stg+row*64+ch*8); ATTN_STORE16(Ow+(long)row*DM+ch*8,v);} }
  asm volatile("s_waitcnt lgkmcnt(0)\n\ts_barrier":::"memory");
  #undef DMA_K
  #undef DMA_V
  #undef CMASK
  #undef START
  #undef RESC
  #undef ROT
}
constexpr int ATTN_LDS_BYTES=LDS_BYTES;
#undef SBAR
#undef WAIT_BAR
}

constexpr float SKIP_MARGIN = 64.f;
constexpr int ATT_F2_OFF = 86016, ATT_SCN_OFF = ATT_F2_OFF + 32768;
static_assert(attn_body::ATTN_LDS_BYTES <= ATT_F2_OFF && ATT_SCN_OFF + 64 <= 131072, "attention LDS map");
__device__ __forceinline__ void f2_items(PrmP p, int l, LAS unsigned char* lds, int wg, int nwg) {
    const int tid = fresh_tid(), lane = tid & 63, wave = tid >> 6;
    LAS float* scn = (LAS float*)(lds + ATT_SCN_OFF);
    const bf16_t* PB = (const bf16_t*)(p->ws + WS_PB); float* F2G = (float*)(p->ws + WS_FC2);
    for (int bh = wg; bh < 32; bh += nwg) { const int b = bh >> 3, hh = bh & 7;
        const float fb = p->in[I_FOXFB][l * 8 + hh];
        float loc[16]; float run = 0.f;
#pragma unroll
        for (int i = 0; i < 16; ++i) { const float z = bf2f(PB[(size_t)(b * T + tid * 16 + i) * NP + C_F + hh]) + fb;
            run += -(fmaxf(-z, 0.f) + __logf(1.f + __expf(-fabsf(z)))) * LOG2E; loc[i] = run; }
        float incl = run;
#pragma unroll
        for (int o = 1; o < 64; o <<= 1) { const float v = __shfl_up(incl, o); if (lane >= o) incl += v; }
        __syncthreads();
        if (lane == 63) scn[wave] = incl;
        __syncthreads();
        float base = incl - run;
        for (int w = 0; w < wave; ++w) base += scn[w];
#pragma unroll
        for (int i = 0; i < 16; ++i) F2G[(size_t)bh * T + tid * 16 + i] = base + loc[i];
    }
}
__device__ __forceinline__ void fa_attn(PrmP p, int l, LAS unsigned char* lds, int wg, int nwg) {
    const int tid = fresh_tid();
    if (nwg != 256) return;
    LAS float* F2s = (LAS float*)(lds + ATT_F2_OFF);
    LAS int* work = (LAS int*)(lds + ATT_SCN_OFF); LAS int* tst = work + 1024; LAS int* mine = tst + 1024;
    const float* F2G = (const float*)(p->ws + WS_FC2);
    __syncthreads();
    const unsigned* CT = (const unsigned*)(p->ws + WS_CTL);
#pragma unroll
    for (int k = 0; k < 8; ++k) { const int i = tid + 512 * k; F2s[i] = F2G[(size_t)(i >> 7) * T + (i & 127) * 64 + 63];
        F2s[4096 + i] = sqrtf(__uint_as_float(__hip_atomic_load(CT + CW_KT + l * 4096 + i, __ATOMIC_RELAXED, __HIP_MEMORY_SCOPE_AGENT))); }
    __syncthreads();
#pragma unroll
    for (int k = 0; k < 2; ++k) { const int u = tid + 512 * k, bh = u >> 5, qb = u & 31;
        const unsigned* NRM = (const unsigned*)(p->ws + WS_CTL) + CW_NRM + (l * 32 + bh) * 2;
        const float qn = sqrtf(__uint_as_float(__hip_atomic_load(NRM, __ATOMIC_RELAXED, __HIP_MEMORY_SCOPE_AGENT))), kn = sqrtf(__uint_as_float(__hip_atomic_load(NRM + 1, __ATOMIC_RELAXED, __HIP_MEMORY_SCOPE_AGENT)));
        (void)qn; (void)kn;
        const float qI = sqrtf(__uint_as_float(__hip_atomic_load(CT + CW_QN + (l * 32 + bh) * 32 + qb, __ATOMIC_RELAXED, __HIP_MEMORY_SCOPE_AGENT)));
        const float kI = fmaxf(fmaxf(F2s[4096 + bh * 128 + 4 * qb], F2s[4096 + bh * 128 + 4 * qb + 1]), fmaxf(F2s[4096 + bh * 128 + 4 * qb + 2], F2s[4096 + bh * 128 + 4 * qb + 3]));
        const float base = F2G[(size_t)bh * T + qb * 256] + SKIP_MARGIN + qI * kI;
        int ts = 0; bool ok = true;
        for (int J = 0; J < 4 * qb; ++J) { ok = ok && (F2s[bh * 128 + J] > base + qI * F2s[4096 + bh * 128 + J]); ts = (ok && (J & 1)) ? J + 1 : ts; }
        tst[u] = ts; work[u] = 4 * (qb + 1) - ts; }
    if (tid < 4) mine[tid] = 0;
    __syncthreads();
    { const int ua = tid, ub = tid + 512; const int wa = work[ua], wb = work[ub]; int ra = 0, rb = 0;
      typedef int i32x4_ __attribute__((ext_vector_type(4)));
      const int ka = wa * 1024 + (1023 - ua), kb = wb * 1024 + (1023 - ub);
#pragma unroll 4
      for (int v = 0; v < 1024; v += 4) { const i32x4_ w4 = *(const LAS i32x4_*)(work + v);
#pragma unroll
          for (int q = 0; q < 4; ++q) { const int kv = w4[q] * 1024 + (1023 - (v + q)); ra += (kv > ka) ? 1 : 0; rb += (kv > kb) ? 1 : 0; } }
      const int t0 = wg, t1 = 511 - wg, t2 = 512 + wg, t3 = 1023 - wg;
      if (ra == t0) mine[0] = ua; if (ra == t1) mine[1] = ua; if (ra == t2) mine[2] = ua; if (ra == t3) mine[3] = ua;
      if (rb == t0) mine[0] = ub; if (rb == t1) mine[1] = ub; if (rb == t2) mine[2] = ub; if (rb == t3) mine[3] = ub; }
    __syncthreads();
    const unsigned* NRMB = (const unsigned*)(p->ws + WS_CTL) + CW_NRM + l * 64;
    attn_body::bf16* pb = (attn_body::bf16*)(p->ws + WS_PB);
#pragma unroll 1
    for (int k = 0; k < 4; ++k) { const int u = __builtin_amdgcn_readfirstlane(mine[k]), bh = u >> 5, qb = u & 31, ts_u = __builtin_amdgcn_readfirstlane(tst[u]);
        __syncthreads();
#pragma unroll
        for (int i = 0; i < 4; ++i) *(LAS f32x4*)(F2s + tid * 4 + 2048 * i) = *(const f32x4*)(F2G + (size_t)bh * T + tid * 4 + 2048 * i);
        __syncthreads();
        const float m0 = sqrtf(__uint_as_float(__hip_atomic_load(NRMB + bh * 2 + 1, __ATOMIC_RELAXED, __HIP_MEMORY_SCOPE_AGENT)));
        attn_body::attn_unit<8>(bh >> 3, bh & 7, qb, pb + C_Q, pb + C_K, pb + C_V, pb + C_Q, (char*)lds, (attn_body::lds_fptr)F2s, ts_u, m0);
    }
}

typedef float f32x16 __attribute__((ext_vector_type(16)));
struct S5M { float ar[2], ai[2], a16r[2], a16i[2]; bf16x8 bfr[4]; };
__device__ __forceinline__ int tau32(int i) { return 16 * ((i >> 2) & 1) + 4 * (i >> 3) + (i & 3); }
__device__ __forceinline__ void s5m_setup(PrmP p, int l, int g, int lane, S5M& c) {
    const int nl = lane & 31, hi = lane >> 5;
    const float dt = expf(p->in[I_S5LOGDT][l * 16 + g]);
    u32x4 fre[2], fim[2];
#pragma unroll
    for (int s = 0; s < 2; ++s) { const int pi = 32 * s + nl;
        const float are = p->in[I_S5ARE][(l * 16 + g) * 64 + pi], aim = p->in[I_S5AIM][(l * 16 + g) * 64 + pi];
        const float mag = expf(are * dt); const float th = aim * dt * 0.3183098861837907f; const float abr = mag * cospif(th), abi = mag * sinpif(th);
        const float den = are * are + aim * aim, nre = abr - 1.f;
        const float kre = (nre * are + abi * aim) / den, kim = (abi * are - nre * aim) / den;
        c.ar[s] = abr; c.ai[s] = abi;
        float pr = abr, pi_ = abi;
#pragma unroll
        for (int q = 0; q < 4; ++q) { const float nr = pr * pr - pi_ * pi_, ni = 2.f * pr * pi_; pr = nr; pi_ = ni; }
        c.a16r[s] = pr; c.a16i[s] = pi_;
        const float* brp = p->in[I_S5BRE] + ((size_t)(l * 16 + g) * 64 + pi) * 16 + 8 * hi; const float* bip = p->in[I_S5BIM] + ((size_t)(l * 16 + g) * 64 + pi) * 16 + 8 * hi;
        const f32x4 br0 = *(const f32x4*)brp, br1 = *(const f32x4*)(brp + 4), bi0 = *(const f32x4*)bip, bi1 = *(const f32x4*)(bip + 4);
        const f32x4 re0 = br0 * kre - bi0 * kim, re1 = br1 * kre - bi1 * kim, im0 = bi0 * kre + br0 * kim, im1 = bi1 * kre + br1 * kim;
        fre[s] = (u32x4){pk2(re0.x, re0.y), pk2(re0.z, re0.w), pk2(re1.x, re1.y), pk2(re1.z, re1.w)};
        fim[s] = (u32x4){pk2(im0.x, im0.y), pk2(im0.z, im0.w), pk2(im1.x, im1.y), pk2(im1.z, im1.w)}; }
    c.bfr[0] = __builtin_bit_cast(bf16x8, fre[0]); c.bfr[1] = __builtin_bit_cast(bf16x8, fre[1]); c.bfr[2] = __builtin_bit_cast(bf16x8, fim[0]); c.bfr[3] = __builtin_bit_cast(bf16x8, fim[1]);
}
__device__ __forceinline__ void s5m_cfrag(PrmP p, int l, int g, int lane, bf16x8 (&cmf)[8], bf16x8& dfr) {
    const int nl = lane & 31, hi = lane >> 5;
    const float* cre = p->in[I_S5CRE] + ((size_t)(l * 16 + g) * 16 + (nl & 15)) * 64; const float* cim = p->in[I_S5CIM] + ((size_t)(l * 16 + g) * 16 + (nl & 15)) * 64;
    const bool okc = nl < 16;
#pragma unroll
    for (int ks = 0; ks < 8; ++ks) { const int j0 = 4 * ks + 2 * hi; const float2 ra = *(const float2*)(cre + j0), rb2 = *(const float2*)(cre + 32 + j0), ia = *(const float2*)(cim + j0), ib = *(const float2*)(cim + 32 + j0);
        u32x4 w; w.x = pk2(ra.x, rb2.x); w.y = pk2(-ia.x, -ib.x); w.z = pk2(ra.y, rb2.y); w.w = pk2(-ia.y, -ib.y);
        if (!okc) w = (u32x4){0u, 0u, 0u, 0u}; cmf[ks] = __builtin_bit_cast(bf16x8, w); }
    const float dv = p->in[I_S5D][l * 256 + g * 16 + (nl & 15)]; const int jd = nl - 8 * hi;
    const unsigned db = f2bf(dv); u32x4 w = (u32x4){0u, 0u, 0u, 0u};
    if (okc && jd >= 0 && jd < 8) { const unsigned v = (jd & 1) ? (db << 16) : db; if ((jd >> 1) == 0) w.x = v; else if ((jd >> 1) == 1) w.y = v; else if ((jd >> 1) == 2) w.z = v; else w.w = v; }
    dfr = __builtin_bit_cast(bf16x8, w);
}
__device__ __forceinline__ void s5m_table_build(PrmP p, int l, int g, int lane) {
    S5M c; s5m_setup(p, l, g, lane, c); bf16x8 cmf[8]; bf16x8 dfr; s5m_cfrag(p, l, g, lane, cmf, dfr);
    u32x4* tb = (u32x4*)(p->ws + WS_S5T) + (size_t)(l * 16 + g) * 15 * 64 + lane;
    tb[0 * 64] = (u32x4){__float_as_uint(c.ar[0]), __float_as_uint(c.ar[1]), __float_as_uint(c.ai[0]), __float_as_uint(c.ai[1])};
    tb[1 * 64] = (u32x4){__float_as_uint(c.a16r[0]), __float_as_uint(c.a16r[1]), __float_as_uint(c.a16i[0]), __float_as_uint(c.a16i[1])};
#pragma unroll
    for (int q = 0; q < 4; ++q) tb[(2 + q) * 64] = __builtin_bit_cast(u32x4, c.bfr[q]);
#pragma unroll
    for (int q = 0; q < 8; ++q) tb[(6 + q) * 64] = __builtin_bit_cast(u32x4, cmf[q]);
    tb[14 * 64] = __builtin_bit_cast(u32x4, dfr);
}
__device__ __forceinline__ void s5m_load(PrmP p, int l, int g, int lane, S5M& c) {
    const u32x4* tb = (const u32x4*)(p->ws + WS_S5T) + (size_t)(l * 16 + g) * 15 * 64 + lane;
    const u32x4 a = tb[0], b = tb[64];
    c.ar[0] = __uint_as_float(a.x); c.ar[1] = __uint_as_float(a.y); c.ai[0] = __uint_as_float(a.z); c.ai[1] = __uint_as_float(a.w);
    c.a16r[0] = __uint_as_float(b.x); c.a16r[1] = __uint_as_float(b.y); c.a16i[0] = __uint_as_float(b.z); c.a16i[1] = __uint_as_float(b.w);
#pragma unroll
    for (int q = 0; q < 4; ++q) c.bfr[q] = __builtin_bit_cast(bf16x8, tb[(2 + q) * 64]);
}
__device__ __forceinline__ void s5m_load_c(PrmP p, int l, int g, int lane, bf16x8 (&cmf)[8], bf16x8& dfr) {
    const u32x4* tb = (const u32x4*)(p->ws + WS_S5T) + (size_t)(l * 16 + g) * 15 * 64 + lane;
#pragma unroll
    for (int q = 0; q < 8; ++q) cmf[q] = __builtin_bit_cast(bf16x8, tb[(6 + q) * 64]);
    dfr = __builtin_bit_cast(bf16x8, tb[14 * 64]);
}
__device__ __forceinline__ void s5m_bu(const bf16_t* PB, size_t rb, int tb, int g, int lane, const S5M& c, f32x16 (&bu)[4], bf16x8& ufrag) {
    const int i = lane & 31, hi = lane >> 5;
    ufrag = *(const bf16x8*)(PB + (rb + tb + tau32(i)) * NP + C_S5 + 16 * g + 8 * hi);
    const f32x16 z = f32x16{};
#pragma unroll
    for (int q = 0; q < 4; ++q) bu[q] = __builtin_amdgcn_mfma_f32_32x32x16_bf16(ufrag, c.bfr[q], z, 0, 0, 0);
}
__device__ __forceinline__ void s5m_tile_end(const S5M& c, const f32x16 (&bu)[4], float (&xr)[2], float (&xi)[2]) {
#pragma unroll
    for (int s = 0; s < 2; ++s) { float er = bu[s][0], ei = bu[2 + s][0];
#pragma unroll
        for (int r = 1; r < 16; ++r) { const float nr = c.ar[s] * er - c.ai[s] * ei + bu[s][r], ni = c.ar[s] * ei + c.ai[s] * er + bu[2 + s][r]; er = nr; ei = ni; }
        const float por = __shfl_xor(er, 32), poi = __shfl_xor(ei, 32);
        const bool hi = ::fresh_tid() & 32; const float elr = hi ? por : er, eli = hi ? poi : ei, ehr = hi ? er : por, ehi = hi ? ei : poi;
        const float t1r = c.a16r[s] * xr[s] - c.a16i[s] * xi[s] + elr, t1i = c.a16r[s] * xi[s] + c.a16i[s] * xr[s] + eli;
        xr[s] = c.a16r[s] * t1r - c.a16i[s] * t1i + ehr; xi[s] = c.a16r[s] * t1i + c.a16i[s] * t1r + ehi; }
}
__device__ __forceinline__ void fs_scan(PrmP p, int l, LAS unsigned char* lds, int wg, int nwg) {
    const int tid = fresh_tid(), lane = tid & 63, wave = tid >> 6;
    f2_items(p, l, lds, wg, nwg);
    const bf16_t* PB = (const bf16_t*)(p->ws + WS_PB);
    { bf16_t* HLOC = (bf16_t*)(p->ws + WS_YL); bf16_t* PCUM = (bf16_t*)(p->ws + WS_YS0); float* AGG = (float*)(p->ws + WS_AGG);
      LAS unsigned char* xa = lds + wave * 13312; LAS unsigned char* xf = xa + 4608;
      const int nl = lane & 31, hi = lane >> 5;
      for (int it = wave * nwg + wg; it < 2048; it += nwg * NWAVES) {
        const int b = it >> 9, c = (it >> 2) & 127, blk = it & 3; const size_t rb = (size_t)b * T; const int t0 = c * 64;
        const bf16_t* wt = (const bf16_t*)(p->ws + WS_LRUW) + (size_t)(l * 4 + blk) * 2 * 4096 + (size_t)nl * 64 + 8 * hi;
        const int chc = blk * 64 + lane;
        const float cw0 = p->in[I_CONVW][(l * 4 + 0) * 256 + chc], cw1 = p->in[I_CONVW][(l * 4 + 1) * 256 + chc], cw2 = p->in[I_CONVW][(l * 4 + 2) * 256 + chc], cw3 = p->in[I_CONVW][(l * 4 + 3) * 256 + chc], cb = p->in[I_CONVB][l * 256 + chc];
        float ba[2], bx[2], sp8[2];
#pragma unroll
        for (int s2 = 0; s2 < 2; ++s2) { const int ch = blk * 64 + 32 * s2 + nl; ba[s2] = p->in[I_LRUBA][l * 256 + ch]; bx[s2] = p->in[I_LRUBX][l * 256 + ch]; sp8[s2] = -8.f * log1pf(expf(-p->in[I_LAMBDA][l * 256 + ch])); }
        float x1 = (t0 >= 1) ? bf2f(PB[(rb + t0 - 1) * NP + C_LX + chc]) : 0.f, x2 = (t0 >= 2) ? bf2f(PB[(rb + t0 - 2) * NP + C_LX + chc]) : 0.f, x3 = (t0 >= 3) ? bf2f(PB[(rb + t0 - 3) * NP + C_LX + chc]) : 0.f;
        float hin[2] = {0.f, 0.f}, pin[2] = {1.f, 1.f};
#pragma unroll 1
        for (int mt = 0; mt < 2; ++mt) { const int tb = t0 + mt * 32;
#pragma unroll 1
            for (int th = 0; th < 32; th += 16) { float xin[16];
#pragma unroll
              for (int tt = 0; tt < 16; ++tt) xin[tt] = bf2f(PB[(rb + tb + th + tt) * NP + C_LX + chc]);
#pragma unroll
              for (int tt = 0; tt < 16; ++tt) { const float xr = cb + cw0 * x3 + cw1 * x2 + cw2 * x1 + cw3 * xin[tt]; x3 = x2; x2 = x1; x1 = xin[tt];
                  *(LAS bf16_t*)(xa + (th + tt) * 144 + lane * 2) = (bf16_t)f2bf(xr); *(LAS float*)(xf + (th + tt) * 272 + lane * 4) = xr; } }
            asm volatile("s_waitcnt lgkmcnt(0)" ::: "memory");
            f32x16 acc[4];
#pragma unroll
            for (int q = 0; q < 4; ++q) acc[q] = f32x16{};
#pragma unroll
            for (int ks = 0; ks < 4; ++ks) { const bf16x8 af = *(const LAS bf16x8*)(xa + tau32(nl) * 144 + (16 * ks + 8 * hi) * 2);
#pragma unroll
                for (int q = 0; q < 4; ++q) { const bf16x8 wfr = *(const bf16x8*)(wt + ((size_t)(q >> 1) * 64 + 32 * (q & 1)) * 64 + 16 * ks); acc[q] = __builtin_amdgcn_mfma_f32_32x32x16_bf16(af, wfr, acc[q], 0, 0, 0); } }
#pragma unroll
            for (int s2 = 0; s2 < 2; ++s2) { const int ch = blk * 64 + 32 * s2 + nl;
                float hl[16], pl[16]; float h = 0.f, P = 1.f;
#pragma unroll
                for (int r = 0; r < 16; ++r) { const float xr = *(const LAS float*)(xf + (16 * hi + r) * 272 + (32 * s2 + nl) * 4);
                    const float rg = sigmoidf_(acc[s2][r] + ba[s2]), ig = sigmoidf_(acc[2 + s2][r] + bx[s2]);
                    const float la = sp8[s2] * rg, a = __expf(la), x2a = 2.f * la;
                    const float om = (x2a > -0.125f) ? -x2a * (1.f + x2a * (0.5f + x2a * (0.16666667f + x2a * 0.041666668f))) : 1.f - a * a;
                    h = a * h + xr * ig * __builtin_amdgcn_sqrtf(om); P *= a; hl[r] = h; pl[r] = P; }
                const float h0e = __shfl(h, nl), p0e = __shfl(P, nl);
                const float hs = hi ? h0e + p0e * hin[s2] : hin[s2], ps = hi ? pin[s2] * p0e : pin[s2];
#pragma unroll
                for (int r = 0; r < 16; ++r) { const size_t m = rb + tb + 16 * hi + r; HLOC[m * 256 + ch] = (bf16_t)f2bf(hl[r] + pl[r] * hs); PCUM[m * 256 + ch] = (bf16_t)f2bf(pl[r] * ps); }
                const float he = hl[15] + pl[15] * hs, pe = pl[15] * ps;
                hin[s2] = __shfl(he, 32 + nl); pin[s2] = __shfl(pe, 32 + nl); }
            asm volatile("s_waitcnt lgkmcnt(0)" ::: "memory");
        }
        if (hi == 0) {
#pragma unroll
            for (int s2 = 0; s2 < 2; ++s2) { const int ch = blk * 64 + 32 * s2 + nl; AGG[((size_t)(b * 128 + c) * 2 + 0) * 256 + ch] = pin[s2]; AGG[((size_t)(b * 128 + c) * 2 + 1) * 256 + ch] = hin[s2]; } }
      }
    }
    { unsigned* NRM = (unsigned*)(p->ws + WS_CTL) + CW_NRM;
      for (int it = wg; it < M / 128; it += nwg) { const int b = it / (T / 128); float mq = 0.f, mk = 0.f;
#pragma unroll 1
        for (int r8 = 0; r8 < 2; ++r8) { u32x4 qwv[8], kwv[8];
#pragma unroll
          for (int q8 = 0; q8 < 8; ++q8) { const size_t m = (size_t)it * 128 + wave * 16 + r8 * 8 + q8; qwv[q8] = *(const u32x4*)(PB + m * NP + C_Q + 8 * lane); kwv[q8] = *(const u32x4*)(PB + m * NP + C_K + 8 * lane); }
#pragma unroll
          for (int q8 = 0; q8 < 8; ++q8) { const u32x4 qw = qwv[q8], kw = kwv[q8];
            float sq = bflo(qw.x) * bflo(qw.x) + bfhi(qw.x) * bfhi(qw.x) + bflo(qw.y) * bflo(qw.y) + bfhi(qw.y) * bfhi(qw.y) + bflo(qw.z) * bflo(qw.z) + bfhi(qw.z) * bfhi(qw.z) + bflo(qw.w) * bflo(qw.w) + bfhi(qw.w) * bfhi(qw.w);
            float sk = bflo(kw.x) * bflo(kw.x) + bfhi(kw.x) * bfhi(kw.x) + bflo(kw.y) * bflo(kw.y) + bfhi(kw.y) * bfhi(kw.y) + bflo(kw.z) * bflo(kw.z) + bfhi(kw.z) * bfhi(kw.z) + bflo(kw.w) * bflo(kw.w) + bfhi(kw.w) * bfhi(kw.w);
#pragma unroll
            for (int o = 1; o < 8; o <<= 1) { sq += __shfl_xor(sq, o); sk += __shfl_xor(sk, o); }
            mq = fmaxf(mq, sq); mk = fmaxf(mk, sk); } }
        if ((lane & 7) == 0) { const int hh = lane >> 3, bh = b * 8 + hh, il = it % (T / 128); atomicMax(NRM + (l * 32 + bh) * 2, __float_as_uint(mq)); atomicMax(NRM + (l * 32 + bh) * 2 + 1, __float_as_uint(mk));
            unsigned* CT = (unsigned*)(p->ws + WS_CTL); atomicMax(CT + CW_QN + (l * 32 + bh) * 32 + (il >> 1), __float_as_uint(mq)); atomicMax(CT + CW_KT + (l * 32 + bh) * 128 + il * 2 + (wave >> 2), __float_as_uint(mk)); } }
    }
    { float* XEND = (float*)(p->ws + WS_XEND);
      for (int it = wave * nwg + wg; it < 2048; it += nwg * NWAVES) {
        const int b = it >> 9, g = (it >> 5) & 15, cq = it & 31;
        S5M cf; s5m_load(p, l, g, lane, cf);
        float a64r[2], a64i[2], x4r[2] = {0.f, 0.f}, x4i[2] = {0.f, 0.f};
#pragma unroll
        for (int s2 = 0; s2 < 2; ++s2) { float pr = cf.a16r[s2], pi_ = cf.a16i[s2];
#pragma unroll
            for (int q = 0; q < 2; ++q) { const float nr = pr * pr - pi_ * pi_, ni = 2.f * pr * pi_; pr = nr; pi_ = ni; }
            a64r[s2] = pr; a64i[s2] = pi_; }
        bf16x8 ufs[8];
#pragma unroll
        for (int t8 = 0; t8 < 8; ++t8) ufs[t8] = *(const bf16x8*)(PB + ((size_t)b * T + cq * 256 + t8 * 32 + tau32(lane & 31)) * NP + C_S5 + 16 * g + 8 * (lane >> 5));
#pragma unroll
        for (int k = 0; k < 4; ++k) { const int c = cq * 4 + k; float xr[2] = {0.f, 0.f}, xi[2] = {0.f, 0.f};
#pragma unroll
            for (int mt = 0; mt < 2; ++mt) { f32x16 bu[4]; const f32x16 z = f32x16{};
#pragma unroll
                for (int q = 0; q < 4; ++q) bu[q] = __builtin_amdgcn_mfma_f32_32x32x16_bf16(ufs[2 * k + mt], cf.bfr[q], z, 0, 0, 0);
                s5m_tile_end(cf, bu, xr, xi); }
#pragma unroll
            for (int s2 = 0; s2 < 2; ++s2) { const float nr = a64r[s2] * x4r[s2] - a64i[s2] * x4i[s2] + xr[s2], ni = a64r[s2] * x4i[s2] + a64i[s2] * x4r[s2] + xi[s2]; x4r[s2] = nr; x4i[s2] = ni; }
            if (lane < 32) { float* xe = XEND + ((size_t)((b * 16 + g) * 128 + c) * 64) * 2;
                *(float2*)(xe + lane * 2) = make_float2(xr[0], xi[0]); *(float2*)(xe + (32 + lane) * 2) = make_float2(xr[1], xi[1]); } }
        if (lane < 32) { float* xe = (float*)(p->ws + WS_X4END) + ((size_t)((b * 16 + g) * 32 + cq) * 64) * 2;
            *(float2*)(xe + lane * 2) = make_float2(x4r[0], x4i[0]); *(float2*)(xe + (32 + lane) * 2) = make_float2(x4r[1], x4i[1]); }
      }
    }
}

constexpr int FIN_YSB = 0, FIN_XST = 34816, FIN_CAR = FIN_XST + 8 * 8704;
static_assert(64 * 264 * 2 <= FIN_XST && FIN_CAR + 1024 <= 131072, "finalize LDS map");
__device__ __forceinline__ void fs_fin(PrmP p, int l, LAS unsigned char* lds, int wg, int nwg) {
    const int tid = fresh_tid(), lane = tid & 63, wave = tid >> 6, fr = lane & 15, fq = lane >> 4, nl = lane & 31, hi = lane >> 5;
    const bf16_t* PB = (const bf16_t*)(p->ws + WS_PB); bf16_t* YC = (bf16_t*)(p->ws + WS_YC);
    const bf16_t* HLOC = (const bf16_t*)(p->ws + WS_YL); const bf16_t* PCUM = (const bf16_t*)(p->ws + WS_YS0); const float* AGG = (const float*)(p->ws + WS_AGG); const float* XEND = (const float*)(p->ws + WS_XEND);
    LAS bf16_t* ysb = (LAS bf16_t*)(lds + FIN_YSB); LAS unsigned char* xst = lds + FIN_XST + wave * 8704; LAS float* car = (LAS float*)(lds + FIN_CAR);
    for (int it = wg; it < NB * 128; it += nwg) {
        const int b = it >> 7, c = it & 127, t0 = c * 64; const size_t rb = (size_t)b * T;
        __syncthreads();
        if (tid < 256) { float cr = 0.f; const float* ag = AGG + (size_t)(b * 128) * 512 + (fresh_tid() & 255); int cc = 0;
            for (; cc + 8 <= c; cc += 8) { float A[8], H[8];
#pragma unroll
                for (int q = 0; q < 8; ++q) { A[q] = ag[(size_t)(cc + q) * 512]; H[q] = ag[(size_t)(cc + q) * 512 + 256]; }
#pragma unroll
                for (int q = 0; q < 8; ++q) cr = A[q] * cr + H[q]; }
            for (; cc < c; ++cc) cr = ag[(size_t)cc * 512] * cr + ag[(size_t)cc * 512 + 256];
            car[tid] = cr; }
#pragma unroll 1
        for (int gi = 0; gi < 2; ++gi) { const int g = wave + 8 * gi;
            S5M cf; s5m_load(p, l, g, lane, cf);
            bf16x8 cmf[8]; bf16x8 dfr; s5m_load_c(p, l, g, lane, cmf, dfr);
            float xr[2] = {0.f, 0.f}, xi[2] = {0.f, 0.f};
            { float a64r[2], a64i[2];
#pragma unroll
              for (int s = 0; s < 2; ++s) { float pr = cf.a16r[s], pi_ = cf.a16i[s];
#pragma unroll
                  for (int q = 0; q < 2; ++q) { const float nr = pr * pr - pi_ * pi_, ni = 2.f * pr * pi_; pr = nr; pi_ = ni; }
                  a64r[s] = pr; a64i[s] = pi_; }
              float a256r[2], a256i[2];
#pragma unroll
              for (int s = 0; s < 2; ++s) { float pr = a64r[s], pi_ = a64i[s];
#pragma unroll
                  for (int q = 0; q < 2; ++q) { const float nr = pr * pr - pi_ * pi_, ni = 2.f * pr * pi_; pr = nr; pi_ = ni; }
                  a256r[s] = pr; a256i[s] = pi_; }
              const float* x4 = (const float*)(p->ws + WS_X4END) + ((size_t)((b * 16 + g) * 32) * 64) * 2 + nl * 2;
              const int nb4 = c >> 2; int cb = 0;
              for (; cb + 4 <= nb4; cb += 4) { float2 e0[4], e1[4];
#pragma unroll
                  for (int q = 0; q < 4; ++q) { e0[q] = *(const float2*)(x4 + (size_t)(cb + q) * 128); e1[q] = *(const float2*)(x4 + (size_t)(cb + q) * 128 + 64); }
#pragma unroll
                  for (int q = 0; q < 4; ++q) {
                      float nr = a256r[0] * xr[0] - a256i[0] * xi[0] + e0[q].x, ni = a256r[0] * xi[0] + a256i[0] * xr[0] + e0[q].y; xr[0] = nr; xi[0] = ni;
                      nr = a256r[1] * xr[1] - a256i[1] * xi[1] + e1[q].x; ni = a256r[1] * xi[1] + a256i[1] * xr[1] + e1[q].y; xr[1] = nr; xi[1] = ni; } }
              for (; cb < nb4; ++cb) { const float2 e0 = *(const float2*)(x4 + (size_t)cb * 128), e1 = *(const float2*)(x4 + (size_t)cb * 128 + 64);
                  float nr = a256r[0] * xr[0] - a256i[0] * xi[0] + e0.x, ni = a256r[0] * xi[0] + a256i[0] * xr[0] + e0.y; xr[0] = nr; xi[0] = ni;
                  nr = a256r[1] * xr[1] - a256i[1] * xi[1] + e1.x; ni = a256r[1] * xi[1] + a256i[1] * xr[1] + e1.y; xr[1] = nr; xi[1] = ni; }
              const float* xe = XEND + ((size_t)((b * 16 + g) * 128) * 64) * 2 + nl * 2;
              for (int cc = nb4 * 4; cc < c; ++cc) { const float2 e0 = *(const float2*)(xe + (size_t)cc * 128), e1 = *(const float2*)(xe + (size_t)cc * 128 + 64);
                  float nr = a64r[0] * xr[0] - a64i[0] * xi[0] + e0.x, ni = a64r[0] * xi[0] + a64i[0] * xr[0] + e0.y; xr[0] = nr; xi[0] = ni;
                  nr = a64r[1] * xr[1] - a64i[1] * xi[1] + e1.x; ni = a64r[1] * xi[1] + a64i[1] * xr[1] + e1.y; xr[1] = nr; xi[1] = ni; } }
#pragma unroll 1
            for (int mt = 0; mt < 2; ++mt) {
                f32x16 bu[4]; bf16x8 uf; s5m_bu(PB, rb, t0 + mt * 32, g, lane, cf, bu, uf);
#pragma unroll
                for (int s = 0; s < 2; ++s) {
#pragma unroll
                    for (int r = 1; r < 16; ++r) { const float pr = bu[s][r - 1], pi_ = bu[2 + s][r - 1]; bu[s][r] += cf.ar[s] * pr - cf.ai[s] * pi_; bu[2 + s][r] += cf.ar[s] * pi_ + cf.ai[s] * pr; }
                    const float er = bu[s][15], ei = bu[2 + s][15];
                    const float por = __shfl_xor(er, 32), poi = __shfl_xor(ei, 32);
                    const float elr = hi ? por : er, eli = hi ? poi : ei, ehr = hi ? er : por, ehi = hi ? ei : poi;
                    const float t1r = cf.a16r[s] * xr[s] - cf.a16i[s] * xi[s] + elr, t1i = cf.a16r[s] * xi[s] + cf.a16i[s] * xr[s] + eli;
                    float wr = hi ? t1r : xr[s], wi = hi ? t1i : xi[s];
                    xr[s] = cf.a16r[s] * t1r - cf.a16i[s] * t1i + ehr; xi[s] = cf.a16r[s] * t1i + cf.a16i[s] * t1r + ehi;
#pragma unroll
                    for (int r = 0; r < 16; ++r) { const float nr = cf.ar[s] * wr - cf.ai[s] * wi, ni = cf.ar[s] * wi + cf.ai[s] * wr; wr = nr; wi = ni; bu[s][r] += wr; bu[2 + s][r] += wi; }
                }
#pragma unroll
                for (int r = 0; r < 16; ++r) { u32x2 w; w.x = pk2(bu[0][r], bu[1][r]); w.y = pk2(bu[2][r], bu[3][r]); *(LAS u32x2*)(xst + (16 * hi + r) * 272 + nl * 8) = w; }
                asm volatile("s_waitcnt lgkmcnt(0)" ::: "memory");
                f32x16 acc = __builtin_amdgcn_mfma_f32_32x32x16_bf16(uf, dfr, f32x16{}, 0, 0, 0);
#pragma unroll
                for (int ks = 0; ks < 8; ++ks) { const bf16x8 af = *(const LAS bf16x8*)(xst + tau32(nl) * 272 + (16 * ks + 8 * hi) * 2); acc = __builtin_amdgcn_mfma_f32_32x32x16_bf16(af, cmf[ks], acc, 0, 0, 0); }
                if (nl < 16) {
#pragma unroll
                    for (int r = 0; r < 16; ++r) ysb[(mt * 32 + 16 * hi + r) * 264 + g * 16 + nl] = (bf16_t)f2bf(gelu_tanh(acc[r])); }
                asm volatile("s_waitcnt lgkmcnt(0)" ::: "memory");
            }
        }
        __syncthreads();
        { const bf16_t* GW = (const bf16_t*)(p->ws + WS_GLUW) + (size_t)l * 65536;
          f32x4 acc[4][2];
#pragma unroll
          for (int m = 0; m < 4; ++m) { acc[m][0] = (f32x4){0.f, 0.f, 0.f, 0.f}; acc[m][1] = (f32x4){0.f, 0.f, 0.f, 0.f}; }
#pragma unroll 2
          for (int ks = 0; ks < 8; ++ks) { bf16x8 a[4], bb[2];
#pragma unroll
              for (int m = 0; m < 4; ++m) a[m] = *(const LAS bf16x8*)(ysb + (m * 16 + fr) * 264 + ks * 32 + 8 * fq);
#pragma unroll
              for (int n = 0; n < 2; ++n) bb[n] = *(const bf16x8*)(GW + (size_t)((2 * wave + n) * 16 + fr) * 256 + ks * 32 + 8 * fq);
#pragma unroll
              for (int m = 0; m < 4; ++m)
#pragma unroll
                  for (int n = 0; n < 2; ++n) acc[m][n] = __builtin_amdgcn_mfma_f32_16x16x32_bf16(a[m], bb[n], acc[m][n], 0, 0, 0); }
          __syncthreads();
#pragma unroll
          for (int n = 0; n < 2; ++n) { const int j = (2 * wave + n) * 16 + fr; const float gb = p->in[I_GLUB][l * 256 + j];
#pragma unroll
              for (int m = 0; m < 4; ++m)
#pragma unroll
                  for (int r = 0; r < 4; ++r) { const int tk = m * 16 + 4 * fq + r; const float y = bf2f(ysb[tk * 264 + j]); ysb[tk * 264 + j] = (bf16_t)f2bf(y * sigmoidf_(acc[m][n][r] + gb)); } }
        }
        __syncthreads();
        { const f32x4 ggl = *(const f32x4*)(p->in[I_GNLRU] + l * 256 + 4 * lane), ggs = *(const f32x4*)(p->in[I_GNS5] + l * 256 + 4 * lane);
          const f32x4 g0 = *(const f32x4*)(p->in[I_GNATT] + l * 512 + 8 * lane), g1 = *(const f32x4*)(p->in[I_GNATT] + l * 512 + 8 * lane + 4); const f32x4 cr = *(const LAS f32x4*)(car + 4 * lane);
#pragma unroll 1
          for (int rq = 0; rq < 2; ++rq) {
            u32x2 hw[4], pw[4], gw[4]; u32x4 ow[4];
#pragma unroll
            for (int q = 0; q < 4; ++q) { const size_t m = rb + t0 + wave + 8 * (4 * rq + q);
                hw[q] = *(const u32x2*)(HLOC + m * 256 + 4 * lane); pw[q] = *(const u32x2*)(PCUM + m * 256 + 4 * lane); gw[q] = *(const u32x2*)(PB + m * NP + C_LG + 4 * lane); ow[q] = *(const u32x4*)(PB + m * NP + C_Q + 8 * lane); }
#pragma unroll
            for (int q = 0; q < 4; ++q) { const int r = wave + 8 * (4 * rq + q); const size_t m = rb + t0 + r;
              { const f32x4 hl = (f32x4){bflo(hw[q].x), bfhi(hw[q].x), bflo(hw[q].y), bfhi(hw[q].y)}, pc = (f32x4){bflo(pw[q].x), bfhi(pw[q].x), bflo(pw[q].y), bfhi(pw[q].y)};
                f32x4 v; v.x = (hl.x + pc.x * cr.x) * gelu_tanh(bflo(gw[q].x)); v.y = (hl.y + pc.y * cr.y) * gelu_tanh(bfhi(gw[q].x)); v.z = (hl.z + pc.z * cr.z) * gelu_tanh(bflo(gw[q].y)); v.w = (hl.w + pc.w * cr.w) * gelu_tanh(bfhi(gw[q].y));
                const float rs = __builtin_amdgcn_rsqf(wave_sum(v.x * v.x + v.y * v.y + v.z * v.z + v.w * v.w) * (1.f / 256.f) + RMS_EPS);
                u32x2 o; o.x = pk2(v.x * rs * ggl.x, v.y * rs * ggl.y); o.y = pk2(v.z * rs * ggl.z, v.w * rs * ggl.w); *(u32x2*)(YC + m * 1024 + 4 * lane) = o; }
              { const u32x2 yw = *(const LAS u32x2*)(ysb + r * 264 + 4 * lane); const f32x4 v = (f32x4){bflo(yw.x), bfhi(yw.x), bflo(yw.y), bfhi(yw.y)};
                const float rs = __builtin_amdgcn_rsqf(wave_sum(v.x * v.x + v.y * v.y + v.z * v.z + v.w * v.w) * (1.f / 256.f) + RMS_EPS);
                u32x2 o; o.x = pk2(v.x * rs * ggs.x, v.y * rs * ggs.y); o.y = pk2(v.z * rs * ggs.z, v.w * rs * ggs.w); *(u32x2*)(YC + m * 1024 + 256 + 4 * lane) = o; }
              { const u32x4 w = ow[q];
                const float v[8] = {bflo(w.x), bfhi(w.x), bflo(w.y), bfhi(w.y), bflo(w.z), bfhi(w.z), bflo(w.w), bfhi(w.w)};
                float ss = 0.f;
#pragma unroll
                for (int i = 0; i < 8; ++i) ss += v[i] * v[i];
                const float rs = __builtin_amdgcn_rsqf(wave_sum(ss) * (1.f / 512.f) + RMS_EPS);
                u32x4 o; o.x = pk2(v[0] * rs * g0.x, v[1] * rs * g0.y); o.y = pk2(v[2] * rs * g0.z, v[3] * rs * g0.w); o.z = pk2(v[4] * rs * g1.x, v[5] * rs * g1.y); o.w = pk2(v[6] * rs * g1.z, v[7] * rs * g1.w);
                *(u32x4*)(YC + m * 1024 + 512 + 8 * lane) = o; } } } }
    }
}

constexpr int ROW_WT = 0, ROW_WT_LD = 1028, ROW_ETAB = 131584 + 64;
__device__ __forceinline__ void ph_row(PrmP p, int l, LAS unsigned char* lds, int wg, int nwg) {
    const int tid = fresh_tid(), lane = tid & 63, wave = tid >> 6;
    const int R = M / nwg;
    const float* Xin = p->in[I_X]; bf16_t* XB = (bf16_t*)(p->ws + WS_XB); const bf16_t* Y = (const bf16_t*)(p->ws + WS_Y);
    const float* MOD = (const float*)(p->ws + WS_MOD); bf16_t* HB = (bf16_t*)(p->ws + WS_HB);
    int* TOPI = (int*)(p->ws + WS_MISC + MS_TOPI); float* TOPG = (float*)(p->ws + WS_MISC + MS_TOPG); int* RANK = (int*)(p->ws + WS_MISC + MS_RANK); int* HIST = (int*)(p->ws + WS_MISC + MS_HIST);
    LAS int* etab = (LAS int*)(lds + ROW_ETAB);
    LAS float* wt = (LAS float*)(lds + ROW_WT);
    const float* RW = p->in[I_ROUTW] + (size_t)l * 1024 * 32; const float* RB = p->in[I_ROUTB] + l * 32;
    __syncthreads();
    { f32x4 wv[16];
#pragma unroll
      for (int k = 0; k < 16; ++k) wv[k] = *(const f32x4*)(RW + tid * 4 + 2048 * k);
#pragma unroll
      for (int k = 0; k < 16; ++k) { const int i = tid * 4 + 2048 * k, e = i & 31, d = i >> 5; wt[e * ROW_WT_LD + d] = wv[k].x; wt[(e + 1) * ROW_WT_LD + d] = wv[k].y; wt[(e + 2) * ROW_WT_LD + d] = wv[k].z; wt[(e + 3) * ROW_WT_LD + d] = wv[k].w; } }
    __syncthreads();
    const float rbias = RB[(lane >> 1) & 31];
    const int RPW = R / NWAVES; constexpr int NR = 2;
    u32x2 ywn[NR][4]; f32x4 xfn[NR][4]; u32x2 xbn[NR][4];
#define ROW_LOAD(r0_) do { _Pragma("unroll") for (int q = 0; q < NR; ++q) _Pragma("unroll") for (int j = 0; j < 4; ++j) { const size_t mm_ = (size_t)wg * R + (r0_) + q; const int c_ = 4 * lane + 256 * j; \
        ywn[q][j] = *(const u32x2*)(Y + mm_ * 1024 + c_); if (l == 0) xfn[q][j] = *(const f32x4*)(Xin + mm_ * 1024 + c_); else xbn[q][j] = *(const u32x2*)(XB + mm_ * 1024 + c_); } } while (0)
    ROW_LOAD(wave * RPW);
    for (int r0 = wave * RPW; r0 < (wave + 1) * RPW; r0 += NR) {
        const size_t m0 = (size_t)wg * R + r0; const int b = (int)(m0 / T);
        const float* mod = MOD + (size_t)(l * 4 + b) * 6144;
        u32x2 ywc[NR][4]; f32x4 xfc[NR][4];
#pragma unroll
        for (int q = 0; q < NR; ++q)
#pragma unroll
            for (int j = 0; j < 4; ++j) { ywc[q][j] = ywn[q][j]; if (l == 0) xfc[q][j] = xfn[q][j]; else xfc[q][j] = (f32x4){bflo(xbn[q][j].x), bfhi(xbn[q][j].x), bflo(xbn[q][j].y), bfhi(xbn[q][j].y)}; }
        if (r0 + NR < (wave + 1) * RPW) ROW_LOAD(r0 + NR);
        f32x4 h[NR][4];
        { f32x4 y[NR][4]; float ss[NR] = {};
#pragma unroll
          for (int q = 0; q < NR; ++q)
#pragma unroll
              for (int j = 0; j < 4; ++j) { const u32x2 yw = ywc[q][j]; y[q][j] = (f32x4){bflo(yw.x), bfhi(yw.x), bflo(yw.y), bfhi(yw.y)}; ss[q] += (y[q][j].x * y[q][j].x + y[q][j].y * y[q][j].y) + (y[q][j].z * y[q][j].z + y[q][j].w * y[q][j].w); }
          float rstd[NR], s2[NR] = {};
#pragma unroll
          for (int q = 0; q < NR; ++q) rstd[q] = __builtin_amdgcn_rsqf(wave_sum(ss[q]) * (1.f / 1024.f) + RMS_EPS);
#pragma unroll
          for (int j = 0; j < 4; ++j) { const int c = 4 * lane + 256 * j; const f32x4 g = *(const f32x4*)(p->in[I_POSTMIXG] + l * 1024 + c), gate = *(const f32x4*)(mod + 2 * 1024 + c);
#pragma unroll
              for (int q = 0; q < NR; ++q) { const f32x4 x0 = xfc[q][j];
                  const f32x4 x = x0 + gate * (y[q][j] * rstd[q] * g); { u32x2 xo; xo.x = pk2(x.x, x.y); xo.y = pk2(x.z, x.w); *(u32x2*)(XB + (m0 + q) * 1024 + c) = xo; } h[q][j] = x;
                  s2[q] += (x.x * x.x + x.y * x.y) + (x.z * x.z + x.w * x.w); } }
          float rstd2[NR];
#pragma unroll
          for (int q = 0; q < NR; ++q) rstd2[q] = __builtin_amdgcn_rsqf(wave_sum(s2[q]) * (1.f / 1024.f) + RMS_EPS);
#pragma unroll
          for (int j = 0; j < 4; ++j) { const int c = 4 * lane + 256 * j; const f32x4 g = *(const f32x4*)(p->in[I_PREFFNG] + l * 1024 + c), sc = *(const f32x4*)(mod + 4 * 1024 + c), sh = *(const f32x4*)(mod + 3 * 1024 + c);
#pragma unroll
              for (int q = 0; q < NR; ++q) { h[q][j] = h[q][j] * rstd2[q] * g * (sc + 1.f) + sh;
                  if (EXPERT_FP8) *(unsigned*)((unsigned char*)HB + (m0 + q) * 1024 + c) = pk4_fp8(4.f * h[q][j].x, 4.f * h[q][j].y, 4.f * h[q][j].z, 4.f * h[q][j].w);
                  else { u32x2 o; o.x = pk2(h[q][j].x, h[q][j].y); o.y = pk2(h[q][j].z, h[q][j].w); *(u32x2*)(HB + (m0 + q) * 1024 + c) = o; } } } }
        float v16[NR][16];
        const bool b5 = lane & 32;
#pragma unroll
        for (int i = 0; i < 16; ++i) { float lo[NR] = {}, hi[NR] = {};
#pragma unroll
            for (int j = 0; j < 4; ++j) { const f32x4 wl = *(const LAS f32x4*)(wt + i * ROW_WT_LD + 4 * lane + 256 * j), wh = *(const LAS f32x4*)(wt + (i + 16) * ROW_WT_LD + 4 * lane + 256 * j);
#pragma unroll
                for (int q = 0; q < NR; ++q) { lo[q] += h[q][j].x * wl.x + h[q][j].y * wl.y + h[q][j].z * wl.z + h[q][j].w * wl.w; hi[q] += h[q][j].x * wh.x + h[q][j].y * wh.y + h[q][j].z * wh.z + h[q][j].w * wh.w; } }
#pragma unroll
            for (int q = 0; q < NR; ++q) { const float rcv = __shfl_xor(b5 ? lo[q] : hi[q], 32); v16[q][i] = (b5 ? hi[q] : lo[q]) + rcv; } }
#pragma unroll
        for (int q = 0; q < NR; ++q) { const int r = r0 + q; const size_t m = m0 + q;
            float v8[8], v4[4], v2[2], mine;
            { const bool b4 = lane & 16, b3 = lane & 8, b2 = lane & 4, b1 = lane & 2;
#pragma unroll
              for (int i = 0; i < 8; ++i) { const float rcv = __shfl_xor(b4 ? v16[q][i] : v16[q][i + 8], 16); v8[i] = (b4 ? v16[q][i + 8] : v16[q][i]) + rcv; }
#pragma unroll
              for (int i = 0; i < 4; ++i) { const float rcv = __shfl_xor(b3 ? v8[i] : v8[i + 4], 8); v4[i] = (b3 ? v8[i + 4] : v8[i]) + rcv; }
#pragma unroll
              for (int i = 0; i < 2; ++i) { const float rcv = __shfl_xor(b2 ? v4[i] : v4[i + 2], 4); v2[i] = (b2 ? v4[i + 2] : v4[i]) + rcv; }
              { const float rcv = __shfl_xor(b1 ? v2[0] : v2[1], 2); mine = (b1 ? v2[1] : v2[0]) + rcv; }
              mine += __shfl_xor(mine, 1); }
            mine += rbias;
            if (lane & 1) mine = -3e38f;
            float tv[4]; int ti[4];
#pragma unroll
            for (int k = 0; k < 4; ++k) { float mx = mine;
#pragma unroll
                for (int o = 1; o < 64; o <<= 1) mx = fmaxf(mx, __shfl_xor(mx, o));
                const unsigned long long bal = __ballot(mine == mx && !(lane & 1)); const int wl_ = __ffsll((long long)bal) - 1;
                tv[k] = mx; ti[k] = wl_ >> 1; if (lane == wl_) mine = -3e38f; }
            const float e1 = __expf(tv[1] - tv[0]), e2 = __expf(tv[2] - tv[0]), e3 = __expf(tv[3] - tv[0]); const float inv = __builtin_amdgcn_rcpf(1.f + e1 + e2 + e3);
            if (lane < 4) { const int id = (lane == 0) ? ti[0] : (lane == 1) ? ti[1] : (lane == 2) ? ti[2] : ti[3]; const float gv = ((lane == 0) ? 1.f : (lane == 1) ? e1 : (lane == 2) ? e2 : e3) * inv;
                TOPI[m * 4 + lane] = id; TOPG[m * 4 + lane] = gv; etab[r * 4 + lane] = id; } }
    }
    __syncthreads();
    const int NEn = R * 4;
    if (NEn == NTHREADS) {
        LAS int* wcnt = etab + NTHREADS;
        const int e = etab[tid]; int myrank = 0;
#pragma unroll 4
        for (int q = 0; q < 32; ++q) { const unsigned long long mk = __ballot(e == q); if (e == q) myrank = __popcll(mk & ((1ull << lane) - 1ull)); if (lane == q) wcnt[wave * 32 + q] = __popcll(mk); }
        __syncthreads();
        int pre = 0; for (int w = 0; w < wave; ++w) pre += wcnt[w * 32 + e];
        RANK[(size_t)wg * NEn + tid] = pre + myrank;
        if (tid < 32) { int c = 0;
#pragma unroll
            for (int w = 0; w < NWAVES; ++w) c += wcnt[w * 32 + tid];
            HIST[wg * 32 + tid] = c; }
    } else {
    if (tid < NEn) { const int e = etab[tid]; int rk = 0; for (int j = 0; j < tid; ++j) rk += (etab[j] == e) ? 1 : 0; RANK[(size_t)wg * NEn + tid] = rk; }
    if (tid < 32) { int c = 0; for (int j = 0; j < NEn; ++j) c += (etab[j] == tid) ? 1 : 0; HIST[wg * 32 + tid] = c; }
    }
    __syncthreads();
}

__device__ __forceinline__ void ph_offs(PrmP p, int l, LAS unsigned char* lds, int wg, int nwg) {
    const int tid = fresh_tid(), lane = tid & 63, wave = tid >> 6;
    const int R = M / nwg, NEn = R * 4;
    const int* TOPI = (const int*)(p->ws + WS_MISC + MS_TOPI); const int* RANK = (const int*)(p->ws + WS_MISC + MS_RANK); const int* HIST = (const int*)(p->ws + WS_MISC + MS_HIST);
    int* POS = (int*)(p->ws + WS_MISC + MS_POS); int* TILE_E = (int*)(p->ws + WS_MISC + MS_TILEE); int* CTL = (int*)(p->ws + WS_CTL);
    const bf16_t* HB = (const bf16_t*)(p->ws + WS_HB); bf16_t* XS = (bf16_t*)(p->ws + WS_XS);
    LAS int* tot = (LAS int*)lds; LAS int* mine = tot + 32; LAS int* base = mine + 32; LAS int* ptab = base + 32;
    __syncthreads();
    { LAS int* part = ptab + 512;
      const int e = tid & 31, pt = tid >> 5, per = (nwg + 15) / 16; int t = 0, mb = 0;
      for (int w = pt * per; w < (pt + 1) * per && w < nwg; ++w) { const int c = HIST[w * 32 + e]; t += c; mb += (w < wg) ? c : 0; }
      part[(pt * 2 + 0) * 32 + e] = t; part[(pt * 2 + 1) * 32 + e] = mb;
      __syncthreads();
      if (tid < 32) { int ts = 0, ms = 0;
#pragma unroll
          for (int q = 0; q < 16; ++q) { ts += part[(q * 2 + 0) * 32 + tid]; ms += part[(q * 2 + 1) * 32 + tid]; }
          tot[tid] = ts; mine[tid] = ms; } }
    __syncthreads();
    if (tid == 0) { int run = 0; for (int e = 0; e < 32; ++e) { const int pad = (tot[e] + 255) / 256 * 256; base[e] = run + mine[e];
            if (wg == 0) for (int t = run / 256; t < (run + pad) / 256; ++t) TILE_E[t] = e;
            run += pad; }
        if (wg == 0) CTL[CW_NT] = run / 256; }
    __syncthreads();
    int* ROWTOK = (int*)(p->ws + WS_MISC + MS_ROWTOK);
    if (tid < NEn) { const size_t idx = (size_t)wg * NEn + tid; const int pos = base[TOPI[idx]] + RANK[idx]; POS[idx] = pos; ptab[tid] = pos; ROWTOK[pos] = (int)(idx >> 2); }
    if (wg < 32) { const int e = wg, st = base[e] - mine[e] + tot[e], en = base[e] - mine[e] + (tot[e] + 255) / 256 * 256; for (int r = st + tid; r < en; r += NTHREADS) ROWTOK[r] = 0; }
    __syncthreads();
    if (EXPERT_FP8) return;
    for (int r0 = wave * (R / NWAVES); r0 < (wave + 1) * (R / NWAVES); r0 += 4) {
        u32x4 va[4], vb[4];
        if (EXPERT_FP8) {
#pragma unroll
            for (int q = 0; q < 4; ++q) va[q] = ((const u32x4*)((const unsigned char*)HB + ((size_t)wg * R + r0 + q) * 1024))[lane];
#pragma unroll
            for (int q = 0; q < 4; ++q)
#pragma unroll
                for (int k = 0; k < 4; ++k) ((u32x4*)((unsigned char*)XS + (size_t)ptab[(r0 + q) * 4 + k] * 1024))[lane] = va[q];
        } else {
#pragma unroll
        for (int q = 0; q < 4; ++q) { const u32x4* src = (const u32x4*)(HB + ((size_t)wg * R + r0 + q) * 1024); va[q] = src[lane]; vb[q] = src[lane + 64]; }
#pragma unroll
        for (int q = 0; q < 4; ++q)
#pragma unroll
            for (int k = 0; k < 4; ++k) { u32x4* dst = (u32x4*)(XS + (size_t)ptab[(r0 + q) * 4 + k] * 1024); dst[lane] = va[q]; dst[lane + 64] = vb[q]; }
        }
    }
}

__device__ __forceinline__ void ph_comb(PrmP p, int l, int wg, int nwg) {
    const int tid = fresh_tid(), lane = tid & 63, wave = tid >> 6;
    const bf16_t* YR = (const bf16_t*)(p->ws + WS_YR); const int* POS = (const int*)(p->ws + WS_MISC + MS_POS); const float* TOPG = (const float*)(p->ws + WS_MISC + MS_TOPG);
    const float* MOD = (const float*)(p->ws + WS_MOD); float* X = p->out; bf16_t* XB = (bf16_t*)(p->ws + WS_XB);
    int posv = POS[(size_t)(wg * NWAVES + wave) * 4 + (lane & 3)]; float gvv = TOPG[(size_t)(wg * NWAVES + wave) * 4 + (lane & 3)];
    for (int m = wg * NWAVES + wave; m < M; m += nwg * NWAVES) {
        const int b = m / T; const float* gate = MOD + (size_t)(l * 4 + b) * 6144 + 5 * 1024;
        const int posc = posv; const float gvc = gvv;
        { const int mn = m + nwg * NWAVES; if (mn < M) { posv = POS[(size_t)mn * 4 + (lane & 3)]; gvv = TOPG[(size_t)mn * 4 + (lane & 3)]; } }
        float y[16];
#pragma unroll
        for (int i = 0; i < 16; ++i) y[i] = 0.f;
#pragma unroll
        for (int k = 0; k < 4; ++k) { const int pos = __builtin_amdgcn_readlane(posc, k); const float gv = __builtin_bit_cast(float, __builtin_amdgcn_readlane(__builtin_bit_cast(int, gvc), k));
            if (YR_FP8) { typedef float f32x2_ __attribute__((ext_vector_type(2))); const float g16 = gv * 0.0625f;
                const u32x2 a8 = *(const u32x2*)((const unsigned char*)YR + (size_t)pos * 1024 + 8 * lane), c8 = *(const u32x2*)((const unsigned char*)YR + (size_t)pos * 1024 + 512 + 8 * lane);
                const unsigned wv[4] = {a8.x, a8.y, c8.x, c8.y};
#pragma unroll
                for (int q = 0; q < 4; ++q) { const f32x2_ lo = __builtin_amdgcn_cvt_pk_f32_fp8((int)wv[q], false), hi = __builtin_amdgcn_cvt_pk_f32_fp8((int)wv[q], true);
                    y[4 * q + 0] += g16 * lo.x; y[4 * q + 1] += g16 * lo.y; y[4 * q + 2] += g16 * hi.x; y[4 * q + 3] += g16 * hi.y; }
            } else {
            const u32x4 a = *(const u32x4*)(YR + (size_t)pos * 1024 + 8 * lane), c = *(const u32x4*)(YR + (size_t)pos * 1024 + 512 + 8 * lane);
            y[0] += gv * bflo(a.x); y[1] += gv * bfhi(a.x); y[2] += gv * bflo(a.y); y[3] += gv * bfhi(a.y); y[4] += gv * bflo(a.z); y[5] += gv * bfhi(a.z); y[6] += gv * bflo(a.w); y[7] += gv * bfhi(a.w);
            y[8] += gv * bflo(c.x); y[9] += gv * bfhi(c.x); y[10] += gv * bflo(c.y); y[11] += gv * bfhi(c.y); y[12] += gv * bflo(c.z); y[13] += gv * bfhi(c.z); y[14] += gv * bflo(c.w); y[15] += gv * bfhi(c.w); } }
        float ss = 0.f;
#pragma unroll
        for (int i = 0; i < 16; ++i) ss += y[i] * y[i];
        const float rstd = __builtin_amdgcn_rsqf(wave_sum(ss) * (1.f / 1024.f) + RMS_EPS);
        float xs[16]; float s2 = 0.f;
#pragma unroll
        for (int hf = 0; hf < 2; ++hf) { const int c0 = hf * 512 + 8 * lane;
#pragma unroll
            for (int q = 0; q < 2; ++q) { const int c = c0 + 4 * q; const f32x4 g = *(const f32x4*)(p->in[I_POSTFFNG] + l * 1024 + c), gt = *(const f32x4*)(gate + c); const u32x2 xw = *(const u32x2*)(XB + (size_t)m * 1024 + c); f32x4 xv = (f32x4){bflo(xw.x), bfhi(xw.x), bflo(xw.y), bfhi(xw.y)};
                xv.x += gt.x * (y[hf * 8 + 4 * q + 0] * rstd * g.x); xv.y += gt.y * (y[hf * 8 + 4 * q + 1] * rstd * g.y); xv.z += gt.z * (y[hf * 8 + 4 * q + 2] * rstd * g.z); xv.w += gt.w * (y[hf * 8 + 4 * q + 3] * rstd * g.w);
                if (l + 1 < NL) { u32x2 xo; xo.x = pk2(xv.x, xv.y); xo.y = pk2(xv.z, xv.w); *(u32x2*)(XB + (size_t)m * 1024 + c) = xo; } else *(f32x4*)(X + (size_t)m * 1024 + c) = xv;
                xs[hf * 8 + 4 * q + 0] = xv.x; xs[hf * 8 + 4 * q + 1] = xv.y; xs[hf * 8 + 4 * q + 2] = xv.z; xs[hf * 8 + 4 * q + 3] = xv.w; s2 += (xv.x * xv.x + xv.y * xv.y) + (xv.z * xv.z + xv.w * xv.w); } }
        if (l + 1 < NL) {
            const float rs2 = __builtin_amdgcn_rsqf(wave_sum(s2) * (1.f / 1024.f) + RMS_EPS);
            const float* shift = MOD + (size_t)((l + 1) * 4 + b) * 6144; const float* scale = shift + 1024; const float* g2 = p->in[I_PREMIXG] + (l + 1) * 1024;
            bf16_t* HB = (bf16_t*)(p->ws + WS_HB);
#pragma unroll
            for (int hf = 0; hf < 2; ++hf) { const int c0 = hf * 512 + 8 * lane; float hv[8];
#pragma unroll
                for (int q = 0; q < 2; ++q) { const f32x4 gg = *(const f32x4*)(g2 + c0 + 4 * q), sc = *(const f32x4*)(scale + c0 + 4 * q), sh = *(const f32x4*)(shift + c0 + 4 * q);
                    hv[4 * q + 0] = xs[hf * 8 + 4 * q + 0] * rs2 * gg.x * (sc.x + 1.f) + sh.x; hv[4 * q + 1] = xs[hf * 8 + 4 * q + 1] * rs2 * gg.y * (sc.y + 1.f) + sh.y;
                    hv[4 * q + 2] = xs[hf * 8 + 4 * q + 2] * rs2 * gg.z * (sc.z + 1.f) + sh.z; hv[4 * q + 3] = xs[hf * 8 + 4 * q + 3] * rs2 * gg.w * (sc.w + 1.f) + sh.w; }
                u32x4 o; o.x = pk2(hv[0], hv[1]); o.y = pk2(hv[2], hv[3]); o.z = pk2(hv[4], hv[5]); o.w = pk2(hv[6], hv[7]);
                *(u32x4*)(HB + (size_t)m * 1024 + c0) = o; } }
    }
}

__device__ __forceinline__ void ph_tables(PrmP p, int wg, int nwg) {
    const int tid = fresh_tid(), lane = tid & 63, wave = tid >> 6;
    for (int it = wave * nwg + wg; it < NL * 16; it += nwg * NWAVES) s5m_table_build(p, it >> 4, it & 15, lane);
}

#define XB_TMO      128
#define XB_XCNT(j)  (256  + 64 * (j))
#define XB_XSUB(j)  (1280 + 64 * (j))
#define XB_XGEN(j)  (2304 + 64 * (j))
#define XB_TOP      3328
#define XB_TOPGEN   3392
#define XCD_BAR_WORDS 3456
#define XB_SPIN_CAP (1u << 22)

__device__ __forceinline__ unsigned xb_ld(unsigned* p)              { return __hip_atomic_load(p, __ATOMIC_RELAXED, __HIP_MEMORY_SCOPE_AGENT); }
__device__ __forceinline__ unsigned xb_add(unsigned* p, unsigned v) { return __hip_atomic_fetch_add(p, v, __ATOMIC_RELAXED, __HIP_MEMORY_SCOPE_AGENT); }
__device__ __forceinline__ unsigned xb_xcc_id() { return (unsigned)__builtin_amdgcn_s_getreg((3 << 11) | 20) & 0xFu; }
#define XB_SPIN(cond, bar) do { unsigned _sp = 0; while (cond) { __builtin_amdgcn_s_sleep(1); \
    if ((++_sp & 255u) == 0u) { if (xb_ld(&(bar)[XB_TMO])) break; if (_sp > XB_SPIN_CAP) { atomicAdd(&(bar)[XB_TMO], 1u); break; } } } } while (0)

struct XcdBarrier { unsigned* bar; unsigned x; volatile LAS unsigned* st; };

__device__ __forceinline__ XcdBarrier xcd_barrier_post(unsigned* bar, volatile LAS unsigned* st) {
    XcdBarrier b; b.bar = bar; b.x = xb_xcc_id(); b.st = st;
    if (threadIdx.x == 0) (void)xb_add(&bar[XB_XCNT(b.x)], 1u);
    return b;
}
__device__ __forceinline__ void xcd_barrier_complete(unsigned* bar, unsigned x, unsigned& nloc, unsigned& nx) {
    const unsigned G = gridDim.x * gridDim.y * gridDim.z;
    unsigned sum, cnt, mine, sp = 0u;
    for (;;) {
        sum = 0u; cnt = 0u; mine = 0u;
#pragma unroll
        for (unsigned j = 0; j < 16; ++j) { const unsigned c = xb_ld(&bar[XB_XCNT(j)]); sum += c; cnt += (c > 0u) ? 1u : 0u; mine = (j == x) ? c : mine; }
        if (sum == G) break;
        __builtin_amdgcn_s_sleep(1);
        if ((++sp & 255u) == 0u) { if (xb_ld(&bar[XB_TMO])) break; if (sp > XB_SPIN_CAP) { atomicAdd(&bar[XB_TMO], 1u); break; } }
    }
    nloc = mine > 0u ? mine : 1u; nx = cnt > 0u ? cnt : 1u;
}
__device__ __forceinline__ void xcd_barrier(const XcdBarrier& b) {
    asm volatile("s_waitcnt vmcnt(0)" ::: "memory");
    __syncthreads();
    if (threadIdx.x == 0) {
        unsigned* bar = b.bar;
        __builtin_amdgcn_s_waitcnt(0);
        unsigned nloc = b.st[0], nx = b.st[1];
        if (nloc == 0u) { xcd_barrier_complete(bar, b.x, nloc, nx); b.st[0] = nloc; b.st[1] = nx; }
        const unsigned old = xb_add(&bar[XB_XSUB(b.x)], 1u);
        const unsigned gen = old / nloc;
        if (old + 1u == (gen + 1u) * nloc) {
            __builtin_amdgcn_fence(__ATOMIC_RELEASE, "agent");
            asm volatile("s_waitcnt vmcnt(0)" ::: "memory");
            const unsigned og = xb_add(&bar[XB_TOP], 1u);
            const unsigned tg = og / nx;
            if (og + 1u == (tg + 1u) * nx) xb_add(&bar[XB_TOPGEN], 1u);
            else XB_SPIN(xb_ld(&bar[XB_TOPGEN]) == tg, bar);
            __builtin_amdgcn_fence(__ATOMIC_ACQUIRE, "agent");
            xb_add(&bar[XB_XGEN(b.x)], 1u);
            asm volatile("s_waitcnt vmcnt(0)" ::: "memory");
        } else {
            XB_SPIN(xb_ld(&bar[XB_XGEN(b.x)]) == gen, bar);
            __builtin_amdgcn_fence(__ATOMIC_ACQUIRE, "agent");
            asm volatile("s_waitcnt vmcnt(0)" ::: "memory");
        }
    }
    __syncthreads();
}

constexpr int LDS_BYTES = 147456;
constexpr int LDS_BAR_OFF = LDS_BYTES - 64;
constexpr int CW_BAR = 4096;

__global__ void __launch_bounds__(NTHREADS, 2) mk_fwd(Prm p_unused) {
    extern __shared__ __attribute__((aligned(16))) unsigned char lds_raw[];
    LAS unsigned char* lds = (LAS unsigned char*)lds_raw;
    const int wg = blockIdx.x, nwg = gridDim.x;
    if (threadIdx.x < 4) ((LAS unsigned*)(lds + LDS_BAR_OFF))[threadIdx.x] = 0u;
    __syncthreads();
    (void)xcd_barrier_post((unsigned*)(prm_fresh()->ws + WS_CTL) + CW_BAR, (volatile LAS unsigned*)(lds + LDS_BAR_OFF));
#define GRID_BAR() do { XcdBarrier b_; b_.bar = (unsigned*)(prm_fresh()->ws + WS_CTL) + CW_BAR; b_.x = xb_xcc_id(); b_.st = (volatile LAS unsigned*)(lds + LDS_BAR_OFF); xcd_barrier(b_); } while (0)
#ifndef REP_PHASE
#define REP_PHASE -1
#endif
#define PHASE(id, call) do { call; GRID_BAR(); if (REP_PHASE == (id)) { call; GRID_BAR(); } } while (0)
    PHASE(0, (ph_prologue(prm_fresh(), lds, wg, nwg), ph_tables(prm_fresh(), wg, nwg)));
#define MK_LAYER(l) do { \
        if ((l) == 0) PHASE(1, ph_norm1(prm_fresh(), l, wg, nwg));     \
        PHASE(2, fg_gemm_in(prm_fresh(), l, lds, wg, nwg)); \
        PHASE(3, fs_scan(prm_fresh(), l, lds, wg, nwg)); \
        fa_attn(prm_fresh(), l, lds, wg, nwg); GRID_BAR(); \
        PHASE(5, fs_fin(prm_fresh(), l, lds, wg, nwg)); \
        PHASE(6, fg_gemm_out(prm_fresh(), l, lds, wg, nwg)); \
        ph_row(prm_fresh(), l, lds, wg, nwg); GRID_BAR(); \
        PHASE(8, ph_offs(prm_fresh(), l, lds, wg, nwg)); \
        PHASE(9, fg_gemm1(prm_fresh(), l, lds, wg, nwg)); \
        PHASE(10, fg_gemm2(prm_fresh(), l, lds, wg, nwg)); \
        ph_comb(prm_fresh(), l, wg, nwg); GRID_BAR(); } while (0)
    MK_LAYER(0);
    MK_LAYER(1);
#undef MK_LAYER
}

extern "C" void kernel_launch(void* const* d_in, const int* in_sizes, int n_in, void* d_out, int out_size, void* d_ws, size_t ws_size, hipStream_t stream) {
    if (n_in != N_IN || out_size != M * D || ws_size < WS_END) { fprintf(stderr, "kernel_launch: unexpected shapes: n_in %d out %d ws %zu (need %zu)\n", n_in, out_size, ws_size, (size_t)WS_END); return; }
    Prm p{};
    for (int i = 0; i < N_IN; ++i) p.in[i] = (const float*)d_in[i];
    p.out = (float*)d_out; p.ws = (unsigned char*)d_ws;
    (void)hipMemsetAsync((char*)d_ws + WS_CTL, 0, 1 * MiB, stream);
    static int grid = 0;
    if (grid == 0) {
        int dev = 0, cus = 0, per_cu = 0;
        if (hipGetDevice(&dev) != hipSuccess || hipDeviceGetAttribute(&cus, hipDeviceAttributeMultiprocessorCount, dev) != hipSuccess) { fprintf(stderr, "kernel_launch: device query failed\n"); grid = -1; return; }
        if (hipFuncSetAttribute((const void*)mk_fwd, hipFuncAttributeMaxDynamicSharedMemorySize, LDS_BYTES) != hipSuccess) { fprintf(stderr, "kernel_launch: hipFuncSetAttribute failed\n"); grid = -1; return; }
        if (hipOccupancyMaxActiveBlocksPerMultiprocessor(&per_cu, (const void*)mk_fwd, NTHREADS, LDS_BYTES) != hipSuccess || per_cu < 1) fprintf(stderr, "kernel_launch: occupancy query reports %d\n", per_cu);
        (void)hipGetLastError();
        grid = 256;
        if (cus < 256) fprintf(stderr, "kernel_launch: %d CUs: 256 workgroups of 144 KiB LDS cannot all be resident\n", cus);
    }
    if (grid < 0) return;
    hipLaunchKernelGGL(mk_fwd, dim3(grid), dim3(NTHREADS), LDS_BYTES, stream, p);
}
```

```cpp
#include <hip/hip_runtime.h>
#include <stdint.h>
#include <stdio.h>

#define LAS __attribute__((address_space(3)))
typedef unsigned short bf16_t;
typedef short bf16x8 __attribute__((ext_vector_type(8)));
typedef float f32x4 __attribute__((ext_vector_type(4)));
typedef unsigned u32x4 __attribute__((ext_vector_type(4)));
typedef unsigned u32x2 __attribute__((ext_vector_type(2)));

constexpr int NB = 4, T = 8192, D = 1024, M = NB * T, NL = 2;
constexpr int INC = 2312, NP = 2560;
constexpr int C_LX = 0, C_LG = 256, C_S5 = 512, C_Q = 768, C_K = 1280, C_V = 1792, C_F = 2304;
constexpr int NH = 8, HD = 64, NE = 32, TOPK = 4, DFF = 1024;
constexpr int RP = M * TOPK + NE * 256;
constexpr float C2 = 0.125f * 1.4426950408889634f;
constexpr float LOG2E = 1.4426950408889634f;
constexpr float RMS_EPS = 1e-6f;
constexpr int NTHREADS = 512, NWAVES = 8;
#ifndef FAST_ATTN
#define FAST_ATTN 1
#endif
#ifndef YR_FP8
#define YR_FP8 1
#endif
#ifndef F8_ALLV
#define F8_ALLV 1
#endif
#ifndef EXPERT_FP8
#define EXPERT_FP8 1
#endif

enum { I_X = 0, I_C, I_ADAW, I_ADAB, I_PREMIXG, I_WIN, I_CONVW, I_CONVB, I_LRUWA, I_LRUBA, I_LRUWX, I_LRUBX, I_LAMBDA, I_S5ARE, I_S5AIM, I_S5BRE, I_S5BIM,
       I_S5CRE, I_S5CIM, I_S5D, I_S5LOGDT, I_GLUW, I_GLUB, I_FOXFB, I_GNLRU, I_GNS5, I_GNATT, I_WOUT, I_POSTMIXG, I_PREFFNG, I_ROUTW, I_ROUTB, I_WGU, I_BGU,
       I_WDN, I_BDN, I_POSTFFNG, N_IN };

constexpr size_t MiB = 1u << 20;
constexpr size_t WS_CTL = 0;
constexpr size_t WS_MOD = 1 * MiB;
constexpr size_t WS_MISC = 2 * MiB;
constexpr size_t WS_FC2 = 6 * MiB;
constexpr size_t WS_WIN = 8 * MiB;
constexpr size_t WS_WOUT = 18 * MiB;
constexpr size_t WS_WGU = 22 * MiB;
constexpr size_t WS_WDN = 278 * MiB;
constexpr size_t WS_HB = 406 * MiB;
constexpr size_t WS_PB = 470 * MiB;
constexpr size_t WS_YL = 630 * MiB;
constexpr size_t WS_YS0 = 662 * MiB;
constexpr size_t WS_OA = 694 * MiB;
constexpr size_t WS_AGG = WS_OA;
constexpr size_t WS_XEND = WS_OA + 2 * MiB;
constexpr size_t WS_GLUW = WS_OA + 8 * MiB;
constexpr size_t WS_X4END = WS_OA + 7 * MiB;
constexpr size_t WS_S5T = WS_OA + 10 * MiB;
constexpr size_t WS_LRUW = WS_OA + 9 * MiB;
constexpr size_t WS_YC = 758 * MiB;
constexpr size_t WS_Y = 822 * MiB;
constexpr size_t WS_XS = 950 * MiB;
constexpr size_t WS_XB = WS_XS;
constexpr size_t WS_H1 = 1222 * MiB;
constexpr size_t WS_YR = 1494 * MiB;
constexpr size_t WS_END = 1766 * MiB;
constexpr size_t MS_ROWTOK = 2560 * 1024;
constexpr size_t MS_TOPI = 0, MS_TOPG = 512 * 1024, MS_RANK = 1024 * 1024, MS_POS = 1536 * 1024, MS_HIST = 2048 * 1024, MS_TILEE = 2048 * 1024 + 64 * 1024;
constexpr int CW_NT = 8;
constexpr int CW_QN = 16384, CW_KT = 32768;
constexpr int CW_NRM = 8192;

struct Prm { const float* in[N_IN]; float* out; unsigned char* ws; };
__device__ __forceinline__ int fresh_tid() { int t = threadIdx.x; asm volatile("" : "+v"(t)); return t; }
typedef const __attribute__((address_space(4))) Prm* PrmP;
__device__ __forceinline__ PrmP prm_fresh() { PrmP q = (PrmP)__builtin_amdgcn_kernarg_segment_ptr(); asm volatile("" : "+s"(q)); return q; }

typedef float f32x2h_ __attribute__((ext_vector_type(2))); typedef __bf16 bf16x2h_ __attribute__((ext_vector_type(2)));
__device__ __forceinline__ unsigned pk2(float lo, float hi) { const f32x2h_ v = {lo, hi}; return __builtin_bit_cast(unsigned, __builtin_convertvector(v, bf16x2h_)); }
__device__ __forceinline__ unsigned f2bf(float f) { return pk2(f, 0.f) & 0xffffu; }
__device__ __forceinline__ float bf2f(unsigned v) { return __builtin_bit_cast(float, v << 16); }
__device__ __forceinline__ float bflo(unsigned w) { return __builtin_bit_cast(float, w << 16); }
__device__ __forceinline__ float bfhi(unsigned w) { return __builtin_bit_cast(float, w & 0xffff0000u); }
template <int CTRL> __device__ __forceinline__ float dppf(float x) { return __builtin_bit_cast(float, __builtin_amdgcn_update_dpp(0, __builtin_bit_cast(int, x), CTRL, 0xf, 0xf, true)); }
constexpr int DPP_XOR1 = 0xB1, DPP_XOR2 = 0x4E, DPP_REV4 = 0x1B, DPP_HMIRROR = 0x141, DPP_MIRROR = 0x140, DPP_ROR8 = 0x128;
__device__ __forceinline__ float wave_sum(float v) {
    v += dppf<DPP_XOR1>(v); v += dppf<DPP_XOR2>(v); v += dppf<DPP_HMIRROR>(v); v += dppf<DPP_MIRROR>(v);
    const auto s = __builtin_amdgcn_permlane16_swap(__float_as_uint(v), __float_as_uint(v), false, false); v = __uint_as_float(s[0]) + __uint_as_float(s[1]);
    const auto t = __builtin_amdgcn_permlane32_swap(__float_as_uint(v), __float_as_uint(v), false, false); return __uint_as_float(t[0]) + __uint_as_float(t[1]);
}
__device__ __forceinline__ float wave_max(float v) {
    v = fmaxf(v, dppf<DPP_XOR1>(v)); v = fmaxf(v, dppf<DPP_XOR2>(v)); v = fmaxf(v, dppf<DPP_HMIRROR>(v)); v = fmaxf(v, dppf<DPP_MIRROR>(v));
    const auto s = __builtin_amdgcn_permlane16_swap(__float_as_uint(v), __float_as_uint(v), false, false); v = fmaxf(__uint_as_float(s[0]), __uint_as_float(s[1]));
    const auto t = __builtin_amdgcn_permlane32_swap(__float_as_uint(v), __float_as_uint(v), false, false); return fmaxf(__uint_as_float(t[0]), __uint_as_float(t[1]));
}
__device__ __forceinline__ float sigmoidf_(float x) { return __builtin_amdgcn_rcpf(1.f + __expf(-x)); }
__device__ __forceinline__ float gelu_tanh(float x) { const float u = 0.7978845608028654f * (x + 0.044715f * x * x * x); return x * sigmoidf_(2.f * u); }

__device__ __forceinline__ void tr_item(const float* W, int ldw, int nvalid, int k0, int n0, bf16_t* dst, float scale, LAS float* scr, int lane, int ldd = 1024) {
    const int nn = n0 + (lane & 31); const bool ok = nn < nvalid;
#pragma unroll 8
    for (int i = 0; i < 32; ++i) { const int kk = 2 * i + (lane >> 5); scr[kk * 33 + (lane & 31)] = ok ? W[(size_t)(k0 + kk) * ldw + nn] * scale : 0.f; }
    asm volatile("s_waitcnt lgkmcnt(0)" ::: "memory");
    const int c = lane & 7;
#pragma unroll
    for (int j = 0; j < 4; ++j) { const int n = (lane >> 3) + 8 * j; const LAS float* s = scr + (8 * c) * 33 + n;
        u32x4 o; o.x = pk2(s[0 * 33], s[1 * 33]); o.y = pk2(s[2 * 33], s[3 * 33]); o.z = pk2(s[4 * 33], s[5 * 33]); o.w = pk2(s[6 * 33], s[7 * 33]);
        *(u32x4*)(dst + (size_t)n * ldd + k0 + 8 * c) = o; }
    asm volatile("s_waitcnt lgkmcnt(0)" ::: "memory");
}

__device__ __forceinline__ unsigned pk4_fp8(float a, float b, float c, float d) { int w = __builtin_amdgcn_cvt_pk_fp8_f32(a, b, 0, false); w = __builtin_amdgcn_cvt_pk_fp8_f32(c, d, w, true); return (unsigned)w; }
__device__ __forceinline__ void tr_item8w(const float* W, int ldw, int k0, int n0, unsigned char* dst, float scale, LAS float* scr, int lane) {
#pragma unroll 1
    for (int hh = 0; hh < 2; ++hh) { f32x4 v[8];
#pragma unroll
      for (int i = 0; i < 8; ++i) v[i] = *(const f32x4*)(W + (size_t)(k0 + hh * 32 + (lane >> 4) + 4 * i) * ldw + n0 + 4 * (lane & 15));
#pragma unroll
      for (int i = 0; i < 8; ++i) { LAS float* d = scr + (hh * 32 + (lane >> 4) + 4 * i) * 65 + 4 * (lane & 15); d[0] = v[i].x * scale; d[1] = v[i].y * scale; d[2] = v[i].z * scale; d[3] = v[i].w * scale; } }
    asm volatile("s_waitcnt lgkmcnt(0)" ::: "memory");
    const int kq = lane & 3;
#pragma unroll
    for (int j = 0; j < 4; ++j) { const int n = (lane >> 2) + 16 * j; const LAS float* s = scr + (16 * kq) * 65 + n;
        u32x4 o; o.x = pk4_fp8(s[0 * 65], s[1 * 65], s[2 * 65], s[3 * 65]); o.y = pk4_fp8(s[4 * 65], s[5 * 65], s[6 * 65], s[7 * 65]);
        o.z = pk4_fp8(s[8 * 65], s[9 * 65], s[10 * 65], s[11 * 65]); o.w = pk4_fp8(s[12 * 65], s[13 * 65], s[14 * 65], s[15 * 65]);
        *(u32x4*)(dst + (size_t)n * 1024 + k0 + 16 * kq) = o; }
    asm volatile("s_waitcnt lgkmcnt(0)" ::: "memory");
}
#ifndef PRO_PROBE
#define PRO_PROBE 0
#endif
template <int MODE> __device__ __forceinline__ void ex_convert(PrmP p, LAS float* scr, int gw, int NGW, int lane) {
    constexpr int I_GU = 16 * 32, I_DN = 16 * 16, NEX = 64 * I_GU + 64 * I_DN;
#define EX_ITEM(r_, src_, dst_, ldw_) do { int r2_ = (r_); if (r2_ < 64 * I_GU) { const int le = r2_ >> 9, q = r2_ & 511, kb = q >> 5, n0 = (q & 31) * 64; \
        const int sx = n0 >> 10, rr = n0 & 1023, j = rr >> 7, cc = rr & 127, drow = 256 * j + 128 * sx + cc; \
        ldw_ = 2048; src_ = p->in[I_WGU] + (size_t)le * 1024 * 2048 + (size_t)(kb * 64) * 2048 + n0; dst_ = p->ws + (MODE == 2 ? WS_YR : WS_WGU) + ((size_t)le * 2048 + drow) * 1024 + kb * 64; } \
      else { r2_ -= 64 * I_GU; const int le = r2_ >> 8, q = r2_ & 255, kb = q >> 4, n0 = (q & 15) * 64; \
        ldw_ = 1024; src_ = p->in[I_WDN] + (size_t)le * 1024 * 1024 + (size_t)(kb * 64) * 1024 + n0; dst_ = p->ws + (MODE == 2 ? WS_YR + 128 * MiB : WS_WDN) + ((size_t)le * 1024 + n0) * 1024 + kb * 64; } } while (0)
#define EX_LOAD(src_, ldw_) do { _Pragma("unroll") for (int i = 0; i < 16; ++i) { if (MODE == 2) v[i] = (f32x4){(float)i, (float)lane, 1.f, 2.f}; else v[i] = *(const f32x4*)((src_) + (size_t)((lane >> 4) + 4 * i) * (ldw_) + 4 * (lane & 15)); } } while (0)
    int r = gw;
    if (r < NEX) {
        const float* src; unsigned char* dst; int ldw; f32x4 v[16];
        EX_ITEM(r, src, dst, ldw); EX_LOAD(src, ldw);
#pragma unroll 1
        for (;;) {
#pragma unroll
            for (int i = 0; i < 16; ++i) { LAS float* d = scr + ((lane >> 4) + 4 * i) * 65 + 4 * (lane & 15); d[0] = v[i].x * 64.f; d[1] = v[i].y * 64.f; d[2] = v[i].z * 64.f; d[3] = v[i].w * 64.f; }
            const int rn = r + NGW; const bool more = rn < NEX; unsigned char* dcur = dst;
            if (more) { EX_ITEM(rn, src, dst, ldw); EX_LOAD(src, ldw); }
            asm volatile("s_waitcnt lgkmcnt(0)" ::: "memory");
            const int kq = lane & 3;
#pragma unroll
            for (int j = 0; j < 4; ++j) { const int n = (lane >> 2) + 16 * j; const LAS float* sp = scr + (16 * kq) * 65 + n;
                u32x4 o; o.x = pk4_fp8(sp[0 * 65], sp[1 * 65], sp[2 * 65], sp[3 * 65]); o.y = pk4_fp8(sp[4 * 65], sp[5 * 65], sp[6 * 65], sp[7 * 65]);
                o.z = pk4_fp8(sp[8 * 65], sp[9 * 65], sp[10 * 65], sp[11 * 65]); o.w = pk4_fp8(sp[12 * 65], sp[13 * 65], sp[14 * 65], sp[15 * 65]);
                if (MODE != 1 || (o.x == 0x12345678u && o.y == 0x9abcdef0u && o.z == 0x0fedcba9u)) *(u32x4*)(dcur + (size_t)n * 1024 + 16 * kq) = o; }
            asm volatile("s_waitcnt lgkmcnt(0)" ::: "memory");
            if (!more) break;
            r = rn;
        }
    }
#undef EX_ITEM
#undef EX_LOAD
}
__device__ __forceinline__ void ph_prologue(PrmP p, LAS unsigned char* lds, int wg, int nwg) {
    const int tid = fresh_tid(), lane = tid & 63, wave = tid >> 6;
    {
        LAS float* sc = (LAS float*)lds; LAS float* red = sc + 4096;
        const float* c = p->in[I_C];
        for (int i = tid; i < 4096; i += NTHREADS) { const float v = c[i]; sc[i] = v / (1.f + __expf(-v)); }
        __syncthreads();
        float* MOD = (float*)(p->ws + WS_MOD);
        for (int it = wg; it < 2 * 96; it += nwg) {
            const int l = it / 96, n0 = (it % 96) * 64, kg = tid >> 6, nl = tid & 63;
            const float* W = p->in[I_ADAW] + (size_t)l * 1024 * 6144 + n0 + nl;
            float a0 = 0.f, a1 = 0.f, a2 = 0.f, a3 = 0.f;
            for (int k0 = kg; k0 < 1024; k0 += 8 * 16) { float w[16];
#pragma unroll
                for (int q = 0; q < 16; ++q) w[q] = W[(size_t)(k0 + 8 * q) * 6144];
#pragma unroll
                for (int q = 0; q < 16; ++q) { const int k = k0 + 8 * q; a0 += sc[k] * w[q]; a1 += sc[1024 + k] * w[q]; a2 += sc[2048 + k] * w[q]; a3 += sc[3072 + k] * w[q]; } }
            red[(kg * 4 + 0) * 64 + nl] = a0; red[(kg * 4 + 1) * 64 + nl] = a1; red[(kg * 4 + 2) * 64 + nl] = a2; red[(kg * 4 + 3) * 64 + nl] = a3;
            __syncthreads();
            if (tid < 256) { const int b = tid >> 6; float s = 0.f;
#pragma unroll
                for (int g = 0; g < 8; ++g) s += red[(g * 4 + b) * 64 + nl];
                MOD[(size_t)(l * 4 + b) * 6144 + n0 + nl] = s + p->in[I_ADAB][l * 6144 + n0 + nl]; }
            __syncthreads();
        }
    }
    {
        LAS float* scr = (LAS float*)lds + wave * (64 * 65);
        const int gw = wave * nwg + wg, NGW = nwg * NWAVES;
        constexpr int I_IN = 16 * 80, I_OUT = 16 * 32, I_GU = EXPERT_FP8 ? 16 * 32 : 16 * 64, I_DN = EXPERT_FP8 ? 16 * 16 : 16 * 32;
        constexpr int I_GLU = 4 * 8;
        constexpr int I_LRU = 4 * 2 * 2;
        constexpr int NGU = EXPERT_FP8 ? 0 : 64 * I_GU, NDN = EXPERT_FP8 ? 0 : 64 * I_DN;
        constexpr int TOT = 2 * I_IN + 2 * I_OUT + NGU + NDN + 2 * I_GLU + 2 * I_LRU;
        for (int it = gw; it < TOT; it += NGW) {
            int r = it;
            if (r < 2 * I_IN) { const int l = r / I_IN, q = r % I_IN, kb = q / 80, nb = q % 80, n0 = nb * 32;
                const float sc = (n0 >= C_Q && n0 < C_K) ? C2 : 1.f;
                tr_item(p->in[I_WIN] + (size_t)l * 1024 * INC, INC, INC, kb * 64, n0, (bf16_t*)(p->ws + WS_WIN) + ((size_t)l * NP + n0) * 1024, sc, scr, lane); continue; }
            r -= 2 * I_IN;
            if (r < 2 * I_OUT) { const int l = r / I_OUT, q = r % I_OUT, kb = q / 32, nb = q % 32, n0 = nb * 32;
                tr_item(p->in[I_WOUT] + (size_t)l * 1024 * 1024, 1024, 1024, kb * 64, n0, (bf16_t*)(p->ws + WS_WOUT) + ((size_t)l * 1024 + n0) * 1024, 1.f, scr, lane); continue; }
            r -= 2 * I_OUT;
            if (r < NGU) { const int le = r / I_GU, q = r % I_GU, NBK = EXPERT_FP8 ? 32 : 64, kb = q / NBK, nb = q % NBK, n0 = nb * (2048 / NBK);
                const int s = n0 / 1024, rr = n0 % 1024, j = rr / 128, cc = rr % 128, drow = 256 * j + 128 * s + cc;
                if (EXPERT_FP8) tr_item8w(p->in[I_WGU] + (size_t)le * 1024 * 2048, 2048, kb * 64, n0, p->ws + WS_WGU + ((size_t)le * 2048 + drow) * 1024, 64.f, scr, lane);
                else tr_item(p->in[I_WGU] + (size_t)le * 1024 * 2048, 2048, 2048, kb * 64, n0, (bf16_t*)(p->ws + WS_WGU) + ((size_t)le * 2048 + drow) * 1024, 1.f, scr, lane); continue; }
            r -= NGU;
            if (r < NDN) { const int le = r / I_DN, q = r % I_DN, NBK = EXPERT_FP8 ? 16 : 32, kb = q / NBK, nb = q % NBK, n0 = nb * (1024 / NBK);
                if (EXPERT_FP8) tr_item8w(p->in[I_WDN] + (size_t)le * 1024 * 1024, 1024, kb * 64, n0, p->ws + WS_WDN + ((size_t)le * 1024 + n0) * 1024, 64.f, scr, lane);
                else tr_item(p->in[I_WDN] + (size_t)le * 1024 * 1024, 1024, 1024, kb * 64, n0, (bf16_t*)(p->ws + WS_WDN) + ((size_t)le * 1024 + n0) * 1024, 1.f, scr, lane); continue; }
            r -= NDN;
            if (r < 2 * I_GLU) { const int l = r / I_GLU, q = r % I_GLU, kb = q / 8, nb = q % 8, n0 = nb * 32;
                tr_item(p->in[I_GLUW] + (size_t)l * 256 * 256, 256, 256, kb * 64, n0, (bf16_t*)(p->ws + WS_GLUW) + ((size_t)l * 256 + n0) * 256, 1.f, scr, lane, 256); continue; }
            r -= 2 * I_GLU;
            { const int l = r / I_LRU, q = r % I_LRU, blk = q >> 2, gate = (q >> 1) & 1, n0 = (q & 1) * 32;
                tr_item(p->in[gate ? I_LRUWX : I_LRUWA] + (size_t)(l * 4 + blk) * 4096, 64, 64, 0, n0, (bf16_t*)(p->ws + WS_LRUW) + ((size_t)((l * 4 + blk) * 2 + gate) * 64 + n0) * 64, 1.f, scr, lane, 64); }
        }
#if EXPERT_FP8
        ex_convert<0>(p, scr, gw, NGW, lane);
        if (PRO_PROBE == 1) ex_convert<1>(p, scr, gw, NGW, lane);
        if (PRO_PROBE == 2) ex_convert<2>(p, scr, gw, NGW, lane);
#endif
    }
}

__device__ __forceinline__ void ph_norm1(PrmP p, int l, int wg, int nwg) {
    const int tid = fresh_tid(), lane = tid & 63, wave = tid >> 6;
    const float* X = (l == 0) ? p->in[I_X] : p->out;
    const float* MOD = (const float*)(p->ws + WS_MOD);
    bf16_t* HB = (bf16_t*)(p->ws + WS_HB);
    const float* g = p->in[I_PREMIXG] + l * 1024;
    for (int m = wg * NWAVES + wave; m < M; m += nwg * NWAVES) {
        const int b = m / T;
        const float* shift = MOD + (size_t)(l * 4 + b) * 6144 + 0 * 1024; const float* scale = shift + 1024;
        f32x4 v[4]; float ss = 0.f;
#pragma unroll
        for (int j = 0; j < 4; ++j) { v[j] = *(const f32x4*)(X + (size_t)m * 1024 + 4 * lane + 256 * j); ss += (v[j].x * v[j].x + v[j].y * v[j].y) + (v[j].z * v[j].z + v[j].w * v[j].w); }
        const float rstd = __builtin_amdgcn_rsqf(wave_sum(ss) * (1.f / 1024.f) + RMS_EPS);
#pragma unroll
        for (int j = 0; j < 4; ++j) { const int c = 4 * lane + 256 * j; const f32x4 gg = *(const f32x4*)(g + c), sc = *(const f32x4*)(scale + c), sh = *(const f32x4*)(shift + c);
            const f32x4 h = v[j] * rstd * gg * (sc + 1.f) + sh;
            u32x2 o; o.x = pk2(h.x, h.y); o.y = pk2(h.z, h.w); *(u32x2*)(HB + (size_t)m * 1024 + c) = o; }
    }
}

namespace pg8 {
#define PG8_LAS __attribute__((address_space(3)))
typedef unsigned short bf16_t;
typedef short bf16x8 __attribute__((ext_vector_type(8)));
typedef float f32x4 __attribute__((ext_vector_type(4)));
typedef unsigned u32x4 __attribute__((ext_vector_type(4)));
constexpr int BM = 256, BK = 64, HALF = 128, HTB = HALF * BK * 2  , STAGE_BYTES = 8 * HTB, NXCD = 8, WGM = 8;

__host__ __device__ __forceinline__ int lds_byte(int r, int c) { const int st = (r >> 4) * 2 + (c >> 5), rr = r & 15, cc = c & 31, ob = rr * 64 + cc * 2; return st * 1024 + (ob ^ (((ob >> 9) & 1) << 5)); }
__host__ __device__ __forceinline__ void stage_rc(int b, int& R, int& C) { const int st = b / 1024, sb = b % 1024, swz = sb ^ (((sb >> 9) & 1) << 5); R = (st >> 1) * 16 + swz / 64; C = (st & 1) * 32 + (swz % 64) / 2; }
__host__ __device__ __forceinline__ int perm32(int rho) { const int n = rho >> 4, i = rho & 15; return 8 * (i >> 2) + 4 * n + (i & 3); }

struct Unit { int pm, pn; };
struct Gemm { const bf16_t* A; const bf16_t* Bt; int M, N, K; const PG8_LAS unsigned short* rowtok = nullptr; };

struct StaticOrder {
    int nM, nN, nwg, G, c;
    __host__ __device__ void init(int M, int N, int G_, int c_) { nM = M / BM; nN = N / BM; nwg = nM * nN; G = G_; c = c_; }
    __host__ __device__ bool next(int i, Unit& u) const {
        const long L = (long)i * G + c; if (L >= nwg) return false;
        int wgid = (int)L; { const int q = nwg / NXCD, r = nwg % NXCD, xcd = wgid % NXCD, off = wgid / NXCD; wgid = (xcd < r ? xcd * (q + 1) : r * (q + 1) + (xcd - r) * q) + off; }
        const int nig = WGM * nN, gid = wgid / nig, fm = gid * WGM, gsz = (nM - fm) < WGM ? (nM - fm) : WGM;
        u.pm = fm + ((wgid % nig) % gsz); u.pn = (wgid % nig) / gsz; return true;
    }
    __device__ __forceinline__ void a_ready(const Unit&) const {}
    __device__ __forceinline__ void done(const Unit&) const {}
};


__device__ __forceinline__ unsigned cvt_pk_bf16(float lo, float hi) { unsigned r; asm volatile("v_cvt_pk_bf16_f32 %0, %1, %2" : "=v"(r) : "v"(lo), "v"(hi)); return r; }
struct EpiBf16Plain {
    static constexpr bool PERM = true, AFTER_DRAIN = false;
    bf16_t* O; int ldc;
    __device__ __forceinline__ void operator()(const f32x4 (&acc)[2][2][4][2], const Unit& u, int wr, int wc, int fr, int fq) const {
        const int row0 = u.pm * BM + wr * 64 + fr, col0 = u.pn * BM + wc * 32 + 8 * fq;
#pragma unroll
        for (int ai = 0; ai < 2; ++ai)
#pragma unroll
            for (int m = 0; m < 4; ++m) { bf16_t* rowp = O + (size_t)(row0 + ai * HALF + m * 16) * ldc + col0;
#pragma unroll
                for (int bj = 0; bj < 2; ++bj) { const f32x4 v0 = acc[ai][bj][m][0], v1 = acc[ai][bj][m][1];
                    u32x4 w; w.x = cvt_pk_bf16(v0[0], v0[1]); w.y = cvt_pk_bf16(v0[2], v0[3]); w.z = cvt_pk_bf16(v1[0], v1[1]); w.w = cvt_pk_bf16(v1[2], v1[3]);
                    *(u32x4*)(rowp + bj * HALF) = w; } }
    }
};
struct EpiSwiglu {
    static constexpr bool PERM = true, AFTER_DRAIN = false;
    bf16_t* H1; const float* bgu;
    __device__ __forceinline__ void operator()(const f32x4 (&acc)[2][2][4][2], const Unit& u, int wr, int wc, int fr, int fq) const {
        const int e = u.pn >> 3, j = u.pn & 7, row0 = u.pm * BM + wr * 64 + fr, lc0 = wc * 32 + 8 * fq;
        const float* bb = bgu + (size_t)e * 2048 + j * 128 + lc0;
        const f32x4 bg0 = *(const f32x4*)(bb), bg1 = *(const f32x4*)(bb + 4), bu0 = *(const f32x4*)(bb + 1024), bu1 = *(const f32x4*)(bb + 1028);
#pragma unroll
        for (int ai = 0; ai < 2; ++ai)
#pragma unroll
            for (int m = 0; m < 4; ++m) { float o[8];
#pragma unroll
                for (int n = 0; n < 2; ++n) { const f32x4 g4 = acc[ai][0][m][n] + (n ? bg1 : bg0), u4 = acc[ai][1][m][n] + (n ? bu1 : bu0);
#pragma unroll
                    for (int q = 0; q < 4; ++q) { const float g = fminf(g4[q], 7.f), up = fminf(fmaxf(u4[q], -7.f), 7.f);
                        o[4 * n + q] = (up + 1.f) * g * __builtin_amdgcn_rcpf(1.f + __builtin_amdgcn_exp2f(-1.702f * 1.4426950408889634f * g)); } }
                u32x4 w; w.x = cvt_pk_bf16(o[0], o[1]); w.y = cvt_pk_bf16(o[2], o[3]); w.z = cvt_pk_bf16(o[4], o[5]); w.w = cvt_pk_bf16(o[6], o[7]);
                *(u32x4*)(H1 + (size_t)(row0 + ai * HALF + m * 16) * 1024 + j * 128 + lc0) = w; }
    }
};
__device__ __forceinline__ unsigned pk4_fp8(float a, float b, float c, float d) { int w = __builtin_amdgcn_cvt_pk_fp8_f32(a, b, 0, false); w = __builtin_amdgcn_cvt_pk_fp8_f32(c, d, w, true); return (unsigned)w; }
struct EpiSwiglu8 {
    static constexpr bool PERM = true, AFTER_DRAIN = false;
    unsigned char* H1; const float* bgu;
    __device__ __forceinline__ void operator()(const f32x4 (&acc)[2][2][4][2], const Unit& u, int wr, int wc, int fr, int fq) const {
        const int e = u.pn >> 3, j = u.pn & 7, row0 = u.pm * BM + wr * 64 + fr, lc0 = wc * 32 + 8 * fq;
        const float* bb = bgu + (size_t)e * 2048 + j * 128 + lc0;
        const f32x4 bg0 = *(const f32x4*)(bb), bg1 = *(const f32x4*)(bb + 4), bu0 = *(const f32x4*)(bb + 1024), bu1 = *(const f32x4*)(bb + 1028);
#pragma unroll
        for (int ai = 0; ai < 2; ++ai)
#pragma unroll
            for (int m = 0; m < 4; ++m) { float o[8];
#pragma unroll
                for (int n = 0; n < 2; ++n) { const f32x4 g4 = acc[ai][0][m][n] + (n ? bg1 : bg0), u4 = acc[ai][1][m][n] + (n ? bu1 : bu0);
#pragma unroll
                    for (int q = 0; q < 4; ++q) { const float g = fminf(g4[q], 7.f), up = fminf(fmaxf(u4[q], -7.f), 7.f);
                        o[4 * n + q] = 2.f * (up + 1.f) * g * __builtin_amdgcn_rcpf(1.f + __builtin_amdgcn_exp2f(-1.702f * 1.4426950408889634f * g)); } }
                typedef unsigned u32x2_ __attribute__((ext_vector_type(2))); u32x2_ w; w.x = pk4_fp8(o[0], o[1], o[2], o[3]); w.y = pk4_fp8(o[4], o[5], o[6], o[7]);
                *(u32x2_*)(H1 + (size_t)(row0 + ai * HALF + m * 16) * 1024 + j * 128 + lc0) = w; }
    }
};
struct EpiDown {
    static constexpr bool PERM = true, AFTER_DRAIN = false;
    bf16_t* YR; const float* bdn;
    __device__ __forceinline__ void operator()(const f32x4 (&acc)[2][2][4][2], const Unit& u, int wr, int wc, int fr, int fq) const {
        const int e = u.pn >> 2, jn = u.pn & 3, row0 = u.pm * BM + wr * 64 + fr, col0 = jn * BM + wc * 32 + 8 * fq;
        f32x4 bv[2][2];
#pragma unroll
        for (int bj = 0; bj < 2; ++bj)
#pragma unroll
            for (int n = 0; n < 2; ++n) bv[bj][n] = *(const f32x4*)(bdn + (size_t)e * 1024 + col0 + bj * HALF + 4 * n);
#pragma unroll
        for (int ai = 0; ai < 2; ++ai)
#pragma unroll
            for (int m = 0; m < 4; ++m) { bf16_t* rowp = YR + (size_t)(row0 + ai * HALF + m * 16) * 1024 + col0;
#pragma unroll
                for (int bj = 0; bj < 2; ++bj) { const f32x4 v0 = acc[ai][bj][m][0] + bv[bj][0], v1 = acc[ai][bj][m][1] + bv[bj][1];
                    u32x4 w; w.x = cvt_pk_bf16(v0[0], v0[1]); w.y = cvt_pk_bf16(v0[2], v0[3]); w.z = cvt_pk_bf16(v1[0], v1[1]); w.w = cvt_pk_bf16(v1[2], v1[3]);
                    *(u32x4*)(rowp + bj * HALF) = w; } }
    }
};
struct EpiDown8 {
    static constexpr bool PERM = true, AFTER_DRAIN = false;
    unsigned char* YR; const float* bdn;
    __device__ __forceinline__ void operator()(const f32x4 (&acc)[2][2][4][2], const Unit& u, int wr, int wc, int fr, int fq) const {
        const int e = u.pn >> 2, jn = u.pn & 3, row0 = u.pm * BM + wr * 64 + fr, col0 = jn * BM + wc * 32 + 8 * fq;
        f32x4 bv[2][2];
#pragma unroll
        for (int bj = 0; bj < 2; ++bj)
#pragma unroll
            for (int n = 0; n < 2; ++n) bv[bj][n] = *(const f32x4*)(bdn + (size_t)e * 1024 + col0 + bj * HALF + 4 * n);
#pragma unroll
        for (int ai = 0; ai < 2; ++ai)
#pragma unroll
            for (int m = 0; m < 4; ++m) { unsigned char* rowp = YR + (size_t)(row0 + ai * HALF + m * 16) * 1024 + col0;
#pragma unroll
                for (int bj = 0; bj < 2; ++bj) { const f32x4 v0 = (acc[ai][bj][m][0] + bv[bj][0]) * 16.f, v1 = (acc[ai][bj][m][1] + bv[bj][1]) * 16.f;
                    typedef unsigned u32x2_ __attribute__((ext_vector_type(2))); u32x2_ w; w.x = pk4_fp8(v0[0], v0[1], v0[2], v0[3]); w.y = pk4_fp8(v1[0], v1[1], v1[2], v1[3]);
                    *(u32x2_*)(rowp + bj * HALF) = w; } }
    }
};
struct GroupOrder {
    int nt, nct, G, c; const PG8_LAS int* tile_e;
    __device__ __forceinline__ bool peek_pm(int i, int& rt) const { const int x = c & 7, j = c >> 3, rpg = 32 / nct, gi = i * 8 + x; rt = gi * rpg + j / nct; return G == 256 && rt < nt; }
    __device__ __forceinline__ bool next(int i, Unit& u) const {
        const int x = c & 7, j = c >> 3, rpg = 32 / nct, gi = i * 8 + x, rt = gi * rpg + j / nct, ct = j % nct;
        if (G != 256 || rt >= nt) return false;
        u.pm = rt; u.pn = tile_e[rt] * nct + ct; return true; }
    __device__ __forceinline__ void a_ready(const Unit&) const {}
    __device__ __forceinline__ void done(const Unit&) const {}
};

typedef int i32x8 __attribute__((ext_vector_type(8))); typedef int i32x4 __attribute__((ext_vector_type(4)));
__device__ __forceinline__ i32x8 cat8(bf16x8 lo, bf16x8 hi) { const i32x4 a = __builtin_bit_cast(i32x4, lo), b = __builtin_bit_cast(i32x4, hi); return __builtin_shufflevector(a, b, 0, 1, 2, 3, 4, 5, 6, 7); }
template <class Epi, class Sched, bool ALIGN_EPI = false, bool SP2 = false, int F8SCALE = 0, bool GATHER = false>
__device__ __forceinline__ void gemm_phase(PG8_LAS unsigned char* lds, const Gemm g, const Sched& S, const Epi& E) {
    const int tid = fresh_tid(), wid = __builtin_amdgcn_readfirstlane(tid >> 6), lane = tid & 63, wr = wid >> 2, wc = wid & 3, fr = lane & 15, fq = lane >> 4;
    const int K = g.K, nt = K / BK;
    unsigned voffA[2], voffB[2];
#pragma unroll
    for (int i = 0; i < 2; ++i) { int R, C; stage_rc(tid * 16 + i * 8192, R, C); const int Rb = Epi::PERM ? ((R & ~31) + perm32(R & 31)) : R;
        voffA[i] = GATHER ? (unsigned)((R << 16) | (C * 2)) : (unsigned)(R * K + C) * 2u; voffB[i] = (unsigned)(Rb * K + C) * 2u; }
    static_assert(!GATHER || SP2, "the gathered form is written for the SP2 loop");
    unsigned gA[2][2] = {{0u, 0u}, {0u, 0u}}, gN[2][2] = {{0u, 0u}, {0u, 0u}};
#define PG8_GLOOK(dst, unit) do { _Pragma("unroll") for (int h_ = 0; h_ < 2; ++h_) _Pragma("unroll") for (int i_ = 0; i_ < 2; ++i_) \
        dst[h_][i_] = (unsigned)g.rowtok[(unit) * BM + h_ * HALF + (int)(voffA[i_] >> 16)]; } while (0)
#define PG8_GOFF(dst, src) do { _Pragma("unroll") for (int h_ = 0; h_ < 2; ++h_) _Pragma("unroll") for (int i_ = 0; i_ < 2; ++i_) dst[h_][i_] = src[h_][i_] * (unsigned)(K * 2) + (voffA[i_] & 0xffffu); } while (0)
#define PG8_STAGE_A(bufoff, gbase, half, OFFS) do { if constexpr (GATHER) { _Pragma("unroll") for (int _i = 0; _i < 2; ++_i) \
        __builtin_amdgcn_global_load_lds((const unsigned*)((const char*)(gbase) + OFFS[half][_i]), (PG8_LAS unsigned*)(lds + (bufoff) + ldsw + _i * 8192), 16, 0, 0); } \
        else { PG8_STAGE(bufoff, (gbase) + (half) * hstep, voffA); } } while (0)
    const size_t kstep = (size_t)(BK * 2);
    const size_t hstep = (size_t)HALF * K * 2;
    const size_t tstep = 2 * hstep;
    const unsigned ldsw = (unsigned)wid * 1024u;
    const int aoff = lds_byte(wr * 64 + fr, fq * 8), boff = lds_byte(wc * 32 + fr, fq * 8);
#define PG8_SA(b, h) (((b) * 2 + (h)) * HTB)
#define PG8_SB(b, h) ((4 + (b) * 2 + (h)) * HTB)
#define PG8_STAGE(bufoff, gbase, voff) do { _Pragma("unroll") for (int _i = 0; _i < 2; ++_i) \
        __builtin_amdgcn_global_load_lds((const unsigned*)((const char*)(gbase) + (voff)[_i]), (PG8_LAS unsigned*)(lds + (bufoff) + ldsw + _i * 8192), 16, 0, 0); } while (0)
#define PG8_LDA(dst, b, h) do { _Pragma("unroll") for (int m = 0; m < 4; ++m) { const bf16x8 l0_ = *(const PG8_LAS bf16x8*)(lds + PG8_SA(b, h) + aoff + m * 2048), l1_ = *(const PG8_LAS bf16x8*)(lds + PG8_SA(b, h) + aoff + m * 2048 + 1024); \
        if constexpr (F8SCALE != 0) dst##8[m] = cat8(l0_, l1_); else { dst[m][0] = l0_; dst[m][1] = l1_; } } } while (0)
#define PG8_LDB(dst, b, h) do { _Pragma("unroll") for (int n = 0; n < 2; ++n) { const bf16x8 l0_ = *(const PG8_LAS bf16x8*)(lds + PG8_SB(b, h) + boff + n * 2048), l1_ = *(const PG8_LAS bf16x8*)(lds + PG8_SB(b, h) + boff + n * 2048 + 1024); \
        if constexpr (F8SCALE != 0) dst##8[n] = cat8(l0_, l1_); else { dst[n][0] = l0_; dst[n][1] = l1_; } } } while (0)
#define PG8_MMA(ai, bj, At, Bt) do { __builtin_amdgcn_s_setprio(1); _Pragma("unroll") for (int m = 0; m < 4; ++m) _Pragma("unroll") for (int n = 0; n < 2; ++n) { \
        if constexpr (F8SCALE != 0) { if (F8_ALLV || ((ai) == 1 && (bj) == 1)) asm volatile("v_mfma_scale_f32_16x16x128_f8f6f4 %0, %1, %2, %0, %3, %4 op_sel_hi:[0,0,0]" : "+v"(acc[ai][bj][m][n]) : "v"(Bt##8[n]), "v"(At##8[m]), "v"(f8sa), "v"(f8sb)); \
            else asm volatile("v_mfma_scale_f32_16x16x128_f8f6f4 %0, %1, %2, %0, %3, %4 op_sel_hi:[0,0,0]" : "+a"(acc[ai][bj][m][n]) : "v"(Bt##8[n]), "v"(At##8[m]), "v"(f8sa), "v"(f8sb)); } \
        else { _Pragma("unroll") for (int k = 0; k < 2; ++k) acc[ai][bj][m][n] = __builtin_amdgcn_mfma_f32_16x16x32_bf16(Bt[n][k], At[m][k], acc[ai][bj][m][n], 0, 0, 0); } } __builtin_amdgcn_s_setprio(0); } while (0)
#define PG8_WAIT_V(n) asm volatile("s_waitcnt vmcnt(" #n ")" ::: "memory")
#define PG8_WAIT_L(n) asm volatile("s_waitcnt lgkmcnt(" #n ")" ::: "memory")
#define PG8_BAR __builtin_amdgcn_s_barrier()
#define PG8_SCHED __builtin_amdgcn_sched_barrier(0)
    Unit cur, nxt; int ui = 0;
    if (!S.next(0, cur)) return;
    f32x4 acc[2][2][4][2];
#pragma unroll
    for (int a = 0; a < 2; ++a)
#pragma unroll
        for (int b = 0; b < 2; ++b)
#pragma unroll
            for (int m = 0; m < 4; ++m)
#pragma unroll
                for (int n = 0; n < 2; ++n) acc[a][b][m][n] = (f32x4){0.f, 0.f, 0.f, 0.f};
    bf16x8 At[4][2], B0[2][2], B1[2][2]; i32x8 At8[4], B08[2], B18[2];
    const int f8sa = F8SCALE * 0x01010101, f8sb = 0x7f7f7f7f;
    const char* cA = GATHER ? (const char*)g.A : (const char*)g.A + (size_t)cur.pm * tstep; const char* cB = (const char*)g.Bt + (size_t)cur.pn * tstep;
    if constexpr (GATHER) { PG8_GLOOK(gN, 0); PG8_GOFF(gA, gN); }
    S.a_ready(cur);
    if constexpr (SP2) {
        PG8_STAGE(PG8_SB(0, 0), cB, voffB); PG8_STAGE(PG8_SB(0, 1), cB + hstep, voffB); PG8_STAGE_A(PG8_SA(0, 0), cA, 0, gA); PG8_STAGE_A(PG8_SA(0, 1), cA, 1, gA);
        if (wr == 1) PG8_BAR;
        PG8_WAIT_V(2); PG8_BAR;
        PG8_STAGE(PG8_SB(1, 0), cB + kstep, voffB); PG8_STAGE_A(PG8_SA(1, 0), cA + kstep, 0, gA); PG8_STAGE(PG8_SB(1, 1), cB + hstep + kstep, voffB);
        PG8_WAIT_V(6); PG8_BAR;
    } else {
        PG8_STAGE(PG8_SB(0, 0), cB, voffB); PG8_STAGE(PG8_SA(0, 0), cA, voffA); PG8_STAGE(PG8_SB(0, 1), cB + hstep, voffB); PG8_STAGE(PG8_SA(0, 1), cA + hstep, voffA);
        if (wr == 1) PG8_BAR;
        PG8_WAIT_V(4); PG8_BAR;
        PG8_STAGE(PG8_SB(1, 0), cB + kstep, voffB); PG8_STAGE(PG8_SA(1, 0), cA + kstep, voffA); PG8_STAGE(PG8_SB(1, 1), cB + hstep + kstep, voffB);
        PG8_WAIT_V(6); PG8_BAR;
    }
    for (;;) {
        if constexpr (GATHER) { int rt_; if (S.peek_pm(ui + 1, rt_)) PG8_GLOOK(gN, ui + 1); }
        const bool has_next = S.next(ui + 1, nxt);
        const char* nA = (has_next && !GATHER) ? (const char*)g.A + (size_t)nxt.pm * tstep : cA; const char* nB = has_next ? (const char*)g.Bt + (size_t)nxt.pn * tstep : cB;
        for (int t = 0; t < nt; t += 2) {
            const bool last = (t == nt - 2);
            const char* a1 = cA + (size_t)(t + 1) * kstep;
            const char* a2 = last ? nA : cA + (size_t)(t + 2) * kstep; const char* b2 = last ? nB : cB + (size_t)(t + 2) * kstep;
            const char* a3 = a2 + kstep; const char* b3 = b2 + kstep;
            if (last && has_next) S.a_ready(nxt);
            unsigned o2[2][2] = {{gA[0][0], gA[0][1]}, {gA[1][0], gA[1][1]}};
            if constexpr (GATHER) { if (last) { asm volatile("" : "+v"(gN[0][0]), "+v"(gN[0][1]), "+v"(gN[1][0]), "+v"(gN[1][1]) :: "memory"); PG8_GOFF(o2, gN); } }
            if constexpr (SP2) {
            PG8_LDB(B0, 0, 0); PG8_LDB(B1, 0, 1); PG8_SCHED; PG8_LDA(At, 0, 0); PG8_STAGE_A(PG8_SA(1, 1), a1, 1, gA);
            PG8_WAIT_V(8); PG8_WAIT_L(0); PG8_BAR; PG8_MMA(0, 0, At, B0); PG8_MMA(0, 1, At, B1); PG8_BAR; PG8_SCHED;
            PG8_LDA(At, 0, 1); PG8_STAGE(PG8_SB(0, 0), b2, voffB); PG8_STAGE(PG8_SB(0, 1), b2 + hstep, voffB); PG8_STAGE_A(PG8_SA(0, 0), a2, 0, o2);
            PG8_WAIT_V(8); PG8_WAIT_L(0); PG8_BAR; PG8_MMA(1, 0, At, B0); PG8_MMA(1, 1, At, B1); PG8_BAR; PG8_SCHED;
            PG8_LDB(B0, 1, 0); PG8_LDB(B1, 1, 1); PG8_SCHED; PG8_LDA(At, 1, 0); PG8_STAGE_A(PG8_SA(0, 1), a2, 1, o2);
            PG8_WAIT_V(8); PG8_WAIT_L(0); PG8_BAR; PG8_MMA(0, 0, At, B0); PG8_MMA(0, 1, At, B1); PG8_BAR; PG8_SCHED;
            PG8_LDA(At, 1, 1); PG8_STAGE(PG8_SB(1, 0), b3, voffB); PG8_STAGE(PG8_SB(1, 1), b3 + hstep, voffB); PG8_STAGE_A(PG8_SA(1, 0), a3, 0, o2);
            PG8_WAIT_V(8); PG8_WAIT_L(0); PG8_BAR; PG8_MMA(1, 0, At, B0); PG8_MMA(1, 1, At, B1); PG8_BAR; PG8_SCHED;
            } else {
            PG8_LDB(B0, 0, 0); PG8_SCHED; PG8_LDA(At, 0, 0); PG8_STAGE(PG8_SA(1, 1), a1 + hstep, voffA);
            PG8_WAIT_L(8); PG8_BAR; PG8_WAIT_L(0); PG8_MMA(0, 0, At, B0); PG8_BAR; PG8_SCHED;
            PG8_LDB(B1, 0, 1); PG8_STAGE(PG8_SB(0, 0), b2, voffB);
            PG8_BAR; PG8_WAIT_L(0); PG8_MMA(0, 1, At, B1); PG8_BAR;
            PG8_LDA(At, 0, 1); PG8_STAGE(PG8_SA(0, 0), a2, voffA);
            PG8_BAR; PG8_WAIT_L(0); PG8_MMA(1, 0, At, B0); PG8_BAR; PG8_SCHED;
            PG8_STAGE(PG8_SB(0, 1), b2 + hstep, voffB);
            PG8_WAIT_V(6); PG8_BAR; PG8_MMA(1, 1, At, B1); PG8_BAR;
            PG8_LDB(B0, 1, 0); PG8_SCHED; PG8_LDA(At, 1, 0); PG8_STAGE(PG8_SA(0, 1), a2 + hstep, voffA);
            PG8_WAIT_L(8); PG8_BAR; PG8_WAIT_L(0); PG8_MMA(0, 0, At, B0); PG8_BAR; PG8_SCHED;
            PG8_LDB(B1, 1, 1); PG8_STAGE(PG8_SB(1, 0), b3, voffB);
            PG8_BAR; PG8_WAIT_L(0); PG8_MMA(0, 1, At, B1); PG8_BAR;
            PG8_LDA(At, 1, 1); PG8_STAGE(PG8_SA(1, 0), a3, voffA);
            PG8_BAR; PG8_WAIT_L(0); PG8_MMA(1, 0, At, B0); PG8_BAR; PG8_SCHED;
            PG8_STAGE(PG8_SB(1, 1), b3 + hstep, voffB);
            PG8_WAIT_V(6); PG8_BAR; PG8_MMA(1, 1, At, B1); PG8_BAR;
            }
        }
        if constexpr (ALIGN_EPI) { if (wr == 0) PG8_BAR; }
        if constexpr (!Epi::AFTER_DRAIN) { E(acc, cur, wr, wc, fr, fq); S.done(cur); }
        if (!has_next) break;
#pragma unroll
        for (int a = 0; a < 2; ++a)
#pragma unroll
            for (int b = 0; b < 2; ++b)
#pragma unroll
                for (int m = 0; m < 4; ++m)
#pragma unroll
                    for (int n = 0; n < 2; ++n) acc[a][b][m][n] = (f32x4){0.f, 0.f, 0.f, 0.f};
        cur = nxt; cA = nA; cB = nB; ++ui;
        if constexpr (GATHER) PG8_GOFF(gA, gN);
        if constexpr (ALIGN_EPI) { if (wr == 1) PG8_BAR; }
    }
    PG8_WAIT_V(0);
    if constexpr (!ALIGN_EPI) { if (wr == 0) PG8_BAR; }
    PG8_BAR;
    if constexpr (Epi::AFTER_DRAIN) { E.fused(acc, cur, wr, wc, fr, fq, lds, wid, lane); S.done(cur); }
#undef PG8_SA
#undef PG8_SB
#undef PG8_STAGE
#undef PG8_STAGE_A
#undef PG8_GLOOK
#undef PG8_GOFF
#undef PG8_LDA
#undef PG8_LDB
#undef PG8_MMA
#undef PG8_WAIT_V
#undef PG8_WAIT_L
#undef PG8_BAR
#undef PG8_SCHED
}
}

constexpr int GX_TILE = 133760, GX_ROWS = GX_TILE + 2240;
static_assert(GX_ROWS + 17 * 512 <= 147456 - 64, "grouped-GEMM LDS tables");
__device__ __forceinline__ void fg_gemm_in(PrmP p, int l, LAS unsigned char* lds, int wg, int nwg) {
    pg8::Gemm g{(const bf16_t*)(p->ws + WS_HB), (const bf16_t*)(p->ws + WS_WIN) + (size_t)l * NP * 1024, M, NP, 1024}; pg8::StaticOrder S; S.init(M, NP, nwg, wg);
    pg8::EpiBf16Plain E{(bf16_t*)(p->ws + WS_PB), NP};
    pg8::gemm_phase<pg8::EpiBf16Plain, pg8::StaticOrder, true, true>(lds, g, S, E);
}
__device__ __forceinline__ void fg_gemm_out(PrmP p, int l, LAS unsigned char* lds, int wg, int nwg) {
    pg8::Gemm g{(const bf16_t*)(p->ws + WS_YC), (const bf16_t*)(p->ws + WS_WOUT) + (size_t)l * 1024 * 1024, M, 1024, 1024}; pg8::StaticOrder S; S.init(M, 1024, nwg, wg);
    pg8::EpiBf16Plain E{(bf16_t*)(p->ws + WS_Y), 1024};
    pg8::gemm_phase<pg8::EpiBf16Plain, pg8::StaticOrder, true, true>(lds, g, S, E);
}
__device__ __forceinline__ void fg_gemm1(PrmP p, int l, LAS unsigned char* lds, int wg, int nwg) {
    const int nt = ((const int*)(p->ws + WS_CTL))[CW_NT];
    LAS int* tl = (LAS int*)(lds + GX_TILE); LAS unsigned short* rl = (LAS unsigned short*)(lds + GX_ROWS);
    pg8::GroupOrder S{nt, 8, nwg, wg, tl};
    { const int tid = fresh_tid(); const int* TE = (const int*)(p->ws + WS_MISC + MS_TILEE); const int* RT = (const int*)(p->ws + WS_MISC + MS_ROWTOK);
      __syncthreads();
      for (int i = tid; i < nt; i += NTHREADS) tl[i] = TE[i];
      { int rv[17];
#pragma unroll
        for (int ui = 0; ui < 17; ++ui) { int rt; rv[ui] = (S.peek_pm(ui, rt) && tid < 256) ? RT[rt * 256 + tid] : 0; }
#pragma unroll
        for (int ui = 0; ui < 17; ++ui) if (tid < 256) rl[ui * 256 + tid] = (unsigned short)rv[ui]; }
      __syncthreads(); }
    if (EXPERT_FP8) {
        pg8::Gemm g{(const bf16_t*)(p->ws + WS_HB), (const bf16_t*)(p->ws + WS_WGU + (size_t)l * NE * 2048 * 1024), RP, NE * 2048, 512, rl};
        pg8::EpiSwiglu8 E{p->ws + WS_H1, p->in[I_BGU] + (size_t)l * NE * 2048};
        pg8::gemm_phase<pg8::EpiSwiglu8, pg8::GroupOrder, true, true, 119, true>(lds, g, S, E);
    } else {
    pg8::Gemm g{(const bf16_t*)(p->ws + WS_XS), (const bf16_t*)(p->ws + WS_WGU) + (size_t)l * NE * 2048 * 1024, RP, NE * 2048, 1024};
    pg8::EpiSwiglu E{(bf16_t*)(p->ws + WS_H1), p->in[I_BGU] + (size_t)l * NE * 2048};
    pg8::gemm_phase<pg8::EpiSwiglu, pg8::GroupOrder, true, true>(lds, g, S, E);
    }
}
__device__ __forceinline__ void fg_gemm2(PrmP p, int l, LAS unsigned char* lds, int wg, int nwg) {
    const int nt = ((const int*)(p->ws + WS_CTL))[CW_NT];
    LAS int* tl = (LAS int*)(lds + GX_TILE);
    { const int tid = fresh_tid(); const int* TE = (const int*)(p->ws + WS_MISC + MS_TILEE); __syncthreads(); for (int i = tid; i < nt; i += NTHREADS) tl[i] = TE[i]; __syncthreads(); }
    pg8::GroupOrder S{nt, 4, nwg, wg, tl};
    pg8::EpiDown E{(bf16_t*)(p->ws + WS_YR), p->in[I_BDN] + (size_t)l * NE * 1024};
    if (EXPERT_FP8) {
        pg8::Gemm g{(const bf16_t*)(p->ws + WS_H1), (const bf16_t*)(p->ws + WS_WDN + (size_t)l * NE * 1024 * 1024), RP, NE * 1024, 512};
        if (YR_FP8) { pg8::EpiDown8 E8{p->ws + WS_YR, p->in[I_BDN] + (size_t)l * NE * 1024}; pg8::gemm_phase<pg8::EpiDown8, pg8::GroupOrder, true, true, 120>(lds, g, S, E8); }
        else pg8::gemm_phase<pg8::EpiDown, pg8::GroupOrder, true, true, 120>(lds, g, S, E);
    } else {
    pg8::Gemm g{(const bf16_t*)(p->ws + WS_H1), (const bf16_t*)(p->ws + WS_WDN) + (size_t)l * NE * 1024 * 1024, RP, NE * 1024, 1024};
    pg8::gemm_phase<pg8::EpiDown, pg8::GroupOrder, true, true>(lds, g, S, E);
    }
}

#include <hip/hip_bf16.h>
#include <cmath>
namespace attn_body {
using bf16=__hip_bfloat16;
using bf16x8=__attribute__((ext_vector_type(8)))short;
using s16x4=__attribute__((ext_vector_type(4)))short;
using f32x16=__attribute__((ext_vector_type(16)))float;
using u32x4=__attribute__((ext_vector_type(4)))unsigned;
constexpr int BATCH=4,NHEAD=8,SEQ=8192,D=64,DM=2560;
constexpr int NW=8,QBLK=32,QB=QBLK*NW,KVBLK=64,NQB=SEQ/QB;
constexpr int ATTN_PITCH=DM, ATTN_UNIT_ROWS=QB;
__device__ __forceinline__ int crow(int r,int hi){return (r&3)+8*(r>>2)+4*hi;}
#define SBAR() __builtin_amdgcn_sched_barrier(0)
__device__ __forceinline__ void cmask(f32x16&p0,f32x16&p1,int jb,int qrel,int hi){
  const float NEG=-INFINITY; int kb=64*jb+4*hi;
  #pragma unroll
  for(int r=0;r<16;++r){int kv=kb+(r&3)+8*(r>>2); if(kv>qrel)p0[r]=NEG; if(kv+32>qrel)p1[r]=NEG;}
}

constexpr int NSLOT=3, SLOTB=8192;
constexpr int LDS_K=0, LDS_V=NSLOT*SLOTB, LDS_WS=2*NSLOT*SLOTB, LDS_OST=LDS_WS+NW*64*4, LDS_BYTES=LDS_OST+NW*4096;
constexpr float C2=0.125f*1.4426950408889634f;
__device__ __forceinline__ void glds16(const void*gsrc,unsigned lds_dst){unsigned keep;
  asm volatile("s_mov_b32 %0, m0\n\ts_mov_b32 m0, %2\n\ts_nop 0\n\tglobal_load_lds_dwordx4 %1, off\n\ts_mov_b32 m0, %0":"=&s"(keep):"v"(gsrc),"s"(lds_dst):"memory");}
__device__ __forceinline__ float max3f(float a,float b,float c){float r;asm("v_max3_f32 %0, %1, %2, %3":"=v"(r):"v"(a),"v"(b),"v"(c));return r;}
__device__ __forceinline__ float max2f(float a,float b){float r;asm("v_max_f32_e32 %0, %1, %2":"=v"(r):"v"(a),"v"(b));return r;}
__device__ __forceinline__ float fadd_s(float a,float b){float r;asm("v_add_f32_e32 %0, %1, %2":"=v"(r):"v"(a),"v"(b));return r;}
__device__ __forceinline__ float fsub_s(float a,float b){float r;asm("v_sub_f32_e32 %0, %1, %2":"=v"(r):"v"(a),"v"(b));return r;}
typedef float f32x2_t __attribute__((ext_vector_type(2))); typedef __bf16 bf16x2_t __attribute__((ext_vector_type(2)));
__device__ __forceinline__ unsigned cvtpk_s(float lo,float hi){f32x2_t v={lo,hi};bf16x2_t b=__builtin_convertvector(v,bf16x2_t);return __builtin_bit_cast(unsigned,b);}
__device__ __forceinline__ unsigned f2bf(float f) { return pk2(f, 0.f) & 0xffffu; }
#define WAIT_BAR(N) asm volatile("s_waitcnt vmcnt(" #N ") lgkmcnt(0)\n\ts_barrier":::"memory")

typedef __attribute__((address_space(3))) const float* lds_fptr;
__device__ __forceinline__ void split3(float f,unsigned&hb,unsigned&mb,unsigned&lb){
  hb=__float_as_uint(f)&0xffff0000u; const float r1=f-__uint_as_float(hb); mb=__float_as_uint(r1)&0xffff0000u; const float r2=r1-__uint_as_float(mb); lb=__float_as_uint(r2)&0xffff0000u; }
__device__ __forceinline__ bf16x8 mk_kx(float fk,int hi){ unsigned hb,mb,lb; split3(-fk,hb,mb,lb);
  u32x4 w; w.x=0x3f803f80u; w.y=hi?0x00003f80u:(0x00003f80u|hb); w.z=hi?0u:((mb>>16)|lb); w.w=0u; return __builtin_bit_cast(bf16x8,w); }
__device__ __forceinline__ bf16x8 mk_qx(float fq,float mhat,int hi){ unsigned hb,mb,lb; split3(hi?-mhat:fq,hb,mb,lb);
  u32x4 w; w.x=(hb>>16)|mb; w.y=hi?(lb>>16):((lb>>16)|0x3f800000u); w.z=hi?0u:0x3f803f80u; w.w=0u; return __builtin_bit_cast(bf16x8,w); }
__device__ __forceinline__ void qkt(f32x16&p0,f32x16&p1,const char*Kslot,const bf16x8*qr,bf16x8 kxa,bf16x8 kxb,bf16x8 qx,int r32,int hi){
  const f32x16 zc=f32x16{};
  const char*kb=Kslot+hi*1024+r32*16;
  #pragma unroll
  for(int d0=0;d0<4;++d0){
    const bf16x8 b0=*reinterpret_cast<const bf16x8*>(kb+d0*2048);
    const bf16x8 b1=*reinterpret_cast<const bf16x8*>(kb+d0*2048+512);
    if(d0==0){p0=__builtin_amdgcn_mfma_f32_32x32x16_bf16(b0,qr[0],zc,0,0,0);p1=__builtin_amdgcn_mfma_f32_32x32x16_bf16(b1,qr[0],zc,0,0,0);}
    else{p0=__builtin_amdgcn_mfma_f32_32x32x16_bf16(b0,qr[d0],p0,0,0,0);p1=__builtin_amdgcn_mfma_f32_32x32x16_bf16(b1,qr[d0],p1,0,0,0);}}
  p0=__builtin_amdgcn_mfma_f32_32x32x16_bf16(kxa,qx,p0,0,0,0);p1=__builtin_amdgcn_mfma_f32_32x32x16_bf16(kxb,qx,p1,0,0,0);
}
typedef __attribute__((address_space(3))) const char* lds_cptr;
typedef short v4i16_t __attribute__((ext_vector_type(4)));
__device__ __forceinline__ void kload8(bf16x8*kf,lds_cptr kp){
  kf[0]=*(const __attribute__((address_space(3))) bf16x8*)(kp);      kf[1]=*(const __attribute__((address_space(3))) bf16x8*)(kp+512);
  kf[2]=*(const __attribute__((address_space(3))) bf16x8*)(kp+2048); kf[3]=*(const __attribute__((address_space(3))) bf16x8*)(kp+2560);
  kf[4]=*(const __attribute__((address_space(3))) bf16x8*)(kp+4096); kf[5]=*(const __attribute__((address_space(3))) bf16x8*)(kp+4608);
  kf[6]=*(const __attribute__((address_space(3))) bf16x8*)(kp+6144); kf[7]=*(const __attribute__((address_space(3))) bf16x8*)(kp+6656);
}
__device__ __forceinline__ void kload2(bf16x8*kf,lds_cptr kp,int j){ kf[2*j]=*(const __attribute__((address_space(3))) bf16x8*)(kp+j*2048); kf[2*j+1]=*(const __attribute__((address_space(3))) bf16x8*)(kp+j*2048+512); }
__device__ __forceinline__ s16x4 vtr(lds_cptr p){ return __builtin_bit_cast(s16x4,__builtin_amdgcn_ds_read_tr16_b64_v4i16((__attribute__((address_space(3))) v4i16_t*)p)); }
__device__ __forceinline__ float rowmax(const f32x16&p0,const f32x16&p1){
  float a=max3f(p0[0],p0[1],p1[0]),b=max3f(p0[2],p0[3],p1[1]);a=max3f(a,p1[2],p1[3]);
  #pragma unroll
  for(int r=4;r<16;r+=4){a=max3f(a,p0[r],p0[r+1]);b=max3f(b,p0[r+2],p0[r+3]);a=max3f(a,p1[r],p1[r+1]);b=max3f(b,p1[r+2],p1[r+3]);}
  const float m=max2f(a,b);
  auto rr=__builtin_amdgcn_permlane32_swap(__float_as_uint(m),__float_as_uint(m),false,false);
  return max2f(__uint_as_float(rr[0]),__uint_as_float(rr[1]));
}
__device__ __forceinline__ void pv(f32x16*o,int vb,bf16x8 pa0,bf16x8 pa1,bf16x8 pa2,bf16x8 pa3){
  #pragma unroll
  for(int d0=0;d0<2;++d0){s16x4 lo[4],hi[4];
    #pragma unroll
    for(int ks=0;ks<4;++ks){
      asm volatile("ds_read_b64_tr_b16 %0,%1 offset:%c2":"=&v"(lo[ks]):"v"(vb),"i"(d0*4096+ks*1024):"memory");
      asm volatile("ds_read_b64_tr_b16 %0,%1 offset:%c2":"=&v"(hi[ks]):"v"(vb),"i"(d0*4096+ks*1024+512):"memory");}
    asm volatile("s_waitcnt lgkmcnt(0)":::"memory");SBAR();
    #define PK(k) (bf16x8){lo[k][0],lo[k][1],lo[k][2],lo[k][3],hi[k][0],hi[k][1],hi[k][2],hi[k][3]}
    o[d0]=__builtin_amdgcn_mfma_f32_32x32x16_bf16(pa0,PK(0),o[d0],0,0,0);
    o[d0]=__builtin_amdgcn_mfma_f32_32x32x16_bf16(pa1,PK(1),o[d0],0,0,0);
    o[d0]=__builtin_amdgcn_mfma_f32_32x32x16_bf16(pa2,PK(2),o[d0],0,0,0);
    o[d0]=__builtin_amdgcn_mfma_f32_32x32x16_bf16(pa3,PK(3),o[d0],0,0,0);
    #undef PK
  }
}

#ifndef ATTN_STORE16
#define ATTN_STORE16(p,v) (*(u32x4*)(p)=(v))
#endif
template<int THRL> __device__ __forceinline__ void attn_unit(int b,int h,int qb,const bf16*Q,const bf16*__restrict__ K,const bf16*__restrict__ V,bf16*O,char*shm,lds_fptr F2s,int tstart,float kmx){
  const int tid=::fresh_tid(),lane=tid&63,r32=lane&31,hi=lane>>5; const int wid=__builtin_amdgcn_readfirstlane(tid>>6);
  const long rowbase=(long)b*SEQ; const int q0=qb*QB;
  const bf16*Qw=Q+(rowbase+q0+wid*QBLK)*DM+h*D;
  const bf16*Kh=K+(rowbase+(long)tstart*KVBLK)*DM+h*D,*Vh=V+(rowbase+(long)tstart*KVBLK)*DM+h*D; const lds_fptr F2k=F2s+tstart*KVBLK;
  const unsigned lds0=(unsigned)(uintptr_t)shm;
  float*wsf=(float*)(shm+LDS_WS)+wid*64;
  const bf16*ksrc=Kh+(long)lane*DM+wid*8;
  const bf16*vsrc=Vh+(long)(16*(wid&3)+(lane>>2))*DM+(wid>>2)*32+(lane&3)*8;
  const unsigned kdst=lds0+LDS_K+wid*1024, vdst=lds0+LDS_V+wid*1024;
  #define DMA_K(t,slot) glds16(ksrc+(long)(t)*KVBLK*DM,(unsigned)__builtin_amdgcn_readfirstlane(kdst+(slot)))
  #define DMA_V(t,slot) glds16(vsrc+(long)(t)*KVBLK*DM,(unsigned)__builtin_amdgcn_readfirstlane(vdst+(slot)))
  const int vb0=(int)(lds0+LDS_V)+((lane>>4)&1)*32+(lane&3)*8+(4*hi+((lane&15)>>2))*64;
  const char*Kbase=shm+LDS_K; bf16x8 kf[8];
  const lds_cptr shm3=(lds_cptr)shm; const lds_cptr kp0=shm3+LDS_K+hi*1024+r32*16; const lds_cptr vp0=shm3+LDS_V+((lane>>4)&1)*32+(lane&3)*8+(4*hi+((lane&15)>>2))*64;
  const int NT=(q0+QB)/KVBLK-tstart;
  DMA_K(0,0);DMA_V(0,0);DMA_K(1,SLOTB);
  bf16x8 qr[4];
  #pragma unroll
  for(int d0=0;d0<4;++d0)qr[d0]=*reinterpret_cast<const bf16x8*>(&Qw[(long)r32*DM+d0*16+hi*8]);
  float m0; { float qq=0.f;
    #pragma unroll
    for(int d0=0;d0<4;++d0){const u32x4 w_=__builtin_bit_cast(u32x4,qr[d0]);
      #pragma unroll
      for(int j_=0;j_<4;++j_){const float a_=__uint_as_float(w_[j_]<<16),b_=__uint_as_float(w_[j_]&0xffff0000u);qq+=a_*a_+b_*b_;}}
    qq+=__shfl_xor(qq,32); m0=sqrtf(qq)*kmx+1.f; }
  float l_reg=0.f;f32x16 o[2];o[0]=f32x16{};o[1]=f32x16{};const f32x16 zc=f32x16{};
  const float fq_=F2s[q0+wid*QBLK+r32]; const bf16x8 qx=mk_qx(fq_,m0,hi);
  const int qrel=wid*QBLK+r32;
  #define CMASK(P0,P1,t) do{int jb_=(t)-(NT-4); if(jb_>=0)cmask(P0,P1,jb_,qrel,hi);}while(0)
  #define START(P0,P1) do{ _Pragma("unroll") for(int r=0;r<16;++r)P0[r]=__builtin_amdgcn_exp2f(P0[r]); }while(0)
  #define RESC() do{}while(0)
  f32x16 pA0,pA1,pB0,pB1;
  int sl_prev=0,sl_cur=0,sl_next=SLOTB;
  #define ROT() do{sl_prev=sl_cur;sl_cur=sl_next;sl_next=(sl_next==(NSLOT-1)*SLOTB)?0:sl_next+SLOTB;}while(0)
  DMA_K(2,2*SLOTB);
  WAIT_BAR(3);
  qkt(pA0,pA1,Kbase,qr,mk_kx(F2k[r32],hi),mk_kx(F2k[32+r32],hi),qx,r32,hi);asm volatile("s_nop 15\n\ts_nop 7":"+v"(pA0),"+v"(pA1));CMASK(pA0,pA1,0);
  START(pA0,pA1);
  _Pragma("unroll") for(int r=0;r<16;++r)pA1[r]=__builtin_amdgcn_exp2f(pA1[r]);
  WAIT_BAR(0);
  DMA_K(3,0);DMA_V(1,SLOTB);
  ROT();
  kload8(kf,kp0+sl_cur);
  WAIT_BAR(2);
  s16x4 vlo[8],vhi[8]; u32x4 pw0,pw1,pw2,pw3;
  #define PKW(P,B) cvtpk_s(P[B],P[B+1])
  #define PAF(k) __builtin_bit_cast(bf16x8,pw##k)
  #define VFR(i) (bf16x8){vlo[i][0],vlo[i][1],vlo[i][2],vlo[i][3],vhi[i][0],vhi[i][1],vhi[i][2],vhi[i][3]}
  #define PIN(x) asm volatile("":"+v"(x))
  #define MX3(a,b,c) __builtin_fmaxf(__builtin_fmaxf((a),(b)),(c))
  #define GAPA(MF,A0,A1,A2,A3,W0,W1,PW) do{ MF; sacc+=A0; sacc+=A1; sacc+=A2; sacc+=A3; PIN(sacc); W0; W1; PIN(PW); SBAR(); }while(0)
  #define EX(v) __builtin_amdgcn_exp2f(v)
  #define GAPB(MF,X,B) do{ MF; X[B]=EX(X[B]); X[B+1]=EX(X[B+1]); X[B+2]=EX(X[B+2]); X[B+3]=EX(X[B+3]); PIN(X); SBAR(); }while(0)
  #define VRD(i) do{ vlo[i]=vtr(vp_+(((i)>>2)*4096+((i)&3)*1024)); vhi[i]=vtr(vp_+(((i)>>2)*4096+((i)&3)*1024+512)); }while(0)
  #define KRD(G,j) do{ if(G){ kload2(kf,kp0+sl_next,j); SBAR(); } }while(0)
  #define STEP(C0,C1,P0,P1,t,GK,GV,GL) do{ const float fka_=F2k[(t)*KVBLK+r32],fkb_=F2k[(t)*KVBLK+32+r32]; SBAR(); \
    const lds_cptr vp_=vp0+sl_prev; \
    VRD(0); SBAR(); float sacc=(P0[0]+P0[1]); \
    GAPA(C0=__builtin_amdgcn_mfma_f32_32x32x16_bf16(kf[0],qr[0],zc,0,0,0), P0[2],P0[3],P0[4],P0[5],     pw0[0]=PKW(P0,0), pw0[1]=PKW(P0,2), pw0); \
    VRD(4); SBAR(); GAPA(C1=__builtin_amdgcn_mfma_f32_32x32x16_bf16(kf[1],qr[0],zc,0,0,0), P0[6],P0[7],P0[8],P0[9],     pw0[2]=PKW(P0,4), pw0[3]=PKW(P0,6), pw0); \
    VRD(1); SBAR(); GAPA(C0=__builtin_amdgcn_mfma_f32_32x32x16_bf16(kf[2],qr[1],C0,0,0,0),   P0[10],P0[11],P0[12],P0[13], pw1[0]=PKW(P0,8), pw1[1]=PKW(P0,10), pw1); \
    VRD(5); SBAR(); GAPA(C1=__builtin_amdgcn_mfma_f32_32x32x16_bf16(kf[3],qr[1],C1,0,0,0),   P0[14],P0[15],P1[0],P1[1],   pw1[2]=PKW(P0,12),pw1[3]=PKW(P0,14), pw1); \
    VRD(2); SBAR(); GAPA(C0=__builtin_amdgcn_mfma_f32_32x32x16_bf16(kf[4],qr[2],C0,0,0,0),   P1[2],P1[3],P1[4],P1[5],     pw2[0]=PKW(P1,0), pw2[1]=PKW(P1,2), pw2); \
    VRD(6); SBAR(); GAPA(C1=__builtin_amdgcn_mfma_f32_32x32x16_bf16(kf[5],qr[2],C1,0,0,0),   P1[6],P1[7],P1[8],P1[9],     pw2[2]=PKW(P1,4), pw2[3]=PKW(P1,6), pw2); \
    VRD(3); SBAR(); GAPA(C0=__builtin_amdgcn_mfma_f32_32x32x16_bf16(kf[6],qr[3],C0,0,0,0),   P1[10],P1[11],P1[12],P1[13], pw3[0]=PKW(P1,8), pw3[1]=PKW(P1,10), pw3); \
    VRD(7); SBAR(); GAPA(C1=__builtin_amdgcn_mfma_f32_32x32x16_bf16(kf[7],qr[3],C1,0,0,0),   P1[14],P1[15],0.f,0.f,       pw3[2]=PKW(P1,12),pw3[3]=PKW(P1,14), pw3); \
    { C0=__builtin_amdgcn_mfma_f32_32x32x16_bf16(mk_kx(fka_,hi),qx,C0,0,0,0); SBAR(); C1=__builtin_amdgcn_mfma_f32_32x32x16_bf16(mk_kx(fkb_,hi),qx,C1,0,0,0); } \
    l_reg+=sacc; \
    if(GK){DMA_K((t)+3,sl_cur);} if(GV){DMA_V((t)+1,sl_next);} \
    CMASK(C0,C1,t); \
    SBAR(); \
    GAPB(o[0]=__builtin_amdgcn_mfma_f32_32x32x16_bf16(PAF(0),VFR(0),o[0],0,0,0), C0,0); \
    GAPB(o[1]=__builtin_amdgcn_mfma_f32_32x32x16_bf16(PAF(0),VFR(4),o[1],0,0,0), C0,4); \
    KRD(GL,0); GAPB(o[0]=__builtin_amdgcn_mfma_f32_32x32x16_bf16(PAF(1),VFR(1),o[0],0,0,0), C0,8); \
    KRD(GL,1); GAPB(o[1]=__builtin_amdgcn_mfma_f32_32x32x16_bf16(PAF(1),VFR(5),o[1],0,0,0), C0,12); \
    KRD(GL,2); GAPB(o[0]=__builtin_amdgcn_mfma_f32_32x32x16_bf16(PAF(2),VFR(2),o[0],0,0,0), C1,0); \
    KRD(GL,3); GAPB(o[1]=__builtin_amdgcn_mfma_f32_32x32x16_bf16(PAF(2),VFR(6),o[1],0,0,0), C1,4); \
    GAPB(o[0]=__builtin_amdgcn_mfma_f32_32x32x16_bf16(PAF(3),VFR(3),o[0],0,0,0), C1,8); \
    GAPB(o[1]=__builtin_amdgcn_mfma_f32_32x32x16_bf16(PAF(3),VFR(7),o[1],0,0,0), C1,12); \
    }while(0)
  int t=1;
  #undef CMASK
  #define CMASK(P0,P1,t) do{}while(0)
  for(;t+5<NT;t+=2){
    STEP(pB0,pB1,pA0,pA1,t,true,true,true);     WAIT_BAR(2); RESC(); ROT();
    STEP(pA0,pA1,pB0,pB1,t+1,true,true,true);   WAIT_BAR(2); RESC(); ROT();
  }
  #undef CMASK
  #define CMASK(P0,P1,t) do{int jb_=(t)-(NT-4); if(jb_>=0)cmask(P0,P1,jb_,qrel,hi);}while(0)
  #define ENDW(tt) do{ if((tt)+3<NT){WAIT_BAR(2);} else if((tt)+2<NT){WAIT_BAR(1);} else {WAIT_BAR(0);} }while(0)
  for(;t+1<NT;t+=2){
    STEP(pB0,pB1,pA0,pA1,t,(t+3<NT),(t+1<NT),(t+1<NT));       ENDW(t);   RESC(); ROT();
    STEP(pA0,pA1,pB0,pB1,t+1,(t+4<NT),(t+2<NT),(t+2<NT));     ENDW(t+1); RESC(); ROT();
  }
  STEP(pB0,pB1,pA0,pA1,NT-1,false,false,false); RESC();
  { float sacc=pB0[0]+pB0[1]; _Pragma("unroll") for(int r=2;r<16;++r)sacc+=pB0[r]; _Pragma("unroll") for(int r=0;r<16;++r)sacc+=pB1[r]; l_reg+=sacc;
    pw0=(u32x4){PKW(pB0,0),PKW(pB0,2),PKW(pB0,4),PKW(pB0,6)};pw1=(u32x4){PKW(pB0,8),PKW(pB0,10),PKW(pB0,12),PKW(pB0,14)};pw2=(u32x4){PKW(pB1,0),PKW(pB1,2),PKW(pB1,4),PKW(pB1,6)};pw3=(u32x4){PKW(pB1,8),PKW(pB1,10),PKW(pB1,12),PKW(pB1,14)};
    SBAR(); pv(o,vb0+sl_cur,PAF(0),PAF(1),PAF(2),PAF(3)); }
  #undef PKW
  #undef PAF
  #undef VFR
  #undef PIN
  #undef MX3
  #undef GAPA
  #undef GAPB
  #undef EX
  #undef VRD
  #undef KRD
  #undef STEP
  #undef ENDW
  {auto rr=__builtin_amdgcn_permlane32_swap(__float_as_uint(l_reg),__float_as_uint(l_reg),false,false);l_reg=__uint_as_float(rr[0])+__uint_as_float(rr[1]);}
  if(hi==0)wsf[32+r32]=l_reg;asm volatile("s_waitcnt lgkmcnt(0)":::"memory");
  float rli[16];
  #pragma unroll
  for(int r=0;r<16;++r)rli[r]=__builtin_amdgcn_rcpf(wsf[32+crow(r,hi)]);
  bf16*Ow=O+(rowbase+q0+wid*QBLK)*DM+h*D;
  { bf16*stg=(bf16*)(shm+LDS_OST)+wid*2048;
    #pragma unroll
    for(int r=0;r<16;++r){const int orow=crow(r,hi);
      #pragma unroll
      for(int d0=0;d0<2;++d0)stg[orow*64+d0*32+r32]=__float2bfloat16(o[d0][r]*rli[r]);}
    asm volatile("s_waitcnt lgkmcnt(0)":::"memory");
    #pragma unroll
    for(int i=0;i<4;++i){const int row=i*8+(lane>>3),ch=lane&7; const u32x4 v=*(const u32x4*)(stg+row*64+ch*8); ATTN_STORE16(Ow+(long)row*DM+ch*8,v);} }
  asm volatile("s_waitcnt lgkmcnt(0)\n\ts_barrier":::"memory");
  #undef DMA_K
  #undef DMA_V
  #undef CMASK
  #undef START
  #undef RESC
  #undef ROT
}
constexpr int ATTN_LDS_BYTES=LDS_BYTES;
#undef SBAR
#undef WAIT_BAR
}

constexpr float SKIP_MARGIN = 64.f;
constexpr int ATT_F2_OFF = 86016, ATT_SCN_OFF = ATT_F2_OFF + 32768;
static_assert(attn_body::ATTN_LDS_BYTES <= ATT_F2_OFF && ATT_SCN_OFF + 64 <= 131072, "attention LDS map");
__device__ __forceinline__ void f2_items(PrmP p, int l, LAS unsigned char* lds, int wg, int nwg) {
    const int tid = fresh_tid(), lane = tid & 63, wave = tid >> 6;
    LAS float* scn = (LAS float*)(lds + ATT_SCN_OFF);
    const bf16_t* PB = (const bf16_t*)(p->ws + WS_PB); float* F2G = (float*)(p->ws + WS_FC2);
    for (int bh = wg; bh < 32; bh += nwg) { const int b = bh >> 3, hh = bh & 7;
        const float fb = p->in[I_FOXFB][l * 8 + hh];
        float loc[16]; float run = 0.f;
#pragma unroll
        for (int i = 0; i < 16; ++i) { const float z = bf2f(PB[(size_t)(b * T + tid * 16 + i) * NP + C_F + hh]) + fb;
            run += -(fmaxf(-z, 0.f) + __logf(1.f + __expf(-fabsf(z)))) * LOG2E; loc[i] = run; }
        float incl = run;
#pragma unroll
        for (int o = 1; o < 64; o <<= 1) { const float v = __shfl_up(incl, o); if (lane >= o) incl += v; }
        __syncthreads();
        if (lane == 63) scn[wave] = incl;
        __syncthreads();
        float base = incl - run;
        for (int w = 0; w < wave; ++w) base += scn[w];
#pragma unroll
        for (int i = 0; i < 16; ++i) F2G[(size_t)bh * T + tid * 16 + i] = base + loc[i];
    }
}
__device__ __forceinline__ void fa_attn(PrmP p, int l, LAS unsigned char* lds, int wg, int nwg) {
    const int tid = fresh_tid();
    if (nwg != 256) return;
    LAS float* F2s = (LAS float*)(lds + ATT_F2_OFF);
    LAS int* work = (LAS int*)(lds + ATT_SCN_OFF); LAS int* tst = work + 1024; LAS int* mine = tst + 1024;
    const float* F2G = (const float*)(p->ws + WS_FC2);
    __syncthreads();
    const unsigned* CT = (const unsigned*)(p->ws + WS_CTL);
#pragma unroll
    for (int k = 0; k < 8; ++k) { const int i = tid + 512 * k; F2s[i] = F2G[(size_t)(i >> 7) * T + (i & 127) * 64 + 63];
        F2s[4096 + i] = sqrtf(__uint_as_float(__hip_atomic_load(CT + CW_KT + l * 4096 + i, __ATOMIC_RELAXED, __HIP_MEMORY_SCOPE_AGENT))); }
    __syncthreads();
#pragma unroll
    for (int k = 0; k < 2; ++k) { const int u = tid + 512 * k, bh = u >> 5, qb = u & 31;
        const unsigned* NRM = (const unsigned*)(p->ws + WS_CTL) + CW_NRM + (l * 32 + bh) * 2;
        const float qn = sqrtf(__uint_as_float(__hip_atomic_load(NRM, __ATOMIC_RELAXED, __HIP_MEMORY_SCOPE_AGENT))), kn = sqrtf(__uint_as_float(__hip_atomic_load(NRM + 1, __ATOMIC_RELAXED, __HIP_MEMORY_SCOPE_AGENT)));
        (void)qn; (void)kn;
        const float qI = sqrtf(__uint_as_float(__hip_atomic_load(CT + CW_QN + (l * 32 + bh) * 32 + qb, __ATOMIC_RELAXED, __HIP_MEMORY_SCOPE_AGENT)));
        const float kI = fmaxf(fmaxf(F2s[4096 + bh * 128 + 4 * qb], F2s[4096 + bh * 128 + 4 * qb + 1]), fmaxf(F2s[4096 + bh * 128 + 4 * qb + 2], F2s[4096 + bh * 128 + 4 * qb + 3]));
        const float base = F2G[(size_t)bh * T + qb * 256] + SKIP_MARGIN + qI * kI;
        int ts = 0; bool ok = true;
        for (int J = 0; J < 4 * qb; ++J) { ok = ok && (F2s[bh * 128 + J] > base + qI * F2s[4096 + bh * 128 + J]); ts = (ok && (J & 1)) ? J + 1 : ts; }
        tst[u] = ts; work[u] = 4 * (qb + 1) - ts; }
    if (tid < 4) mine[tid] = 0;
    __syncthreads();
    { const int ua = tid, ub = tid + 512; const int wa = work[ua], wb = work[ub]; int ra = 0, rb = 0;
      typedef int i32x4_ __attribute__((ext_vector_type(4)));
      const int ka = wa * 1024 + (1023 - ua), kb = wb * 1024 + (1023 - ub);
#pragma unroll 4
      for (int v = 0; v < 1024; v += 4) { const i32x4_ w4 = *(const LAS i32x4_*)(work + v);
#pragma unroll
          for (int q = 0; q < 4; ++q) { const int kv = w4[q] * 1024 + (1023 - (v + q)); ra += (kv > ka) ? 1 : 0; rb += (kv > kb) ? 1 : 0; } }
      const int t0 = wg, t1 = 511 - wg, t2 = 512 + wg, t3 = 1023 - wg;
      if (ra == t0) mine[0] = ua; if (ra == t1) mine[1] = ua; if (ra == t2) mine[2] = ua; if (ra == t3) mine[3] = ua;
      if (rb == t0) mine[0] = ub; if (rb == t1) mine[1] = ub; if (rb == t2) mine[2] = ub; if (rb == t3) mine[3] = ub; }
    __syncthreads();
    const unsigned* NRMB = (const unsigned*)(p->ws + WS_CTL) + CW_NRM + l * 64;
    attn_body::bf16* pb = (attn_body::bf16*)(p->ws + WS_PB);
#pragma unroll 1
    for (int k = 0; k < 4; ++k) { const int u = __builtin_amdgcn_readfirstlane(mine[k]), bh = u >> 5, qb = u & 31, ts_u = __builtin_amdgcn_readfirstlane(tst[u]);
        __syncthreads();
#pragma unroll
        for (int i = 0; i < 4; ++i) *(LAS f32x4*)(F2s + tid * 4 + 2048 * i) = *(const f32x4*)(F2G + (size_t)bh * T + tid * 4 + 2048 * i);
        __syncthreads();
        const float m0 = sqrtf(__uint_as_float(__hip_atomic_load(NRMB + bh * 2 + 1, __ATOMIC_RELAXED, __HIP_MEMORY_SCOPE_AGENT)));
        attn_body::attn_unit<8>(bh >> 3, bh & 7, qb, pb + C_Q, pb + C_K, pb + C_V, pb + C_Q, (char*)lds, (attn_body::lds_fptr)F2s, ts_u, m0);
    }
}

typedef float f32x16 __attribute__((ext_vector_type(16)));
struct S5M { float ar[2], ai[2], a16r[2], a16i[2]; bf16x8 bfr[4]; };
__device__ __forceinline__ int tau32(int i) { return 16 * ((i >> 2) & 1) + 4 * (i >> 3) + (i & 3); }
__device__ __forceinline__ void s5m_setup(PrmP p, int l, int g, int lane, S5M& c) {
    const int nl = lane & 31, hi = lane >> 5;
    const float dt = expf(p->in[I_S5LOGDT][l * 16 + g]);
    u32x4 fre[2], fim[2];
#pragma unroll
    for (int s = 0; s < 2; ++s) { const int pi = 32 * s + nl;
        const float are = p->in[I_S5ARE][(l * 16 + g) * 64 + pi], aim = p->in[I_S5AIM][(l * 16 + g) * 64 + pi];
        const float mag = expf(are * dt); const float th = aim * dt * 0.3183098861837907f; const float abr = mag * cospif(th), abi = mag * sinpif(th);
        const float den = are * are + aim * aim, nre = abr - 1.f;
        const float kre = (nre * are + abi * aim) / den, kim = (abi * are - nre * aim) / den;
        c.ar[s] = abr; c.ai[s] = abi;
        float pr = abr, pi_ = abi;
#pragma unroll
        for (int q = 0; q < 4; ++q) { const float nr = pr * pr - pi_ * pi_, ni = 2.f * pr * pi_; pr = nr; pi_ = ni; }
        c.a16r[s] = pr; c.a16i[s] = pi_;
        const float* brp = p->in[I_S5BRE] + ((size_t)(l * 16 + g) * 64 + pi) * 16 + 8 * hi; const float* bip = p->in[I_S5BIM] + ((size_t)(l * 16 + g) * 64 + pi) * 16 + 8 * hi;
        const f32x4 br0 = *(const f32x4*)brp, br1 = *(const f32x4*)(brp + 4), bi0 = *(const f32x4*)bip, bi1 = *(const f32x4*)(bip + 4);
        const f32x4 re0 = br0 * kre - bi0 * kim, re1 = br1 * kre - bi1 * kim, im0 = bi0 * kre + br0 * kim, im1 = bi1 * kre + br1 * kim;
        fre[s] = (u32x4){pk2(re0.x, re0.y), pk2(re0.z, re0.w), pk2(re1.x, re1.y), pk2(re1.z, re1.w)};
        fim[s] = (u32x4){pk2(im0.x, im0.y), pk2(im0.z, im0.w), pk2(im1.x, im1.y), pk2(im1.z, im1.w)}; }
    c.bfr[0] = __builtin_bit_cast(bf16x8, fre[0]); c.bfr[1] = __builtin_bit_cast(bf16x8, fre[1]); c.bfr[2] = __builtin_bit_cast(bf16x8, fim[0]); c.bfr[3] = __builtin_bit_cast(bf16x8, fim[1]);
}
__device__ __forceinline__ void s5m_cfrag(PrmP p, int l, int g, int lane, bf16x8 (&cmf)[8], bf16x8& dfr) {
    const int nl = lane & 31, hi = lane >> 5;
    const float* cre = p->in[I_S5CRE] + ((size_t)(l * 16 + g) * 16 + (nl & 15)) * 64; const float* cim = p->in[I_S5CIM] + ((size_t)(l * 16 + g) * 16 + (nl & 15)) * 64;
    const bool okc = nl < 16;
#pragma unroll
    for (int ks = 0; ks < 8; ++ks) { const int j0 = 4 * ks + 2 * hi; const float2 ra = *(const float2*)(cre + j0), rb2 = *(const float2*)(cre + 32 + j0), ia = *(const float2*)(cim + j0), ib = *(const float2*)(cim + 32 + j0);
        u32x4 w; w.x = pk2(ra.x, rb2.x); w.y = pk2(-ia.x, -ib.x); w.z = pk2(ra.y, rb2.y); w.w = pk2(-ia.y, -ib.y);
        if (!okc) w = (u32x4){0u, 0u, 0u, 0u}; cmf[ks] = __builtin_bit_cast(bf16x8, w); }
    const float dv = p->in[I_S5D][l * 256 + g * 16 + (nl & 15)]; const int jd = nl - 8 * hi;
    const unsigned db = f2bf(dv); u32x4 w = (u32x4){0u, 0u, 0u, 0u};
    if (okc && jd >= 0 && jd < 8) { const unsigned v = (jd & 1) ? (db << 16) : db; if ((jd >> 1) == 0) w.x = v; else if ((jd >> 1) == 1) w.y = v; else if ((jd >> 1) == 2) w.z = v; else w.w = v; }
    dfr = __builtin_bit_cast(bf16x8, w);
}
__device__ __forceinline__ void s5m_table_build(PrmP p, int l, int g, int lane) {
    S5M c; s5m_setup(p, l, g, lane, c); bf16x8 cmf[8]; bf16x8 dfr; s5m_cfrag(p, l, g, lane, cmf, dfr);
    u32x4* tb = (u32x4*)(p->ws + WS_S5T) + (size_t)(l * 16 + g) * 15 * 64 + lane;
    tb[0 * 64] = (u32x4){__float_as_uint(c.ar[0]), __float_as_uint(c.ar[1]), __float_as_uint(c.ai[0]), __float_as_uint(c.ai[1])};
    tb[1 * 64] = (u32x4){__float_as_uint(c.a16r[0]), __float_as_uint(c.a16r[1]), __float_as_uint(c.a16i[0]), __float_as_uint(c.a16i[1])};
#pragma unroll
    for (int q = 0; q < 4; ++q) tb[(2 + q) * 64] = __builtin_bit_cast(u32x4, c.bfr[q]);
#pragma unroll
    for (int q = 0; q < 8; ++q) tb[(6 + q) * 64] = __builtin_bit_cast(u32x4, cmf[q]);
    tb[14 * 64] = __builtin_bit_cast(u32x4, dfr);
}
__device__ __forceinline__ void s5m_load(PrmP p, int l, int g, int lane, S5M& c) {
    const u32x4* tb = (const u32x4*)(p->ws + WS_S5T) + (size_t)(l * 16 + g) * 15 * 64 + lane;
    const u32x4 a = tb[0], b = tb[64];
    c.ar[0] = __uint_as_float(a.x); c.ar[1] = __uint_as_float(a.y); c.ai[0] = __uint_as_float(a.z); c.ai[1] = __uint_as_float(a.w);
    c.a16r[0] = __uint_as_float(b.x); c.a16r[1] = __uint_as_float(b.y); c.a16i[0] = __uint_as_float(b.z); c.a16i[1] = __uint_as_float(b.w);
#pragma unroll
    for (int q = 0; q < 4; ++q) c.bfr[q] = __builtin_bit_cast(bf16x8, tb[(2 + q) * 64]);
}
__device__ __forceinline__ void s5m_load_c(PrmP p, int l, int g, int lane, bf16x8 (&cmf)[8], bf16x8& dfr) {
    const u32x4* tb = (const u32x4*)(p->ws + WS_S5T) + (size_t)(l * 16 + g) * 15 * 64 + lane;
#pragma unroll
    for (int q = 0; q < 8; ++q) cmf[q] = __builtin_bit_cast(bf16x8, tb[(6 + q) * 64]);
    dfr = __builtin_bit_cast(bf16x8, tb[14 * 64]);
}
__device__ __forceinline__ void s5m_bu(const bf16_t* PB, size_t rb, int tb, int g, int lane, const S5M& c, f32x16 (&bu)[4], bf16x8& ufrag) {
    const int i = lane & 31, hi = lane >> 5;
    ufrag = *(const bf16x8*)(PB + (rb + tb + tau32(i)) * NP + C_S5 + 16 * g + 8 * hi);
    const f32x16 z = f32x16{};
#pragma unroll
    for (int q = 0; q < 4; ++q) bu[q] = __builtin_amdgcn_mfma_f32_32x32x16_bf16(ufrag, c.bfr[q], z, 0, 0, 0);
}
__device__ __forceinline__ void s5m_tile_end(const S5M& c, const f32x16 (&bu)[4], float (&xr)[2], float (&xi)[2]) {
#pragma unroll
    for (int s = 0; s < 2; ++s) { float er = bu[s][0], ei = bu[2 + s][0];
#pragma unroll
        for (int r = 1; r < 16; ++r) { const float nr = c.ar[s] * er - c.ai[s] * ei + bu[s][r], ni = c.ar[s] * ei + c.ai[s] * er + bu[2 + s][r]; er = nr; ei = ni; }
        const auto swr_ = __builtin_amdgcn_permlane32_swap(__float_as_uint(er), __float_as_uint(er), false, false), swi_ = __builtin_amdgcn_permlane32_swap(__float_as_uint(ei), __float_as_uint(ei), false, false);
        const float elr = __uint_as_float(swr_[0]), eli = __uint_as_float(swi_[0]), ehr = __uint_as_float(swr_[1]), ehi = __uint_as_float(swi_[1]);
        const float t1r = c.a16r[s] * xr[s] - c.a16i[s] * xi[s] + elr, t1i = c.a16r[s] * xi[s] + c.a16i[s] * xr[s] + eli;
        xr[s] = c.a16r[s] * t1r - c.a16i[s] * t1i + ehr; xi[s] = c.a16r[s] * t1i + c.a16i[s] * t1r + ehi; }
}
__device__ __forceinline__ void fs_scan(PrmP p, int l, LAS unsigned char* lds, int wg, int nwg) {
    const int tid = fresh_tid(), lane = tid & 63, wave = tid >> 6;
    f2_items(p, l, lds, wg, nwg);
    const bf16_t* PB = (const bf16_t*)(p->ws + WS_PB);
    { bf16_t* HLOC = (bf16_t*)(p->ws + WS_YL); bf16_t* PCUM = (bf16_t*)(p->ws + WS_YS0); float* AGG = (float*)(p->ws + WS_AGG);
      LAS unsigned char* xa = lds + wave * 13312; LAS unsigned char* xf = xa + 4608;
      const int nl = lane & 31, hi = lane >> 5;
      for (int it = wave * nwg + wg; it < 2048; it += nwg * NWAVES) {
        const int b = it >> 9, c = (it >> 2) & 127, blk = it & 3; const size_t rb = (size_t)b * T; const int t0 = c * 64;
        const bf16_t* wt = (const bf16_t*)(p->ws + WS_LRUW) + (size_t)(l * 4 + blk) * 2 * 4096 + (size_t)nl * 64 + 8 * hi;
        const int chc = blk * 64 + lane;
        const float cw0 = p->in[I_CONVW][(l * 4 + 0) * 256 + chc], cw1 = p->in[I_CONVW][(l * 4 + 1) * 256 + chc], cw2 = p->in[I_CONVW][(l * 4 + 2) * 256 + chc], cw3 = p->in[I_CONVW][(l * 4 + 3) * 256 + chc], cb = p->in[I_CONVB][l * 256 + chc];
        float ba[2], bx[2], sp8[2];
#pragma unroll
        for (int s2 = 0; s2 < 2; ++s2) { const int ch = blk * 64 + 32 * s2 + nl; ba[s2] = p->in[I_LRUBA][l * 256 + ch]; bx[s2] = p->in[I_LRUBX][l * 256 + ch]; sp8[s2] = -8.f * log1pf(expf(-p->in[I_LAMBDA][l * 256 + ch])); }
        float x1 = (t0 >= 1) ? bf2f(PB[(rb + t0 - 1) * NP + C_LX + chc]) : 0.f, x2 = (t0 >= 2) ? bf2f(PB[(rb + t0 - 2) * NP + C_LX + chc]) : 0.f, x3 = (t0 >= 3) ? bf2f(PB[(rb + t0 - 3) * NP + C_LX + chc]) : 0.f;
        float hin[2] = {0.f, 0.f}, pin[2] = {1.f, 1.f};
#pragma unroll 1
        for (int mt = 0; mt < 2; ++mt) { const int tb = t0 + mt * 32;
#pragma unroll 1
            for (int th = 0; th < 32; th += 16) { float xin[16];
#pragma unroll
              for (int tt = 0; tt < 16; ++tt) xin[tt] = bf2f(PB[(rb + tb + th + tt) * NP + C_LX + chc]);
#pragma unroll
              for (int tt = 0; tt < 16; ++tt) { const float xr = cb + cw0 * x3 + cw1 * x2 + cw2 * x1 + cw3 * xin[tt]; x3 = x2; x2 = x1; x1 = xin[tt];
                  *(LAS bf16_t*)(xa + (th + tt) * 144 + lane * 2) = (bf16_t)f2bf(xr); *(LAS float*)(xf + (th + tt) * 272 + lane * 4) = xr; } }
            asm volatile("s_waitcnt lgkmcnt(0)" ::: "memory");
            f32x16 acc[4];
#pragma unroll
            for (int q = 0; q < 4; ++q) acc[q] = f32x16{};
#pragma unroll
            for (int ks = 0; ks < 4; ++ks) { const bf16x8 af = *(const LAS bf16x8*)(xa + tau32(nl) * 144 + (16 * ks + 8 * hi) * 2);
#pragma unroll
                for (int q = 0; q < 4; ++q) { const bf16x8 wfr = *(const bf16x8*)(wt + ((size_t)(q >> 1) * 64 + 32 * (q & 1)) * 64 + 16 * ks); acc[q] = __builtin_amdgcn_mfma_f32_32x32x16_bf16(af, wfr, acc[q], 0, 0, 0); } }
#pragma unroll
            for (int s2 = 0; s2 < 2; ++s2) { const int ch = blk * 64 + 32 * s2 + nl;
                float hl[16], pl[16]; float h = 0.f, P = 1.f;
#pragma unroll
                for (int r = 0; r < 16; ++r) { const float xr = *(const LAS float*)(xf + (16 * hi + r) * 272 + (32 * s2 + nl) * 4);
                    const float rg = sigmoidf_(acc[s2][r] + ba[s2]), ig = sigmoidf_(acc[2 + s2][r] + bx[s2]);
                    const float la = sp8[s2] * rg, a = __expf(la), x2a = 2.f * la;
                    const float om = (x2a > -0.125f) ? -x2a * (1.f + x2a * (0.5f + x2a * (0.16666667f + x2a * 0.041666668f))) : 1.f - a * a;
                    h = a * h + xr * ig * __builtin_amdgcn_sqrtf(om); P *= a; hl[r] = h; pl[r] = P; }
                const float h0e = __shfl(h, nl), p0e = __shfl(P, nl);
                const float hs = hi ? h0e + p0e * hin[s2] : hin[s2], ps = hi ? pin[s2] * p0e : pin[s2];
#pragma unroll
                for (int r = 0; r < 16; ++r) { const size_t m = rb + tb + 16 * hi + r; HLOC[m * 256 + ch] = (bf16_t)f2bf(hl[r] + pl[r] * hs); PCUM[m * 256 + ch] = (bf16_t)f2bf(pl[r] * ps); }
                const float he = hl[15] + pl[15] * hs, pe = pl[15] * ps;
                hin[s2] = __shfl(he, 32 + nl); pin[s2] = __shfl(pe, 32 + nl); }
            asm volatile("s_waitcnt lgkmcnt(0)" ::: "memory");
        }
        if (hi == 0) {
#pragma unroll
            for (int s2 = 0; s2 < 2; ++s2) { const int ch = blk * 64 + 32 * s2 + nl; AGG[((size_t)(b * 128 + c) * 2 + 0) * 256 + ch] = pin[s2]; AGG[((size_t)(b * 128 + c) * 2 + 1) * 256 + ch] = hin[s2]; } }
      }
    }
    { unsigned* NRM = (unsigned*)(p->ws + WS_CTL) + CW_NRM;
      for (int it = wg; it < M / 128; it += nwg) { const int b = it / (T / 128); float mq = 0.f, mk = 0.f;
#pragma unroll 1
        for (int r8 = 0; r8 < 2; ++r8) { u32x4 qwv[8], kwv[8];
#pragma unroll
          for (int q8 = 0; q8 < 8; ++q8) { const size_t m = (size_t)it * 128 + wave * 16 + r8 * 8 + q8; qwv[q8] = *(const u32x4*)(PB + m * NP + C_Q + 8 * lane); kwv[q8] = *(const u32x4*)(PB + m * NP + C_K + 8 * lane); }
#pragma unroll
          for (int q8 = 0; q8 < 8; ++q8) { const u32x4 qw = qwv[q8], kw = kwv[q8];
            float sq = bflo(qw.x) * bflo(qw.x) + bfhi(qw.x) * bfhi(qw.x) + bflo(qw.y) * bflo(qw.y) + bfhi(qw.y) * bfhi(qw.y) + bflo(qw.z) * bflo(qw.z) + bfhi(qw.z) * bfhi(qw.z) + bflo(qw.w) * bflo(qw.w) + bfhi(qw.w) * bfhi(qw.w);
            float sk = bflo(kw.x) * bflo(kw.x) + bfhi(kw.x) * bfhi(kw.x) + bflo(kw.y) * bflo(kw.y) + bfhi(kw.y) * bfhi(kw.y) + bflo(kw.z) * bflo(kw.z) + bfhi(kw.z) * bfhi(kw.z) + bflo(kw.w) * bflo(kw.w) + bfhi(kw.w) * bfhi(kw.w);
#pragma unroll
            for (int o = 0; o < 1; ++o) { sq += dppf<DPP_XOR1>(sq); sk += dppf<DPP_XOR1>(sk); sq += dppf<DPP_XOR2>(sq); sk += dppf<DPP_XOR2>(sk); sq += dppf<DPP_HMIRROR>(sq); sk += dppf<DPP_HMIRROR>(sk); }
            mq = fmaxf(mq, sq); mk = fmaxf(mk, sk); } }
        if ((lane & 7) == 0) { const int hh = lane >> 3, bh = b * 8 + hh, il = it % (T / 128); atomicMax(NRM + (l * 32 + bh) * 2, __float_as_uint(mq)); atomicMax(NRM + (l * 32 + bh) * 2 + 1, __float_as_uint(mk));
            unsigned* CT = (unsigned*)(p->ws + WS_CTL); atomicMax(CT + CW_QN + (l * 32 + bh) * 32 + (il >> 1), __float_as_uint(mq)); atomicMax(CT + CW_KT + (l * 32 + bh) * 128 + il * 2 + (wave >> 2), __float_as_uint(mk)); } }
    }
    { float* XEND = (float*)(p->ws + WS_XEND);
      for (int it = wave * nwg + wg; it < 2048; it += nwg * NWAVES) {
        const int b = it >> 9, g = (it >> 5) & 15, cq = it & 31;
        S5M cf; s5m_load(p, l, g, lane, cf);
        float a64r[2], a64i[2], x4r[2] = {0.f, 0.f}, x4i[2] = {0.f, 0.f};
#pragma unroll
        for (int s2 = 0; s2 < 2; ++s2) { float pr = cf.a16r[s2], pi_ = cf.a16i[s2];
#pragma unroll
            for (int q = 0; q < 2; ++q) { const float nr = pr * pr - pi_ * pi_, ni = 2.f * pr * pi_; pr = nr; pi_ = ni; }
            a64r[s2] = pr; a64i[s2] = pi_; }
        bf16x8 ufs[8];
#pragma unroll
        for (int t8 = 0; t8 < 8; ++t8) ufs[t8] = *(const bf16x8*)(PB + ((size_t)b * T + cq * 256 + t8 * 32 + tau32(lane & 31)) * NP + C_S5 + 16 * g + 8 * (lane >> 5));
#pragma unroll
        for (int k = 0; k < 4; ++k) { const int c = cq * 4 + k; float xr[2] = {0.f, 0.f}, xi[2] = {0.f, 0.f};
#pragma unroll
            for (int mt = 0; mt < 2; ++mt) { f32x16 bu[4]; const f32x16 z = f32x16{};
#pragma unroll
                for (int q = 0; q < 4; ++q) bu[q] = __builtin_amdgcn_mfma_f32_32x32x16_bf16(ufs[2 * k + mt], cf.bfr[q], z, 0, 0, 0);
                s5m_tile_end(cf, bu, xr, xi); }
#pragma unroll
            for (int s2 = 0; s2 < 2; ++s2) { const float nr = a64r[s2] * x4r[s2] - a64i[s2] * x4i[s2] + xr[s2], ni = a64r[s2] * x4i[s2] + a64i[s2] * x4r[s2] + xi[s2]; x4r[s2] = nr; x4i[s2] = ni; }
            if (lane < 32) { float* xe = XEND + ((size_t)((b * 16 + g) * 128 + c) * 64) * 2;
                *(float2*)(xe + lane * 2) = make_float2(xr[0], xi[0]); *(float2*)(xe + (32 + lane) * 2) = make_float2(xr[1], xi[1]); } }
        if (lane < 32) { float* xe = (float*)(p->ws + WS_X4END) + ((size_t)((b * 16 + g) * 32 + cq) * 64) * 2;
            *(float2*)(xe + lane * 2) = make_float2(x4r[0], x4i[0]); *(float2*)(xe + (32 + lane) * 2) = make_float2(x4r[1], x4i[1]); }
      }
    }
}

constexpr int FIN_YSB = 0, FIN_XST = 34816, FIN_CAR = FIN_XST + 8 * 8704;
static_assert(64 * 264 * 2 <= FIN_XST && FIN_CAR + 1024 <= 131072, "finalize LDS map");
__device__ __forceinline__ void fs_fin(PrmP p, int l, LAS unsigned char* lds, int wg, int nwg) {
    const int tid = fresh_tid(), lane = tid & 63, wave = tid >> 6, fr = lane & 15, fq = lane >> 4, nl = lane & 31, hi = lane >> 5;
    const bf16_t* PB = (const bf16_t*)(p->ws + WS_PB); bf16_t* YC = (bf16_t*)(p->ws + WS_YC);
    const bf16_t* HLOC = (const bf16_t*)(p->ws + WS_YL); const bf16_t* PCUM = (const bf16_t*)(p->ws + WS_YS0); const float* AGG = (const float*)(p->ws + WS_AGG); const float* XEND = (const float*)(p->ws + WS_XEND);
    LAS bf16_t* ysb = (LAS bf16_t*)(lds + FIN_YSB); LAS unsigned char* xst = lds + FIN_XST + wave * 8704; LAS float* car = (LAS float*)(lds + FIN_CAR);
    for (int it = wg; it < NB * 128; it += nwg) {
        const int b = it >> 7, c = it & 127, t0 = c * 64; const size_t rb = (size_t)b * T;
        __syncthreads();
        if (tid < 256) { float cr = 0.f; const float* ag = AGG + (size_t)(b * 128) * 512 + (fresh_tid() & 255); int cc = 0;
            for (; cc + 8 <= c; cc += 8) { float A[8], H[8];
#pragma unroll
                for (int q = 0; q < 8; ++q) { A[q] = ag[(size_t)(cc + q) * 512]; H[q] = ag[(size_t)(cc + q) * 512 + 256]; }
#pragma unroll
                for (int q = 0; q < 8; ++q) cr = A[q] * cr + H[q]; }
            for (; cc < c; ++cc) cr = ag[(size_t)cc * 512] * cr + ag[(size_t)cc * 512 + 256];
            car[tid] = cr; }
#pragma unroll 1
        for (int gi = 0; gi < 2; ++gi) { const int g = wave + 8 * gi;
            S5M cf; s5m_load(p, l, g, lane, cf);
            bf16x8 cmf[8]; bf16x8 dfr; s5m_load_c(p, l, g, lane, cmf, dfr);
            float xr[2] = {0.f, 0.f}, xi[2] = {0.f, 0.f};
            { float a64r[2], a64i[2];
#pragma unroll
              for (int s = 0; s < 2; ++s) { float pr = cf.a16r[s], pi_ = cf.a16i[s];
#pragma unroll
                  for (int q = 0; q < 2; ++q) { const float nr = pr * pr - pi_ * pi_, ni = 2.f * pr * pi_; pr = nr; pi_ = ni; }
                  a64r[s] = pr; a64i[s] = pi_; }
              float a256r[2], a256i[2];
#pragma unroll
              for (int s = 0; s < 2; ++s) { float pr = a64r[s], pi_ = a64i[s];
#pragma unroll
                  for (int q = 0; q < 2; ++q) { const float nr = pr * pr - pi_ * pi_, ni = 2.f * pr * pi_; pr = nr; pi_ = ni; }
                  a256r[s] = pr; a256i[s] = pi_; }
              const float* x4 = (const float*)(p->ws + WS_X4END) + ((size_t)((b * 16 + g) * 32) * 64) * 2 + nl * 2;
              const int nb4 = c >> 2; int cb = 0;
              for (; cb + 4 <= nb4; cb += 4) { float2 e0[4], e1[4];
#pragma unroll
                  for (int q = 0; q < 4; ++q) { e0[q] = *(const float2*)(x4 + (size_t)(cb + q) * 128); e1[q] = *(const float2*)(x4 + (size_t)(cb + q) * 128 + 64); }
#pragma unroll
                  for (int q = 0; q < 4; ++q) {
                      float nr = a256r[0] * xr[0] - a256i[0] * xi[0] + e0[q].x, ni = a256r[0] * xi[0] + a256i[0] * xr[0] + e0[q].y; xr[0] = nr; xi[0] = ni;
                      nr = a256r[1] * xr[1] - a256i[1] * xi[1] + e1[q].x; ni = a256r[1] * xi[1] + a256i[1] * xr[1] + e1[q].y; xr[1] = nr; xi[1] = ni; } }
              for (; cb < nb4; ++cb) { const float2 e0 = *(const float2*)(x4 + (size_t)cb * 128), e1 = *(const float2*)(x4 + (size_t)cb * 128 + 64);
                  float nr = a256r[0] * xr[0] - a256i[0] * xi[0] + e0.x, ni = a256r[0] * xi[0] + a256i[0] * xr[0] + e0.y; xr[0] = nr; xi[0] = ni;
                  nr = a256r[1] * xr[1] - a256i[1] * xi[1] + e1.x; ni = a256r[1] * xi[1] + a256i[1] * xr[1] + e1.y; xr[1] = nr; xi[1] = ni; }
              const float* xe = XEND + ((size_t)((b * 16 + g) * 128) * 64) * 2 + nl * 2;
              for (int cc = nb4 * 4; cc < c; ++cc) { const float2 e0 = *(const float2*)(xe + (size_t)cc * 128), e1 = *(const float2*)(xe + (size_t)cc * 128 + 64);
                  float nr = a64r[0] * xr[0] - a64i[0] * xi[0] + e0.x, ni = a64r[0] * xi[0] + a64i[0] * xr[0] + e0.y; xr[0] = nr; xi[0] = ni;
                  nr = a64r[1] * xr[1] - a64i[1] * xi[1] + e1.x; ni = a64r[1] * xi[1] + a64i[1] * xr[1] + e1.y; xr[1] = nr; xi[1] = ni; } }
#pragma unroll 1
            for (int mt = 0; mt < 2; ++mt) {
                f32x16 bu[4]; bf16x8 uf; s5m_bu(PB, rb, t0 + mt * 32, g, lane, cf, bu, uf);
#pragma unroll
                for (int s = 0; s < 2; ++s) {
#pragma unroll
                    for (int r = 1; r < 16; ++r) { const float pr = bu[s][r - 1], pi_ = bu[2 + s][r - 1]; bu[s][r] += cf.ar[s] * pr - cf.ai[s] * pi_; bu[2 + s][r] += cf.ar[s] * pi_ + cf.ai[s] * pr; }
                    const float er = bu[s][15], ei = bu[2 + s][15];
                    const auto swr_ = __builtin_amdgcn_permlane32_swap(__float_as_uint(er), __float_as_uint(er), false, false), swi_ = __builtin_amdgcn_permlane32_swap(__float_as_uint(ei), __float_as_uint(ei), false, false);
                    const float elr = __uint_as_float(swr_[0]), eli = __uint_as_float(swi_[0]), ehr = __uint_as_float(swr_[1]), ehi = __uint_as_float(swi_[1]);
                    const float t1r = cf.a16r[s] * xr[s] - cf.a16i[s] * xi[s] + elr, t1i = cf.a16r[s] * xi[s] + cf.a16i[s] * xr[s] + eli;
                    float wr = hi ? t1r : xr[s], wi = hi ? t1i : xi[s];
                    xr[s] = cf.a16r[s] * t1r - cf.a16i[s] * t1i + ehr; xi[s] = cf.a16r[s] * t1i + cf.a16i[s] * t1r + ehi;
#pragma unroll
                    for (int r = 0; r < 16; ++r) { const float nr = cf.ar[s] * wr - cf.ai[s] * wi, ni = cf.ar[s] * wi + cf.ai[s] * wr; wr = nr; wi = ni; bu[s][r] += wr; bu[2 + s][r] += wi; }
                }
#pragma unroll
                for (int r = 0; r < 16; ++r) { u32x2 w; w.x = pk2(bu[0][r], bu[1][r]); w.y = pk2(bu[2][r], bu[3][r]); *(LAS u32x2*)(xst + (16 * hi + r) * 272 + nl * 8) = w; }
                asm volatile("s_waitcnt lgkmcnt(0)" ::: "memory");
                f32x16 acc = __builtin_amdgcn_mfma_f32_32x32x16_bf16(uf, dfr, f32x16{}, 0, 0, 0);
#pragma unroll
                for (int ks = 0; ks < 8; ++ks) { const bf16x8 af = *(const LAS bf16x8*)(xst + tau32(nl) * 272 + (16 * ks + 8 * hi) * 2); acc = __builtin_amdgcn_mfma_f32_32x32x16_bf16(af, cmf[ks], acc, 0, 0, 0); }
                if (nl < 16) {
#pragma unroll
                    for (int r = 0; r < 16; ++r) ysb[(mt * 32 + 16 * hi + r) * 264 + g * 16 + nl] = (bf16_t)f2bf(gelu_tanh(acc[r])); }
                asm volatile("s_waitcnt lgkmcnt(0)" ::: "memory");
            }
        }
        __syncthreads();
        { const bf16_t* GW = (const bf16_t*)(p->ws + WS_GLUW) + (size_t)l * 65536;
          f32x4 acc[4][2];
#pragma unroll
          for (int m = 0; m < 4; ++m) { acc[m][0] = (f32x4){0.f, 0.f, 0.f, 0.f}; acc[m][1] = (f32x4){0.f, 0.f, 0.f, 0.f}; }
#pragma unroll 2
          for (int ks = 0; ks < 8; ++ks) { bf16x8 a[4], bb[2];
#pragma unroll
              for (int m = 0; m < 4; ++m) a[m] = *(const LAS bf16x8*)(ysb + (m * 16 + fr) * 264 + ks * 32 + 8 * fq);
#pragma unroll
              for (int n = 0; n < 2; ++n) bb[n] = *(const bf16x8*)(GW + (size_t)((2 * wave + n) * 16 + fr) * 256 + ks * 32 + 8 * fq);
#pragma unroll
              for (int m = 0; m < 4; ++m)
#pragma unroll
                  for (int n = 0; n < 2; ++n) acc[m][n] = __builtin_amdgcn_mfma_f32_16x16x32_bf16(a[m], bb[n], acc[m][n], 0, 0, 0); }
          __syncthreads();
#pragma unroll
          for (int n = 0; n < 2; ++n) { const int j = (2 * wave + n) * 16 + fr; const float gb = p->in[I_GLUB][l * 256 + j];
#pragma unroll
              for (int m = 0; m < 4; ++m)
#pragma unroll
                  for (int r = 0; r < 4; ++r) { const int tk = m * 16 + 4 * fq + r; const float y = bf2f(ysb[tk * 264 + j]); ysb[tk * 264 + j] = (bf16_t)f2bf(y * sigmoidf_(acc[m][n][r] + gb)); } }
        }
        __syncthreads();
        { const f32x4 ggl = *(const f32x4*)(p->in[I_GNLRU] + l * 256 + 4 * lane), ggs = *(const f32x4*)(p->in[I_GNS5] + l * 256 + 4 * lane);
          const f32x4 g0 = *(const f32x4*)(p->in[I_GNATT] + l * 512 + 8 * lane), g1 = *(const f32x4*)(p->in[I_GNATT] + l * 512 + 8 * lane + 4); const f32x4 cr = *(const LAS f32x4*)(car + 4 * lane);
#pragma unroll 1
          for (int rq = 0; rq < 2; ++rq) {
            u32x2 hw[4], pw[4], gw[4]; u32x4 ow[4];
#pragma unroll
            for (int q = 0; q < 4; ++q) { const size_t m = rb + t0 + wave + 8 * (4 * rq + q);
                hw[q] = *(const u32x2*)(HLOC + m * 256 + 4 * lane); pw[q] = *(const u32x2*)(PCUM + m * 256 + 4 * lane); gw[q] = *(const u32x2*)(PB + m * NP + C_LG + 4 * lane); ow[q] = *(const u32x4*)(PB + m * NP + C_Q + 8 * lane); }
#pragma unroll
            for (int q = 0; q < 4; ++q) { const int r = wave + 8 * (4 * rq + q); const size_t m = rb + t0 + r;
              { const f32x4 hl = (f32x4){bflo(hw[q].x), bfhi(hw[q].x), bflo(hw[q].y), bfhi(hw[q].y)}, pc = (f32x4){bflo(pw[q].x), bfhi(pw[q].x), bflo(pw[q].y), bfhi(pw[q].y)};
                f32x4 v; v.x = (hl.x + pc.x * cr.x) * gelu_tanh(bflo(gw[q].x)); v.y = (hl.y + pc.y * cr.y) * gelu_tanh(bfhi(gw[q].x)); v.z = (hl.z + pc.z * cr.z) * gelu_tanh(bflo(gw[q].y)); v.w = (hl.w + pc.w * cr.w) * gelu_tanh(bfhi(gw[q].y));
                const float rs = __builtin_amdgcn_rsqf(wave_sum(v.x * v.x + v.y * v.y + v.z * v.z + v.w * v.w) * (1.f / 256.f) + RMS_EPS);
                u32x2 o; o.x = pk2(v.x * rs * ggl.x, v.y * rs * ggl.y); o.y = pk2(v.z * rs * ggl.z, v.w * rs * ggl.w); *(u32x2*)(YC + m * 1024 + 4 * lane) = o; }
              { const u32x2 yw = *(const LAS u32x2*)(ysb + r * 264 + 4 * lane); const f32x4 v = (f32x4){bflo(yw.x), bfhi(yw.x), bflo(yw.y), bfhi(yw.y)};
                const float rs = __builtin_amdgcn_rsqf(wave_sum(v.x * v.x + v.y * v.y + v.z * v.z + v.w * v.w) * (1.f / 256.f) + RMS_EPS);
                u32x2 o; o.x = pk2(v.x * rs * ggs.x, v.y * rs * ggs.y); o.y = pk2(v.z * rs * ggs.z, v.w * rs * ggs.w); *(u32x2*)(YC + m * 1024 + 256 + 4 * lane) = o; }
              { const u32x4 w = ow[q];
                const float v[8] = {bflo(w.x), bfhi(w.x), bflo(w.y), bfhi(w.y), bflo(w.z), bfhi(w.z), bflo(w.w), bfhi(w.w)};
                float ss = 0.f;
#pragma unroll
                for (int i = 0; i < 8; ++i) ss += v[i] * v[i];
                const float rs = __builtin_amdgcn_rsqf(wave_sum(ss) * (1.f / 512.f) + RMS_EPS);
                u32x4 o; o.x = pk2(v[0] * rs * g0.x, v[1] * rs * g0.y); o.y = pk2(v[2] * rs * g0.z, v[3] * rs * g0.w); o.z = pk2(v[4] * rs * g1.x, v[5] * rs * g1.y); o.w = pk2(v[6] * rs * g1.z, v[7] * rs * g1.w);
                *(u32x4*)(YC + m * 1024 + 512 + 8 * lane) = o; } } } }
    }
}

constexpr int ROW_WT = 0, ROW_WT_LD = 1028, ROW_ETAB = 131584 + 64;
__device__ __forceinline__ void ph_row(PrmP p, int l, LAS unsigned char* lds, int wg, int nwg) {
    const int tid = fresh_tid(), lane = tid & 63, wave = tid >> 6;
    const int R = M / nwg;
    const float* Xin = p->in[I_X]; bf16_t* XB = (bf16_t*)(p->ws + WS_XB); const bf16_t* Y = (const bf16_t*)(p->ws + WS_Y);
    const float* MOD = (const float*)(p->ws + WS_MOD); bf16_t* HB = (bf16_t*)(p->ws + WS_HB);
    int* TOPI = (int*)(p->ws + WS_MISC + MS_TOPI); float* TOPG = (float*)(p->ws + WS_MISC + MS_TOPG); int* RANK = (int*)(p->ws + WS_MISC + MS_RANK); int* HIST = (int*)(p->ws + WS_MISC + MS_HIST);
    LAS int* etab = (LAS int*)(lds + ROW_ETAB);
    LAS float* wt = (LAS float*)(lds + ROW_WT);
    const float* RW = p->in[I_ROUTW] + (size_t)l * 1024 * 32; const float* RB = p->in[I_ROUTB] + l * 32;
    __syncthreads();
    { f32x4 wv[16];
#pragma unroll
      for (int k = 0; k < 16; ++k) wv[k] = *(const f32x4*)(RW + tid * 4 + 2048 * k);
#pragma unroll
      for (int k = 0; k < 16; ++k) { const int i = tid * 4 + 2048 * k, e = i & 31, d = i >> 5; wt[e * ROW_WT_LD + d] = wv[k].x; wt[(e + 1) * ROW_WT_LD + d] = wv[k].y; wt[(e + 2) * ROW_WT_LD + d] = wv[k].z; wt[(e + 3) * ROW_WT_LD + d] = wv[k].w; } }
    __syncthreads();
    const float rbias = RB[(lane >> 1) & 31];
    const int RPW = R / NWAVES; constexpr int NR = 2;
    u32x2 ywn[NR][4]; f32x4 xfn[NR][4]; u32x2 xbn[NR][4];
#define ROW_LOAD(r0_) do { _Pragma("unroll") for (int q = 0; q < NR; ++q) _Pragma("unroll") for (int j = 0; j < 4; ++j) { const size_t mm_ = (size_t)wg * R + (r0_) + q; const int c_ = 4 * lane + 256 * j; \
        ywn[q][j] = *(const u32x2*)(Y + mm_ * 1024 + c_); if (l == 0) xfn[q][j] = *(const f32x4*)(Xin + mm_ * 1024 + c_); else xbn[q][j] = *(const u32x2*)(XB + mm_ * 1024 + c_); } } while (0)
    ROW_LOAD(wave * RPW);
    for (int r0 = wave * RPW; r0 < (wave + 1) * RPW; r0 += NR) {
        const size_t m0 = (size_t)wg * R + r0; const int b = (int)(m0 / T);
        const float* mod = MOD + (size_t)(l * 4 + b) * 6144;
        u32x2 ywc[NR][4]; f32x4 xfc[NR][4];
#pragma unroll
        for (int q = 0; q < NR; ++q)
#pragma unroll
            for (int j = 0; j < 4; ++j) { ywc[q][j] = ywn[q][j]; if (l == 0) xfc[q][j] = xfn[q][j]; else xfc[q][j] = (f32x4){bflo(xbn[q][j].x), bfhi(xbn[q][j].x), bflo(xbn[q][j].y), bfhi(xbn[q][j].y)}; }
        if (r0 + NR < (wave + 1) * RPW) ROW_LOAD(r0 + NR);
        f32x4 h[NR][4];
        { f32x4 y[NR][4]; float ss[NR] = {};
#pragma unroll
          for (int q = 0; q < NR; ++q)
#pragma unroll
              for (int j = 0; j < 4; ++j) { const u32x2 yw = ywc[q][j]; y[q][j] = (f32x4){bflo(yw.x), bfhi(yw.x), bflo(yw.y), bfhi(yw.y)}; ss[q] += (y[q][j].x * y[q][j].x + y[q][j].y * y[q][j].y) + (y[q][j].z * y[q][j].z + y[q][j].w * y[q][j].w); }
          float rstd[NR], s2[NR] = {};
#pragma unroll
          for (int q = 0; q < NR; ++q) rstd[q] = __builtin_amdgcn_rsqf(wave_sum(ss[q]) * (1.f / 1024.f) + RMS_EPS);
#pragma unroll
          for (int j = 0; j < 4; ++j) { const int c = 4 * lane + 256 * j; const f32x4 g = *(const f32x4*)(p->in[I_POSTMIXG] + l * 1024 + c), gate = *(const f32x4*)(mod + 2 * 1024 + c);
#pragma unroll
              for (int q = 0; q < NR; ++q) { const f32x4 x0 = xfc[q][j];
                  const f32x4 x = x0 + gate * (y[q][j] * rstd[q] * g); { u32x2 xo; xo.x = pk2(x.x, x.y); xo.y = pk2(x.z, x.w); *(u32x2*)(XB + (m0 + q) * 1024 + c) = xo; } h[q][j] = x;
                  s2[q] += (x.x * x.x + x.y * x.y) + (x.z * x.z + x.w * x.w); } }
          float rstd2[NR];
#pragma unroll
          for (int q = 0; q < NR; ++q) rstd2[q] = __builtin_amdgcn_rsqf(wave_sum(s2[q]) * (1.f / 1024.f) + RMS_EPS);
#pragma unroll
          for (int j = 0; j < 4; ++j) { const int c = 4 * lane + 256 * j; const f32x4 g = *(const f32x4*)(p->in[I_PREFFNG] + l * 1024 + c), sc = *(const f32x4*)(mod + 4 * 1024 + c), sh = *(const f32x4*)(mod + 3 * 1024 + c);
#pragma unroll
              for (int q = 0; q < NR; ++q) { h[q][j] = h[q][j] * rstd2[q] * g * (sc + 1.f) + sh;
                  if (EXPERT_FP8) *(unsigned*)((unsigned char*)HB + (m0 + q) * 1024 + c) = pk4_fp8(4.f * h[q][j].x, 4.f * h[q][j].y, 4.f * h[q][j].z, 4.f * h[q][j].w);
                  else { u32x2 o; o.x = pk2(h[q][j].x, h[q][j].y); o.y = pk2(h[q][j].z, h[q][j].w); *(u32x2*)(HB + (m0 + q) * 1024 + c) = o; } } } }
        float v16[NR][16];
        const bool b5 = lane & 32;
#pragma unroll
        for (int i = 0; i < 16; ++i) { float lo[NR], hi[NR]; f32x2h_ lo2[NR], hi2[NR];
#pragma unroll
            for (int q = 0; q < NR; ++q) { lo2[q] = (f32x2h_){0.f, 0.f}; hi2[q] = (f32x2h_){0.f, 0.f}; }
#pragma unroll
            for (int j = 0; j < 4; ++j) { const f32x4 wl = *(const LAS f32x4*)(wt + i * ROW_WT_LD + 4 * lane + 256 * j), wh = *(const LAS f32x4*)(wt + (i + 16) * ROW_WT_LD + 4 * lane + 256 * j);
                const f32x2h_ wl0 = {wl.x, wl.y}, wl1 = {wl.z, wl.w}, wh0 = {wh.x, wh.y}, wh1 = {wh.z, wh.w};
#pragma unroll
                for (int q = 0; q < NR; ++q) { const f32x2h_ h0 = {h[q][j].x, h[q][j].y}, h1 = {h[q][j].z, h[q][j].w};
                    lo2[q] = __builtin_elementwise_fma(h0, wl0, lo2[q]); lo2[q] = __builtin_elementwise_fma(h1, wl1, lo2[q]); hi2[q] = __builtin_elementwise_fma(h0, wh0, hi2[q]); hi2[q] = __builtin_elementwise_fma(h1, wh1, hi2[q]); } }
#pragma unroll
            for (int q = 0; q < NR; ++q) { lo[q] = lo2[q].x + lo2[q].y; hi[q] = hi2[q].x + hi2[q].y; }
#pragma unroll
            for (int q = 0; q < NR; ++q) { const auto sw = __builtin_amdgcn_permlane32_swap(__float_as_uint(lo[q]), __float_as_uint(hi[q]), false, false);
                v16[q][i] = __uint_as_float(sw[0]) + __uint_as_float(sw[1]); } }
#pragma unroll
        for (int q = 0; q < NR; ++q) { const int r = r0 + q; const size_t m = m0 + q;
            float v8[8], v4[4], v2[2], mine;
            { const bool b4 = lane & 16, b3 = lane & 8, b2 = lane & 4, b1 = lane & 2;
#pragma unroll
              for (int i = 0; i < 8; ++i) { const auto sw = __builtin_amdgcn_permlane16_swap(__float_as_uint(v16[q][i]), __float_as_uint(v16[q][i + 8]), false, false); v8[i] = __uint_as_float(sw[0]) + __uint_as_float(sw[1]); }
#pragma unroll
              for (int i = 0; i < 4; ++i) { const float rcv = dppf<DPP_ROR8>(b3 ? v8[i] : v8[i + 4]); v4[i] = (b3 ? v8[i + 4] : v8[i]) + rcv; }
#pragma unroll
              for (int i = 0; i < 2; ++i) { const float rcv = dppf<DPP_HMIRROR>(dppf<DPP_REV4>(b2 ? v4[i] : v4[i + 2])); v2[i] = (b2 ? v4[i + 2] : v4[i]) + rcv; }
              { const float rcv = dppf<DPP_XOR2>(b1 ? v2[0] : v2[1]); mine = (b1 ? v2[1] : v2[0]) + rcv; }
              mine += dppf<DPP_XOR1>(mine); (void)b4; }
            mine += rbias;
            if (lane & 1) mine = -3e38f;
            float tv[4]; int ti[4];
#pragma unroll
            for (int k = 0; k < 4; ++k) { const float mx = wave_max(mine);
                const unsigned long long bal = __ballot(mine == mx && !(lane & 1)); const int wl_ = __ffsll((long long)bal) - 1;
                tv[k] = mx; ti[k] = wl_ >> 1; if (lane == wl_) mine = -3e38f; }
            const float e1 = __expf(tv[1] - tv[0]), e2 = __expf(tv[2] - tv[0]), e3 = __expf(tv[3] - tv[0]); const float inv = __builtin_amdgcn_rcpf(1.f + e1 + e2 + e3);
            if (lane < 4) { const int id = (lane == 0) ? ti[0] : (lane == 1) ? ti[1] : (lane == 2) ? ti[2] : ti[3]; const float gv = ((lane == 0) ? 1.f : (lane == 1) ? e1 : (lane == 2) ? e2 : e3) * inv;
                TOPI[m * 4 + lane] = id; TOPG[m * 4 + lane] = gv; etab[r * 4 + lane] = id; } }
    }
    __syncthreads();
    const int NEn = R * 4;
    if (NEn == NTHREADS) {
        LAS int* wcnt = etab + NTHREADS;
        const int e = etab[tid]; int myrank = 0;
#pragma unroll 4
        for (int q = 0; q < 32; ++q) { const unsigned long long mk = __ballot(e == q); if (e == q) myrank = __popcll(mk & ((1ull << lane) - 1ull)); if (lane == q) wcnt[wave * 32 + q] = __popcll(mk); }
        __syncthreads();
        int pre = 0; for (int w = 0; w < wave; ++w) pre += wcnt[w * 32 + e];
        RANK[(size_t)wg * NEn + tid] = pre + myrank;
        if (tid < 32) { int c = 0;
#pragma unroll
            for (int w = 0; w < NWAVES; ++w) c += wcnt[w * 32 + tid];
            HIST[wg * 32 + tid] = c; }
    } else {
    if (tid < NEn) { const int e = etab[tid]; int rk = 0; for (int j = 0; j < tid; ++j) rk += (etab[j] == e) ? 1 : 0; RANK[(size_t)wg * NEn + tid] = rk; }
    if (tid < 32) { int c = 0; for (int j = 0; j < NEn; ++j) c += (etab[j] == tid) ? 1 : 0; HIST[wg * 32 + tid] = c; }
    }
    __syncthreads();
}

__device__ __forceinline__ void ph_offs(PrmP p, int l, LAS unsigned char* lds, int wg, int nwg) {
    const int tid = fresh_tid(), lane = tid & 63, wave = tid >> 6;
    const int R = M / nwg, NEn = R * 4;
    const int* TOPI = (const int*)(p->ws + WS_MISC + MS_TOPI); const int* RANK = (const int*)(p->ws + WS_MISC + MS_RANK); const int* HIST = (const int*)(p->ws + WS_MISC + MS_HIST);
    int* POS = (int*)(p->ws + WS_MISC + MS_POS); int* TILE_E = (int*)(p->ws + WS_MISC + MS_TILEE); int* CTL = (int*)(p->ws + WS_CTL);
    const bf16_t* HB = (const bf16_t*)(p->ws + WS_HB); bf16_t* XS = (bf16_t*)(p->ws + WS_XS);
    LAS int* tot = (LAS int*)lds; LAS int* mine = tot + 32; LAS int* base = mine + 32; LAS int* ptab = base + 32;
    __syncthreads();
    { LAS int* part = ptab + 512;
      const int e = tid & 31, pt = tid >> 5, per = (nwg + 15) / 16; int t = 0, mb = 0;
      for (int w = pt * per; w < (pt + 1) * per && w < nwg; ++w) { const int c = HIST[w * 32 + e]; t += c; mb += (w < wg) ? c : 0; }
      part[(pt * 2 + 0) * 32 + e] = t; part[(pt * 2 + 1) * 32 + e] = mb;
      __syncthreads();
      if (tid < 32) { int ts = 0, ms = 0;
#pragma unroll
          for (int q = 0; q < 16; ++q) { ts += part[(q * 2 + 0) * 32 + tid]; ms += part[(q * 2 + 1) * 32 + tid]; }
          tot[tid] = ts; mine[tid] = ms; } }
    __syncthreads();
    if (tid == 0) { int run = 0; for (int e = 0; e < 32; ++e) { const int pad = (tot[e] + 255) / 256 * 256; base[e] = run + mine[e];
            if (wg == 0) for (int t = run / 256; t < (run + pad) / 256; ++t) TILE_E[t] = e;
            run += pad; }
        if (wg == 0) CTL[CW_NT] = run / 256; }
    __syncthreads();
    int* ROWTOK = (int*)(p->ws + WS_MISC + MS_ROWTOK);
    if (tid < NEn) { const size_t idx = (size_t)wg * NEn + tid; const int pos = base[TOPI[idx]] + RANK[idx]; POS[idx] = pos; ptab[tid] = pos; ROWTOK[pos] = (int)(idx >> 2); }
    if (wg < 32) { const int e = wg, st = base[e] - mine[e] + tot[e], en = base[e] - mine[e] + (tot[e] + 255) / 256 * 256; for (int r = st + tid; r < en; r += NTHREADS) ROWTOK[r] = 0; }
    __syncthreads();
    if (EXPERT_FP8) return;
    for (int r0 = wave * (R / NWAVES); r0 < (wave + 1) * (R / NWAVES); r0 += 4) {
        u32x4 va[4], vb[4];
        if (EXPERT_FP8) {
#pragma unroll
            for (int q = 0; q < 4; ++q) va[q] = ((const u32x4*)((const unsigned char*)HB + ((size_t)wg * R + r0 + q) * 1024))[lane];
#pragma unroll
            for (int q = 0; q < 4; ++q)
#pragma unroll
                for (int k = 0; k < 4; ++k) ((u32x4*)((unsigned char*)XS + (size_t)ptab[(r0 + q) * 4 + k] * 1024))[lane] = va[q];
        } else {
#pragma unroll
        for (int q = 0; q < 4; ++q) { const u32x4* src = (const u32x4*)(HB + ((size_t)wg * R + r0 + q) * 1024); va[q] = src[lane]; vb[q] = src[lane + 64]; }
#pragma unroll
        for (int q = 0; q < 4; ++q)
#pragma unroll
            for (int k = 0; k < 4; ++k) { u32x4* dst = (u32x4*)(XS + (size_t)ptab[(r0 + q) * 4 + k] * 1024); dst[lane] = va[q]; dst[lane + 64] = vb[q]; }
        }
    }
}

__device__ __forceinline__ void ph_comb(PrmP p, int l, int wg, int nwg) {
    const int tid = fresh_tid(), lane = tid & 63, wave = tid >> 6;
    const bf16_t* YR = (const bf16_t*)(p->ws + WS_YR); const int* POS = (const int*)(p->ws + WS_MISC + MS_POS); const float* TOPG = (const float*)(p->ws + WS_MISC + MS_TOPG);
    const float* MOD = (const float*)(p->ws + WS_MOD); float* X = p->out; bf16_t* XB = (bf16_t*)(p->ws + WS_XB);
    int posv = POS[(size_t)(wg * NWAVES + wave) * 4 + (lane & 3)]; float gvv = TOPG[(size_t)(wg * NWAVES + wave) * 4 + (lane & 3)];
    for (int m = wg * NWAVES + wave; m < M; m += nwg * NWAVES) {
        const int b = m / T; const float* gate = MOD + (size_t)(l * 4 + b) * 6144 + 5 * 1024;
        const int posc = posv; const float gvc = gvv;
        { const int mn = m + nwg * NWAVES; if (mn < M) { posv = POS[(size_t)mn * 4 + (lane & 3)]; gvv = TOPG[(size_t)mn * 4 + (lane & 3)]; } }
        float y[16];
#pragma unroll
        for (int i = 0; i < 16; ++i) y[i] = 0.f;
#pragma unroll
        for (int k = 0; k < 4; ++k) { const int pos = __builtin_amdgcn_readlane(posc, k); const float gv = __builtin_bit_cast(float, __builtin_amdgcn_readlane(__builtin_bit_cast(int, gvc), k));
            if (YR_FP8) { typedef float f32x2_ __attribute__((ext_vector_type(2))); const float g16 = gv * 0.0625f;
                const u32x2 a8 = *(const u32x2*)((const unsigned char*)YR + (size_t)pos * 1024 + 8 * lane), c8 = *(const u32x2*)((const unsigned char*)YR + (size_t)pos * 1024 + 512 + 8 * lane);
                const unsigned wv[4] = {a8.x, a8.y, c8.x, c8.y};
#pragma unroll
                for (int q = 0; q < 4; ++q) { const f32x2_ lo = __builtin_amdgcn_cvt_pk_f32_fp8((int)wv[q], false), hi = __builtin_amdgcn_cvt_pk_f32_fp8((int)wv[q], true);
                    y[4 * q + 0] += g16 * lo.x; y[4 * q + 1] += g16 * lo.y; y[4 * q + 2] += g16 * hi.x; y[4 * q + 3] += g16 * hi.y; }
            } else {
            const u32x4 a = *(const u32x4*)(YR + (size_t)pos * 1024 + 8 * lane), c = *(const u32x4*)(YR + (size_t)pos * 1024 + 512 + 8 * lane);
            y[0] += gv * bflo(a.x); y[1] += gv * bfhi(a.x); y[2] += gv * bflo(a.y); y[3] += gv * bfhi(a.y); y[4] += gv * bflo(a.z); y[5] += gv * bfhi(a.z); y[6] += gv * bflo(a.w); y[7] += gv * bfhi(a.w);
            y[8] += gv * bflo(c.x); y[9] += gv * bfhi(c.x); y[10] += gv * bflo(c.y); y[11] += gv * bfhi(c.y); y[12] += gv * bflo(c.z); y[13] += gv * bfhi(c.z); y[14] += gv * bflo(c.w); y[15] += gv * bfhi(c.w); } }
        float ss = 0.f;
#pragma unroll
        for (int i = 0; i < 16; ++i) ss += y[i] * y[i];
        const float rstd = __builtin_amdgcn_rsqf(wave_sum(ss) * (1.f / 1024.f) + RMS_EPS);
        float xs[16]; float s2 = 0.f;
#pragma unroll
        for (int hf = 0; hf < 2; ++hf) { const int c0 = hf * 512 + 8 * lane;
#pragma unroll
            for (int q = 0; q < 2; ++q) { const int c = c0 + 4 * q; const f32x4 g = *(const f32x4*)(p->in[I_POSTFFNG] + l * 1024 + c), gt = *(const f32x4*)(gate + c); const u32x2 xw = *(const u32x2*)(XB + (size_t)m * 1024 + c); f32x4 xv = (f32x4){bflo(xw.x), bfhi(xw.x), bflo(xw.y), bfhi(xw.y)};
                xv.x += gt.x * (y[hf * 8 + 4 * q + 0] * rstd * g.x); xv.y += gt.y * (y[hf * 8 + 4 * q + 1] * rstd * g.y); xv.z += gt.z * (y[hf * 8 + 4 * q + 2] * rstd * g.z); xv.w += gt.w * (y[hf * 8 + 4 * q + 3] * rstd * g.w);
                if (l + 1 < NL) { u32x2 xo; xo.x = pk2(xv.x, xv.y); xo.y = pk2(xv.z, xv.w); *(u32x2*)(XB + (size_t)m * 1024 + c) = xo; } else *(f32x4*)(X + (size_t)m * 1024 + c) = xv;
                xs[hf * 8 + 4 * q + 0] = xv.x; xs[hf * 8 + 4 * q + 1] = xv.y; xs[hf * 8 + 4 * q + 2] = xv.z; xs[hf * 8 + 4 * q + 3] = xv.w; s2 += (xv.x * xv.x + xv.y * xv.y) + (xv.z * xv.z + xv.w * xv.w); } }
        if (l + 1 < NL) {
            const float rs2 = __builtin_amdgcn_rsqf(wave_sum(s2) * (1.f / 1024.f) + RMS_EPS);
            const float* shift = MOD + (size_t)((l + 1) * 4 + b) * 6144; const float* scale = shift + 1024; const float* g2 = p->in[I_PREMIXG] + (l + 1) * 1024;
            bf16_t* HB = (bf16_t*)(p->ws + WS_HB);
#pragma unroll
            for (int hf = 0; hf < 2; ++hf) { const int c0 = hf * 512 + 8 * lane; float hv[8];
#pragma unroll
                for (int q = 0; q < 2; ++q) { const f32x4 gg = *(const f32x4*)(g2 + c0 + 4 * q), sc = *(const f32x4*)(scale + c0 + 4 * q), sh = *(const f32x4*)(shift + c0 + 4 * q);
                    hv[4 * q + 0] = xs[hf * 8 + 4 * q + 0] * rs2 * gg.x * (sc.x + 1.f) + sh.x; hv[4 * q + 1] = xs[hf * 8 + 4 * q + 1] * rs2 * gg.y * (sc.y + 1.f) + sh.y;
                    hv[4 * q + 2] = xs[hf * 8 + 4 * q + 2] * rs2 * gg.z * (sc.z + 1.f) + sh.z; hv[4 * q + 3] = xs[hf * 8 + 4 * q + 3] * rs2 * gg.w * (sc.w + 1.f) + sh.w; }
                u32x4 o; o.x = pk2(hv[0], hv[1]); o.y = pk2(hv[2], hv[3]); o.z = pk2(hv[4], hv[5]); o.w = pk2(hv[6], hv[7]);
                *(u32x4*)(HB + (size_t)m * 1024 + c0) = o; } }
    }
}

__device__ __forceinline__ void ph_tables(PrmP p, int wg, int nwg) {
    const int tid = fresh_tid(), lane = tid & 63, wave = tid >> 6;
    for (int it = wave * nwg + wg; it < NL * 16; it += nwg * NWAVES) s5m_table_build(p, it >> 4, it & 15, lane);
}

#define XB_TMO      128
#define XB_XCNT(j)  (256  + 64 * (j))
#define XB_XSUB(j)  (1280 + 64 * (j))
#define XB_XGEN(j)  (2304 + 64 * (j))
#define XB_TOP      3328
#define XB_TOPGEN   3392
#define XCD_BAR_WORDS 3456
#define XB_SPIN_CAP (1u << 22)

__device__ __forceinline__ unsigned xb_ld(unsigned* p)              { return __hip_atomic_load(p, __ATOMIC_RELAXED, __HIP_MEMORY_SCOPE_AGENT); }
__device__ __forceinline__ unsigned xb_add(unsigned* p, unsigned v) { return __hip_atomic_fetch_add(p, v, __ATOMIC_RELAXED, __HIP_MEMORY_SCOPE_AGENT); }
__device__ __forceinline__ unsigned xb_xcc_id() { return (unsigned)__builtin_amdgcn_s_getreg((3 << 11) | 20) & 0xFu; }
#define XB_SPIN(cond, bar) do { unsigned _sp = 0; while (cond) { __builtin_amdgcn_s_sleep(1); \
    if ((++_sp & 255u) == 0u) { if (xb_ld(&(bar)[XB_TMO])) break; if (_sp > XB_SPIN_CAP) { atomicAdd(&(bar)[XB_TMO], 1u); break; } } } } while (0)

struct XcdBarrier { unsigned* bar; unsigned x; volatile LAS unsigned* st; };

__device__ __forceinline__ XcdBarrier xcd_barrier_post(unsigned* bar, volatile LAS unsigned* st) {
    XcdBarrier b; b.bar = bar; b.x = xb_xcc_id(); b.st = st;
    if (threadIdx.x == 0) (void)xb_add(&bar[XB_XCNT(b.x)], 1u);
    return b;
}
__device__ __forceinline__ void xcd_barrier_complete(unsigned* bar, unsigned x, unsigned& nloc, unsigned& nx) {
    const unsigned G = gridDim.x * gridDim.y * gridDim.z;
    unsigned sum, cnt, mine, sp = 0u;
    for (;;) {
        sum = 0u; cnt = 0u; mine = 0u;
#pragma unroll
        for (unsigned j = 0; j < 16; ++j) { const unsigned c = xb_ld(&bar[XB_XCNT(j)]); sum += c; cnt += (c > 0u) ? 1u : 0u; mine = (j == x) ? c : mine; }
        if (sum == G) break;
        __builtin_amdgcn_s_sleep(1);
        if ((++sp & 255u) == 0u) { if (xb_ld(&bar[XB_TMO])) break; if (sp > XB_SPIN_CAP) { atomicAdd(&bar[XB_TMO], 1u); break; } }
    }
    nloc = mine > 0u ? mine : 1u; nx = cnt > 0u ? cnt : 1u;
}
__device__ __forceinline__ void xcd_barrier(const XcdBarrier& b) {
    asm volatile("s_waitcnt vmcnt(0)" ::: "memory");
    __syncthreads();
    if (threadIdx.x == 0) {
        unsigned* bar = b.bar;
        __builtin_amdgcn_s_waitcnt(0);
        unsigned nloc = b.st[0], nx = b.st[1];
        if (nloc == 0u) { xcd_barrier_complete(bar, b.x, nloc, nx); b.st[0] = nloc; b.st[1] = nx; }
        const unsigned old = xb_add(&bar[XB_XSUB(b.x)], 1u);
        const unsigned gen = old / nloc;
        if (old + 1u == (gen + 1u) * nloc) {
            __builtin_amdgcn_fence(__ATOMIC_RELEASE, "agent");
            asm volatile("s_waitcnt vmcnt(0)" ::: "memory");
            const unsigned og = xb_add(&bar[XB_TOP], 1u);
            const unsigned tg = og / nx;
            if (og + 1u == (tg + 1u) * nx) xb_add(&bar[XB_TOPGEN], 1u);
            else XB_SPIN(xb_ld(&bar[XB_TOPGEN]) == tg, bar);
            __builtin_amdgcn_fence(__ATOMIC_ACQUIRE, "agent");
            xb_add(&bar[XB_XGEN(b.x)], 1u);
            asm volatile("s_waitcnt vmcnt(0)" ::: "memory");
        } else {
            XB_SPIN(xb_ld(&bar[XB_XGEN(b.x)]) == gen, bar);
            __builtin_amdgcn_fence(__ATOMIC_ACQUIRE, "agent");
            asm volatile("s_waitcnt vmcnt(0)" ::: "memory");
        }
    }
    __syncthreads();
}

constexpr int LDS_BYTES = 147456;
constexpr int LDS_BAR_OFF = LDS_BYTES - 64;
constexpr int CW_BAR = 4096;

__global__ void __launch_bounds__(NTHREADS, 2) mk_fwd(Prm p_unused) {
    extern __shared__ __attribute__((aligned(16))) unsigned char lds_raw[];
    LAS unsigned char* lds = (LAS unsigned char*)lds_raw;
    const int wg = blockIdx.x, nwg = gridDim.x;
    if (threadIdx.x < 4) ((LAS unsigned*)(lds + LDS_BAR_OFF))[threadIdx.x] = 0u;
    __syncthreads();
    (void)xcd_barrier_post((unsigned*)(prm_fresh()->ws + WS_CTL) + CW_BAR, (volatile LAS unsigned*)(lds + LDS_BAR_OFF));
#define GRID_BAR() do { XcdBarrier b_; b_.bar = (unsigned*)(prm_fresh()->ws + WS_CTL) + CW_BAR; b_.x = xb_xcc_id(); b_.st = (volatile LAS unsigned*)(lds + LDS_BAR_OFF); xcd_barrier(b_); } while (0)
#ifndef REP_PHASE
#define REP_PHASE -1
#endif
#define PHASE(id, call) do { call; GRID_BAR(); if (REP_PHASE == (id)) { call; GRID_BAR(); } } while (0)
    PHASE(0, (ph_prologue(prm_fresh(), lds, wg, nwg), ph_tables(prm_fresh(), wg, nwg)));
#define MK_LAYER(l) do { \
        if ((l) == 0) PHASE(1, ph_norm1(prm_fresh(), l, wg, nwg));     \
        PHASE(2, fg_gemm_in(prm_fresh(), l, lds, wg, nwg)); \
        PHASE(3, fs_scan(prm_fresh(), l, lds, wg, nwg)); \
        fa_attn(prm_fresh(), l, lds, wg, nwg); GRID_BAR(); \
        PHASE(5, fs_fin(prm_fresh(), l, lds, wg, nwg)); \
        PHASE(6, fg_gemm_out(prm_fresh(), l, lds, wg, nwg)); \
        ph_row(prm_fresh(), l, lds, wg, nwg); GRID_BAR(); \
        PHASE(8, ph_offs(prm_fresh(), l, lds, wg, nwg)); \
        PHASE(9, fg_gemm1(prm_fresh(), l, lds, wg, nwg)); \
        PHASE(10, fg_gemm2(prm_fresh(), l, lds, wg, nwg)); \
        ph_comb(prm_fresh(), l, wg, nwg); GRID_BAR(); } while (0)
    MK_LAYER(0);
    MK_LAYER(1);
#undef MK_LAYER
}

extern "C" void kernel_launch(void* const* d_in, const int* in_sizes, int n_in, void* d_out, int out_size, void* d_ws, size_t ws_size, hipStream_t stream) {
    if (n_in != N_IN || out_size != M * D || ws_size < WS_END) { fprintf(stderr, "kernel_launch: unexpected shapes: n_in %d out %d ws %zu (need %zu)\n", n_in, out_size, ws_size, (size_t)WS_END); return; }
    Prm p{};
    for (int i = 0; i < N_IN; ++i) p.in[i] = (const float*)d_in[i];
    p.out = (float*)d_out; p.ws = (unsigned char*)d_ws;
    (void)hipMemsetAsync((char*)d_ws + WS_CTL, 0, 1 * MiB, stream);
    static int grid = 0;
    if (grid == 0) {
        int dev = 0, cus = 0, per_cu = 0;
        if (hipGetDevice(&dev) != hipSuccess || hipDeviceGetAttribute(&cus, hipDeviceAttributeMultiprocessorCount, dev) != hipSuccess) { fprintf(stderr, "kernel_launch: device query failed\n"); grid = -1; return; }
        if (hipFuncSetAttribute((const void*)mk_fwd, hipFuncAttributeMaxDynamicSharedMemorySize, LDS_BYTES) != hipSuccess) { fprintf(stderr, "kernel_launch: hipFuncSetAttribute failed\n"); grid = -1; return; }
        if (hipOccupancyMaxActiveBlocksPerMultiprocessor(&per_cu, (const void*)mk_fwd, NTHREADS, LDS_BYTES) != hipSuccess || per_cu < 1) fprintf(stderr, "kernel_launch: occupancy query reports %d\n", per_cu);
        (void)hipGetLastError();
        grid = 256;
        if (cus < 256) fprintf(stderr, "kernel_launch: %d CUs: 256 workgroups of 144 KiB LDS cannot all be resident\n", cus);
    }
    if (grid < 0) return;
    hipLaunchKernelGGL(mk_fwd, dim3(grid), dim3(NTHREADS), LDS_BYTES, stream, p);
}
```

```cpp
#include <hip/hip_runtime.h>
#include <stdint.h>
#include <stdio.h>

#define LAS __attribute__((address_space(3)))
typedef unsigned short bf16_t;
typedef short bf16x8 __attribute__((ext_vector_type(8)));
typedef float f32x4 __attribute__((ext_vector_type(4)));
typedef unsigned u32x4 __attribute__((ext_vector_type(4)));
typedef unsigned u32x2 __attribute__((ext_vector_type(2)));

constexpr int NB = 4, T = 8192, D = 1024, M = NB * T, NL = 2;
constexpr int INC = 2312, NP = 2560;
constexpr int C_LX = 0, C_LG = 256, C_S5 = 512, C_Q = 768, C_K = 1280, C_V = 1792, C_F = 2304;
constexpr int NH = 8, HD = 64, NE = 32, TOPK = 4, DFF = 1024;
constexpr int RP = M * TOPK + NE * 256;
constexpr float C2 = 0.125f * 1.4426950408889634f;
constexpr float LOG2E = 1.4426950408889634f;
constexpr float RMS_EPS = 1e-6f;
constexpr int NTHREADS = 512, NWAVES = 8;
#ifndef FAST_ATTN
#define FAST_ATTN 1
#endif
#ifndef YR_FP8
#define YR_FP8 1
#endif
#ifndef F8_ALLV
#define F8_ALLV 1
#endif
#ifndef EXPERT_FP8
#define EXPERT_FP8 1
#endif

enum { I_X = 0, I_C, I_ADAW, I_ADAB, I_PREMIXG, I_WIN, I_CONVW, I_CONVB, I_LRUWA, I_LRUBA, I_LRUWX, I_LRUBX, I_LAMBDA, I_S5ARE, I_S5AIM, I_S5BRE, I_S5BIM,
       I_S5CRE, I_S5CIM, I_S5D, I_S5LOGDT, I_GLUW, I_GLUB, I_FOXFB, I_GNLRU, I_GNS5, I_GNATT, I_WOUT, I_POSTMIXG, I_PREFFNG, I_ROUTW, I_ROUTB, I_WGU, I_BGU,
       I_WDN, I_BDN, I_POSTFFNG, N_IN };

constexpr size_t MiB = 1u << 20;
constexpr size_t WS_CTL = 0;
constexpr size_t WS_MOD = 1 * MiB;
constexpr size_t WS_MISC = 2 * MiB;
constexpr size_t WS_FC2 = 6 * MiB;
constexpr size_t WS_WIN = 8 * MiB;
constexpr size_t WS_WOUT = 18 * MiB;
constexpr size_t WS_WGU = 22 * MiB;
constexpr size_t WS_WDN = 278 * MiB;
constexpr size_t WS_HB = 406 * MiB;
constexpr size_t WS_PB = 470 * MiB;
constexpr size_t WS_YL = 630 * MiB;
constexpr size_t WS_YS0 = 662 * MiB;
constexpr size_t WS_OA = 694 * MiB;
constexpr size_t WS_AGG = WS_OA;
constexpr size_t WS_XEND = WS_OA + 2 * MiB;
constexpr size_t WS_GLUW = WS_OA + 8 * MiB;
constexpr size_t WS_X4END = WS_OA + 7 * MiB;
constexpr size_t WS_S5T = WS_OA + 10 * MiB;
constexpr size_t WS_LRUW = WS_OA + 9 * MiB;
constexpr size_t WS_YC = 758 * MiB;
constexpr size_t WS_Y = 822 * MiB;
constexpr size_t WS_XS = 950 * MiB;
constexpr size_t WS_XB = WS_XS;
constexpr size_t WS_H1 = 1222 * MiB;
constexpr size_t WS_YR = 1494 * MiB;
constexpr size_t WS_END = 1766 * MiB;
constexpr size_t MS_ROWTOK = 2560 * 1024;
constexpr size_t MS_TOPI = 0, MS_TOPG = 512 * 1024, MS_RANK = 1024 * 1024, MS_POS = 1536 * 1024, MS_HIST = 2048 * 1024, MS_TILEE = 2048 * 1024 + 64 * 1024;
constexpr int CW_NT = 8;
constexpr int CW_QN = 16384, CW_KT = 32768;
constexpr int CW_NRM = 8192;

struct Prm { const float* in[N_IN]; float* out; unsigned char* ws; };
__device__ __forceinline__ int fresh_tid() { int t = threadIdx.x; asm volatile("" : "+v"(t)); return t; }
typedef const __attribute__((address_space(4))) Prm* PrmP;
__device__ __forceinline__ PrmP prm_fresh() { PrmP q = (PrmP)__builtin_amdgcn_kernarg_segment_ptr(); asm volatile("" : "+s"(q)); return q; }

typedef float f32x2h_ __attribute__((ext_vector_type(2))); typedef __bf16 bf16x2h_ __attribute__((ext_vector_type(2)));
__device__ __forceinline__ unsigned pk2(float lo, float hi) { const f32x2h_ v = {lo, hi}; return __builtin_bit_cast(unsigned, __builtin_convertvector(v, bf16x2h_)); }
__device__ __forceinline__ unsigned f2bf(float f) { return pk2(f, 0.f) & 0xffffu; }
__device__ __forceinline__ float bf2f(unsigned v) { return __builtin_bit_cast(float, v << 16); }
__device__ __forceinline__ float bflo(unsigned w) { return __builtin_bit_cast(float, w << 16); }
__device__ __forceinline__ float bfhi(unsigned w) { return __builtin_bit_cast(float, w & 0xffff0000u); }
template <int CTRL> __device__ __forceinline__ float dppf(float x) { return __builtin_bit_cast(float, __builtin_amdgcn_update_dpp(0, __builtin_bit_cast(int, x), CTRL, 0xf, 0xf, true)); }
constexpr int DPP_XOR1 = 0xB1, DPP_XOR2 = 0x4E, DPP_REV4 = 0x1B, DPP_HMIRROR = 0x141, DPP_MIRROR = 0x140, DPP_ROR8 = 0x128;
__device__ __forceinline__ float wave_sum(float v) {
    v += dppf<DPP_XOR1>(v); v += dppf<DPP_XOR2>(v); v += dppf<DPP_HMIRROR>(v); v += dppf<DPP_MIRROR>(v);
    const auto s = __builtin_amdgcn_permlane16_swap(__float_as_uint(v), __float_as_uint(v), false, false); v = __uint_as_float(s[0]) + __uint_as_float(s[1]);
    const auto t = __builtin_amdgcn_permlane32_swap(__float_as_uint(v), __float_as_uint(v), false, false); return __uint_as_float(t[0]) + __uint_as_float(t[1]);
}
__device__ __forceinline__ float wave_max(float v) {
    v = fmaxf(v, dppf<DPP_XOR1>(v)); v = fmaxf(v, dppf<DPP_XOR2>(v)); v = fmaxf(v, dppf<DPP_HMIRROR>(v)); v = fmaxf(v, dppf<DPP_MIRROR>(v));
    const auto s = __builtin_amdgcn_permlane16_swap(__float_as_uint(v), __float_as_uint(v), false, false); v = fmaxf(__uint_as_float(s[0]), __uint_as_float(s[1]));
    const auto t = __builtin_amdgcn_permlane32_swap(__float_as_uint(v), __float_as_uint(v), false, false); return fmaxf(__uint_as_float(t[0]), __uint_as_float(t[1]));
}
__device__ __forceinline__ float sigmoidf_(float x) { return __builtin_amdgcn_rcpf(1.f + __expf(-x)); }
__device__ __forceinline__ float gelu_tanh(float x) { const float u = 0.7978845608028654f * (x + 0.044715f * x * x * x); return x * sigmoidf_(2.f * u); }

__device__ __forceinline__ void tr_item(const float* W, int ldw, int nvalid, int k0, int n0, bf16_t* dst, float scale, LAS float* scr, int lane, int ldd = 1024) {
    const int nn = n0 + (lane & 31); const bool ok = nn < nvalid;
    float wv[32];
#pragma unroll
    for (int i = 0; i < 32; ++i) { const int kk = 2 * i + (lane >> 5); wv[i] = ok ? W[(size_t)(k0 + kk) * ldw + nn] : 0.f; }
#pragma unroll
    for (int i = 0; i < 32; ++i) { const int kk = 2 * i + (lane >> 5); scr[kk * 33 + (lane & 31)] = wv[i] * scale; }
    asm volatile("s_waitcnt lgkmcnt(0)" ::: "memory");
    const int c = lane & 7;
#pragma unroll
    for (int j = 0; j < 4; ++j) { const int n = (lane >> 3) + 8 * j; const LAS float* s = scr + (8 * c) * 33 + n;
        u32x4 o; o.x = pk2(s[0 * 33], s[1 * 33]); o.y = pk2(s[2 * 33], s[3 * 33]); o.z = pk2(s[4 * 33], s[5 * 33]); o.w = pk2(s[6 * 33], s[7 * 33]);
        *(u32x4*)(dst + (size_t)n * ldd + k0 + 8 * c) = o; }
    asm volatile("s_waitcnt lgkmcnt(0)" ::: "memory");
}

__device__ __forceinline__ unsigned pk4_fp8(float a, float b, float c, float d) { int w = __builtin_amdgcn_cvt_pk_fp8_f32(a, b, 0, false); w = __builtin_amdgcn_cvt_pk_fp8_f32(c, d, w, true); return (unsigned)w; }
__device__ __forceinline__ void tr_item8w(const float* W, int ldw, int k0, int n0, unsigned char* dst, float scale, LAS float* scr, int lane) {
#pragma unroll 1
    for (int hh = 0; hh < 2; ++hh) { f32x4 v[8];
#pragma unroll
      for (int i = 0; i < 8; ++i) v[i] = *(const f32x4*)(W + (size_t)(k0 + hh * 32 + (lane >> 4) + 4 * i) * ldw + n0 + 4 * (lane & 15));
#pragma unroll
      for (int i = 0; i < 8; ++i) { LAS float* d = scr + (hh * 32 + (lane >> 4) + 4 * i) * 65 + 4 * (lane & 15); d[0] = v[i].x * scale; d[1] = v[i].y * scale; d[2] = v[i].z * scale; d[3] = v[i].w * scale; } }
    asm volatile("s_waitcnt lgkmcnt(0)" ::: "memory");
    const int kq = lane & 3;
#pragma unroll
    for (int j = 0; j < 4; ++j) { const int n = (lane >> 2) + 16 * j; const LAS float* s = scr + (16 * kq) * 65 + n;
        u32x4 o; o.x = pk4_fp8(s[0 * 65], s[1 * 65], s[2 * 65], s[3 * 65]); o.y = pk4_fp8(s[4 * 65], s[5 * 65], s[6 * 65], s[7 * 65]);
        o.z = pk4_fp8(s[8 * 65], s[9 * 65], s[10 * 65], s[11 * 65]); o.w = pk4_fp8(s[12 * 65], s[13 * 65], s[14 * 65], s[15 * 65]);
        *(u32x4*)(dst + (size_t)n * 1024 + k0 + 16 * kq) = o; }
    asm volatile("s_waitcnt lgkmcnt(0)" ::: "memory");
}
#ifndef PRO_PROBE
#define PRO_PROBE 0
#endif
template <int MODE> __device__ __forceinline__ void ex_convert(PrmP p, LAS float* scr, int gw, int NGW, int lane) {
    constexpr int I_GU = 16 * 32, I_DN = 16 * 16, NEX = 64 * I_GU + 64 * I_DN;
#define EX_ITEM(r_, src_, dst_, ldw_) do { int r2_ = (r_); if (r2_ < 64 * I_GU) { const int le = r2_ >> 9, q = r2_ & 511, kb = q >> 5, n0 = (q & 31) * 64; \
        const int sx = n0 >> 10, rr = n0 & 1023, j = rr >> 7, cc = rr & 127, drow = 256 * j + 128 * sx + cc; \
        ldw_ = 2048; src_ = p->in[I_WGU] + (size_t)le * 1024 * 2048 + (size_t)(kb * 64) * 2048 + n0; dst_ = p->ws + (MODE == 2 ? WS_YR : WS_WGU) + ((size_t)le * 2048 + drow) * 1024 + kb * 64; } \
      else { r2_ -= 64 * I_GU; const int le = r2_ >> 8, q = r2_ & 255, kb = q >> 4, n0 = (q & 15) * 64; \
        ldw_ = 1024; src_ = p->in[I_WDN] + (size_t)le * 1024 * 1024 + (size_t)(kb * 64) * 1024 + n0; dst_ = p->ws + (MODE == 2 ? WS_YR + 128 * MiB : WS_WDN) + ((size_t)le * 1024 + n0) * 1024 + kb * 64; } } while (0)
#define EX_LOAD(src_, ldw_) do { _Pragma("unroll") for (int i = 0; i < 16; ++i) { if (MODE == 2) v[i] = (f32x4){(float)i, (float)lane, 1.f, 2.f}; else v[i] = *(const f32x4*)((src_) + (size_t)((lane >> 4) + 4 * i) * (ldw_) + 4 * (lane & 15)); } } while (0)
    int r = gw;
    if (r < NEX) {
        const float* src; unsigned char* dst; int ldw; f32x4 v[16];
        EX_ITEM(r, src, dst, ldw); EX_LOAD(src, ldw);
#pragma unroll 1
        for (;;) {
#pragma unroll
            for (int i = 0; i < 16; ++i) { LAS float* d = scr + ((lane >> 4) + 4 * i) * 65 + 4 * (lane & 15); d[0] = v[i].x * 64.f; d[1] = v[i].y * 64.f; d[2] = v[i].z * 64.f; d[3] = v[i].w * 64.f; }
            const int rn = r + NGW; const bool more = rn < NEX; unsigned char* dcur = dst;
            if (more) { EX_ITEM(rn, src, dst, ldw); EX_LOAD(src, ldw); }
            asm volatile("s_waitcnt lgkmcnt(0)" ::: "memory");
            const int kq = lane & 3;
#pragma unroll
            for (int j = 0; j < 4; ++j) { const int n = (lane >> 2) + 16 * j; const LAS float* sp = scr + (16 * kq) * 65 + n;
                u32x4 o; o.x = pk4_fp8(sp[0 * 65], sp[1 * 65], sp[2 * 65], sp[3 * 65]); o.y = pk4_fp8(sp[4 * 65], sp[5 * 65], sp[6 * 65], sp[7 * 65]);
                o.z = pk4_fp8(sp[8 * 65], sp[9 * 65], sp[10 * 65], sp[11 * 65]); o.w = pk4_fp8(sp[12 * 65], sp[13 * 65], sp[14 * 65], sp[15 * 65]);
                if (MODE != 1 || (o.x == 0x12345678u && o.y == 0x9abcdef0u && o.z == 0x0fedcba9u)) *(u32x4*)(dcur + (size_t)n * 1024 + 16 * kq) = o; }
            asm volatile("s_waitcnt lgkmcnt(0)" ::: "memory");
            if (!more) break;
            r = rn;
        }
    }
#undef EX_ITEM
#undef EX_LOAD
}
constexpr int EXC_IMG = 256 * 128;
__device__ __forceinline__ void ex_convert_wg(PrmP p, LAS unsigned char* lds, int wg, int nwg) {
    const int tid = fresh_tid(), lane = tid & 63, wave = tid >> 6;
    constexpr int NGU = 64 * 8 * 8, NIT = NGU + 64 * 8 * 4;
#define EXW_ITEM(it_, src_, ldw_, dbase_, gu_, nb_) do { int r_ = (it_); if (r_ < NGU) { const int le = r_ >> 6, q = r_ & 63, kb = q >> 3; nb_ = q & 7; gu_ = 1; ldw_ = 2048; \
        src_ = p->in[I_WGU] + (size_t)le * 1024 * 2048 + (size_t)(kb * 128 + wave * 16) * 2048 + nb_ * 256 + 4 * lane; dbase_ = p->ws + WS_WGU + (size_t)le * 2048 * 1024 + kb * 128; } \
      else { r_ -= NGU; const int le = r_ >> 5, q = r_ & 31, kb = q >> 2; nb_ = q & 3; gu_ = 0; ldw_ = 1024; \
        src_ = p->in[I_WDN] + (size_t)le * 1024 * 1024 + (size_t)(kb * 128 + wave * 16) * 1024 + nb_ * 256 + 4 * lane; dbase_ = p->ws + WS_WDN + (size_t)le * 1024 * 1024 + kb * 128; } } while (0)
#define EXW_LOAD(src_, ldw_) do { _Pragma("unroll") for (int i = 0; i < 16; ++i) v[i] = *(const f32x4*)((src_) + (size_t)i * (ldw_)); } while (0)
    int it = wg; if (it >= NIT) return;
    const float* src; unsigned char* dbase; int ldw, gu, nb; f32x4 v[16];
    EXW_ITEM(it, src, ldw, dbase, gu, nb); EXW_LOAD(src, ldw);
    int buf = 0;
#pragma unroll 1
    for (;;) {
        LAS unsigned char* img = lds + buf * EXC_IMG;
#pragma unroll
        for (int q = 0; q < 4; ++q) { u32x4 o;
            o.x = pk4_fp8(v[0][q] * 64.f, v[1][q] * 64.f, v[2][q] * 64.f, v[3][q] * 64.f); o.y = pk4_fp8(v[4][q] * 64.f, v[5][q] * 64.f, v[6][q] * 64.f, v[7][q] * 64.f);
            o.z = pk4_fp8(v[8][q] * 64.f, v[9][q] * 64.f, v[10][q] * 64.f, v[11][q] * 64.f); o.w = pk4_fp8(v[12][q] * 64.f, v[13][q] * 64.f, v[14][q] * 64.f, v[15][q] * 64.f);
            *(LAS u32x4*)(img + (4 * lane + q) * 128 + ((wave ^ (lane & 7)) << 4)) = o; }
        const int itn = it + nwg; const bool more = itn < NIT; unsigned char* dcur = dbase; const int gucur = gu, nbcur = nb;
        if (more) { EXW_ITEM(itn, src, ldw, dbase, gu, nb); EXW_LOAD(src, ldw); }
        __syncthreads();
#pragma unroll
        for (int j = 0; j < 4; ++j) { const int pidx = tid + 512 * j, n = pidx >> 3, pc = pidx & 7;
            const u32x4 o = *(const LAS u32x4*)(img + n * 128 + ((pc ^ ((n >> 2) & 7)) << 4));
            const int ncol = nbcur * 256 + n; const int drow = gucur ? (256 * ((ncol & 1023) >> 7) + 128 * (ncol >> 10) + (ncol & 127)) : ncol;
            *(u32x4*)(dcur + (size_t)drow * 1024 + 16 * pc) = o; }
        if (!more) break;
        it = itn; buf ^= 1;
    }
#undef EXW_ITEM
#undef EXW_LOAD
}
__device__ __forceinline__ void ph_prologue(PrmP p, LAS unsigned char* lds, int wg, int nwg) {
    const int tid = fresh_tid(), lane = tid & 63, wave = tid >> 6;
    {
        LAS float* sc = (LAS float*)lds; LAS float* red = sc + 4096;
        const float* c = p->in[I_C];
        for (int i = tid; i < 4096; i += NTHREADS) { const float v = c[i]; sc[i] = v / (1.f + __expf(-v)); }
        __syncthreads();
        float* MOD = (float*)(p->ws + WS_MOD);
        for (int it = wg; it < 2 * 96; it += nwg) {
            const int l = it / 96, n0 = (it % 96) * 64, kg = tid >> 6, nl = tid & 63;
            const float* W = p->in[I_ADAW] + (size_t)l * 1024 * 6144 + n0 + nl;
            float a0 = 0.f, a1 = 0.f, a2 = 0.f, a3 = 0.f;
            for (int k0 = kg; k0 < 1024; k0 += 8 * 32) { float w[32];
#pragma unroll
                for (int q = 0; q < 32; ++q) w[q] = W[(size_t)(k0 + 8 * q) * 6144];
#pragma unroll
                for (int q = 0; q < 32; ++q) { const int k = k0 + 8 * q; a0 += sc[k] * w[q]; a1 += sc[1024 + k] * w[q]; a2 += sc[2048 + k] * w[q]; a3 += sc[3072 + k] * w[q]; } }
            red[(kg * 4 + 0) * 64 + nl] = a0; red[(kg * 4 + 1) * 64 + nl] = a1; red[(kg * 4 + 2) * 64 + nl] = a2; red[(kg * 4 + 3) * 64 + nl] = a3;
            __syncthreads();
            if (tid < 256) { const int b = tid >> 6; float s = 0.f;
#pragma unroll
                for (int g = 0; g < 8; ++g) s += red[(g * 4 + b) * 64 + nl];
                MOD[(size_t)(l * 4 + b) * 6144 + n0 + nl] = s + p->in[I_ADAB][l * 6144 + n0 + nl]; }
            __syncthreads();
        }
    }
    {
        LAS float* scr = (LAS float*)lds + wave * (64 * 65);
        const int gw = wave * nwg + wg, NGW = nwg * NWAVES;
        constexpr int I_IN = 16 * 80, I_OUT = 16 * 32, I_GU = EXPERT_FP8 ? 16 * 32 : 16 * 64, I_DN = EXPERT_FP8 ? 16 * 16 : 16 * 32;
        constexpr int I_GLU = 4 * 8;
        constexpr int I_LRU = 4 * 2 * 2;
        constexpr int NGU = EXPERT_FP8 ? 0 : 64 * I_GU, NDN = EXPERT_FP8 ? 0 : 64 * I_DN;
        constexpr int TOT = 2 * I_IN + 2 * I_OUT + NGU + NDN + 2 * I_GLU + 2 * I_LRU;
        for (int it = gw; it < TOT; it += NGW) {
            int r = it;
            if (r < 2 * I_IN) { const int l = r / I_IN, q = r % I_IN, kb = q / 80, nb = q % 80, n0 = nb * 32;
                const float sc = (n0 >= C_Q && n0 < C_K) ? C2 : 1.f;
                tr_item(p->in[I_WIN] + (size_t)l * 1024 * INC, INC, INC, kb * 64, n0, (bf16_t*)(p->ws + WS_WIN) + ((size_t)l * NP + n0) * 1024, sc, scr, lane); continue; }
            r -= 2 * I_IN;
            if (r < 2 * I_OUT) { const int l = r / I_OUT, q = r % I_OUT, kb = q / 32, nb = q % 32, n0 = nb * 32;
                tr_item(p->in[I_WOUT] + (size_t)l * 1024 * 1024, 1024, 1024, kb * 64, n0, (bf16_t*)(p->ws + WS_WOUT) + ((size_t)l * 1024 + n0) * 1024, 1.f, scr, lane); continue; }
            r -= 2 * I_OUT;
            if (r < NGU) { const int le = r / I_GU, q = r % I_GU, NBK = EXPERT_FP8 ? 32 : 64, kb = q / NBK, nb = q % NBK, n0 = nb * (2048 / NBK);
                const int s = n0 / 1024, rr = n0 % 1024, j = rr / 128, cc = rr % 128, drow = 256 * j + 128 * s + cc;
                if (EXPERT_FP8) tr_item8w(p->in[I_WGU] + (size_t)le * 1024 * 2048, 2048, kb * 64, n0, p->ws + WS_WGU + ((size_t)le * 2048 + drow) * 1024, 64.f, scr, lane);
                else tr_item(p->in[I_WGU] + (size_t)le * 1024 * 2048, 2048, 2048, kb * 64, n0, (bf16_t*)(p->ws + WS_WGU) + ((size_t)le * 2048 + drow) * 1024, 1.f, scr, lane); continue; }
            r -= NGU;
            if (r < NDN) { const int le = r / I_DN, q = r % I_DN, NBK = EXPERT_FP8 ? 16 : 32, kb = q / NBK, nb = q % NBK, n0 = nb * (1024 / NBK);
                if (EXPERT_FP8) tr_item8w(p->in[I_WDN] + (size_t)le * 1024 * 1024, 1024, kb * 64, n0, p->ws + WS_WDN + ((size_t)le * 1024 + n0) * 1024, 64.f, scr, lane);
                else tr_item(p->in[I_WDN] + (size_t)le * 1024 * 1024, 1024, 1024, kb * 64, n0, (bf16_t*)(p->ws + WS_WDN) + ((size_t)le * 1024 + n0) * 1024, 1.f, scr, lane); continue; }
            r -= NDN;
            if (r < 2 * I_GLU) { const int l = r / I_GLU, q = r % I_GLU, kb = q / 8, nb = q % 8, n0 = nb * 32;
                tr_item(p->in[I_GLUW] + (size_t)l * 256 * 256, 256, 256, kb * 64, n0, (bf16_t*)(p->ws + WS_GLUW) + ((size_t)l * 256 + n0) * 256, 1.f, scr, lane, 256); continue; }
            r -= 2 * I_GLU;
            { const int l = r / I_LRU, q = r % I_LRU, blk = q >> 2, gate = (q >> 1) & 1, n0 = (q & 1) * 32;
                tr_item(p->in[gate ? I_LRUWX : I_LRUWA] + (size_t)(l * 4 + blk) * 4096, 64, 64, 0, n0, (bf16_t*)(p->ws + WS_LRUW) + ((size_t)((l * 4 + blk) * 2 + gate) * 64 + n0) * 64, 1.f, scr, lane, 64); }
        }
#if EXPERT_FP8
        __syncthreads();
        ex_convert_wg(p, lds, wg, nwg);
#endif
    }
}

__device__ __forceinline__ void ph_norm1(PrmP p, int l, int wg, int nwg) {
    const int tid = fresh_tid(), lane = tid & 63, wave = tid >> 6;
    const float* X = (l == 0) ? p->in[I_X] : p->out;
    const float* MOD = (const float*)(p->ws + WS_MOD);
    bf16_t* HB = (bf16_t*)(p->ws + WS_HB);
    const float* g = p->in[I_PREMIXG] + l * 1024;
    f32x4 vn[4];
    { const int m0 = wg * NWAVES + wave;
#pragma unroll
      for (int j = 0; j < 4; ++j) vn[j] = *(const f32x4*)(X + (size_t)m0 * 1024 + 4 * lane + 256 * j); }
    for (int m = wg * NWAVES + wave; m < M; m += nwg * NWAVES) {
        const int b = m / T;
        const float* shift = MOD + (size_t)(l * 4 + b) * 6144 + 0 * 1024; const float* scale = shift + 1024;
        f32x4 v[4]; float ss = 0.f;
#pragma unroll
        for (int j = 0; j < 4; ++j) { v[j] = vn[j]; ss += (v[j].x * v[j].x + v[j].y * v[j].y) + (v[j].z * v[j].z + v[j].w * v[j].w); }
        { const int mn = m + nwg * NWAVES; if (mn < M) {
#pragma unroll
            for (int j = 0; j < 4; ++j) vn[j] = *(const f32x4*)(X + (size_t)mn * 1024 + 4 * lane + 256 * j); } }
        const float rstd = __builtin_amdgcn_rsqf(wave_sum(ss) * (1.f / 1024.f) + RMS_EPS);
#pragma unroll
        for (int j = 0; j < 4; ++j) { const int c = 4 * lane + 256 * j; const f32x4 gg = *(const f32x4*)(g + c), sc = *(const f32x4*)(scale + c), sh = *(const f32x4*)(shift + c);
            const f32x4 h = v[j] * rstd * gg * (sc + 1.f) + sh;
            u32x2 o; o.x = pk2(h.x, h.y); o.y = pk2(h.z, h.w); *(u32x2*)(HB + (size_t)m * 1024 + c) = o; }
    }
}

namespace pg8 {
#define PG8_LAS __attribute__((address_space(3)))
typedef unsigned short bf16_t;
typedef short bf16x8 __attribute__((ext_vector_type(8)));
typedef float f32x4 __attribute__((ext_vector_type(4)));
typedef unsigned u32x4 __attribute__((ext_vector_type(4)));
constexpr int BM = 256, BK = 64, HALF = 128, HTB = HALF * BK * 2  , STAGE_BYTES = 8 * HTB, NXCD = 8, WGM = 8;

__host__ __device__ __forceinline__ int lds_byte(int r, int c) { const int st = (r >> 4) * 2 + (c >> 5), rr = r & 15, cc = c & 31, ob = rr * 64 + cc * 2; return st * 1024 + (ob ^ (((ob >> 9) & 1) << 5)); }
__host__ __device__ __forceinline__ void stage_rc(int b, int& R, int& C) { const int st = b / 1024, sb = b % 1024, swz = sb ^ (((sb >> 9) & 1) << 5); R = (st >> 1) * 16 + swz / 64; C = (st & 1) * 32 + (swz % 64) / 2; }
__host__ __device__ __forceinline__ int perm32(int rho) { const int n = rho >> 4, i = rho & 15; return 8 * (i >> 2) + 4 * n + (i & 3); }

struct Unit { int pm, pn; };
struct Gemm { const bf16_t* A; const bf16_t* Bt; int M, N, K; const PG8_LAS unsigned short* rowtok = nullptr; int a_pitch = 0, a_kstep = 0; };

struct StaticOrder {
    int nM, nN, nwg, G, c;
    __host__ __device__ void init(int M, int N, int G_, int c_) { nM = M / BM; nN = N / BM; nwg = nM * nN; G = G_; c = c_; }
    __host__ __device__ bool next(int i, Unit& u) const {
        const long L = (long)i * G + c; if (L >= nwg) return false;
        int wgid = (int)L; { const int q = nwg / NXCD, r = nwg % NXCD, xcd = wgid % NXCD, off = wgid / NXCD; wgid = (xcd < r ? xcd * (q + 1) : r * (q + 1) + (xcd - r) * q) + off; }
        const int nig = WGM * nN, gid = wgid / nig, fm = gid * WGM, gsz = (nM - fm) < WGM ? (nM - fm) : WGM;
        u.pm = fm + ((wgid % nig) % gsz); u.pn = (wgid % nig) / gsz; return true;
    }
    __device__ __forceinline__ void a_ready(const Unit&) const {}
    __device__ __forceinline__ void done(const Unit&) const {}
};


__device__ __forceinline__ unsigned cvt_pk_bf16(float lo, float hi) { unsigned r; asm volatile("v_cvt_pk_bf16_f32 %0, %1, %2" : "=v"(r) : "v"(lo), "v"(hi)); return r; }
struct EpiBf16Plain {
    static constexpr bool PERM = true, AFTER_DRAIN = false, PERM64 = false; static constexpr int NVM = 0;
    bf16_t* O; int ldc;
    __device__ __forceinline__ void operator()(const f32x4 (&acc)[2][2][4][2], const Unit& u, int wr, int wc, int fr, int fq, int) const {
        const int row0 = u.pm * BM + wr * 64 + fr, col0 = u.pn * BM + wc * 32 + 8 * fq;
#pragma unroll
        for (int ai = 0; ai < 2; ++ai)
#pragma unroll
            for (int m = 0; m < 4; ++m) { bf16_t* rowp = O + (size_t)(row0 + ai * HALF + m * 16) * ldc + col0;
#pragma unroll
                for (int bj = 0; bj < 2; ++bj) { const f32x4 v0 = acc[ai][bj][m][0], v1 = acc[ai][bj][m][1];
                    u32x4 w; w.x = cvt_pk_bf16(v0[0], v0[1]); w.y = cvt_pk_bf16(v0[2], v0[3]); w.z = cvt_pk_bf16(v1[0], v1[1]); w.w = cvt_pk_bf16(v1[2], v1[3]);
                    *(u32x4*)(rowp + bj * HALF) = w; } }
    }
};
struct EpiSwiglu {
    static constexpr bool PERM = true, AFTER_DRAIN = false, PERM64 = false; static constexpr int NVM = 0;
    bf16_t* H1; const float* bgu;
    __device__ __forceinline__ void operator()(const f32x4 (&acc)[2][2][4][2], const Unit& u, int wr, int wc, int fr, int fq, int) const {
        const int j = u.pn & 7, row0 = u.pm * BM + wr * 64 + fr, lc0 = wc * 32 + 8 * fq;
        const float* bb = bgu + (size_t)(u.pn >> 3) * 2048 + j * 128 + lc0;
        const f32x4 bg0 = *(const f32x4*)(bb), bg1 = *(const f32x4*)(bb + 4), bu0 = *(const f32x4*)(bb + 1024), bu1 = *(const f32x4*)(bb + 1028);
#pragma unroll
        for (int ai = 0; ai < 2; ++ai)
#pragma unroll
            for (int m = 0; m < 4; ++m) { float o[8];
#pragma unroll
                for (int n = 0; n < 2; ++n) { const f32x4 g4 = acc[ai][0][m][n] + (n ? bg1 : bg0), u4 = acc[ai][1][m][n] + (n ? bu1 : bu0);
#pragma unroll
                    for (int q = 0; q < 4; ++q) { const float g = fminf(g4[q], 7.f), up = fminf(fmaxf(u4[q], -7.f), 7.f);
                        o[4 * n + q] = (up + 1.f) * g * __builtin_amdgcn_rcpf(1.f + __builtin_amdgcn_exp2f(-1.702f * 1.4426950408889634f * g)); } }
                u32x4 w; w.x = cvt_pk_bf16(o[0], o[1]); w.y = cvt_pk_bf16(o[2], o[3]); w.z = cvt_pk_bf16(o[4], o[5]); w.w = cvt_pk_bf16(o[6], o[7]);
                *(u32x4*)(H1 + (size_t)(row0 + ai * HALF + m * 16) * 1024 + j * 128 + lc0) = w; }
    }
};
__device__ __forceinline__ unsigned pk4_fp8(float a, float b, float c, float d) { int w = __builtin_amdgcn_cvt_pk_fp8_f32(a, b, 0, false); w = __builtin_amdgcn_cvt_pk_fp8_f32(c, d, w, true); return (unsigned)w; }
struct EpiSwiglu8 {
    static constexpr bool PERM = true, AFTER_DRAIN = false, PERM64 = false; static constexpr int NVM = 0;
    unsigned char* H1; const PG8_LAS float* bl;
    __device__ __forceinline__ void operator()(const f32x4 (&acc)[2][2][4][2], const Unit& u, int wr, int wc, int fr, int fq, int ui) const {
        const int j = u.pn & 7, row0 = u.pm * BM + wr * 64 + fr, lc0 = wc * 32 + 8 * fq;
        const PG8_LAS float* bb = bl + ui * 256 + lc0;
        const f32x4 bg0 = *(const PG8_LAS f32x4*)(bb), bg1 = *(const PG8_LAS f32x4*)(bb + 4), bu0 = *(const PG8_LAS f32x4*)(bb + 128), bu1 = *(const PG8_LAS f32x4*)(bb + 132);
#pragma unroll
        for (int ai = 0; ai < 2; ++ai)
#pragma unroll
            for (int m = 0; m < 4; ++m) { float o[8];
#pragma unroll
                for (int n = 0; n < 2; ++n) { const f32x4 ga = acc[ai][0][m][n], ua = acc[ai][1][m][n], gb = n ? bg1 : bg0, ub = n ? bu1 : bu0;
#pragma unroll
                    for (int hh = 0; hh < 2; ++hh) {
                        typedef float f2 __attribute__((ext_vector_type(2)));
                        f2 g = (f2){ga[2 * hh], ga[2 * hh + 1]} + (f2){gb[2 * hh], gb[2 * hh + 1]}, up = (f2){ua[2 * hh], ua[2 * hh + 1]} + (f2){ub[2 * hh], ub[2 * hh + 1]};
                        g.x = fminf(g.x, 7.f); g.y = fminf(g.y, 7.f); up.x = __builtin_amdgcn_fmed3f(up.x, -7.f, 7.f); up.y = __builtin_amdgcn_fmed3f(up.y, -7.f, 7.f);
                        const f2 t = g * (f2){-1.702f * 1.4426950408889634f, -1.702f * 1.4426950408889634f};
                        const f2 d = (f2){__builtin_amdgcn_exp2f(t.x), __builtin_amdgcn_exp2f(t.y)} + (f2){1.f, 1.f};
                        const f2 r = {__builtin_amdgcn_rcpf(d.x), __builtin_amdgcn_rcpf(d.y)};
                        const f2 a = __builtin_elementwise_fma(up, (f2){2.f, 2.f}, (f2){2.f, 2.f});
                        const f2 ov = (a * g) * r;
                        o[4 * n + 2 * hh] = ov.x; o[4 * n + 2 * hh + 1] = ov.y; } }
                typedef unsigned u32x2_ __attribute__((ext_vector_type(2))); u32x2_ w; w.x = pk4_fp8(o[0], o[1], o[2], o[3]); w.y = pk4_fp8(o[4], o[5], o[6], o[7]);
                *(u32x2_*)(H1 + ((size_t)(u.pm * 8 + j) * 256 + (wr * 64 + fr + ai * HALF + m * 16)) * 128 + lc0) = w; }
    }
};
struct EpiDown {
    static constexpr bool PERM = true, AFTER_DRAIN = false, PERM64 = false; static constexpr int NVM = 0;
    bf16_t* YR; const float* bdn;
    __device__ __forceinline__ void operator()(const f32x4 (&acc)[2][2][4][2], const Unit& u, int wr, int wc, int fr, int fq, int) const {
        const int jn = u.pn & 3, row0 = u.pm * BM + wr * 64 + fr, col0 = jn * BM + wc * 32 + 8 * fq;
        const float* bb = bdn + (size_t)(u.pn >> 2) * 1024 + col0;
        f32x4 bv[2][2]; bv[0][0] = *(const f32x4*)(bb); bv[0][1] = *(const f32x4*)(bb + 4); bv[1][0] = *(const f32x4*)(bb + HALF); bv[1][1] = *(const f32x4*)(bb + HALF + 4);
#pragma unroll
        for (int ai = 0; ai < 2; ++ai)
#pragma unroll
            for (int m = 0; m < 4; ++m) { bf16_t* rowp = YR + (size_t)(row0 + ai * HALF + m * 16) * 1024 + col0;
#pragma unroll
                for (int bj = 0; bj < 2; ++bj) { const f32x4 v0 = acc[ai][bj][m][0] + bv[bj][0], v1 = acc[ai][bj][m][1] + bv[bj][1];
                    u32x4 w; w.x = cvt_pk_bf16(v0[0], v0[1]); w.y = cvt_pk_bf16(v0[2], v0[3]); w.z = cvt_pk_bf16(v1[0], v1[1]); w.w = cvt_pk_bf16(v1[2], v1[3]);
                    *(u32x4*)(rowp + bj * HALF) = w; } }
    }
};
struct EpiDown8 {
    static constexpr bool PERM = true, AFTER_DRAIN = false, PERM64 = true; static constexpr int NVM = 0;
    unsigned char* YR; const PG8_LAS float* bl;
    __device__ __forceinline__ void operator()(const f32x4 (&acc)[2][2][4][2], const Unit& u, int wr, int wc, int fr, int fq, int ui) const {
        const int jn = u.pn & 3, row0 = u.pm * BM + wr * 64 + fr, col0 = jn * BM + wc * 32 + 8 * fq;
        const PG8_LAS float* bb = bl + ui * 256 + wc * 64 + 16 * fq;
        f32x4 bv[2][2]; bv[0][0] = *(const PG8_LAS f32x4*)(bb); bv[0][1] = *(const PG8_LAS f32x4*)(bb + 4); bv[1][0] = *(const PG8_LAS f32x4*)(bb + 8); bv[1][1] = *(const PG8_LAS f32x4*)(bb + 12);
#pragma unroll
        for (int ai = 0; ai < 2; ++ai)
#pragma unroll
            for (int m = 0; m < 4; ++m) { unsigned char* rowp = YR + ((size_t)(u.pm * 4 + jn) * 256 + (wr * 64 + fr + ai * HALF + m * 16)) * 256 + wc * 64 + 16 * fq;
                u32x4 w;
#pragma unroll
                for (int bj = 0; bj < 2; ++bj) { const f32x4 v0 = (acc[ai][bj][m][0] + bv[bj][0]) * 16.f, v1 = (acc[ai][bj][m][1] + bv[bj][1]) * 16.f;
                    w[2 * bj] = pk4_fp8(v0[0], v0[1], v0[2], v0[3]); w[2 * bj + 1] = pk4_fp8(v1[0], v1[1], v1[2], v1[3]); }
                *(u32x4*)rowp = w; }
    }
};
struct GroupOrder {
    int nt, nct, G, c; const PG8_LAS int* tile_e;
    __device__ __forceinline__ bool peek_pm(int i, int& rt) const { const int x = c & 7, j = c >> 3, rpg = 32 / nct, gi = i * 8 + x; rt = gi * rpg + j / nct; return G == 256 && rt < nt; }
    __device__ __forceinline__ bool next(int i, Unit& u) const {
        const int x = c & 7, j = c >> 3, rpg = 32 / nct, gi = i * 8 + x, rt = gi * rpg + j / nct, ct = j % nct;
        if (G != 256 || rt >= nt) return false;
        u.pm = rt; u.pn = tile_e[rt] * nct + ct; return true; }
    __device__ __forceinline__ void a_ready(const Unit&) const {}
    __device__ __forceinline__ void done(const Unit&) const {}
};

typedef int i32x8 __attribute__((ext_vector_type(8))); typedef int i32x4 __attribute__((ext_vector_type(4)));
__device__ __forceinline__ i32x8 cat8(bf16x8 lo, bf16x8 hi) { const i32x4 a = __builtin_bit_cast(i32x4, lo), b = __builtin_bit_cast(i32x4, hi); return __builtin_shufflevector(a, b, 0, 1, 2, 3, 4, 5, 6, 7); }
template <class Epi, class Sched, bool ALIGN_EPI = false, bool SP2 = false, int F8SCALE = 0, bool GATHER = false>
__device__ __forceinline__ void gemm_phase(PG8_LAS unsigned char* lds, const Gemm g, const Sched& S, const Epi& E) {
    const int tid = fresh_tid(), wid = __builtin_amdgcn_readfirstlane(tid >> 6), lane = tid & 63, wr = wid >> 2, wc = wid & 3, fr = lane & 15, fq = lane >> 4;
    const int K = g.K, nt = K / BK;
    unsigned voffA[2], voffB[2];
#pragma unroll
    for (int i = 0; i < 2; ++i) { int R, C; stage_rc(tid * 16 + i * 8192, R, C); const int Rb = Epi::PERM64 ? (64 * (R >> 5) + 16 * ((R & 15) >> 2) + 4 * ((R >> 4) & 1) + (R & 3)) : Epi::PERM ? ((R & ~31) + perm32(R & 31)) : R;
        voffA[i] = GATHER ? (unsigned)((R << 16) | (C * 2)) : (unsigned)(R * (g.a_pitch ? g.a_pitch : K * 2) + (g.a_pitch ? (C & 63) : C) * 2); voffB[i] = (unsigned)(Rb * K + C) * 2u; }
    static_assert(!GATHER || SP2, "the gathered form is written for the SP2 loop");
    unsigned gA[2][2] = {{0u, 0u}, {0u, 0u}}, gN[2][2] = {{0u, 0u}, {0u, 0u}};
#define PG8_GLOOK(dst, unit) do { _Pragma("unroll") for (int h_ = 0; h_ < 2; ++h_) _Pragma("unroll") for (int i_ = 0; i_ < 2; ++i_) \
        dst[h_][i_] = (unsigned)g.rowtok[(unit) * BM + h_ * HALF + (int)(voffA[i_] >> 16)]; } while (0)
#define PG8_GOFF(dst, src) do { _Pragma("unroll") for (int h_ = 0; h_ < 2; ++h_) _Pragma("unroll") for (int i_ = 0; i_ < 2; ++i_) dst[h_][i_] = src[h_][i_] * (unsigned)(K * 2) + (voffA[i_] & 0xffffu); } while (0)
#define PG8_STAGE_A(bufoff, gbase, half, OFFS) do { if constexpr (GATHER) { _Pragma("unroll") for (int _i = 0; _i < 2; ++_i) \
        __builtin_amdgcn_global_load_lds((const unsigned*)((const char*)(gbase) + OFFS[half][_i]), (PG8_LAS unsigned*)(lds + (bufoff) + ldsw + _i * 8192), 16, 0, 0); } \
        else { PG8_STAGE(bufoff, (gbase) + (half) * hstepA, voffA); } } while (0)
    const size_t kstep = (size_t)(BK * 2);
    const size_t hstep = (size_t)HALF * K * 2;
    const size_t kstepA = g.a_kstep ? (size_t)g.a_kstep : kstep, hstepA = g.a_pitch ? (size_t)HALF * g.a_pitch : hstep;
    const size_t tstep = 2 * hstep;
    const size_t hstepB = Epi::PERM64 ? (size_t)8 * K * 2 : hstep;
    static_assert(!Epi::PERM64 || SP2, "PERM64 is wired into the SP2 loop only");
    const unsigned ldsw = (unsigned)wid * 1024u;
    const int aoff = lds_byte(wr * 64 + fr, fq * 8), boff = lds_byte(wc * 32 + fr, fq * 8);
#define PG8_SA(b, h) (((b) * 2 + (h)) * HTB)
#define PG8_SB(b, h) ((4 + (b) * 2 + (h)) * HTB)
#define PG8_STAGE(bufoff, gbase, voff) do { _Pragma("unroll") for (int _i = 0; _i < 2; ++_i) \
        __builtin_amdgcn_global_load_lds((const unsigned*)((const char*)(gbase) + (voff)[_i]), (PG8_LAS unsigned*)(lds + (bufoff) + ldsw + _i * 8192), 16, 0, 0); } while (0)
#define PG8_LDA(dst, b, h) do { _Pragma("unroll") for (int m = 0; m < 4; ++m) { const bf16x8 l0_ = *(const PG8_LAS bf16x8*)(lds + PG8_SA(b, h) + aoff + m * 2048), l1_ = *(const PG8_LAS bf16x8*)(lds + PG8_SA(b, h) + aoff + m * 2048 + 1024); \
        if constexpr (F8SCALE != 0) dst##8[m] = cat8(l0_, l1_); else { dst[m][0] = l0_; dst[m][1] = l1_; } } } while (0)
#define PG8_LDB(dst, b, h) do { _Pragma("unroll") for (int n = 0; n < 2; ++n) { const bf16x8 l0_ = *(const PG8_LAS bf16x8*)(lds + PG8_SB(b, h) + boff + n * 2048), l1_ = *(const PG8_LAS bf16x8*)(lds + PG8_SB(b, h) + boff + n * 2048 + 1024); \
        if constexpr (F8SCALE != 0) dst##8[n] = cat8(l0_, l1_); else { dst[n][0] = l0_; dst[n][1] = l1_; } } } while (0)
#define PG8_MMA(ai, bj, At, Bt) do { __builtin_amdgcn_s_setprio(1); _Pragma("unroll") for (int m = 0; m < 4; ++m) _Pragma("unroll") for (int n = 0; n < 2; ++n) { \
        if constexpr (F8SCALE != 0) { if (F8_ALLV || ((ai) == 1 && (bj) == 1)) asm volatile("v_mfma_scale_f32_16x16x128_f8f6f4 %0, %1, %2, %0, %3, %4 op_sel_hi:[0,0,0]" : "+v"(acc[ai][bj][m][n]) : "v"(Bt##8[n]), "v"(At##8[m]), "v"(f8sa), "v"(f8sb)); \
            else asm volatile("v_mfma_scale_f32_16x16x128_f8f6f4 %0, %1, %2, %0, %3, %4 op_sel_hi:[0,0,0]" : "+a"(acc[ai][bj][m][n]) : "v"(Bt##8[n]), "v"(At##8[m]), "v"(f8sa), "v"(f8sb)); } \
        else { _Pragma("unroll") for (int k = 0; k < 2; ++k) acc[ai][bj][m][n] = __builtin_amdgcn_mfma_f32_16x16x32_bf16(Bt[n][k], At[m][k], acc[ai][bj][m][n], 0, 0, 0); } } __builtin_amdgcn_s_setprio(0); } while (0)
#define PG8_WAIT_V(n) asm volatile("s_waitcnt vmcnt(" #n ")" ::: "memory")
#define PG8_WAIT_V8F(first) asm volatile("v_cmp_ne_u32_e32 vcc, 0, %0\n\ts_nop 4\n\ts_cbranch_vccnz .Lpg8sk_%=\n\ts_waitcnt vmcnt(8)\n.Lpg8sk_%=:\n\ts_waitcnt vmcnt(%1)" :: "v"(first), "n"(8 + Epi::NVM) : "memory", "vcc")
#define PG8_WAIT_L(n) asm volatile("s_waitcnt lgkmcnt(" #n ")" ::: "memory")
#define PG8_BAR __builtin_amdgcn_s_barrier()
#define PG8_SCHED __builtin_amdgcn_sched_barrier(0)
    Unit cur, nxt; int ui = 0;
    if (!S.next(0, cur)) return;
    f32x4 acc[2][2][4][2];
#pragma unroll
    for (int a = 0; a < 2; ++a)
#pragma unroll
        for (int b = 0; b < 2; ++b)
#pragma unroll
            for (int m = 0; m < 4; ++m)
#pragma unroll
                for (int n = 0; n < 2; ++n) acc[a][b][m][n] = (f32x4){0.f, 0.f, 0.f, 0.f};
    bf16x8 At[4][2], B0[2][2], B1[2][2]; i32x8 At8[4], B08[2], B18[2];
    const int f8sa = F8SCALE * 0x01010101, f8sb = 0x7f7f7f7f;
    const char* cA = GATHER ? (const char*)g.A : (const char*)g.A + (size_t)cur.pm * tstep; const char* cB = (const char*)g.Bt + (size_t)cur.pn * tstep;
    if constexpr (GATHER) { PG8_GLOOK(gN, 0); PG8_GOFF(gA, gN); }
    S.a_ready(cur);
    if constexpr (SP2) {
        PG8_STAGE(PG8_SB(0, 0), cB, voffB); PG8_STAGE(PG8_SB(0, 1), cB + hstepB, voffB); PG8_STAGE_A(PG8_SA(0, 0), cA, 0, gA); PG8_STAGE_A(PG8_SA(0, 1), cA, 1, gA);
        if (wr == 1) PG8_BAR;
        PG8_WAIT_V(2); PG8_BAR;
        PG8_STAGE(PG8_SB(1, 0), cB + kstep, voffB); PG8_STAGE_A(PG8_SA(1, 0), cA + kstepA, 0, gA); PG8_STAGE(PG8_SB(1, 1), cB + hstepB + kstep, voffB);
        PG8_WAIT_V(6); PG8_BAR;
    } else {
        PG8_STAGE(PG8_SB(0, 0), cB, voffB); PG8_STAGE(PG8_SA(0, 0), cA, voffA); PG8_STAGE(PG8_SB(0, 1), cB + hstep, voffB); PG8_STAGE(PG8_SA(0, 1), cA + hstep, voffA);
        if (wr == 1) PG8_BAR;
        PG8_WAIT_V(4); PG8_BAR;
        PG8_STAGE(PG8_SB(1, 0), cB + kstep, voffB); PG8_STAGE(PG8_SA(1, 0), cA + kstep, voffA); PG8_STAGE(PG8_SB(1, 1), cB + hstep + kstep, voffB);
        PG8_WAIT_V(6); PG8_BAR;
    }
    for (;;) {
        if constexpr (GATHER) { int rt_; if (S.peek_pm(ui + 1, rt_)) PG8_GLOOK(gN, ui + 1); }
        const bool has_next = S.next(ui + 1, nxt);
        const char* nA = (has_next && !GATHER) ? (const char*)g.A + (size_t)nxt.pm * tstep : cA; const char* nB = has_next ? (const char*)g.Bt + (size_t)nxt.pn * tstep : cB;
        for (int t = 0; t < nt; t += 2) {
            const bool last = (t == nt - 2); const int ufirst = ((t == 0) && (ui > 0) && (Epi::NVM > 0)) ? 1 : 0;
            const char* a1 = cA + (size_t)(t + 1) * kstepA;
            const char* a2 = last ? nA : cA + (size_t)(t + 2) * kstepA; const char* b2 = last ? nB : cB + (size_t)(t + 2) * kstep;
            const char* a3 = a2 + kstepA; const char* b3 = b2 + kstep;
            if (last && has_next) S.a_ready(nxt);
            unsigned o2[2][2] = {{gA[0][0], gA[0][1]}, {gA[1][0], gA[1][1]}};
            if constexpr (GATHER) { if (last) { asm volatile("" : "+v"(gN[0][0]), "+v"(gN[0][1]), "+v"(gN[1][0]), "+v"(gN[1][1]) :: "memory"); PG8_GOFF(o2, gN); } }
            if constexpr (SP2) {
            PG8_LDB(B0, 0, 0); PG8_LDB(B1, 0, 1); PG8_SCHED; PG8_LDA(At, 0, 0); PG8_STAGE_A(PG8_SA(1, 1), a1, 1, gA);
            PG8_WAIT_V8F(ufirst); PG8_WAIT_L(0); PG8_BAR; PG8_MMA(0, 0, At, B0); PG8_MMA(0, 1, At, B1); PG8_BAR; PG8_SCHED;
            PG8_LDA(At, 0, 1); PG8_STAGE(PG8_SB(0, 0), b2, voffB); PG8_STAGE(PG8_SB(0, 1), b2 + hstepB, voffB); PG8_STAGE_A(PG8_SA(0, 0), a2, 0, o2);
            PG8_WAIT_V8F(ufirst); PG8_WAIT_L(0); PG8_BAR; PG8_MMA(1, 0, At, B0); PG8_MMA(1, 1, At, B1); PG8_BAR; PG8_SCHED;
            PG8_LDB(B0, 1, 0); PG8_LDB(B1, 1, 1); PG8_SCHED; PG8_LDA(At, 1, 0); PG8_STAGE_A(PG8_SA(0, 1), a2, 1, o2);
            PG8_WAIT_V(8); PG8_WAIT_L(0); PG8_BAR; PG8_MMA(0, 0, At, B0); PG8_MMA(0, 1, At, B1); PG8_BAR; PG8_SCHED;
            PG8_LDA(At, 1, 1); PG8_STAGE(PG8_SB(1, 0), b3, voffB); PG8_STAGE(PG8_SB(1, 1), b3 + hstepB, voffB); PG8_STAGE_A(PG8_SA(1, 0), a3, 0, o2);
            PG8_WAIT_V(8); PG8_WAIT_L(0); PG8_BAR; PG8_MMA(1, 0, At, B0); PG8_MMA(1, 1, At, B1); PG8_BAR; PG8_SCHED;
            } else {
            PG8_LDB(B0, 0, 0); PG8_SCHED; PG8_LDA(At, 0, 0); PG8_STAGE(PG8_SA(1, 1), a1 + hstep, voffA);
            PG8_WAIT_L(8); PG8_BAR; PG8_WAIT_L(0); PG8_MMA(0, 0, At, B0); PG8_BAR; PG8_SCHED;
            PG8_LDB(B1, 0, 1); PG8_STAGE(PG8_SB(0, 0), b2, voffB);
            PG8_BAR; PG8_WAIT_L(0); PG8_MMA(0, 1, At, B1); PG8_BAR;
            PG8_LDA(At, 0, 1); PG8_STAGE(PG8_SA(0, 0), a2, voffA);
            PG8_BAR; PG8_WAIT_L(0); PG8_MMA(1, 0, At, B0); PG8_BAR; PG8_SCHED;
            PG8_STAGE(PG8_SB(0, 1), b2 + hstep, voffB);
            PG8_WAIT_V(6); PG8_BAR; PG8_MMA(1, 1, At, B1); PG8_BAR;
            PG8_LDB(B0, 1, 0); PG8_SCHED; PG8_LDA(At, 1, 0); PG8_STAGE(PG8_SA(0, 1), a2 + hstep, voffA);
            PG8_WAIT_L(8); PG8_BAR; PG8_WAIT_L(0); PG8_MMA(0, 0, At, B0); PG8_BAR; PG8_SCHED;
            PG8_LDB(B1, 1, 1); PG8_STAGE(PG8_SB(1, 0), b3, voffB);
            PG8_BAR; PG8_WAIT_L(0); PG8_MMA(0, 1, At, B1); PG8_BAR;
            PG8_LDA(At, 1, 1); PG8_STAGE(PG8_SA(1, 0), a3, voffA);
            PG8_BAR; PG8_WAIT_L(0); PG8_MMA(1, 0, At, B0); PG8_BAR; PG8_SCHED;
            PG8_STAGE(PG8_SB(1, 1), b3 + hstep, voffB);
            PG8_WAIT_V(6); PG8_BAR; PG8_MMA(1, 1, At, B1); PG8_BAR;
            }
        }
        if constexpr (ALIGN_EPI) { if (wr == 0) PG8_BAR; }
        if constexpr (!Epi::AFTER_DRAIN) { E(acc, cur, wr, wc, fr, fq, ui); S.done(cur); }
        if (!has_next) break;
#pragma unroll
        for (int a = 0; a < 2; ++a)
#pragma unroll
            for (int b = 0; b < 2; ++b)
#pragma unroll
                for (int m = 0; m < 4; ++m)
#pragma unroll
                    for (int n = 0; n < 2; ++n) acc[a][b][m][n] = (f32x4){0.f, 0.f, 0.f, 0.f};
        cur = nxt; cA = nA; cB = nB; ++ui;
        if constexpr (GATHER) PG8_GOFF(gA, gN);
        if constexpr (ALIGN_EPI) { if (wr == 1) PG8_BAR; }
    }
    PG8_WAIT_V(0);
    if constexpr (!ALIGN_EPI) { if (wr == 0) PG8_BAR; }
    PG8_BAR;
    if constexpr (Epi::AFTER_DRAIN) { E.fused(acc, cur, wr, wc, fr, fq, lds, wid, lane); S.done(cur); }
#undef PG8_SA
#undef PG8_SB
#undef PG8_STAGE
#undef PG8_STAGE_A
#undef PG8_GLOOK
#undef PG8_GOFF
#undef PG8_LDA
#undef PG8_LDB
#undef PG8_MMA
#undef PG8_WAIT_V
#undef PG8_WAIT_V8F
#undef PG8_WAIT_L
#undef PG8_BAR
#undef PG8_SCHED
}
}

constexpr int GX_TILE = 133760, GX_ROWS = GX_TILE + 2240;
constexpr int GX_BIAS = GX_ROWS + 17 * 512;
static_assert(GX_BIAS + 17 * 1024 <= 163840 - 64, "grouped-GEMM LDS tables");
__device__ __forceinline__ void fg_gemm_in(PrmP p, int l, LAS unsigned char* lds, int wg, int nwg) {
    pg8::Gemm g{(const bf16_t*)(p->ws + WS_HB), (const bf16_t*)(p->ws + WS_WIN) + (size_t)l * NP * 1024, M, NP, 1024}; pg8::StaticOrder S; S.init(M, NP, nwg, wg);
    pg8::EpiBf16Plain E{(bf16_t*)(p->ws + WS_PB), NP};
    pg8::gemm_phase<pg8::EpiBf16Plain, pg8::StaticOrder, true, true>(lds, g, S, E);
}
__device__ __forceinline__ void fg_gemm_out(PrmP p, int l, LAS unsigned char* lds, int wg, int nwg) {
    pg8::Gemm g{(const bf16_t*)(p->ws + WS_YC), (const bf16_t*)(p->ws + WS_WOUT) + (size_t)l * 1024 * 1024, M, 1024, 1024}; pg8::StaticOrder S; S.init(M, 1024, nwg, wg);
    pg8::EpiBf16Plain E{(bf16_t*)(p->ws + WS_Y), 1024};
    pg8::gemm_phase<pg8::EpiBf16Plain, pg8::StaticOrder, true, true>(lds, g, S, E);
}
__device__ __forceinline__ void fg_gemm1(PrmP p, int l, LAS unsigned char* lds, int wg, int nwg) {
    const int nt = ((const int*)(p->ws + WS_CTL))[CW_NT];
    LAS int* tl = (LAS int*)(lds + GX_TILE); LAS unsigned short* rl = (LAS unsigned short*)(lds + GX_ROWS);
    pg8::GroupOrder S{nt, 8, nwg, wg, tl};
    { const int tid = fresh_tid(); const int* TE = (const int*)(p->ws + WS_MISC + MS_TILEE); const int* RT = (const int*)(p->ws + WS_MISC + MS_ROWTOK);
      __syncthreads();
      for (int i = tid; i < nt; i += NTHREADS) tl[i] = TE[i];
      { int rv[17];
#pragma unroll
        for (int ui = 0; ui < 17; ++ui) { int rt; rv[ui] = (S.peek_pm(ui, rt) && tid < 256) ? RT[rt * 256 + tid] : 0; }
#pragma unroll
        for (int ui = 0; ui < 17; ++ui) if (tid < 256) rl[ui * 256 + tid] = (unsigned short)rv[ui]; }
      __syncthreads();
      if (EXPERT_FP8) { LAS float* bl = (LAS float*)(lds + GX_BIAS); const float* bgu = p->in[I_BGU] + (size_t)l * NE * 2048; float bv[17];
#pragma unroll
        for (int ui = 0; ui < 17; ++ui) { pg8::Unit u; bv[ui] = (S.next(ui, u) && tid < 256) ? bgu[(size_t)(u.pn >> 3) * 2048 + (tid >> 7) * 1024 + (u.pn & 7) * 128 + (tid & 127)] : 0.f; }
#pragma unroll
        for (int ui = 0; ui < 17; ++ui) if (tid < 256) bl[ui * 256 + tid] = bv[ui];
        __syncthreads(); } }
    if (EXPERT_FP8) {
        pg8::Gemm g{(const bf16_t*)(p->ws + WS_HB), (const bf16_t*)(p->ws + WS_WGU + (size_t)l * NE * 2048 * 1024), RP, NE * 2048, 512, rl};
        pg8::EpiSwiglu8 E{p->ws + WS_H1, (const LAS float*)(lds + GX_BIAS)};
        pg8::gemm_phase<pg8::EpiSwiglu8, pg8::GroupOrder, true, true, 119, true>(lds, g, S, E);
    } else {
    pg8::Gemm g{(const bf16_t*)(p->ws + WS_XS), (const bf16_t*)(p->ws + WS_WGU) + (size_t)l * NE * 2048 * 1024, RP, NE * 2048, 1024};
    pg8::EpiSwiglu E{(bf16_t*)(p->ws + WS_H1), p->in[I_BGU] + (size_t)l * NE * 2048};
    pg8::gemm_phase<pg8::EpiSwiglu, pg8::GroupOrder, true, true>(lds, g, S, E);
    }
}
__device__ __forceinline__ void fg_gemm2(PrmP p, int l, LAS unsigned char* lds, int wg, int nwg) {
    const int nt = ((const int*)(p->ws + WS_CTL))[CW_NT];
    LAS int* tl = (LAS int*)(lds + GX_TILE);
    pg8::GroupOrder S{nt, 4, nwg, wg, tl};
    { const int tid = fresh_tid(); const int* TE = (const int*)(p->ws + WS_MISC + MS_TILEE); __syncthreads(); for (int i = tid; i < nt; i += NTHREADS) tl[i] = TE[i]; __syncthreads();
      if (EXPERT_FP8 && YR_FP8) { LAS float* bl = (LAS float*)(lds + GX_BIAS); const float* bdn = p->in[I_BDN] + (size_t)l * NE * 1024; float bv[9];
#pragma unroll
        for (int ui = 0; ui < 9; ++ui) { pg8::Unit u; bv[ui] = (S.next(ui, u) && tid < 256) ? bdn[(size_t)(u.pn >> 2) * 1024 + (u.pn & 3) * 256 + tid] : 0.f; }
#pragma unroll
        for (int ui = 0; ui < 9; ++ui) if (tid < 256) bl[ui * 256 + tid] = bv[ui];
        __syncthreads(); } }
    pg8::EpiDown E{(bf16_t*)(p->ws + WS_YR), p->in[I_BDN] + (size_t)l * NE * 1024};
    if (EXPERT_FP8) {
        pg8::Gemm g{(const bf16_t*)(p->ws + WS_H1), (const bf16_t*)(p->ws + WS_WDN + (size_t)l * NE * 1024 * 1024), RP, NE * 1024, 512}; g.a_pitch = 128; g.a_kstep = 256 * 128;
        if (YR_FP8) { pg8::EpiDown8 E8{p->ws + WS_YR, (const LAS float*)(lds + GX_BIAS)}; pg8::gemm_phase<pg8::EpiDown8, pg8::GroupOrder, true, true, 120>(lds, g, S, E8); }
        else pg8::gemm_phase<pg8::EpiDown, pg8::GroupOrder, true, true, 120>(lds, g, S, E);
    } else {
    pg8::Gemm g{(const bf16_t*)(p->ws + WS_H1), (const bf16_t*)(p->ws + WS_WDN) + (size_t)l * NE * 1024 * 1024, RP, NE * 1024, 1024};
    pg8::gemm_phase<pg8::EpiDown, pg8::GroupOrder, true, true>(lds, g, S, E);
    }
}

#include <hip/hip_bf16.h>
#include <cmath>
namespace attn_body {
using bf16=__hip_bfloat16;
using bf16x8=__attribute__((ext_vector_type(8)))short;
using s16x4=__attribute__((ext_vector_type(4)))short;
using f32x16=__attribute__((ext_vector_type(16)))float;
using u32x4=__attribute__((ext_vector_type(4)))unsigned;
constexpr int BATCH=4,NHEAD=8,SEQ=8192,D=64,DM=2560;
constexpr int NW=8,QBLK=32,QB=QBLK*NW,KVBLK=64,NQB=SEQ/QB;
constexpr int ATTN_PITCH=DM, ATTN_UNIT_ROWS=QB;
__device__ __forceinline__ int crow(int r,int hi){return (r&3)+8*(r>>2)+4*hi;}
#define SBAR() __builtin_amdgcn_sched_barrier(0)
__device__ __forceinline__ void cmask(f32x16&p0,f32x16&p1,int jb,int qrel,int hi){
  const float NEG=-INFINITY; int kb=64*jb+4*hi;
  #pragma unroll
  for(int r=0;r<16;++r){int kv=kb+(r&3)+8*(r>>2); if(kv>qrel)p0[r]=NEG; if(kv+32>qrel)p1[r]=NEG;}
}

constexpr int NSLOT=3, SLOTB=8192;
constexpr int LDS_K=0, LDS_V=NSLOT*SLOTB, LDS_WS=2*NSLOT*SLOTB, LDS_OST=LDS_WS+NW*64*4, LDS_BYTES=LDS_OST+NW*4096;
constexpr float C2=0.125f*1.4426950408889634f;
__device__ __forceinline__ void glds16(const void*gsrc,unsigned lds_dst){unsigned keep;
  asm volatile("s_mov_b32 %0, m0\n\ts_mov_b32 m0, %2\n\ts_nop 0\n\tglobal_load_lds_dwordx4 %1, off\n\ts_mov_b32 m0, %0":"=&s"(keep):"v"(gsrc),"s"(lds_dst):"memory");}
__device__ __forceinline__ float max3f(float a,float b,float c){float r;asm("v_max3_f32 %0, %1, %2, %3":"=v"(r):"v"(a),"v"(b),"v"(c));return r;}
__device__ __forceinline__ float max2f(float a,float b){float r;asm("v_max_f32_e32 %0, %1, %2":"=v"(r):"v"(a),"v"(b));return r;}
__device__ __forceinline__ float fadd_s(float a,float b){float r;asm("v_add_f32_e32 %0, %1, %2":"=v"(r):"v"(a),"v"(b));return r;}
__device__ __forceinline__ float fsub_s(float a,float b){float r;asm("v_sub_f32_e32 %0, %1, %2":"=v"(r):"v"(a),"v"(b));return r;}
typedef float f32x2_t __attribute__((ext_vector_type(2))); typedef __bf16 bf16x2_t __attribute__((ext_vector_type(2)));
__device__ __forceinline__ unsigned cvtpk_s(float lo,float hi){f32x2_t v={lo,hi};bf16x2_t b=__builtin_convertvector(v,bf16x2_t);return __builtin_bit_cast(unsigned,b);}
__device__ __forceinline__ unsigned f2bf(float f) { return pk2(f, 0.f) & 0xffffu; }
#define WAIT_BAR(N) asm volatile("s_waitcnt vmcnt(" #N ") lgkmcnt(0)\n\ts_barrier":::"memory")

typedef __attribute__((address_space(3))) const float* lds_fptr;
__device__ __forceinline__ void split3(float f,unsigned&hb,unsigned&mb,unsigned&lb){
  hb=__float_as_uint(f)&0xffff0000u; const float r1=f-__uint_as_float(hb); mb=__float_as_uint(r1)&0xffff0000u; const float r2=r1-__uint_as_float(mb); lb=__float_as_uint(r2)&0xffff0000u; }
__device__ __forceinline__ bf16x8 mk_kx(float fk,int hi){ unsigned hb,mb,lb; split3(-fk,hb,mb,lb);
  u32x4 w; w.x=0x3f803f80u; w.y=hi?0x00003f80u:(0x00003f80u|hb); w.z=hi?0u:((mb>>16)|lb); w.w=0u; return __builtin_bit_cast(bf16x8,w); }
__device__ __forceinline__ bf16x8 mk_qx(float fq,float mhat,int hi){ unsigned hb,mb,lb; split3(hi?-mhat:fq,hb,mb,lb);
  u32x4 w; w.x=(hb>>16)|mb; w.y=hi?(lb>>16):((lb>>16)|0x3f800000u); w.z=hi?0u:0x3f803f80u; w.w=0u; return __builtin_bit_cast(bf16x8,w); }
__device__ __forceinline__ void qkt(f32x16&p0,f32x16&p1,const char*Kslot,const bf16x8*qr,bf16x8 kxa,bf16x8 kxb,bf16x8 qx,int r32,int hi){
  const f32x16 zc=f32x16{};
  const char*kb=Kslot+hi*1024+r32*16;
  #pragma unroll
  for(int d0=0;d0<4;++d0){
    const bf16x8 b0=*reinterpret_cast<const bf16x8*>(kb+d0*2048);
    const bf16x8 b1=*reinterpret_cast<const bf16x8*>(kb+d0*2048+512);
    if(d0==0){p0=__builtin_amdgcn_mfma_f32_32x32x16_bf16(b0,qr[0],zc,0,0,0);p1=__builtin_amdgcn_mfma_f32_32x32x16_bf16(b1,qr[0],zc,0,0,0);}
    else{p0=__builtin_amdgcn_mfma_f32_32x32x16_bf16(b0,qr[d0],p0,0,0,0);p1=__builtin_amdgcn_mfma_f32_32x32x16_bf16(b1,qr[d0],p1,0,0,0);}}
  p0=__builtin_amdgcn_mfma_f32_32x32x16_bf16(kxa,qx,p0,0,0,0);p1=__builtin_amdgcn_mfma_f32_32x32x16_bf16(kxb,qx,p1,0,0,0);
}
typedef __attribute__((address_space(3))) const char* lds_cptr;
typedef short v4i16_t __attribute__((ext_vector_type(4)));
__device__ __forceinline__ void kload8(bf16x8*kf,lds_cptr kp){
  kf[0]=*(const __attribute__((address_space(3))) bf16x8*)(kp);      kf[1]=*(const __attribute__((address_space(3))) bf16x8*)(kp+512);
  kf[2]=*(const __attribute__((address_space(3))) bf16x8*)(kp+2048); kf[3]=*(const __attribute__((address_space(3))) bf16x8*)(kp+2560);
  kf[4]=*(const __attribute__((address_space(3))) bf16x8*)(kp+4096); kf[5]=*(const __attribute__((address_space(3))) bf16x8*)(kp+4608);
  kf[6]=*(const __attribute__((address_space(3))) bf16x8*)(kp+6144); kf[7]=*(const __attribute__((address_space(3))) bf16x8*)(kp+6656);
}
__device__ __forceinline__ void kload2(bf16x8*kf,lds_cptr kp,int j){ kf[2*j]=*(const __attribute__((address_space(3))) bf16x8*)(kp+j*2048); kf[2*j+1]=*(const __attribute__((address_space(3))) bf16x8*)(kp+j*2048+512); }
__device__ __forceinline__ s16x4 vtr(lds_cptr p){ return __builtin_bit_cast(s16x4,__builtin_amdgcn_ds_read_tr16_b64_v4i16((__attribute__((address_space(3))) v4i16_t*)p)); }
__device__ __forceinline__ float rowmax(const f32x16&p0,const f32x16&p1){
  float a=max3f(p0[0],p0[1],p1[0]),b=max3f(p0[2],p0[3],p1[1]);a=max3f(a,p1[2],p1[3]);
  #pragma unroll
  for(int r=4;r<16;r+=4){a=max3f(a,p0[r],p0[r+1]);b=max3f(b,p0[r+2],p0[r+3]);a=max3f(a,p1[r],p1[r+1]);b=max3f(b,p1[r+2],p1[r+3]);}
  const float m=max2f(a,b);
  auto rr=__builtin_amdgcn_permlane32_swap(__float_as_uint(m),__float_as_uint(m),false,false);
  return max2f(__uint_as_float(rr[0]),__uint_as_float(rr[1]));
}
__device__ __forceinline__ void pv(f32x16*o,int vb,bf16x8 pa0,bf16x8 pa1,bf16x8 pa2,bf16x8 pa3){
  #pragma unroll
  for(int d0=0;d0<2;++d0){s16x4 lo[4],hi[4];
    #pragma unroll
    for(int ks=0;ks<4;++ks){
      asm volatile("ds_read_b64_tr_b16 %0,%1 offset:%c2":"=&v"(lo[ks]):"v"(vb),"i"(d0*4096+ks*1024):"memory");
      asm volatile("ds_read_b64_tr_b16 %0,%1 offset:%c2":"=&v"(hi[ks]):"v"(vb),"i"(d0*4096+ks*1024+512):"memory");}
    asm volatile("s_waitcnt lgkmcnt(0)":::"memory");SBAR();
    #define PK(k) (bf16x8){lo[k][0],lo[k][1],lo[k][2],lo[k][3],hi[k][0],hi[k][1],hi[k][2],hi[k][3]}
    o[d0]=__builtin_amdgcn_mfma_f32_32x32x16_bf16(pa0,PK(0),o[d0],0,0,0);
    o[d0]=__builtin_amdgcn_mfma_f32_32x32x16_bf16(pa1,PK(1),o[d0],0,0,0);
    o[d0]=__builtin_amdgcn_mfma_f32_32x32x16_bf16(pa2,PK(2),o[d0],0,0,0);
    o[d0]=__builtin_amdgcn_mfma_f32_32x32x16_bf16(pa3,PK(3),o[d0],0,0,0);
    #undef PK
  }
}

#ifndef ATTN_STORE16
#define ATTN_STORE16(p,v) (*(u32x4*)(p)=(v))
#endif
template<int THRL> __device__ __forceinline__ void attn_unit(int b,int h,int qb,const bf16*Q,const bf16*__restrict__ K,const bf16*__restrict__ V,bf16*O,char*shm,lds_fptr F2s,int tstart,float kmx){
  const int tid=::fresh_tid(),lane=tid&63,r32=lane&31,hi=lane>>5; const int wid=__builtin_amdgcn_readfirstlane(tid>>6);
  const long rowbase=(long)b*SEQ; const int q0=qb*QB;
  const bf16*Qw=Q+(rowbase+q0+wid*QBLK)*DM+h*D;
  const bf16*Kh=K+(rowbase+(long)tstart*KVBLK)*DM+h*D,*Vh=V+(rowbase+(long)tstart*KVBLK)*DM+h*D; const lds_fptr F2k=F2s+tstart*KVBLK;
  const unsigned lds0=(unsigned)(uintptr_t)shm;
  float*wsf=(float*)(shm+LDS_WS)+wid*64;
  const bf16*ksrc=Kh+(long)lane*DM+wid*8;
  const bf16*vsrc=Vh+(long)(16*(wid&3)+(lane>>2))*DM+(wid>>2)*32+(lane&3)*8;
  const unsigned kdst=lds0+LDS_K+wid*1024, vdst=lds0+LDS_V+wid*1024;
  #define DMA_K(t,slot) glds16(ksrc+(long)(t)*KVBLK*DM,(unsigned)__builtin_amdgcn_readfirstlane(kdst+(slot)))
  #define DMA_V(t,slot) glds16(vsrc+(long)(t)*KVBLK*DM,(unsigned)__builtin_amdgcn_readfirstlane(vdst+(slot)))
  const int vb0=(int)(lds0+LDS_V)+((lane>>4)&1)*32+(lane&3)*8+(4*hi+((lane&15)>>2))*64;
  const char*Kbase=shm+LDS_K; bf16x8 kf[8];
  const lds_cptr shm3=(lds_cptr)shm; const lds_cptr kp0=shm3+LDS_K+hi*1024+r32*16; const lds_cptr vp0=shm3+LDS_V+((lane>>4)&1)*32+(lane&3)*8+(4*hi+((lane&15)>>2))*64;
  const int NT=(q0+QB)/KVBLK-tstart;
  DMA_K(0,0);DMA_V(0,0);DMA_K(1,SLOTB);
  bf16x8 qr[4];
  #pragma unroll
  for(int d0=0;d0<4;++d0)qr[d0]=*reinterpret_cast<const bf16x8*>(&Qw[(long)r32*DM+d0*16+hi*8]);
  float m0; { float qq=0.f;
    #pragma unroll
    for(int d0=0;d0<4;++d0){const u32x4 w_=__builtin_bit_cast(u32x4,qr[d0]);
      #pragma unroll
      for(int j_=0;j_<4;++j_){const float a_=__uint_as_float(w_[j_]<<16),b_=__uint_as_float(w_[j_]&0xffff0000u);qq+=a_*a_+b_*b_;}}
    qq+=__shfl_xor(qq,32); m0=sqrtf(qq)*kmx+1.f; }
  float l_reg=0.f;f32x16 o[2];o[0]=f32x16{};o[1]=f32x16{};const f32x16 zc=f32x16{};
  const float fq_=F2s[q0+wid*QBLK+r32]; const bf16x8 qx=mk_qx(fq_,m0,hi);
  const int qrel=wid*QBLK+r32;
  #define CMASK(P0,P1,t) do{int jb_=(t)-(NT-4); if(jb_>=0)cmask(P0,P1,jb_,qrel,hi);}while(0)
  #define START(P0,P1) do{ _Pragma("unroll") for(int r=0;r<16;++r)P0[r]=__builtin_amdgcn_exp2f(P0[r]); }while(0)
  #define RESC() do{}while(0)
  f32x16 pA0,pA1,pB0,pB1;
  int sl_prev=0,sl_cur=0,sl_next=SLOTB;
  #define ROT() do{sl_prev=sl_cur;sl_cur=sl_next;sl_next=(sl_next==(NSLOT-1)*SLOTB)?0:sl_next+SLOTB;}while(0)
  DMA_K(2,2*SLOTB);
  WAIT_BAR(3);
  qkt(pA0,pA1,Kbase,qr,mk_kx(F2k[r32],hi),mk_kx(F2k[32+r32],hi),qx,r32,hi);asm volatile("s_nop 15\n\ts_nop 7":"+v"(pA0),"+v"(pA1));CMASK(pA0,pA1,0);
  START(pA0,pA1);
  _Pragma("unroll") for(int r=0;r<16;++r)pA1[r]=__builtin_amdgcn_exp2f(pA1[r]);
  WAIT_BAR(0);
  DMA_K(3,0);DMA_V(1,SLOTB);
  ROT();
  kload8(kf,kp0+sl_cur);
  WAIT_BAR(2);
  s16x4 vlo[8],vhi[8]; u32x4 pw0,pw1,pw2,pw3;
  #define PKW(P,B) cvtpk_s(P[B],P[B+1])
  #define PAF(k) __builtin_bit_cast(bf16x8,pw##k)
  #define VFR(i) (bf16x8){vlo[i][0],vlo[i][1],vlo[i][2],vlo[i][3],vhi[i][0],vhi[i][1],vhi[i][2],vhi[i][3]}
  #define PIN(x) asm volatile("":"+v"(x))
  #define MX3(a,b,c) __builtin_fmaxf(__builtin_fmaxf((a),(b)),(c))
  #define GAPA(MF,A0,A1,A2,A3,W0,W1,PW) do{ MF; sacc+=A0; sacc+=A1; sacc+=A2; sacc+=A3; PIN(sacc); W0; W1; PIN(PW); SBAR(); }while(0)
  #define EX(v) __builtin_amdgcn_exp2f(v)
  #define GAPB(MF,X,B) do{ MF; X[B]=EX(X[B]); X[B+1]=EX(X[B+1]); X[B+2]=EX(X[B+2]); X[B+3]=EX(X[B+3]); PIN(X); SBAR(); }while(0)
  #define VRD(i) do{ vlo[i]=vtr(vp_+(((i)>>2)*4096+((i)&3)*1024)); vhi[i]=vtr(vp_+(((i)>>2)*4096+((i)&3)*1024+512)); }while(0)
  #define KRD(G,j) do{ if(G){ kload2(kf,kp0+sl_next,j); SBAR(); } }while(0)
  #define STEP(C0,C1,P0,P1,t,GK,GV,GL) do{ const float fka_=F2k[(t)*KVBLK+r32],fkb_=F2k[(t)*KVBLK+32+r32]; SBAR(); \
    const lds_cptr vp_=vp0+sl_prev; \
    VRD(0); SBAR(); float sacc=(P0[0]+P0[1]); \
    GAPA(C0=__builtin_amdgcn_mfma_f32_32x32x16_bf16(kf[0],qr[0],zc,0,0,0), P0[2],P0[3],P0[4],P0[5],     pw0[0]=PKW(P0,0), pw0[1]=PKW(P0,2), pw0); \
    VRD(4); SBAR(); GAPA(C1=__builtin_amdgcn_mfma_f32_32x32x16_bf16(kf[1],qr[0],zc,0,0,0), P0[6],P0[7],P0[8],P0[9],     pw0[2]=PKW(P0,4), pw0[3]=PKW(P0,6), pw0); \
    VRD(1); SBAR(); GAPA(C0=__builtin_amdgcn_mfma_f32_32x32x16_bf16(kf[2],qr[1],C0,0,0,0),   P0[10],P0[11],P0[12],P0[13], pw1[0]=PKW(P0,8), pw1[1]=PKW(P0,10), pw1); \
    VRD(5); SBAR(); GAPA(C1=__builtin_amdgcn_mfma_f32_32x32x16_bf16(kf[3],qr[1],C1,0,0,0),   P0[14],P0[15],P1[0],P1[1],   pw1[2]=PKW(P0,12),pw1[3]=PKW(P0,14), pw1); \
    VRD(2); SBAR(); GAPA(C0=__builtin_amdgcn_mfma_f32_32x32x16_bf16(kf[4],qr[2],C0,0,0,0),   P1[2],P1[3],P1[4],P1[5],     pw2[0]=PKW(P1,0), pw2[1]=PKW(P1,2), pw2); \
    VRD(6); SBAR(); GAPA(C1=__builtin_amdgcn_mfma_f32_32x32x16_bf16(kf[5],qr[2],C1,0,0,0),   P1[6],P1[7],P1[8],P1[9],     pw2[2]=PKW(P1,4), pw2[3]=PKW(P1,6), pw2); \
    VRD(3); SBAR(); GAPA(C0=__builtin_amdgcn_mfma_f32_32x32x16_bf16(kf[6],qr[3],C0,0,0,0),   P1[10],P1[11],P1[12],P1[13], pw3[0]=PKW(P1,8), pw3[1]=PKW(P1,10), pw3); \
    VRD(7); SBAR(); GAPA(C1=__builtin_amdgcn_mfma_f32_32x32x16_bf16(kf[7],qr[3],C1,0,0,0),   P1[14],P1[15],0.f,0.f,       pw3[2]=PKW(P1,12),pw3[3]=PKW(P1,14), pw3); \
    { C0=__builtin_amdgcn_mfma_f32_32x32x16_bf16(mk_kx(fka_,hi),qx,C0,0,0,0); SBAR(); C1=__builtin_amdgcn_mfma_f32_32x32x16_bf16(mk_kx(fkb_,hi),qx,C1,0,0,0); } \
    l_reg+=sacc; \
    if(GK){DMA_K((t)+3,sl_cur);} if(GV){DMA_V((t)+1,sl_next);} \
    CMASK(C0,C1,t); \
    SBAR(); \
    GAPB(o[0]=__builtin_amdgcn_mfma_f32_32x32x16_bf16(PAF(0),VFR(0),o[0],0,0,0), C0,0); \
    GAPB(o[1]=__builtin_amdgcn_mfma_f32_32x32x16_bf16(PAF(0),VFR(4),o[1],0,0,0), C0,4); \
    KRD(GL,0); GAPB(o[0]=__builtin_amdgcn_mfma_f32_32x32x16_bf16(PAF(1),VFR(1),o[0],0,0,0), C0,8); \
    KRD(GL,1); GAPB(o[1]=__builtin_amdgcn_mfma_f32_32x32x16_bf16(PAF(1),VFR(5),o[1],0,0,0), C0,12); \
    KRD(GL,2); GAPB(o[0]=__builtin_amdgcn_mfma_f32_32x32x16_bf16(PAF(2),VFR(2),o[0],0,0,0), C1,0); \
    KRD(GL,3); GAPB(o[1]=__builtin_amdgcn_mfma_f32_32x32x16_bf16(PAF(2),VFR(6),o[1],0,0,0), C1,4); \
    GAPB(o[0]=__builtin_amdgcn_mfma_f32_32x32x16_bf16(PAF(3),VFR(3),o[0],0,0,0), C1,8); \
    GAPB(o[1]=__builtin_amdgcn_mfma_f32_32x32x16_bf16(PAF(3),VFR(7),o[1],0,0,0), C1,12); \
    }while(0)
  int t=1;
  #undef CMASK
  #define CMASK(P0,P1,t) do{}while(0)
  for(;t+5<NT;t+=2){
    STEP(pB0,pB1,pA0,pA1,t,true,true,true);     WAIT_BAR(2); RESC(); ROT();
    STEP(pA0,pA1,pB0,pB1,t+1,true,true,true);   WAIT_BAR(2); RESC(); ROT();
  }
  #undef CMASK
  #define CMASK(P0,P1,t) do{int jb_=(t)-(NT-4); if(jb_>=0)cmask(P0,P1,jb_,qrel,hi);}while(0)
  #define ENDW(tt) do{ if((tt)+3<NT){WAIT_BAR(2);} else if((tt)+2<NT){WAIT_BAR(1);} else {WAIT_BAR(0);} }while(0)
  for(;t+1<NT;t+=2){
    STEP(pB0,pB1,pA0,pA1,t,(t+3<NT),(t+1<NT),(t+1<NT));       ENDW(t);   RESC(); ROT();
    STEP(pA0,pA1,pB0,pB1,t+1,(t+4<NT),(t+2<NT),(t+2<NT));     ENDW(t+1); RESC(); ROT();
  }
  STEP(pB0,pB1,pA0,pA1,NT-1,false,false,false); RESC();
  { float sacc=pB0[0]+pB0[1]; _Pragma("unroll") for(int r=2;r<16;++r)sacc+=pB0[r]; _Pragma("unroll") for(int r=0;r<16;++r)sacc+=pB1[r]; l_reg+=sacc;
    pw0=(u32x4){PKW(pB0,0),PKW(pB0,2),PKW(pB0,4),PKW(pB0,6)};pw1=(u32x4){PKW(pB0,8),PKW(pB0,10),PKW(pB0,12),PKW(pB0,14)};pw2=(u32x4){PKW(pB1,0),PKW(pB1,2),PKW(pB1,4),PKW(pB1,6)};pw3=(u32x4){PKW(pB1,8),PKW(pB1,10),PKW(pB1,12),PKW(pB1,14)};
    SBAR(); pv(o,vb0+sl_cur,PAF(0),PAF(1),PAF(2),PAF(3)); }
  #undef PKW
  #undef PAF
  #undef VFR
  #undef PIN
  #undef MX3
  #undef GAPA
  #undef GAPB
  #undef EX
  #undef VRD
  #undef KRD
  #undef STEP
  #undef ENDW
  {auto rr=__builtin_amdgcn_permlane32_swap(__float_as_uint(l_reg),__float_as_uint(l_reg),false,false);l_reg=__uint_as_float(rr[0])+__uint_as_float(rr[1]);}
  if(hi==0)wsf[32+r32]=l_reg;asm volatile("s_waitcnt lgkmcnt(0)":::"memory");
  float rli[16];
  #pragma unroll
  for(int r=0;r<16;++r)rli[r]=__builtin_amdgcn_rcpf(wsf[32+crow(r,hi)]);
  bf16*Ow=O+(rowbase+q0+wid*QBLK)*DM+h*D;
  { bf16*stg=(bf16*)(shm+LDS_OST)+wid*2048;
    #pragma unroll
    for(int r=0;r<16;++r){const int orow=crow(r,hi);
      #pragma unroll
      for(int d0=0;d0<2;++d0)stg[orow*64+d0*32+r32]=__float2bfloat16(o[d0][r]*rli[r]);}
    asm volatile("s_waitcnt lgkmcnt(0)":::"memory");
    #pragma unroll
    for(int i=0;i<4;++i){const int row=i*8+(lane>>3),ch=lane&7; const u32x4 v=*(const u32x4*)(stg+row*64+ch*8); ATTN_STORE16(Ow+(long)row*DM+ch*8,v);} }
  asm volatile("s_waitcnt lgkmcnt(0)\n\ts_barrier":::"memory");
  #undef DMA_K
  #undef DMA_V
  #undef CMASK
  #undef START
  #undef RESC
  #undef ROT
}
constexpr int ATTN_LDS_BYTES=LDS_BYTES;
#undef SBAR
#undef WAIT_BAR
}

constexpr float SKIP_MARGIN = 64.f;
constexpr int ATT_F2_OFF = 86016, ATT_SCN_OFF = ATT_F2_OFF + 32768;
static_assert(attn_body::ATTN_LDS_BYTES <= ATT_F2_OFF && ATT_SCN_OFF + 64 <= 131072, "attention LDS map");
__device__ __forceinline__ void f2_items(PrmP p, int l, LAS unsigned char* lds, int wg, int nwg) {
    const int tid = fresh_tid(), lane = tid & 63, wave = tid >> 6;
    LAS float* scn = (LAS float*)(lds + ATT_SCN_OFF);
    const bf16_t* PB = (const bf16_t*)(p->ws + WS_PB); float* F2G = (float*)(p->ws + WS_FC2);
    for (int bh = wg; bh < 32; bh += nwg) { const int b = bh >> 3, hh = bh & 7;
        const float fb = p->in[I_FOXFB][l * 8 + hh];
        float loc[16]; float run = 0.f;
#pragma unroll
        for (int i = 0; i < 16; ++i) { const float z = bf2f(PB[(size_t)(b * T + tid * 16 + i) * NP + C_F + hh]) + fb;
            run += -(fmaxf(-z, 0.f) + __logf(1.f + __expf(-fabsf(z)))) * LOG2E; loc[i] = run; }
        float incl = run;
#pragma unroll
        for (int o = 1; o < 64; o <<= 1) { const float v = __shfl_up(incl, o); if (lane >= o) incl += v; }
        __syncthreads();
        if (lane == 63) scn[wave] = incl;
        __syncthreads();
        float base = incl - run;
        for (int w = 0; w < wave; ++w) base += scn[w];
#pragma unroll
        for (int i = 0; i < 16; ++i) F2G[(size_t)bh * T + tid * 16 + i] = base + loc[i];
    }
}
__device__ __forceinline__ void fa_attn(PrmP p, int l, LAS unsigned char* lds, int wg, int nwg) {
    const int tid = fresh_tid();
    if (nwg != 256) return;
    LAS float* F2s = (LAS float*)(lds + ATT_F2_OFF);
    LAS int* work = (LAS int*)(lds + ATT_SCN_OFF); LAS int* tst = work + 1024; LAS int* mine = tst + 1024;
    const float* F2G = (const float*)(p->ws + WS_FC2);
    __syncthreads();
    const unsigned* CT = (const unsigned*)(p->ws + WS_CTL);
#pragma unroll
    for (int k = 0; k < 8; ++k) { const int i = tid + 512 * k; F2s[i] = F2G[(size_t)(i >> 7) * T + (i & 127) * 64 + 63];
        F2s[4096 + i] = sqrtf(__uint_as_float(__hip_atomic_load(CT + CW_KT + l * 4096 + i, __ATOMIC_RELAXED, __HIP_MEMORY_SCOPE_AGENT))); }
    __syncthreads();
#pragma unroll
    for (int k = 0; k < 2; ++k) { const int u = tid + 512 * k, bh = u >> 5, qb = u & 31;
        const unsigned* NRM = (const unsigned*)(p->ws + WS_CTL) + CW_NRM + (l * 32 + bh) * 2;
        const float qn = sqrtf(__uint_as_float(__hip_atomic_load(NRM, __ATOMIC_RELAXED, __HIP_MEMORY_SCOPE_AGENT))), kn = sqrtf(__uint_as_float(__hip_atomic_load(NRM + 1, __ATOMIC_RELAXED, __HIP_MEMORY_SCOPE_AGENT)));
        (void)qn; (void)kn;
        const float qI = sqrtf(__uint_as_float(__hip_atomic_load(CT + CW_QN + (l * 32 + bh) * 32 + qb, __ATOMIC_RELAXED, __HIP_MEMORY_SCOPE_AGENT)));
        const float kI = fmaxf(fmaxf(F2s[4096 + bh * 128 + 4 * qb], F2s[4096 + bh * 128 + 4 * qb + 1]), fmaxf(F2s[4096 + bh * 128 + 4 * qb + 2], F2s[4096 + bh * 128 + 4 * qb + 3]));
        const float base = F2G[(size_t)bh * T + qb * 256] + SKIP_MARGIN + qI * kI;
        int ts = 0; bool ok = true;
        for (int J = 0; J < 4 * qb; ++J) { ok = ok && (F2s[bh * 128 + J] > base + qI * F2s[4096 + bh * 128 + J]); ts = (ok && (J & 1)) ? J + 1 : ts; }
        tst[u] = ts; work[u] = 4 * (qb + 1) - ts; }
    if (tid < 4) mine[tid] = 0;
    __syncthreads();
    { const int ua = tid, ub = tid + 512; const int wa = work[ua], wb = work[ub]; int ra = 0, rb = 0;
      typedef int i32x4_ __attribute__((ext_vector_type(4)));
      const int ka = wa * 1024 + (1023 - ua), kb = wb * 1024 + (1023 - ub);
#pragma unroll 4
      for (int v = 0; v < 1024; v += 4) { const i32x4_ w4 = *(const LAS i32x4_*)(work + v);
#pragma unroll
          for (int q = 0; q < 4; ++q) { const int kv = w4[q] * 1024 + (1023 - (v + q)); ra += (kv > ka) ? 1 : 0; rb += (kv > kb) ? 1 : 0; } }
      const int t0 = wg, t1 = 511 - wg, t2 = 512 + wg, t3 = 1023 - wg;
      if (ra == t0) mine[0] = ua; if (ra == t1) mine[1] = ua; if (ra == t2) mine[2] = ua; if (ra == t3) mine[3] = ua;
      if (rb == t0) mine[0] = ub; if (rb == t1) mine[1] = ub; if (rb == t2) mine[2] = ub; if (rb == t3) mine[3] = ub; }
    __syncthreads();
    const unsigned* NRMB = (const unsigned*)(p->ws + WS_CTL) + CW_NRM + l * 64;
    attn_body::bf16* pb = (attn_body::bf16*)(p->ws + WS_PB);
#pragma unroll 1
    for (int k = 0; k < 4; ++k) { const int u = __builtin_amdgcn_readfirstlane(mine[k]), bh = u >> 5, qb = u & 31, ts_u = __builtin_amdgcn_readfirstlane(tst[u]);
        __syncthreads();
#pragma unroll
        for (int i = 0; i < 4; ++i) *(LAS f32x4*)(F2s + tid * 4 + 2048 * i) = *(const f32x4*)(F2G + (size_t)bh * T + tid * 4 + 2048 * i);
        __syncthreads();
        const float m0 = sqrtf(__uint_as_float(__hip_atomic_load(NRMB + bh * 2 + 1, __ATOMIC_RELAXED, __HIP_MEMORY_SCOPE_AGENT)));
        attn_body::attn_unit<8>(bh >> 3, bh & 7, qb, pb + C_Q, pb + C_K, pb + C_V, pb + C_Q, (char*)lds, (attn_body::lds_fptr)F2s, ts_u, m0);
    }
}

typedef float f32x16 __attribute__((ext_vector_type(16)));
struct S5M { float ar[2], ai[2], a16r[2], a16i[2]; bf16x8 bfr[4]; };
__device__ __forceinline__ int tau32(int i) { return 16 * ((i >> 2) & 1) + 4 * (i >> 3) + (i & 3); }
__device__ __forceinline__ void s5m_setup(PrmP p, int l, int g, int lane, S5M& c) {
    const int nl = lane & 31, hi = lane >> 5;
    const float dt = expf(p->in[I_S5LOGDT][l * 16 + g]);
    u32x4 fre[2], fim[2];
#pragma unroll
    for (int s = 0; s < 2; ++s) { const int pi = 32 * s + nl;
        const float are = p->in[I_S5ARE][(l * 16 + g) * 64 + pi], aim = p->in[I_S5AIM][(l * 16 + g) * 64 + pi];
        const float mag = expf(are * dt); const float th = aim * dt * 0.3183098861837907f; const float abr = mag * cospif(th), abi = mag * sinpif(th);
        const float den = are * are + aim * aim, nre = abr - 1.f;
        const float kre = (nre * are + abi * aim) / den, kim = (abi * are - nre * aim) / den;
        c.ar[s] = abr; c.ai[s] = abi;
        float pr = abr, pi_ = abi;
#pragma unroll
        for (int q = 0; q < 4; ++q) { const float nr = pr * pr - pi_ * pi_, ni = 2.f * pr * pi_; pr = nr; pi_ = ni; }
        c.a16r[s] = pr; c.a16i[s] = pi_;
        const float* brp = p->in[I_S5BRE] + ((size_t)(l * 16 + g) * 64 + pi) * 16 + 8 * hi; const float* bip = p->in[I_S5BIM] + ((size_t)(l * 16 + g) * 64 + pi) * 16 + 8 * hi;
        const f32x4 br0 = *(const f32x4*)brp, br1 = *(const f32x4*)(brp + 4), bi0 = *(const f32x4*)bip, bi1 = *(const f32x4*)(bip + 4);
        const f32x4 re0 = br0 * kre - bi0 * kim, re1 = br1 * kre - bi1 * kim, im0 = bi0 * kre + br0 * kim, im1 = bi1 * kre + br1 * kim;
        fre[s] = (u32x4){pk2(re0.x, re0.y), pk2(re0.z, re0.w), pk2(re1.x, re1.y), pk2(re1.z, re1.w)};
        fim[s] = (u32x4){pk2(im0.x, im0.y), pk2(im0.z, im0.w), pk2(im1.x, im1.y), pk2(im1.z, im1.w)}; }
    c.bfr[0] = __builtin_bit_cast(bf16x8, fre[0]); c.bfr[1] = __builtin_bit_cast(bf16x8, fre[1]); c.bfr[2] = __builtin_bit_cast(bf16x8, fim[0]); c.bfr[3] = __builtin_bit_cast(bf16x8, fim[1]);
}
__device__ __forceinline__ void s5m_cfrag(PrmP p, int l, int g, int lane, bf16x8 (&cmf)[8], bf16x8& dfr) {
    const int nl = lane & 31, hi = lane >> 5;
    const float* cre = p->in[I_S5CRE] + ((size_t)(l * 16 + g) * 16 + (nl & 15)) * 64; const float* cim = p->in[I_S5CIM] + ((size_t)(l * 16 + g) * 16 + (nl & 15)) * 64;
    const bool okc = nl < 16;
#pragma unroll
    for (int ks = 0; ks < 8; ++ks) { const int j0 = 4 * ks + 2 * hi; const float2 ra = *(const float2*)(cre + j0), rb2 = *(const float2*)(cre + 32 + j0), ia = *(const float2*)(cim + j0), ib = *(const float2*)(cim + 32 + j0);
        u32x4 w; w.x = pk2(ra.x, rb2.x); w.y = pk2(-ia.x, -ib.x); w.z = pk2(ra.y, rb2.y); w.w = pk2(-ia.y, -ib.y);
        if (!okc) w = (u32x4){0u, 0u, 0u, 0u}; cmf[ks] = __builtin_bit_cast(bf16x8, w); }
    const float dv = p->in[I_S5D][l * 256 + g * 16 + (nl & 15)]; const int jd = nl - 8 * hi;
    const unsigned db = f2bf(dv); u32x4 w = (u32x4){0u, 0u, 0u, 0u};
    if (okc && jd >= 0 && jd < 8) { const unsigned v = (jd & 1) ? (db << 16) : db; if ((jd >> 1) == 0) w.x = v; else if ((jd >> 1) == 1) w.y = v; else if ((jd >> 1) == 2) w.z = v; else w.w = v; }
    dfr = __builtin_bit_cast(bf16x8, w);
}
__device__ __forceinline__ void s5m_table_build(PrmP p, int l, int g, int lane) {
    S5M c; s5m_setup(p, l, g, lane, c); bf16x8 cmf[8]; bf16x8 dfr; s5m_cfrag(p, l, g, lane, cmf, dfr);
    u32x4* tb = (u32x4*)(p->ws + WS_S5T) + (size_t)(l * 16 + g) * 15 * 64 + lane;
    tb[0 * 64] = (u32x4){__float_as_uint(c.ar[0]), __float_as_uint(c.ar[1]), __float_as_uint(c.ai[0]), __float_as_uint(c.ai[1])};
    tb[1 * 64] = (u32x4){__float_as_uint(c.a16r[0]), __float_as_uint(c.a16r[1]), __float_as_uint(c.a16i[0]), __float_as_uint(c.a16i[1])};
#pragma unroll
    for (int q = 0; q < 4; ++q) tb[(2 + q) * 64] = __builtin_bit_cast(u32x4, c.bfr[q]);
#pragma unroll
    for (int q = 0; q < 8; ++q) tb[(6 + q) * 64] = __builtin_bit_cast(u32x4, cmf[q]);
    tb[14 * 64] = __builtin_bit_cast(u32x4, dfr);
}
__device__ __forceinline__ void s5m_load(PrmP p, int l, int g, int lane, S5M& c) {
    const u32x4* tb = (const u32x4*)(p->ws + WS_S5T) + (size_t)(l * 16 + g) * 15 * 64 + lane;
    const u32x4 a = tb[0], b = tb[64];
    c.ar[0] = __uint_as_float(a.x); c.ar[1] = __uint_as_float(a.y); c.ai[0] = __uint_as_float(a.z); c.ai[1] = __uint_as_float(a.w);
    c.a16r[0] = __uint_as_float(b.x); c.a16r[1] = __uint_as_float(b.y); c.a16i[0] = __uint_as_float(b.z); c.a16i[1] = __uint_as_float(b.w);
#pragma unroll
    for (int q = 0; q < 4; ++q) c.bfr[q] = __builtin_bit_cast(bf16x8, tb[(2 + q) * 64]);
}
__device__ __forceinline__ void s5m_load_c(PrmP p, int l, int g, int lane, bf16x8 (&cmf)[8], bf16x8& dfr) {
    const u32x4* tb = (const u32x4*)(p->ws + WS_S5T) + (size_t)(l * 16 + g) * 15 * 64 + lane;
#pragma unroll
    for (int q = 0; q < 8; ++q) cmf[q] = __builtin_bit_cast(bf16x8, tb[(6 + q) * 64]);
    dfr = __builtin_bit_cast(bf16x8, tb[14 * 64]);
}
__device__ __forceinline__ void s5m_bu(const bf16_t* PB, size_t rb, int tb, int g, int lane, const S5M& c, f32x16 (&bu)[4], bf16x8& ufrag) {
    const int i = lane & 31, hi = lane >> 5;
    ufrag = *(const bf16x8*)(PB + (rb + tb + tau32(i)) * NP + C_S5 + 16 * g + 8 * hi);
    const f32x16 z = f32x16{};
#pragma unroll
    for (int q = 0; q < 4; ++q) bu[q] = __builtin_amdgcn_mfma_f32_32x32x16_bf16(ufrag, c.bfr[q], z, 0, 0, 0);
}
__device__ __forceinline__ void s5m_tile_end(const S5M& c, const f32x16 (&bu)[4], float (&xr)[2], float (&xi)[2]) {
#pragma unroll
    for (int s = 0; s < 2; ++s) { float er = bu[s][0], ei = bu[2 + s][0];
#pragma unroll
        for (int r = 1; r < 16; ++r) { const float nr = c.ar[s] * er - c.ai[s] * ei + bu[s][r], ni = c.ar[s] * ei + c.ai[s] * er + bu[2 + s][r]; er = nr; ei = ni; }
        const auto swr_ = __builtin_amdgcn_permlane32_swap(__float_as_uint(er), __float_as_uint(er), false, false), swi_ = __builtin_amdgcn_permlane32_swap(__float_as_uint(ei), __float_as_uint(ei), false, false);
        const float elr = __uint_as_float(swr_[0]), eli = __uint_as_float(swi_[0]), ehr = __uint_as_float(swr_[1]), ehi = __uint_as_float(swi_[1]);
        const float t1r = c.a16r[s] * xr[s] - c.a16i[s] * xi[s] + elr, t1i = c.a16r[s] * xi[s] + c.a16i[s] * xr[s] + eli;
        xr[s] = c.a16r[s] * t1r - c.a16i[s] * t1i + ehr; xi[s] = c.a16r[s] * t1i + c.a16i[s] * t1r + ehi; }
}
__device__ __forceinline__ void fs_scan(PrmP p, int l, LAS unsigned char* lds, int wg, int nwg) {
    const int tid = fresh_tid(), lane = tid & 63, wave = tid >> 6;
    f2_items(p, l, lds, wg, nwg);
    const bf16_t* PB = (const bf16_t*)(p->ws + WS_PB);
    { bf16_t* HLOC = (bf16_t*)(p->ws + WS_YL); bf16_t* PCUM = (bf16_t*)(p->ws + WS_YS0); float* AGG = (float*)(p->ws + WS_AGG);
      LAS unsigned char* xa = lds + wave * 13312; LAS unsigned char* xf = xa + 4608;
      const int nl = lane & 31, hi = lane >> 5;
      for (int it = wave * nwg + wg; it < 2048; it += nwg * NWAVES) {
        const int b = it >> 9, c = (it >> 2) & 127, blk = it & 3; const size_t rb = (size_t)b * T; const int t0 = c * 64;
        const bf16_t* wt = (const bf16_t*)(p->ws + WS_LRUW) + (size_t)(l * 4 + blk) * 2 * 4096 + (size_t)nl * 64 + 8 * hi;
        const int chc = blk * 64 + lane;
        const float cw0 = p->in[I_CONVW][(l * 4 + 0) * 256 + chc], cw1 = p->in[I_CONVW][(l * 4 + 1) * 256 + chc], cw2 = p->in[I_CONVW][(l * 4 + 2) * 256 + chc], cw3 = p->in[I_CONVW][(l * 4 + 3) * 256 + chc], cb = p->in[I_CONVB][l * 256 + chc];
        float ba[2], bx[2], sp8[2];
#pragma unroll
        for (int s2 = 0; s2 < 2; ++s2) { const int ch = blk * 64 + 32 * s2 + nl; ba[s2] = p->in[I_LRUBA][l * 256 + ch]; bx[s2] = p->in[I_LRUBX][l * 256 + ch]; sp8[s2] = -8.f * log1pf(expf(-p->in[I_LAMBDA][l * 256 + ch])); }
        float x1 = (t0 >= 1) ? bf2f(PB[(rb + t0 - 1) * NP + C_LX + chc]) : 0.f, x2 = (t0 >= 2) ? bf2f(PB[(rb + t0 - 2) * NP + C_LX + chc]) : 0.f, x3 = (t0 >= 3) ? bf2f(PB[(rb + t0 - 3) * NP + C_LX + chc]) : 0.f;
        float hin[2] = {0.f, 0.f}, pin[2] = {1.f, 1.f};
#pragma unroll 1
        for (int mt = 0; mt < 2; ++mt) { const int tb = t0 + mt * 32;
#pragma unroll 1
            for (int th = 0; th < 32; th += 16) { float xin[16];
#pragma unroll
              for (int tt = 0; tt < 16; ++tt) xin[tt] = bf2f(PB[(rb + tb + th + tt) * NP + C_LX + chc]);
#pragma unroll
              for (int tt = 0; tt < 16; ++tt) { const float xr = cb + cw0 * x3 + cw1 * x2 + cw2 * x1 + cw3 * xin[tt]; x3 = x2; x2 = x1; x1 = xin[tt];
                  *(LAS bf16_t*)(xa + (th + tt) * 144 + lane * 2) = (bf16_t)f2bf(xr); *(LAS float*)(xf + (th + tt) * 272 + lane * 4) = xr; } }
            asm volatile("s_waitcnt lgkmcnt(0)" ::: "memory");
            f32x16 acc[4];
#pragma unroll
            for (int q = 0; q < 4; ++q) acc[q] = f32x16{};
#pragma unroll
            for (int ks = 0; ks < 4; ++ks) { const bf16x8 af = *(const LAS bf16x8*)(xa + tau32(nl) * 144 + (16 * ks + 8 * hi) * 2);
#pragma unroll
                for (int q = 0; q < 4; ++q) { const bf16x8 wfr = *(const bf16x8*)(wt + ((size_t)(q >> 1) * 64 + 32 * (q & 1)) * 64 + 16 * ks); acc[q] = __builtin_amdgcn_mfma_f32_32x32x16_bf16(af, wfr, acc[q], 0, 0, 0); } }
#pragma unroll
            for (int s2 = 0; s2 < 2; ++s2) { const int ch = blk * 64 + 32 * s2 + nl;
                float hl[16], pl[16]; float h = 0.f, P = 1.f;
#pragma unroll
                for (int r = 0; r < 16; ++r) { const float xr = *(const LAS float*)(xf + (16 * hi + r) * 272 + (32 * s2 + nl) * 4);
                    const float rg = sigmoidf_(acc[s2][r] + ba[s2]), ig = sigmoidf_(acc[2 + s2][r] + bx[s2]);
                    const float la = sp8[s2] * rg, a = __expf(la), x2a = 2.f * la;
                    const float om = (x2a > -0.125f) ? -x2a * (1.f + x2a * (0.5f + x2a * (0.16666667f + x2a * 0.041666668f))) : 1.f - a * a;
                    h = a * h + xr * ig * __builtin_amdgcn_sqrtf(om); P *= a; hl[r] = h; pl[r] = P; }
                const float h0e = __shfl(h, nl), p0e = __shfl(P, nl);
                const float hs = hi ? h0e + p0e * hin[s2] : hin[s2], ps = hi ? pin[s2] * p0e : pin[s2];
#pragma unroll
                for (int r = 0; r < 16; ++r) { const size_t m = rb + tb + 16 * hi + r; HLOC[m * 256 + ch] = (bf16_t)f2bf(hl[r] + pl[r] * hs); PCUM[m * 256 + ch] = (bf16_t)f2bf(pl[r] * ps); }
                const float he = hl[15] + pl[15] * hs, pe = pl[15] * ps;
                hin[s2] = __shfl(he, 32 + nl); pin[s2] = __shfl(pe, 32 + nl); }
            asm volatile("s_waitcnt lgkmcnt(0)" ::: "memory");
        }
        if (hi == 0) {
#pragma unroll
            for (int s2 = 0; s2 < 2; ++s2) { const int ch = blk * 64 + 32 * s2 + nl; AGG[((size_t)(b * 128 + c) * 2 + 0) * 256 + ch] = pin[s2]; AGG[((size_t)(b * 128 + c) * 2 + 1) * 256 + ch] = hin[s2]; } }
      }
    }
    { unsigned* NRM = (unsigned*)(p->ws + WS_CTL) + CW_NRM;
      for (int it = wg; it < M / 128; it += nwg) { const int b = it / (T / 128); float mq = 0.f, mk = 0.f;
#pragma unroll 1
        for (int r8 = 0; r8 < 2; ++r8) { u32x4 qwv[8], kwv[8];
#pragma unroll
          for (int q8 = 0; q8 < 8; ++q8) { const size_t m = (size_t)it * 128 + wave * 16 + r8 * 8 + q8; qwv[q8] = *(const u32x4*)(PB + m * NP + C_Q + 8 * lane); kwv[q8] = *(const u32x4*)(PB + m * NP + C_K + 8 * lane); }
#pragma unroll
          for (int q8 = 0; q8 < 8; ++q8) { const u32x4 qw = qwv[q8], kw = kwv[q8];
            float sq = bflo(qw.x) * bflo(qw.x) + bfhi(qw.x) * bfhi(qw.x) + bflo(qw.y) * bflo(qw.y) + bfhi(qw.y) * bfhi(qw.y) + bflo(qw.z) * bflo(qw.z) + bfhi(qw.z) * bfhi(qw.z) + bflo(qw.w) * bflo(qw.w) + bfhi(qw.w) * bfhi(qw.w);
            float sk = bflo(kw.x) * bflo(kw.x) + bfhi(kw.x) * bfhi(kw.x) + bflo(kw.y) * bflo(kw.y) + bfhi(kw.y) * bfhi(kw.y) + bflo(kw.z) * bflo(kw.z) + bfhi(kw.z) * bfhi(kw.z) + bflo(kw.w) * bflo(kw.w) + bfhi(kw.w) * bfhi(kw.w);
#pragma unroll
            for (int o = 0; o < 1; ++o) { sq += dppf<DPP_XOR1>(sq); sk += dppf<DPP_XOR1>(sk); sq += dppf<DPP_XOR2>(sq); sk += dppf<DPP_XOR2>(sk); sq += dppf<DPP_HMIRROR>(sq); sk += dppf<DPP_HMIRROR>(sk); }
            mq = fmaxf(mq, sq); mk = fmaxf(mk, sk); } }
        if ((lane & 7) == 0) { const int hh = lane >> 3, bh = b * 8 + hh, il = it % (T / 128); atomicMax(NRM + (l * 32 + bh) * 2, __float_as_uint(mq)); atomicMax(NRM + (l * 32 + bh) * 2 + 1, __float_as_uint(mk));
            unsigned* CT = (unsigned*)(p->ws + WS_CTL); atomicMax(CT + CW_QN + (l * 32 + bh) * 32 + (il >> 1), __float_as_uint(mq)); atomicMax(CT + CW_KT + (l * 32 + bh) * 128 + il * 2 + (wave >> 2), __float_as_uint(mk)); } }
    }
    { float* XEND = (float*)(p->ws + WS_XEND);
      for (int it = wave * nwg + wg; it < 2048; it += nwg * NWAVES) {
        const int b = it >> 9, g = (it >> 5) & 15, cq = it & 31;
        S5M cf; s5m_load(p, l, g, lane, cf);
        float a64r[2], a64i[2], x4r[2] = {0.f, 0.f}, x4i[2] = {0.f, 0.f};
#pragma unroll
        for (int s2 = 0; s2 < 2; ++s2) { float pr = cf.a16r[s2], pi_ = cf.a16i[s2];
#pragma unroll
            for (int q = 0; q < 2; ++q) { const float nr = pr * pr - pi_ * pi_, ni = 2.f * pr * pi_; pr = nr; pi_ = ni; }
            a64r[s2] = pr; a64i[s2] = pi_; }
        bf16x8 ufs[8];
#pragma unroll
        for (int t8 = 0; t8 < 8; ++t8) ufs[t8] = *(const bf16x8*)(PB + ((size_t)b * T + cq * 256 + t8 * 32 + tau32(lane & 31)) * NP + C_S5 + 16 * g + 8 * (lane >> 5));
#pragma unroll
        for (int k = 0; k < 4; ++k) { const int c = cq * 4 + k; float xr[2] = {0.f, 0.f}, xi[2] = {0.f, 0.f};
#pragma unroll
            for (int mt = 0; mt < 2; ++mt) { f32x16 bu[4]; const f32x16 z = f32x16{};
#pragma unroll
                for (int q = 0; q < 4; ++q) bu[q] = __builtin_amdgcn_mfma_f32_32x32x16_bf16(ufs[2 * k + mt], cf.bfr[q], z, 0, 0, 0);
                s5m_tile_end(cf, bu, xr, xi); }
#pragma unroll
            for (int s2 = 0; s2 < 2; ++s2) { const float nr = a64r[s2] * x4r[s2] - a64i[s2] * x4i[s2] + xr[s2], ni = a64r[s2] * x4i[s2] + a64i[s2] * x4r[s2] + xi[s2]; x4r[s2] = nr; x4i[s2] = ni; }
            if (lane < 32) { float* xe = XEND + ((size_t)((b * 16 + g) * 128 + c) * 64) * 2;
                *(float2*)(xe + lane * 2) = make_float2(xr[0], xi[0]); *(float2*)(xe + (32 + lane) * 2) = make_float2(xr[1], xi[1]); } }
        if (lane < 32) { float* xe = (float*)(p->ws + WS_X4END) + ((size_t)((b * 16 + g) * 32 + cq) * 64) * 2;
            *(float2*)(xe + lane * 2) = make_float2(x4r[0], x4i[0]); *(float2*)(xe + (32 + lane) * 2) = make_float2(x4r[1], x4i[1]); }
      }
    }
}

constexpr int FIN_YSB = 0, FIN_XST = 34816, FIN_CAR = FIN_XST + 8 * 8704;
static_assert(64 * 264 * 2 <= FIN_XST && FIN_CAR + 1024 <= 131072, "finalize LDS map");
__device__ __forceinline__ void fs_fin(PrmP p, int l, LAS unsigned char* lds, int wg, int nwg) {
    const int tid = fresh_tid(), lane = tid & 63, wave = tid >> 6, fr = lane & 15, fq = lane >> 4, nl = lane & 31, hi = lane >> 5;
    const bf16_t* PB = (const bf16_t*)(p->ws + WS_PB); bf16_t* YC = (bf16_t*)(p->ws + WS_YC);
    const bf16_t* HLOC = (const bf16_t*)(p->ws + WS_YL); const bf16_t* PCUM = (const bf16_t*)(p->ws + WS_YS0); const float* AGG = (const float*)(p->ws + WS_AGG); const float* XEND = (const float*)(p->ws + WS_XEND);
    LAS bf16_t* ysb = (LAS bf16_t*)(lds + FIN_YSB); LAS unsigned char* xst = lds + FIN_XST + wave * 8704; LAS float* car = (LAS float*)(lds + FIN_CAR);
    for (int it = wg; it < NB * 128; it += nwg) {
        const int b = it >> 7, c = (it & 256) ? 127 - (it & 127) : (it & 127), t0 = c * 64; const size_t rb = (size_t)b * T;
        __syncthreads();
        if (tid < 256) { float cr = 0.f; const float* ag = AGG + (size_t)(b * 128) * 512 + (fresh_tid() & 255); int cc = 0;
            for (; cc + 8 <= c; cc += 8) { float A[8], H[8];
#pragma unroll
                for (int q = 0; q < 8; ++q) { A[q] = ag[(size_t)(cc + q) * 512]; H[q] = ag[(size_t)(cc + q) * 512 + 256]; }
#pragma unroll
                for (int q = 0; q < 8; ++q) cr = A[q] * cr + H[q]; }
            for (; cc < c; ++cc) cr = ag[(size_t)cc * 512] * cr + ag[(size_t)cc * 512 + 256];
            car[tid] = cr; }
#pragma unroll 1
        for (int gi = 0; gi < 2; ++gi) { const int g = wave + 8 * gi;
            S5M cf; s5m_load(p, l, g, lane, cf);
            bf16x8 cmf[8]; bf16x8 dfr; s5m_load_c(p, l, g, lane, cmf, dfr);
            float xr[2] = {0.f, 0.f}, xi[2] = {0.f, 0.f};
            { float a64r[2], a64i[2];
#pragma unroll
              for (int s = 0; s < 2; ++s) { float pr = cf.a16r[s], pi_ = cf.a16i[s];
#pragma unroll
                  for (int q = 0; q < 2; ++q) { const float nr = pr * pr - pi_ * pi_, ni = 2.f * pr * pi_; pr = nr; pi_ = ni; }
                  a64r[s] = pr; a64i[s] = pi_; }
              float a256r[2], a256i[2];
#pragma unroll
              for (int s = 0; s < 2; ++s) { float pr = a64r[s], pi_ = a64i[s];
#pragma unroll
                  for (int q = 0; q < 2; ++q) { const float nr = pr * pr - pi_ * pi_, ni = 2.f * pr * pi_; pr = nr; pi_ = ni; }
                  a256r[s] = pr; a256i[s] = pi_; }
              const float* x4 = (const float*)(p->ws + WS_X4END) + ((size_t)((b * 16 + g) * 32) * 64) * 2 + nl * 2;
              const int nb4 = c >> 2; int cb = 0;
              for (; cb + 4 <= nb4; cb += 4) { float2 e0[4], e1[4];
#pragma unroll
                  for (int q = 0; q < 4; ++q) { e0[q] = *(const float2*)(x4 + (size_t)(cb + q) * 128); e1[q] = *(const float2*)(x4 + (size_t)(cb + q) * 128 + 64); }
#pragma unroll
                  for (int q = 0; q < 4; ++q) {
                      float nr = a256r[0] * xr[0] - a256i[0] * xi[0] + e0[q].x, ni = a256r[0] * xi[0] + a256i[0] * xr[0] + e0[q].y; xr[0] = nr; xi[0] = ni;
                      nr = a256r[1] * xr[1] - a256i[1] * xi[1] + e1[q].x; ni = a256r[1] * xi[1] + a256i[1] * xr[1] + e1[q].y; xr[1] = nr; xi[1] = ni; } }
              for (; cb < nb4; ++cb) { const float2 e0 = *(const float2*)(x4 + (size_t)cb * 128), e1 = *(const float2*)(x4 + (size_t)cb * 128 + 64);
                  float nr = a256r[0] * xr[0] - a256i[0] * xi[0] + e0.x, ni = a256r[0] * xi[0] + a256i[0] * xr[0] + e0.y; xr[0] = nr; xi[0] = ni;
                  nr = a256r[1] * xr[1] - a256i[1] * xi[1] + e1.x; ni = a256r[1] * xi[1] + a256i[1] * xr[1] + e1.y; xr[1] = nr; xi[1] = ni; }
              const float* xe = XEND + ((size_t)((b * 16 + g) * 128) * 64) * 2 + nl * 2;
              for (int cc = nb4 * 4; cc < c; ++cc) { const float2 e0 = *(const float2*)(xe + (size_t)cc * 128), e1 = *(const float2*)(xe + (size_t)cc * 128 + 64);
                  float nr = a64r[0] * xr[0] - a64i[0] * xi[0] + e0.x, ni = a64r[0] * xi[0] + a64i[0] * xr[0] + e0.y; xr[0] = nr; xi[0] = ni;
                  nr = a64r[1] * xr[1] - a64i[1] * xi[1] + e1.x; ni = a64r[1] * xi[1] + a64i[1] * xr[1] + e1.y; xr[1] = nr; xi[1] = ni; } }
#pragma unroll 1
            for (int mt = 0; mt < 2; ++mt) {
                f32x16 bu[4]; bf16x8 uf; s5m_bu(PB, rb, t0 + mt * 32, g, lane, cf, bu, uf);
#pragma unroll
                for (int s = 0; s < 2; ++s) {
#pragma unroll
                    for (int r = 1; r < 16; ++r) { const float pr = bu[s][r - 1], pi_ = bu[2 + s][r - 1]; bu[s][r] += cf.ar[s] * pr - cf.ai[s] * pi_; bu[2 + s][r] += cf.ar[s] * pi_ + cf.ai[s] * pr; }
                    const float er = bu[s][15], ei = bu[2 + s][15];
                    const auto swr_ = __builtin_amdgcn_permlane32_swap(__float_as_uint(er), __float_as_uint(er), false, false), swi_ = __builtin_amdgcn_permlane32_swap(__float_as_uint(ei), __float_as_uint(ei), false, false);
                    const float elr = __uint_as_float(swr_[0]), eli = __uint_as_float(swi_[0]), ehr = __uint_as_float(swr_[1]), ehi = __uint_as_float(swi_[1]);
                    const float t1r = cf.a16r[s] * xr[s] - cf.a16i[s] * xi[s] + elr, t1i = cf.a16r[s] * xi[s] + cf.a16i[s] * xr[s] + eli;
                    float wr = hi ? t1r : xr[s], wi = hi ? t1i : xi[s];
                    xr[s] = cf.a16r[s] * t1r - cf.a16i[s] * t1i + ehr; xi[s] = cf.a16r[s] * t1i + cf.a16i[s] * t1r + ehi;
#pragma unroll
                    for (int r = 0; r < 16; ++r) { const float nr = cf.ar[s] * wr - cf.ai[s] * wi, ni = cf.ar[s] * wi + cf.ai[s] * wr; wr = nr; wi = ni; bu[s][r] += wr; bu[2 + s][r] += wi; }
                }
#pragma unroll
                for (int r = 0; r < 16; ++r) { u32x2 w; w.x = pk2(bu[0][r], bu[1][r]); w.y = pk2(bu[2][r], bu[3][r]); *(LAS u32x2*)(xst + (16 * hi + r) * 272 + nl * 8) = w; }
                asm volatile("s_waitcnt lgkmcnt(0)" ::: "memory");
                f32x16 acc = __builtin_amdgcn_mfma_f32_32x32x16_bf16(uf, dfr, f32x16{}, 0, 0, 0);
#pragma unroll
                for (int ks = 0; ks < 8; ++ks) { const bf16x8 af = *(const LAS bf16x8*)(xst + tau32(nl) * 272 + (16 * ks + 8 * hi) * 2); acc = __builtin_amdgcn_mfma_f32_32x32x16_bf16(af, cmf[ks], acc, 0, 0, 0); }
                if (nl < 16) {
#pragma unroll
                    for (int r = 0; r < 16; ++r) ysb[(mt * 32 + 16 * hi + r) * 264 + g * 16 + nl] = (bf16_t)f2bf(gelu_tanh(acc[r])); }
                asm volatile("s_waitcnt lgkmcnt(0)" ::: "memory");
            }
        }
        __syncthreads();
        { const bf16_t* GW = (const bf16_t*)(p->ws + WS_GLUW) + (size_t)l * 65536;
          f32x4 acc[4][2];
#pragma unroll
          for (int m = 0; m < 4; ++m) { acc[m][0] = (f32x4){0.f, 0.f, 0.f, 0.f}; acc[m][1] = (f32x4){0.f, 0.f, 0.f, 0.f}; }
#pragma unroll 2
          for (int ks = 0; ks < 8; ++ks) { bf16x8 a[4], bb[2];
#pragma unroll
              for (int m = 0; m < 4; ++m) a[m] = *(const LAS bf16x8*)(ysb + (m * 16 + fr) * 264 + ks * 32 + 8 * fq);
#pragma unroll
              for (int n = 0; n < 2; ++n) bb[n] = *(const bf16x8*)(GW + (size_t)((2 * wave + n) * 16 + fr) * 256 + ks * 32 + 8 * fq);
#pragma unroll
              for (int m = 0; m < 4; ++m)
#pragma unroll
                  for (int n = 0; n < 2; ++n) acc[m][n] = __builtin_amdgcn_mfma_f32_16x16x32_bf16(a[m], bb[n], acc[m][n], 0, 0, 0); }
          __syncthreads();
#pragma unroll
          for (int n = 0; n < 2; ++n) { const int j = (2 * wave + n) * 16 + fr; const float gb = p->in[I_GLUB][l * 256 + j];
#pragma unroll
              for (int m = 0; m < 4; ++m)
#pragma unroll
                  for (int r = 0; r < 4; ++r) { const int tk = m * 16 + 4 * fq + r; const float y = bf2f(ysb[tk * 264 + j]); ysb[tk * 264 + j] = (bf16_t)f2bf(y * sigmoidf_(acc[m][n][r] + gb)); } }
        }
        __syncthreads();
        { const f32x4 ggl = *(const f32x4*)(p->in[I_GNLRU] + l * 256 + 4 * lane), ggs = *(const f32x4*)(p->in[I_GNS5] + l * 256 + 4 * lane);
          const f32x4 g0 = *(const f32x4*)(p->in[I_GNATT] + l * 512 + 8 * lane), g1 = *(const f32x4*)(p->in[I_GNATT] + l * 512 + 8 * lane + 4); const f32x4 cr = *(const LAS f32x4*)(car + 4 * lane);
#pragma unroll 1
          for (int rq = 0; rq < 2; ++rq) {
            u32x2 hw[4], pw[4], gw[4]; u32x4 ow[4];
#pragma unroll
            for (int q = 0; q < 4; ++q) { const size_t m = rb + t0 + wave + 8 * (4 * rq + q);
                hw[q] = *(const u32x2*)(HLOC + m * 256 + 4 * lane); pw[q] = *(const u32x2*)(PCUM + m * 256 + 4 * lane); gw[q] = *(const u32x2*)(PB + m * NP + C_LG + 4 * lane); ow[q] = *(const u32x4*)(PB + m * NP + C_Q + 8 * lane); }
#pragma unroll
            for (int q = 0; q < 4; ++q) { const int r = wave + 8 * (4 * rq + q); const size_t m = rb + t0 + r;
              { const f32x4 hl = (f32x4){bflo(hw[q].x), bfhi(hw[q].x), bflo(hw[q].y), bfhi(hw[q].y)}, pc = (f32x4){bflo(pw[q].x), bfhi(pw[q].x), bflo(pw[q].y), bfhi(pw[q].y)};
                f32x4 v; v.x = (hl.x + pc.x * cr.x) * gelu_tanh(bflo(gw[q].x)); v.y = (hl.y + pc.y * cr.y) * gelu_tanh(bfhi(gw[q].x)); v.z = (hl.z + pc.z * cr.z) * gelu_tanh(bflo(gw[q].y)); v.w = (hl.w + pc.w * cr.w) * gelu_tanh(bfhi(gw[q].y));
                const float rs = __builtin_amdgcn_rsqf(wave_sum(v.x * v.x + v.y * v.y + v.z * v.z + v.w * v.w) * (1.f / 256.f) + RMS_EPS);
                u32x2 o; o.x = pk2(v.x * rs * ggl.x, v.y * rs * ggl.y); o.y = pk2(v.z * rs * ggl.z, v.w * rs * ggl.w); *(u32x2*)(YC + m * 1024 + 4 * lane) = o; }
              { const u32x2 yw = *(const LAS u32x2*)(ysb + r * 264 + 4 * lane); const f32x4 v = (f32x4){bflo(yw.x), bfhi(yw.x), bflo(yw.y), bfhi(yw.y)};
                const float rs = __builtin_amdgcn_rsqf(wave_sum(v.x * v.x + v.y * v.y + v.z * v.z + v.w * v.w) * (1.f / 256.f) + RMS_EPS);
                u32x2 o; o.x = pk2(v.x * rs * ggs.x, v.y * rs * ggs.y); o.y = pk2(v.z * rs * ggs.z, v.w * rs * ggs.w); *(u32x2*)(YC + m * 1024 + 256 + 4 * lane) = o; }
              { const u32x4 w = ow[q];
                const float v[8] = {bflo(w.x), bfhi(w.x), bflo(w.y), bfhi(w.y), bflo(w.z), bfhi(w.z), bflo(w.w), bfhi(w.w)};
                float ss = 0.f;
#pragma unroll
                for (int i = 0; i < 8; ++i) ss += v[i] * v[i];
                const float rs = __builtin_amdgcn_rsqf(wave_sum(ss) * (1.f / 512.f) + RMS_EPS);
                u32x4 o; o.x = pk2(v[0] * rs * g0.x, v[1] * rs * g0.y); o.y = pk2(v[2] * rs * g0.z, v[3] * rs * g0.w); o.z = pk2(v[4] * rs * g1.x, v[5] * rs * g1.y); o.w = pk2(v[6] * rs * g1.z, v[7] * rs * g1.w);
                *(u32x4*)(YC + m * 1024 + 512 + 8 * lane) = o; } } } }
    }
}

constexpr int ROW_WT = 0, ROW_WT_LD = 1028, ROW_ETAB = 131584 + 64;
__device__ __forceinline__ void ph_row(PrmP p, int l, LAS unsigned char* lds, int wg, int nwg) {
    const int tid = fresh_tid(), lane = tid & 63, wave = tid >> 6;
    const int R = M / nwg;
    const float* Xin = p->in[I_X]; bf16_t* XB = (bf16_t*)(p->ws + WS_XB); const bf16_t* Y = (const bf16_t*)(p->ws + WS_Y);
    const float* MOD = (const float*)(p->ws + WS_MOD); bf16_t* HB = (bf16_t*)(p->ws + WS_HB);
    int* TOPI = (int*)(p->ws + WS_MISC + MS_TOPI); float* TOPG = (float*)(p->ws + WS_MISC + MS_TOPG); int* RANK = (int*)(p->ws + WS_MISC + MS_RANK); int* HIST = (int*)(p->ws + WS_MISC + MS_HIST);
    LAS int* etab = (LAS int*)(lds + ROW_ETAB);
    LAS float* wt = (LAS float*)(lds + ROW_WT);
    const float* RW = p->in[I_ROUTW] + (size_t)l * 1024 * 32; const float* RB = p->in[I_ROUTB] + l * 32;
    __syncthreads();
    { f32x4 wv[16];
#pragma unroll
      for (int k = 0; k < 16; ++k) wv[k] = *(const f32x4*)(RW + tid * 4 + 2048 * k);
#pragma unroll
      for (int k = 0; k < 16; ++k) { const int i = tid * 4 + 2048 * k, e = i & 31, d = i >> 5; wt[e * ROW_WT_LD + d] = wv[k].x; wt[(e + 1) * ROW_WT_LD + d] = wv[k].y; wt[(e + 2) * ROW_WT_LD + d] = wv[k].z; wt[(e + 3) * ROW_WT_LD + d] = wv[k].w; } }
    __syncthreads();
    const float rbias = RB[(lane >> 1) & 31];
    const int RPW = R / NWAVES; constexpr int NR = 2;
    u32x2 ywn[NR][4]; f32x4 xfn[NR][4]; u32x2 xbn[NR][4];
#define ROW_LOAD(r0_) do { _Pragma("unroll") for (int q = 0; q < NR; ++q) _Pragma("unroll") for (int j = 0; j < 4; ++j) { const size_t mm_ = (size_t)wg * R + (r0_) + q; const int c_ = 4 * lane + 256 * j; \
        ywn[q][j] = *(const u32x2*)(Y + mm_ * 1024 + c_); if (l == 0) xfn[q][j] = *(const f32x4*)(Xin + mm_ * 1024 + c_); else xbn[q][j] = *(const u32x2*)(XB + mm_ * 1024 + c_); } } while (0)
    ROW_LOAD(wave * RPW);
    for (int r0 = wave * RPW; r0 < (wave + 1) * RPW; r0 += NR) {
        const size_t m0 = (size_t)wg * R + r0; const int b = (int)(m0 / T);
        const float* mod = MOD + (size_t)(l * 4 + b) * 6144;
        u32x2 ywc[NR][4]; f32x4 xfc[NR][4];
#pragma unroll
        for (int q = 0; q < NR; ++q)
#pragma unroll
            for (int j = 0; j < 4; ++j) { ywc[q][j] = ywn[q][j]; if (l == 0) xfc[q][j] = xfn[q][j]; else xfc[q][j] = (f32x4){bflo(xbn[q][j].x), bfhi(xbn[q][j].x), bflo(xbn[q][j].y), bfhi(xbn[q][j].y)}; }
        if (r0 + NR < (wave + 1) * RPW) ROW_LOAD(r0 + NR);
        f32x4 h[NR][4];
        { f32x4 y[NR][4]; float ss[NR] = {};
#pragma unroll
          for (int q = 0; q < NR; ++q)
#pragma unroll
              for (int j = 0; j < 4; ++j) { const u32x2 yw = ywc[q][j]; y[q][j] = (f32x4){bflo(yw.x), bfhi(yw.x), bflo(yw.y), bfhi(yw.y)}; ss[q] += (y[q][j].x * y[q][j].x + y[q][j].y * y[q][j].y) + (y[q][j].z * y[q][j].z + y[q][j].w * y[q][j].w); }
          float rstd[NR], s2[NR] = {};
#pragma unroll
          for (int q = 0; q < NR; ++q) rstd[q] = __builtin_amdgcn_rsqf(wave_sum(ss[q]) * (1.f / 1024.f) + RMS_EPS);
#pragma unroll
          for (int j = 0; j < 4; ++j) { const int c = 4 * lane + 256 * j; const f32x4 g = *(const f32x4*)(p->in[I_POSTMIXG] + l * 1024 + c), gate = *(const f32x4*)(mod + 2 * 1024 + c);
#pragma unroll
              for (int q = 0; q < NR; ++q) { const f32x4 x0 = xfc[q][j];
                  const f32x4 x = x0 + gate * (y[q][j] * rstd[q] * g); { u32x2 xo; xo.x = pk2(x.x, x.y); xo.y = pk2(x.z, x.w); *(u32x2*)(XB + (m0 + q) * 1024 + c) = xo; } h[q][j] = x;
                  s2[q] += (x.x * x.x + x.y * x.y) + (x.z * x.z + x.w * x.w); } }
          float rstd2[NR];
#pragma unroll
          for (int q = 0; q < NR; ++q) rstd2[q] = __builtin_amdgcn_rsqf(wave_sum(s2[q]) * (1.f / 1024.f) + RMS_EPS);
#pragma unroll
          for (int j = 0; j < 4; ++j) { const int c = 4 * lane + 256 * j; const f32x4 g = *(const f32x4*)(p->in[I_PREFFNG] + l * 1024 + c), sc = *(const f32x4*)(mod + 4 * 1024 + c), sh = *(const f32x4*)(mod + 3 * 1024 + c);
#pragma unroll
              for (int q = 0; q < NR; ++q) { h[q][j] = h[q][j] * rstd2[q] * g * (sc + 1.f) + sh;
                  if (EXPERT_FP8) *(unsigned*)((unsigned char*)HB + (m0 + q) * 1024 + c) = pk4_fp8(4.f * h[q][j].x, 4.f * h[q][j].y, 4.f * h[q][j].z, 4.f * h[q][j].w);
                  else { u32x2 o; o.x = pk2(h[q][j].x, h[q][j].y); o.y = pk2(h[q][j].z, h[q][j].w); *(u32x2*)(HB + (m0 + q) * 1024 + c) = o; } } } }
        float v16[NR][16];
        const bool b5 = lane & 32;
#pragma unroll
        for (int i = 0; i < 16; ++i) { float lo[NR], hi[NR]; f32x2h_ lo2[NR], hi2[NR];
#pragma unroll
            for (int q = 0; q < NR; ++q) { lo2[q] = (f32x2h_){0.f, 0.f}; hi2[q] = (f32x2h_){0.f, 0.f}; }
#pragma unroll
            for (int j = 0; j < 4; ++j) { const f32x4 wl = *(const LAS f32x4*)(wt + i * ROW_WT_LD + 4 * lane + 256 * j), wh = *(const LAS f32x4*)(wt + (i + 16) * ROW_WT_LD + 4 * lane + 256 * j);
                const f32x2h_ wl0 = {wl.x, wl.y}, wl1 = {wl.z, wl.w}, wh0 = {wh.x, wh.y}, wh1 = {wh.z, wh.w};
#pragma unroll
                for (int q = 0; q < NR; ++q) { const f32x2h_ h0 = {h[q][j].x, h[q][j].y}, h1 = {h[q][j].z, h[q][j].w};
                    lo2[q] = __builtin_elementwise_fma(h0, wl0, lo2[q]); lo2[q] = __builtin_elementwise_fma(h1, wl1, lo2[q]); hi2[q] = __builtin_elementwise_fma(h0, wh0, hi2[q]); hi2[q] = __builtin_elementwise_fma(h1, wh1, hi2[q]); } }
#pragma unroll
            for (int q = 0; q < NR; ++q) { lo[q] = lo2[q].x + lo2[q].y; hi[q] = hi2[q].x + hi2[q].y; }
#pragma unroll
            for (int q = 0; q < NR; ++q) { const auto sw = __builtin_amdgcn_permlane32_swap(__float_as_uint(lo[q]), __float_as_uint(hi[q]), false, false);
                v16[q][i] = __uint_as_float(sw[0]) + __uint_as_float(sw[1]); } }
#pragma unroll
        for (int q = 0; q < NR; ++q) { const int r = r0 + q; const size_t m = m0 + q;
            float v8[8], v4[4], v2[2], mine;
            { const bool b4 = lane & 16, b3 = lane & 8, b2 = lane & 4, b1 = lane & 2;
#pragma unroll
              for (int i = 0; i < 8; ++i) { const auto sw = __builtin_amdgcn_permlane16_swap(__float_as_uint(v16[q][i]), __float_as_uint(v16[q][i + 8]), false, false); v8[i] = __uint_as_float(sw[0]) + __uint_as_float(sw[1]); }
#pragma unroll
              for (int i = 0; i < 4; ++i) { const float rcv = dppf<DPP_ROR8>(b3 ? v8[i] : v8[i + 4]); v4[i] = (b3 ? v8[i + 4] : v8[i]) + rcv; }
#pragma unroll
              for (int i = 0; i < 2; ++i) { const float rcv = dppf<DPP_HMIRROR>(dppf<DPP_REV4>(b2 ? v4[i] : v4[i + 2])); v2[i] = (b2 ? v4[i + 2] : v4[i]) + rcv; }
              { const float rcv = dppf<DPP_XOR2>(b1 ? v2[0] : v2[1]); mine = (b1 ? v2[1] : v2[0]) + rcv; }
              mine += dppf<DPP_XOR1>(mine); (void)b4; }
            mine += rbias;
            if (lane & 1) mine = -3e38f;
            float tv[4]; int ti[4];
#pragma unroll
            for (int k = 0; k < 4; ++k) { const float mx = wave_max(mine);
                const unsigned long long bal = __ballot(mine == mx && !(lane & 1)); const int wl_ = __ffsll((long long)bal) - 1;
                tv[k] = mx; ti[k] = wl_ >> 1; if (lane == wl_) mine = -3e38f; }
            const float e1 = __expf(tv[1] - tv[0]), e2 = __expf(tv[2] - tv[0]), e3 = __expf(tv[3] - tv[0]); const float inv = __builtin_amdgcn_rcpf(1.f + e1 + e2 + e3);
            if (lane < 4) { const int id = (lane == 0) ? ti[0] : (lane == 1) ? ti[1] : (lane == 2) ? ti[2] : ti[3]; const float gv = ((lane == 0) ? 1.f : (lane == 1) ? e1 : (lane == 2) ? e2 : e3) * inv;
                TOPI[m * 4 + lane] = id; TOPG[m * 4 + lane] = gv; etab[r * 4 + lane] = id; } }
    }
    __syncthreads();
    const int NEn = R * 4;
    if (NEn == NTHREADS) {
        LAS int* wcnt = etab + NTHREADS;
        const int e = etab[tid]; int myrank = 0;
#pragma unroll 4
        for (int q = 0; q < 32; ++q) { const unsigned long long mk = __ballot(e == q); if (e == q) myrank = __popcll(mk & ((1ull << lane) - 1ull)); if (lane == q) wcnt[wave * 32 + q] = __popcll(mk); }
        __syncthreads();
        int pre = 0; for (int w = 0; w < wave; ++w) pre += wcnt[w * 32 + e];
        RANK[(size_t)wg * NEn + tid] = pre + myrank;
        if (tid < 32) { int c = 0;
#pragma unroll
            for (int w = 0; w < NWAVES; ++w) c += wcnt[w * 32 + tid];
            HIST[wg * 32 + tid] = c; }
    } else {
    if (tid < NEn) { const int e = etab[tid]; int rk = 0; for (int j = 0; j < tid; ++j) rk += (etab[j] == e) ? 1 : 0; RANK[(size_t)wg * NEn + tid] = rk; }
    if (tid < 32) { int c = 0; for (int j = 0; j < NEn; ++j) c += (etab[j] == tid) ? 1 : 0; HIST[wg * 32 + tid] = c; }
    }
    __syncthreads();
}

__device__ __forceinline__ void ph_offs(PrmP p, int l, LAS unsigned char* lds, int wg, int nwg) {
    const int tid = fresh_tid(), lane = tid & 63, wave = tid >> 6;
    const int R = M / nwg, NEn = R * 4;
    const int* TOPI = (const int*)(p->ws + WS_MISC + MS_TOPI); const int* RANK = (const int*)(p->ws + WS_MISC + MS_RANK); const int* HIST = (const int*)(p->ws + WS_MISC + MS_HIST);
    int* POS = (int*)(p->ws + WS_MISC + MS_POS); int* TILE_E = (int*)(p->ws + WS_MISC + MS_TILEE); int* CTL = (int*)(p->ws + WS_CTL);
    const bf16_t* HB = (const bf16_t*)(p->ws + WS_HB); bf16_t* XS = (bf16_t*)(p->ws + WS_XS);
    LAS int* tot = (LAS int*)lds; LAS int* mine = tot + 32; LAS int* base = mine + 32; LAS int* ptab = base + 32;
    __syncthreads();
    { LAS int* part = ptab + 512;
      const int e = tid & 31, pt = tid >> 5, per = (nwg + 15) / 16; int t = 0, mb = 0;
      for (int w = pt * per; w < (pt + 1) * per && w < nwg; ++w) { const int c = HIST[w * 32 + e]; t += c; mb += (w < wg) ? c : 0; }
      part[(pt * 2 + 0) * 32 + e] = t; part[(pt * 2 + 1) * 32 + e] = mb;
      __syncthreads();
      if (tid < 32) { int ts = 0, ms = 0;
#pragma unroll
          for (int q = 0; q < 16; ++q) { ts += part[(q * 2 + 0) * 32 + tid]; ms += part[(q * 2 + 1) * 32 + tid]; }
          tot[tid] = ts; mine[tid] = ms; } }
    __syncthreads();
    if (tid == 0) { int run = 0; for (int e = 0; e < 32; ++e) { const int pad = (tot[e] + 255) / 256 * 256; base[e] = run + mine[e];
            if (wg == 0) for (int t = run / 256; t < (run + pad) / 256; ++t) TILE_E[t] = e;
            run += pad; }
        if (wg == 0) CTL[CW_NT] = run / 256; }
    __syncthreads();
    int* ROWTOK = (int*)(p->ws + WS_MISC + MS_ROWTOK);
    if (tid < NEn) { const size_t idx = (size_t)wg * NEn + tid; const int pos = base[TOPI[idx]] + RANK[idx]; POS[idx] = pos; ptab[tid] = pos; ROWTOK[pos] = (int)(idx >> 2); }
    if (wg < 32) { const int e = wg, st = base[e] - mine[e] + tot[e], en = base[e] - mine[e] + (tot[e] + 255) / 256 * 256; for (int r = st + tid; r < en; r += NTHREADS) ROWTOK[r] = 0; }
    __syncthreads();
    if (EXPERT_FP8) return;
    for (int r0 = wave * (R / NWAVES); r0 < (wave + 1) * (R / NWAVES); r0 += 4) {
        u32x4 va[4], vb[4];
        if (EXPERT_FP8) {
#pragma unroll
            for (int q = 0; q < 4; ++q) va[q] = ((const u32x4*)((const unsigned char*)HB + ((size_t)wg * R + r0 + q) * 1024))[lane];
#pragma unroll
            for (int q = 0; q < 4; ++q)
#pragma unroll
                for (int k = 0; k < 4; ++k) ((u32x4*)((unsigned char*)XS + (size_t)ptab[(r0 + q) * 4 + k] * 1024))[lane] = va[q];
        } else {
#pragma unroll
        for (int q = 0; q < 4; ++q) { const u32x4* src = (const u32x4*)(HB + ((size_t)wg * R + r0 + q) * 1024); va[q] = src[lane]; vb[q] = src[lane + 64]; }
#pragma unroll
        for (int q = 0; q < 4; ++q)
#pragma unroll
            for (int k = 0; k < 4; ++k) { u32x4* dst = (u32x4*)(XS + (size_t)ptab[(r0 + q) * 4 + k] * 1024); dst[lane] = va[q]; dst[lane + 64] = vb[q]; }
        }
    }
}

__device__ __forceinline__ void ph_comb(PrmP p, int l, int wg, int nwg) {
    const int tid = fresh_tid(), lane = tid & 63, wave = tid >> 6;
    const bf16_t* YR = (const bf16_t*)(p->ws + WS_YR); const int* POS = (const int*)(p->ws + WS_MISC + MS_POS); const float* TOPG = (const float*)(p->ws + WS_MISC + MS_TOPG);
    const float* MOD = (const float*)(p->ws + WS_MOD); float* X = p->out; bf16_t* XB = (bf16_t*)(p->ws + WS_XB);
    int posv = POS[(size_t)(wg * NWAVES + wave) * 4 + (lane & 3)]; float gvv = TOPG[(size_t)(wg * NWAVES + wave) * 4 + (lane & 3)];
    for (int m = wg * NWAVES + wave; m < M; m += nwg * NWAVES) {
        const int b = m / T; const float* gate = MOD + (size_t)(l * 4 + b) * 6144 + 5 * 1024;
        const int posc = posv; const float gvc = gvv;
        { const int mn = m + nwg * NWAVES; if (mn < M) { posv = POS[(size_t)mn * 4 + (lane & 3)]; gvv = TOPG[(size_t)mn * 4 + (lane & 3)]; } }
        float y[16];
#pragma unroll
        for (int i = 0; i < 16; ++i) y[i] = 0.f;
#pragma unroll
        for (int k = 0; k < 4; ++k) { const int pos = __builtin_amdgcn_readlane(posc, k); const float gv = __builtin_bit_cast(float, __builtin_amdgcn_readlane(__builtin_bit_cast(int, gvc), k));
            if (YR_FP8) { typedef float f32x2_ __attribute__((ext_vector_type(2))); const float g16 = gv * 0.0625f;
                const unsigned char* yrow = (const unsigned char*)YR + ((size_t)(pos >> 8) * 1024 + (lane >> 5) * 256 + (pos & 255)) * 256 + 8 * (lane & 31);
                const u32x2 a8 = *(const u32x2*)(yrow), c8 = *(const u32x2*)(yrow + 2 * 65536);
                const unsigned wv[4] = {a8.x, a8.y, c8.x, c8.y};
#pragma unroll
                for (int q = 0; q < 4; ++q) { const f32x2_ lo = __builtin_amdgcn_cvt_pk_f32_fp8((int)wv[q], false), hi = __builtin_amdgcn_cvt_pk_f32_fp8((int)wv[q], true);
                    y[4 * q + 0] += g16 * lo.x; y[4 * q + 1] += g16 * lo.y; y[4 * q + 2] += g16 * hi.x; y[4 * q + 3] += g16 * hi.y; }
            } else {
            const u32x4 a = *(const u32x4*)(YR + (size_t)pos * 1024 + 8 * lane), c = *(const u32x4*)(YR + (size_t)pos * 1024 + 512 + 8 * lane);
            y[0] += gv * bflo(a.x); y[1] += gv * bfhi(a.x); y[2] += gv * bflo(a.y); y[3] += gv * bfhi(a.y); y[4] += gv * bflo(a.z); y[5] += gv * bfhi(a.z); y[6] += gv * bflo(a.w); y[7] += gv * bfhi(a.w);
            y[8] += gv * bflo(c.x); y[9] += gv * bfhi(c.x); y[10] += gv * bflo(c.y); y[11] += gv * bfhi(c.y); y[12] += gv * bflo(c.z); y[13] += gv * bfhi(c.z); y[14] += gv * bflo(c.w); y[15] += gv * bfhi(c.w); } }
        float ss = 0.f;
#pragma unroll
        for (int i = 0; i < 16; ++i) ss += y[i] * y[i];
        const float rstd = __builtin_amdgcn_rsqf(wave_sum(ss) * (1.f / 1024.f) + RMS_EPS);
        float xs[16]; float s2 = 0.f;
#pragma unroll
        for (int hf = 0; hf < 2; ++hf) { const int c0 = hf * 512 + 8 * lane;
#pragma unroll
            for (int q = 0; q < 2; ++q) { const int c = c0 + 4 * q; const f32x4 g = *(const f32x4*)(p->in[I_POSTFFNG] + l * 1024 + c), gt = *(const f32x4*)(gate + c); const u32x2 xw = *(const u32x2*)(XB + (size_t)m * 1024 + c); f32x4 xv = (f32x4){bflo(xw.x), bfhi(xw.x), bflo(xw.y), bfhi(xw.y)};
                xv.x += gt.x * (y[hf * 8 + 4 * q + 0] * rstd * g.x); xv.y += gt.y * (y[hf * 8 + 4 * q + 1] * rstd * g.y); xv.z += gt.z * (y[hf * 8 + 4 * q + 2] * rstd * g.z); xv.w += gt.w * (y[hf * 8 + 4 * q + 3] * rstd * g.w);
                if (l + 1 < NL) { u32x2 xo; xo.x = pk2(xv.x, xv.y); xo.y = pk2(xv.z, xv.w); *(u32x2*)(XB + (size_t)m * 1024 + c) = xo; } else *(f32x4*)(X + (size_t)m * 1024 + c) = xv;
                xs[hf * 8 + 4 * q + 0] = xv.x; xs[hf * 8 + 4 * q + 1] = xv.y; xs[hf * 8 + 4 * q + 2] = xv.z; xs[hf * 8 + 4 * q + 3] = xv.w; s2 += (xv.x * xv.x + xv.y * xv.y) + (xv.z * xv.z + xv.w * xv.w); } }
        if (l + 1 < NL) {
            const float rs2 = __builtin_amdgcn_rsqf(wave_sum(s2) * (1.f / 1024.f) + RMS_EPS);
            const float* shift = MOD + (size_t)((l + 1) * 4 + b) * 6144; const float* scale = shift + 1024; const float* g2 = p->in[I_PREMIXG] + (l + 1) * 1024;
            bf16_t* HB = (bf16_t*)(p->ws + WS_HB);
#pragma unroll
            for (int hf = 0; hf < 2; ++hf) { const int c0 = hf * 512 + 8 * lane; float hv[8];
#pragma unroll
                for (int q = 0; q < 2; ++q) { const f32x4 gg = *(const f32x4*)(g2 + c0 + 4 * q), sc = *(const f32x4*)(scale + c0 + 4 * q), sh = *(const f32x4*)(shift + c0 + 4 * q);
                    hv[4 * q + 0] = xs[hf * 8 + 4 * q + 0] * rs2 * gg.x * (sc.x + 1.f) + sh.x; hv[4 * q + 1] = xs[hf * 8 + 4 * q + 1] * rs2 * gg.y * (sc.y + 1.f) + sh.y;
                    hv[4 * q + 2] = xs[hf * 8 + 4 * q + 2] * rs2 * gg.z * (sc.z + 1.f) + sh.z; hv[4 * q + 3] = xs[hf * 8 + 4 * q + 3] * rs2 * gg.w * (sc.w + 1.f) + sh.w; }
                u32x4 o; o.x = pk2(hv[0], hv[1]); o.y = pk2(hv[2], hv[3]); o.z = pk2(hv[4], hv[5]); o.w = pk2(hv[6], hv[7]);
                *(u32x4*)(HB + (size_t)m * 1024 + c0) = o; } }
    }
}

__device__ __forceinline__ void ph_tables(PrmP p, int wg, int nwg) {
    const int tid = fresh_tid(), lane = tid & 63, wave = tid >> 6;
    for (int it = wave * nwg + wg; it < NL * 16; it += nwg * NWAVES) s5m_table_build(p, it >> 4, it & 15, lane);
}

#define XB_TMO      128
#define XB_XCNT(j)  (256  + 64 * (j))
#define XB_XSUB(j)  (1280 + 64 * (j))
#define XB_XGEN(j)  (2304 + 64 * (j))
#define XB_TOP      3328
#define XB_TOPGEN   3392
#define XCD_BAR_WORDS 3456
#define XB_SPIN_CAP (1u << 22)

__device__ __forceinline__ unsigned xb_ld(unsigned* p)              { return __hip_atomic_load(p, __ATOMIC_RELAXED, __HIP_MEMORY_SCOPE_AGENT); }
__device__ __forceinline__ unsigned xb_add(unsigned* p, unsigned v) { return __hip_atomic_fetch_add(p, v, __ATOMIC_RELAXED, __HIP_MEMORY_SCOPE_AGENT); }
__device__ __forceinline__ unsigned xb_xcc_id() { return (unsigned)__builtin_amdgcn_s_getreg((3 << 11) | 20) & 0xFu; }
#define XB_SPIN(cond, bar) do { unsigned _sp = 0; while (cond) { __builtin_amdgcn_s_sleep(1); \
    if ((++_sp & 255u) == 0u) { if (xb_ld(&(bar)[XB_TMO])) break; if (_sp > XB_SPIN_CAP) { atomicAdd(&(bar)[XB_TMO], 1u); break; } } } } while (0)

struct XcdBarrier { unsigned* bar; unsigned x; volatile LAS unsigned* st; };

__device__ __forceinline__ XcdBarrier xcd_barrier_post(unsigned* bar, volatile LAS unsigned* st) {
    XcdBarrier b; b.bar = bar; b.x = xb_xcc_id(); b.st = st;
    if (threadIdx.x == 0) (void)xb_add(&bar[XB_XCNT(b.x)], 1u);
    return b;
}
__device__ __forceinline__ void xcd_barrier_complete(unsigned* bar, unsigned x, unsigned& nloc, unsigned& nx) {
    const unsigned G = gridDim.x * gridDim.y * gridDim.z;
    unsigned sum, cnt, mine, sp = 0u;
    for (;;) {
        sum = 0u; cnt = 0u; mine = 0u;
#pragma unroll
        for (unsigned j = 0; j < 16; ++j) { const unsigned c = xb_ld(&bar[XB_XCNT(j)]); sum += c; cnt += (c > 0u) ? 1u : 0u; mine = (j == x) ? c : mine; }
        if (sum == G) break;
        __builtin_amdgcn_s_sleep(1);
        if ((++sp & 255u) == 0u) { if (xb_ld(&bar[XB_TMO])) break; if (sp > XB_SPIN_CAP) { atomicAdd(&bar[XB_TMO], 1u); break; } }
    }
    nloc = mine > 0u ? mine : 1u; nx = cnt > 0u ? cnt : 1u;
}
__device__ __forceinline__ void xcd_barrier(const XcdBarrier& b) {
    asm volatile("s_waitcnt vmcnt(0)" ::: "memory");
    __syncthreads();
    if (threadIdx.x == 0) {
        unsigned* bar = b.bar;
        __builtin_amdgcn_s_waitcnt(0);
        unsigned nloc = b.st[0], nx = b.st[1];
        if (nloc == 0u) { xcd_barrier_complete(bar, b.x, nloc, nx); b.st[0] = nloc; b.st[1] = nx; }
        const unsigned old = xb_add(&bar[XB_XSUB(b.x)], 1u);
        const unsigned gen = old / nloc;
        if (old + 1u == (gen + 1u) * nloc) {
            __builtin_amdgcn_fence(__ATOMIC_RELEASE, "agent");
            asm volatile("s_waitcnt vmcnt(0)" ::: "memory");
            const unsigned og = xb_add(&bar[XB_TOP], 1u);
            const unsigned tg = og / nx;
            if (og + 1u == (tg + 1u) * nx) xb_add(&bar[XB_TOPGEN], 1u);
            else XB_SPIN(xb_ld(&bar[XB_TOPGEN]) == tg, bar);
            __builtin_amdgcn_fence(__ATOMIC_ACQUIRE, "agent");
            xb_add(&bar[XB_XGEN(b.x)], 1u);
            asm volatile("s_waitcnt vmcnt(0)" ::: "memory");
        } else {
            XB_SPIN(xb_ld(&bar[XB_XGEN(b.x)]) == gen, bar);
            __builtin_amdgcn_fence(__ATOMIC_ACQUIRE, "agent");
            asm volatile("s_waitcnt vmcnt(0)" ::: "memory");
        }
    }
    __syncthreads();
}

constexpr int LDS_BYTES = 163840;
constexpr int LDS_BAR_OFF = LDS_BYTES - 64;
constexpr int CW_BAR = 4096;

__global__ void __launch_bounds__(NTHREADS, 2) mk_fwd(Prm p_unused) {
    extern __shared__ __attribute__((aligned(16))) unsigned char lds_raw[];
    LAS unsigned char* lds = (LAS unsigned char*)lds_raw;
    const int wg = blockIdx.x, nwg = gridDim.x;
    if (threadIdx.x < 4) ((LAS unsigned*)(lds + LDS_BAR_OFF))[threadIdx.x] = 0u;
    __syncthreads();
    (void)xcd_barrier_post((unsigned*)(prm_fresh()->ws + WS_CTL) + CW_BAR, (volatile LAS unsigned*)(lds + LDS_BAR_OFF));
#define GRID_BAR() do { XcdBarrier b_; b_.bar = (unsigned*)(prm_fresh()->ws + WS_CTL) + CW_BAR; b_.x = xb_xcc_id(); b_.st = (volatile LAS unsigned*)(lds + LDS_BAR_OFF); xcd_barrier(b_); } while (0)
#ifndef REP_PHASE
#define REP_PHASE -1
#endif
#define PHASE(id, call) do { call; GRID_BAR(); if (REP_PHASE == (id)) { call; GRID_BAR(); } } while (0)
    PHASE(0, (ph_prologue(prm_fresh(), lds, wg, nwg), ph_tables(prm_fresh(), wg, nwg)));
#define MK_LAYER(l) do { \
        if ((l) == 0) PHASE(1, ph_norm1(prm_fresh(), l, wg, nwg));     \
        PHASE(2, fg_gemm_in(prm_fresh(), l, lds, wg, nwg)); \
        PHASE(3, fs_scan(prm_fresh(), l, lds, wg, nwg)); \
        fa_attn(prm_fresh(), l, lds, wg, nwg); GRID_BAR(); \
        PHASE(5, fs_fin(prm_fresh(), l, lds, wg, nwg)); \
        PHASE(6, fg_gemm_out(prm_fresh(), l, lds, wg, nwg)); \
        ph_row(prm_fresh(), l, lds, wg, nwg); GRID_BAR(); \
        PHASE(8, ph_offs(prm_fresh(), l, lds, wg, nwg)); \
        PHASE(9, fg_gemm1(prm_fresh(), l, lds, wg, nwg)); \
        PHASE(10, fg_gemm2(prm_fresh(), l, lds, wg, nwg)); \
        ph_comb(prm_fresh(), l, wg, nwg); if ((l) + 1 < NL) GRID_BAR(); } while (0)
    MK_LAYER(0);
    MK_LAYER(1);
#undef MK_LAYER
}

extern "C" void kernel_launch(void* const* d_in, const int* in_sizes, int n_in, void* d_out, int out_size, void* d_ws, size_t ws_size, hipStream_t stream) {
    if (n_in != N_IN || out_size != M * D || ws_size < WS_END) { fprintf(stderr, "kernel_launch: unexpected shapes: n_in %d out %d ws %zu (need %zu)\n", n_in, out_size, ws_size, (size_t)WS_END); return; }
    Prm p{};
    for (int i = 0; i < N_IN; ++i) p.in[i] = (const float*)d_in[i];
    p.out = (float*)d_out; p.ws = (unsigned char*)d_ws;
    (void)hipMemsetAsync((char*)d_ws + WS_CTL, 0, 1 * MiB, stream);
    static int grid = 0;
    if (grid == 0) {
        int dev = 0, cus = 0, per_cu = 0;
        if (hipGetDevice(&dev) != hipSuccess || hipDeviceGetAttribute(&cus, hipDeviceAttributeMultiprocessorCount, dev) != hipSuccess) { fprintf(stderr, "kernel_launch: device query failed\n"); grid = -1; return; }
        if (hipFuncSetAttribute((const void*)mk_fwd, hipFuncAttributeMaxDynamicSharedMemorySize, LDS_BYTES) != hipSuccess) { fprintf(stderr, "kernel_launch: hipFuncSetAttribute failed\n"); grid = -1; return; }
        if (hipOccupancyMaxActiveBlocksPerMultiprocessor(&per_cu, (const void*)mk_fwd, NTHREADS, LDS_BYTES) != hipSuccess || per_cu < 1) fprintf(stderr, "kernel_launch: occupancy query reports %d\n", per_cu);
        (void)hipGetLastError();
        grid = 256;
        if (cus < 256) fprintf(stderr, "kernel_launch: %d CUs: 256 workgroups of 144 KiB LDS cannot all be resident\n", cus);
    }
    if (grid < 0) return;
    hipLaunchKernelGGL(mk_fwd, dim3(grid), dim3(NTHREADS), LDS_BYTES, stream, p);
}
```

```cpp
#include <hip/hip_runtime.h>
#include <stdint.h>
#include <stdio.h>

#define LAS __attribute__((address_space(3)))
typedef unsigned short bf16_t;
typedef short bf16x8 __attribute__((ext_vector_type(8)));
typedef float f32x4 __attribute__((ext_vector_type(4)));
typedef unsigned u32x4 __attribute__((ext_vector_type(4)));
typedef unsigned u32x2 __attribute__((ext_vector_type(2)));

constexpr int NB = 4, T = 8192, D = 1024, M = NB * T, NL = 2;
constexpr int INC = 2312, NP = 2560;
constexpr int C_LX = 0, C_LG = 256, C_S5 = 512, C_Q = 768, C_K = 1280, C_V = 1792, C_F = 2304;
constexpr int NH = 8, HD = 64, NE = 32, TOPK = 4, DFF = 1024;
constexpr int RP = M * TOPK + NE * 256;
constexpr float C2 = 0.125f * 1.4426950408889634f;
constexpr float LOG2E = 1.4426950408889634f;
constexpr float RMS_EPS = 1e-6f;
constexpr int NTHREADS = 512, NWAVES = 8;
#ifndef FAST_ATTN
#define FAST_ATTN 1
#endif
#ifndef YR_FP8
#define YR_FP8 1
#endif
#ifndef F8_ALLV
#define F8_ALLV 1
#endif
#ifndef EXPERT_FP8
#define OUT_FP8 1
#define EXPERT_FP8 1
#endif

enum { I_X = 0, I_C, I_ADAW, I_ADAB, I_PREMIXG, I_WIN, I_CONVW, I_CONVB, I_LRUWA, I_LRUBA, I_LRUWX, I_LRUBX, I_LAMBDA, I_S5ARE, I_S5AIM, I_S5BRE, I_S5BIM,
       I_S5CRE, I_S5CIM, I_S5D, I_S5LOGDT, I_GLUW, I_GLUB, I_FOXFB, I_GNLRU, I_GNS5, I_GNATT, I_WOUT, I_POSTMIXG, I_PREFFNG, I_ROUTW, I_ROUTB, I_WGU, I_BGU,
       I_WDN, I_BDN, I_POSTFFNG, N_IN };

constexpr size_t MiB = 1u << 20;
constexpr size_t WS_CTL = 0;
constexpr size_t WS_MOD = 1 * MiB;
constexpr size_t WS_MISC = 2 * MiB;
constexpr size_t WS_FC2 = 6 * MiB;
constexpr size_t WS_WIN = 8 * MiB;
constexpr size_t WS_WOUT = 18 * MiB;
constexpr size_t WS_WGU = 22 * MiB;
constexpr size_t WS_WDN = 278 * MiB;
constexpr size_t WS_HB = 406 * MiB;
constexpr size_t WS_PB = 470 * MiB;
constexpr size_t WS_YL = 630 * MiB;
constexpr size_t WS_YS0 = 662 * MiB;
constexpr size_t WS_OA = 694 * MiB;
constexpr size_t WS_AGG = WS_OA;
constexpr size_t WS_XEND = WS_OA + 2 * MiB;
constexpr size_t WS_GLUW = WS_OA + 8 * MiB;
constexpr size_t WS_X4END = WS_OA + 7 * MiB;
constexpr size_t WS_S5T = WS_OA + 10 * MiB;
constexpr size_t WS_LRUW = WS_OA + 9 * MiB;
constexpr size_t WS_YC = 758 * MiB;
constexpr size_t WS_Y = 822 * MiB;
constexpr size_t WS_XS = 950 * MiB;
constexpr size_t WS_XB = WS_XS;
constexpr size_t WS_H1 = 1222 * MiB;
constexpr size_t WS_YR = 1494 * MiB;
constexpr size_t WS_END = 1766 * MiB;
constexpr size_t MS_ROWTOK = 2560 * 1024;
constexpr size_t MS_TOPI = 0, MS_TOPG = 512 * 1024, MS_RANK = 1024 * 1024, MS_POS = 1536 * 1024, MS_HIST = 2048 * 1024, MS_TILEE = 2048 * 1024 + 64 * 1024;
constexpr int CW_NT = 8;
constexpr int CW_QN = 16384, CW_KT = 32768;
constexpr int CW_NRM = 8192;

struct Prm { const float* in[N_IN]; float* out; unsigned char* ws; };
__device__ __forceinline__ int fresh_tid() { int t = threadIdx.x; asm volatile("" : "+v"(t)); return t; }
typedef const __attribute__((address_space(4))) Prm* PrmP;
__device__ __forceinline__ PrmP prm_fresh() { PrmP q = (PrmP)__builtin_amdgcn_kernarg_segment_ptr(); asm volatile("" : "+s"(q)); return q; }

typedef float f32x2h_ __attribute__((ext_vector_type(2))); typedef __bf16 bf16x2h_ __attribute__((ext_vector_type(2)));
__device__ __forceinline__ unsigned pk2(float lo, float hi) { const f32x2h_ v = {lo, hi}; return __builtin_bit_cast(unsigned, __builtin_convertvector(v, bf16x2h_)); }
__device__ __forceinline__ unsigned f2bf(float f) { return pk2(f, 0.f) & 0xffffu; }
__device__ __forceinline__ float bf2f(unsigned v) { return __builtin_bit_cast(float, v << 16); }
__device__ __forceinline__ float bflo(unsigned w) { return __builtin_bit_cast(float, w << 16); }
__device__ __forceinline__ float bfhi(unsigned w) { return __builtin_bit_cast(float, w & 0xffff0000u); }
template <int CTRL> __device__ __forceinline__ float dppf(float x) { return __builtin_bit_cast(float, __builtin_amdgcn_update_dpp(0, __builtin_bit_cast(int, x), CTRL, 0xf, 0xf, true)); }
constexpr int DPP_XOR1 = 0xB1, DPP_XOR2 = 0x4E, DPP_REV4 = 0x1B, DPP_HMIRROR = 0x141, DPP_MIRROR = 0x140, DPP_ROR8 = 0x128;
__device__ __forceinline__ float wave_sum(float v) {
    v += dppf<DPP_XOR1>(v); v += dppf<DPP_XOR2>(v); v += dppf<DPP_HMIRROR>(v); v += dppf<DPP_MIRROR>(v);
    const auto s = __builtin_amdgcn_permlane16_swap(__float_as_uint(v), __float_as_uint(v), false, false); v = __uint_as_float(s[0]) + __uint_as_float(s[1]);
    const auto t = __builtin_amdgcn_permlane32_swap(__float_as_uint(v), __float_as_uint(v), false, false); return __uint_as_float(t[0]) + __uint_as_float(t[1]);
}
__device__ __forceinline__ float wave_max(float v) {
    v = fmaxf(v, dppf<DPP_XOR1>(v)); v = fmaxf(v, dppf<DPP_XOR2>(v)); v = fmaxf(v, dppf<DPP_HMIRROR>(v)); v = fmaxf(v, dppf<DPP_MIRROR>(v));
    const auto s = __builtin_amdgcn_permlane16_swap(__float_as_uint(v), __float_as_uint(v), false, false); v = fmaxf(__uint_as_float(s[0]), __uint_as_float(s[1]));
    const auto t = __builtin_amdgcn_permlane32_swap(__float_as_uint(v), __float_as_uint(v), false, false); return fmaxf(__uint_as_float(t[0]), __uint_as_float(t[1]));
}
__device__ __forceinline__ float sigmoidf_(float x) { return __builtin_amdgcn_rcpf(1.f + __expf(-x)); }
__device__ __forceinline__ float gelu_tanh(float x) { const float u = 0.7978845608028654f * (x + 0.044715f * x * x * x); return x * sigmoidf_(2.f * u); }

__device__ __forceinline__ void tr_item(const float* W, int ldw, int nvalid, int k0, int n0, bf16_t* dst, float scale, LAS float* scr, int lane, int ldd = 1024) {
    const int nn = n0 + (lane & 31); const bool ok = nn < nvalid;
    float wv[32];
#pragma unroll
    for (int i = 0; i < 32; ++i) { const int kk = 2 * i + (lane >> 5); wv[i] = ok ? W[(size_t)(k0 + kk) * ldw + nn] : 0.f; }
#pragma unroll
    for (int i = 0; i < 32; ++i) { const int kk = 2 * i + (lane >> 5); scr[kk * 33 + (lane & 31)] = wv[i] * scale; }
    asm volatile("s_waitcnt lgkmcnt(0)" ::: "memory");
    const int c = lane & 7;
#pragma unroll
    for (int j = 0; j < 4; ++j) { const int n = (lane >> 3) + 8 * j; const LAS float* s = scr + (8 * c) * 33 + n;
        u32x4 o; o.x = pk2(s[0 * 33], s[1 * 33]); o.y = pk2(s[2 * 33], s[3 * 33]); o.z = pk2(s[4 * 33], s[5 * 33]); o.w = pk2(s[6 * 33], s[7 * 33]);
        *(u32x4*)(dst + (size_t)n * ldd + k0 + 8 * c) = o; }
    asm volatile("s_waitcnt lgkmcnt(0)" ::: "memory");
}

__device__ __forceinline__ unsigned pk4_fp8(float a, float b, float c, float d) { int w = __builtin_amdgcn_cvt_pk_fp8_f32(a, b, 0, false); w = __builtin_amdgcn_cvt_pk_fp8_f32(c, d, w, true); return (unsigned)w; }
__device__ __forceinline__ void tr_item8w(const float* W, int ldw, int k0, int n0, unsigned char* dst, float scale, LAS float* scr, int lane) {
#pragma unroll 1
    for (int hh = 0; hh < 2; ++hh) { f32x4 v[8];
#pragma unroll
      for (int i = 0; i < 8; ++i) v[i] = *(const f32x4*)(W + (size_t)(k0 + hh * 32 + (lane >> 4) + 4 * i) * ldw + n0 + 4 * (lane & 15));
#pragma unroll
      for (int i = 0; i < 8; ++i) { LAS float* d = scr + (hh * 32 + (lane >> 4) + 4 * i) * 65 + 4 * (lane & 15); d[0] = v[i].x * scale; d[1] = v[i].y * scale; d[2] = v[i].z * scale; d[3] = v[i].w * scale; } }
    asm volatile("s_waitcnt lgkmcnt(0)" ::: "memory");
    const int kq = lane & 3;
#pragma unroll
    for (int j = 0; j < 4; ++j) { const int n = (lane >> 2) + 16 * j; const LAS float* s = scr + (16 * kq) * 65 + n;
        u32x4 o; o.x = pk4_fp8(s[0 * 65], s[1 * 65], s[2 * 65], s[3 * 65]); o.y = pk4_fp8(s[4 * 65], s[5 * 65], s[6 * 65], s[7 * 65]);
        o.z = pk4_fp8(s[8 * 65], s[9 * 65], s[10 * 65], s[11 * 65]); o.w = pk4_fp8(s[12 * 65], s[13 * 65], s[14 * 65], s[15 * 65]);
        *(u32x4*)(dst + (size_t)n * 1024 + k0 + 16 * kq) = o; }
    asm volatile("s_waitcnt lgkmcnt(0)" ::: "memory");
}
#ifndef PRO_PROBE
#define PRO_PROBE 0
#endif
template <int MODE> __device__ __forceinline__ void ex_convert(PrmP p, LAS float* scr, int gw, int NGW, int lane) {
    constexpr int I_GU = 16 * 32, I_DN = 16 * 16, NEX = 64 * I_GU + 64 * I_DN;
#define EX_ITEM(r_, src_, dst_, ldw_) do { int r2_ = (r_); if (r2_ < 64 * I_GU) { const int le = r2_ >> 9, q = r2_ & 511, kb = q >> 5, n0 = (q & 31) * 64; \
        const int sx = n0 >> 10, rr = n0 & 1023, j = rr >> 7, cc = rr & 127, drow = 256 * j + 128 * sx + cc; \
        ldw_ = 2048; src_ = p->in[I_WGU] + (size_t)le * 1024 * 2048 + (size_t)(kb * 64) * 2048 + n0; dst_ = p->ws + (MODE == 2 ? WS_YR : WS_WGU) + ((size_t)le * 2048 + drow) * 1024 + kb * 64; } \
      else { r2_ -= 64 * I_GU; const int le = r2_ >> 8, q = r2_ & 255, kb = q >> 4, n0 = (q & 15) * 64; \
        ldw_ = 1024; src_ = p->in[I_WDN] + (size_t)le * 1024 * 1024 + (size_t)(kb * 64) * 1024 + n0; dst_ = p->ws + (MODE == 2 ? WS_YR + 128 * MiB : WS_WDN) + ((size_t)le * 1024 + n0) * 1024 + kb * 64; } } while (0)
#define EX_LOAD(src_, ldw_) do { _Pragma("unroll") for (int i = 0; i < 16; ++i) { if (MODE == 2) v[i] = (f32x4){(float)i, (float)lane, 1.f, 2.f}; else v[i] = *(const f32x4*)((src_) + (size_t)((lane >> 4) + 4 * i) * (ldw_) + 4 * (lane & 15)); } } while (0)
    int r = gw;
    if (r < NEX) {
        const float* src; unsigned char* dst; int ldw; f32x4 v[16];
        EX_ITEM(r, src, dst, ldw); EX_LOAD(src, ldw);
#pragma unroll 1
        for (;;) {
#pragma unroll
            for (int i = 0; i < 16; ++i) { LAS float* d = scr + ((lane >> 4) + 4 * i) * 65 + 4 * (lane & 15); d[0] = v[i].x * 64.f; d[1] = v[i].y * 64.f; d[2] = v[i].z * 64.f; d[3] = v[i].w * 64.f; }
            const int rn = r + NGW; const bool more = rn < NEX; unsigned char* dcur = dst;
            if (more) { EX_ITEM(rn, src, dst, ldw); EX_LOAD(src, ldw); }
            asm volatile("s_waitcnt lgkmcnt(0)" ::: "memory");
            const int kq = lane & 3;
#pragma unroll
            for (int j = 0; j < 4; ++j) { const int n = (lane >> 2) + 16 * j; const LAS float* sp = scr + (16 * kq) * 65 + n;
                u32x4 o; o.x = pk4_fp8(sp[0 * 65], sp[1 * 65], sp[2 * 65], sp[3 * 65]); o.y = pk4_fp8(sp[4 * 65], sp[5 * 65], sp[6 * 65], sp[7 * 65]);
                o.z = pk4_fp8(sp[8 * 65], sp[9 * 65], sp[10 * 65], sp[11 * 65]); o.w = pk4_fp8(sp[12 * 65], sp[13 * 65], sp[14 * 65], sp[15 * 65]);
                if (MODE != 1 || (o.x == 0x12345678u && o.y == 0x9abcdef0u && o.z == 0x0fedcba9u)) *(u32x4*)(dcur + (size_t)n * 1024 + 16 * kq) = o; }
            asm volatile("s_waitcnt lgkmcnt(0)" ::: "memory");
            if (!more) break;
            r = rn;
        }
    }
#undef EX_ITEM
#undef EX_LOAD
}
constexpr int EXC_IMG = 256 * 128;
__device__ __forceinline__ void ex_convert_wg(PrmP p, LAS unsigned char* lds, int wg, int nwg) {
    const int tid = fresh_tid(), lane = tid & 63, wave = tid >> 6;
    constexpr int NGU = 64 * 8 * 8, NIT = NGU + 64 * 8 * 4;
#define EXW_ITEM(it_, src_, ldw_, dbase_, gu_, nb_) do { int r_ = (it_); if (r_ < NGU) { const int le = r_ >> 6, q = r_ & 63, kb = q >> 3; nb_ = q & 7; gu_ = 1; ldw_ = 2048; \
        src_ = p->in[I_WGU] + (size_t)le * 1024 * 2048 + (size_t)(kb * 128 + wave * 16) * 2048 + nb_ * 256 + 4 * lane; dbase_ = p->ws + WS_WGU + (size_t)le * 2048 * 1024 + kb * 128; } \
      else { r_ -= NGU; const int le = r_ >> 5, q = r_ & 31, kb = q >> 2; nb_ = q & 3; gu_ = 0; ldw_ = 1024; \
        src_ = p->in[I_WDN] + (size_t)le * 1024 * 1024 + (size_t)(kb * 128 + wave * 16) * 1024 + nb_ * 256 + 4 * lane; dbase_ = p->ws + WS_WDN + (size_t)le * 1024 * 1024 + kb * 128; } } while (0)
#define EXW_LOAD(src_, ldw_) do { _Pragma("unroll") for (int i = 0; i < 16; ++i) v[i] = *(const f32x4*)((src_) + (size_t)i * (ldw_)); } while (0)
    int it = wg; if (it >= NIT) return;
    const float* src; unsigned char* dbase; int ldw, gu, nb; f32x4 v[16];
    EXW_ITEM(it, src, ldw, dbase, gu, nb); EXW_LOAD(src, ldw);
    int buf = 0;
#pragma unroll 1
    for (;;) {
        LAS unsigned char* img = lds + buf * EXC_IMG;
#pragma unroll
        for (int q = 0; q < 4; ++q) { u32x4 o;
            o.x = pk4_fp8(v[0][q] * 64.f, v[1][q] * 64.f, v[2][q] * 64.f, v[3][q] * 64.f); o.y = pk4_fp8(v[4][q] * 64.f, v[5][q] * 64.f, v[6][q] * 64.f, v[7][q] * 64.f);
            o.z = pk4_fp8(v[8][q] * 64.f, v[9][q] * 64.f, v[10][q] * 64.f, v[11][q] * 64.f); o.w = pk4_fp8(v[12][q] * 64.f, v[13][q] * 64.f, v[14][q] * 64.f, v[15][q] * 64.f);
            *(LAS u32x4*)(img + (4 * lane + q) * 128 + ((wave ^ (lane & 7)) << 4)) = o; }
        const int itn = it + nwg; const bool more = itn < NIT; unsigned char* dcur = dbase; const int gucur = gu, nbcur = nb;
        if (more) { EXW_ITEM(itn, src, ldw, dbase, gu, nb); EXW_LOAD(src, ldw); }
        __syncthreads();
#pragma unroll
        for (int j = 0; j < 4; ++j) { const int pidx = tid + 512 * j, n = pidx >> 3, pc = pidx & 7;
            const u32x4 o = *(const LAS u32x4*)(img + n * 128 + ((pc ^ ((n >> 2) & 7)) << 4));
            const int ncol = nbcur * 256 + n; const int drow = gucur ? (256 * ((ncol & 1023) >> 7) + 128 * (ncol >> 10) + (ncol & 127)) : ncol;
            *(u32x4*)(dcur + (size_t)drow * 1024 + 16 * pc) = o; }
        if (!more) break;
        it = itn; buf ^= 1;
    }
#undef EXW_ITEM
#undef EXW_LOAD
}
__device__ __forceinline__ void ph_prologue(PrmP p, LAS unsigned char* lds, int wg, int nwg) {
    const int tid = fresh_tid(), lane = tid & 63, wave = tid >> 6;
    {
        LAS float* sc = (LAS float*)lds; LAS float* red = sc + 4096;
        const float* c = p->in[I_C];
        for (int i = tid; i < 4096; i += NTHREADS) { const float v = c[i]; sc[i] = v / (1.f + __expf(-v)); }
        __syncthreads();
        float* MOD = (float*)(p->ws + WS_MOD);
        for (int it = wg; it < 2 * 96; it += nwg) {
            const int l = it / 96, n0 = (it % 96) * 64, kg = tid >> 6, nl = tid & 63;
            const float* W = p->in[I_ADAW] + (size_t)l * 1024 * 6144 + n0 + nl;
            float a0 = 0.f, a1 = 0.f, a2 = 0.f, a3 = 0.f;
            for (int k0 = kg; k0 < 1024; k0 += 8 * 32) { float w[32];
#pragma unroll
                for (int q = 0; q < 32; ++q) w[q] = W[(size_t)(k0 + 8 * q) * 6144];
#pragma unroll
                for (int q = 0; q < 32; ++q) { const int k = k0 + 8 * q; a0 += sc[k] * w[q]; a1 += sc[1024 + k] * w[q]; a2 += sc[2048 + k] * w[q]; a3 += sc[3072 + k] * w[q]; } }
            red[(kg * 4 + 0) * 64 + nl] = a0; red[(kg * 4 + 1) * 64 + nl] = a1; red[(kg * 4 + 2) * 64 + nl] = a2; red[(kg * 4 + 3) * 64 + nl] = a3;
            __syncthreads();
            if (tid < 256) { const int b = tid >> 6; float s = 0.f;
#pragma unroll
                for (int g = 0; g < 8; ++g) s += red[(g * 4 + b) * 64 + nl];
                MOD[(size_t)(l * 4 + b) * 6144 + n0 + nl] = s + p->in[I_ADAB][l * 6144 + n0 + nl]; }
            __syncthreads();
        }
    }
    {
        LAS float* scr = (LAS float*)lds + wave * (64 * 65);
        const int gw = wave * nwg + wg, NGW = nwg * NWAVES;
        constexpr int I_IN = 16 * 80, I_OUT = OUT_FP8 ? 16 * 16 : 16 * 32, I_GU = EXPERT_FP8 ? 16 * 32 : 16 * 64, I_DN = EXPERT_FP8 ? 16 * 16 : 16 * 32;
        constexpr int I_GLU = 4 * 8;
        constexpr int I_LRU = 4 * 2 * 2;
        constexpr int NGU = EXPERT_FP8 ? 0 : 64 * I_GU, NDN = EXPERT_FP8 ? 0 : 64 * I_DN;
        constexpr int TOT = 2 * I_IN + 2 * I_OUT + NGU + NDN + 2 * I_GLU + 2 * I_LRU;
        for (int it = gw; it < TOT; it += NGW) {
            int r = it;
            if (r < 2 * I_IN) { const int l = r / I_IN, q = r % I_IN, kb = q / 80, nb = q % 80, n0 = nb * 32;
                const float sc = (n0 >= C_Q && n0 < C_K) ? C2 : 1.f;
                tr_item(p->in[I_WIN] + (size_t)l * 1024 * INC, INC, INC, kb * 64, n0, (bf16_t*)(p->ws + WS_WIN) + ((size_t)l * NP + n0) * 1024, sc, scr, lane); continue; }
            r -= 2 * I_IN;
            if (OUT_FP8 && r < 2 * I_OUT) { const int l = r / I_OUT, q = r % I_OUT, kb = q / 16, nb = q % 16;
                tr_item8w(p->in[I_WOUT] + (size_t)l * 1024 * 1024, 1024, kb * 64, nb * 64, p->ws + WS_WOUT + ((size_t)l * 1024 + nb * 64) * 1024, 64.f, scr, lane); continue; }
            if (r < 2 * I_OUT) { const int l = r / I_OUT, q = r % I_OUT, kb = q / 32, nb = q % 32, n0 = nb * 32;
                tr_item(p->in[I_WOUT] + (size_t)l * 1024 * 1024, 1024, 1024, kb * 64, n0, (bf16_t*)(p->ws + WS_WOUT) + ((size_t)l * 1024 + n0) * 1024, 1.f, scr, lane); continue; }
            r -= 2 * I_OUT;
            if (r < NGU) { const int le = r / I_GU, q = r % I_GU, NBK = EXPERT_FP8 ? 32 : 64, kb = q / NBK, nb = q % NBK, n0 = nb * (2048 / NBK);
                const int s = n0 / 1024, rr = n0 % 1024, j = rr / 128, cc = rr % 128, drow = 256 * j + 128 * s + cc;
                if (EXPERT_FP8) tr_item8w(p->in[I_WGU] + (size_t)le * 1024 * 2048, 2048, kb * 64, n0, p->ws + WS_WGU + ((size_t)le * 2048 + drow) * 1024, 64.f, scr, lane);
                else tr_item(p->in[I_WGU] + (size_t)le * 1024 * 2048, 2048, 2048, kb * 64, n0, (bf16_t*)(p->ws + WS_WGU) + ((size_t)le * 2048 + drow) * 1024, 1.f, scr, lane); continue; }
            r -= NGU;
            if (r < NDN) { const int le = r / I_DN, q = r % I_DN, NBK = EXPERT_FP8 ? 16 : 32, kb = q / NBK, nb = q % NBK, n0 = nb * (1024 / NBK);
                if (EXPERT_FP8) tr_item8w(p->in[I_WDN] + (size_t)le * 1024 * 1024, 1024, kb * 64, n0, p->ws + WS_WDN + ((size_t)le * 1024 + n0) * 1024, 64.f, scr, lane);
                else tr_item(p->in[I_WDN] + (size_t)le * 1024 * 1024, 1024, 1024, kb * 64, n0, (bf16_t*)(p->ws + WS_WDN) + ((size_t)le * 1024 + n0) * 1024, 1.f, scr, lane); continue; }
            r -= NDN;
            if (r < 2 * I_GLU) { const int l = r / I_GLU, q = r % I_GLU, kb = q / 8, nb = q % 8, n0 = nb * 32;
                tr_item(p->in[I_GLUW] + (size_t)l * 256 * 256, 256, 256, kb * 64, n0, (bf16_t*)(p->ws + WS_GLUW) + ((size_t)l * 256 + n0) * 256, 1.f, scr, lane, 256); continue; }
            r -= 2 * I_GLU;
            { const int l = r / I_LRU, q = r % I_LRU, blk = q >> 2, gate = (q >> 1) & 1, n0 = (q & 1) * 32;
                tr_item(p->in[gate ? I_LRUWX : I_LRUWA] + (size_t)(l * 4 + blk) * 4096, 64, 64, 0, n0, (bf16_t*)(p->ws + WS_LRUW) + ((size_t)((l * 4 + blk) * 2 + gate) * 64 + n0) * 64, 1.f, scr, lane, 64); }
        }
#if EXPERT_FP8
        __syncthreads();
        ex_convert_wg(p, lds, wg, nwg);
#endif
    }
}

__device__ __forceinline__ void ph_norm1(PrmP p, int l, int wg, int nwg) {
    const int tid = fresh_tid(), lane = tid & 63, wave = tid >> 6;
    const float* X = (l == 0) ? p->in[I_X] : p->out;
    const float* MOD = (const float*)(p->ws + WS_MOD);
    bf16_t* HB = (bf16_t*)(p->ws + WS_HB);
    const float* g = p->in[I_PREMIXG] + l * 1024;
    f32x4 vn[4];
    { const int m0 = wg * NWAVES + wave;
#pragma unroll
      for (int j = 0; j < 4; ++j) vn[j] = *(const f32x4*)(X + (size_t)m0 * 1024 + 4 * lane + 256 * j); }
    for (int m = wg * NWAVES + wave; m < M; m += nwg * NWAVES) {
        const int b = m / T;
        const float* shift = MOD + (size_t)(l * 4 + b) * 6144 + 0 * 1024; const float* scale = shift + 1024;
        f32x4 v[4]; float ss = 0.f;
#pragma unroll
        for (int j = 0; j < 4; ++j) { v[j] = vn[j]; ss += (v[j].x * v[j].x + v[j].y * v[j].y) + (v[j].z * v[j].z + v[j].w * v[j].w); }
        { const int mn = m + nwg * NWAVES; if (mn < M) {
#pragma unroll
            for (int j = 0; j < 4; ++j) vn[j] = *(const f32x4*)(X + (size_t)mn * 1024 + 4 * lane + 256 * j); } }
        const float rstd = __builtin_amdgcn_rsqf(wave_sum(ss) * (1.f / 1024.f) + RMS_EPS);
#pragma unroll
        for (int j = 0; j < 4; ++j) { const int c = 4 * lane + 256 * j; const f32x4 gg = *(const f32x4*)(g + c), sc = *(const f32x4*)(scale + c), sh = *(const f32x4*)(shift + c);
            const f32x4 h = v[j] * rstd * gg * (sc + 1.f) + sh;
            u32x2 o; o.x = pk2(h.x, h.y); o.y = pk2(h.z, h.w); *(u32x2*)(HB + (size_t)m * 1024 + c) = o; }
    }
}

namespace pg8 {
#define PG8_LAS __attribute__((address_space(3)))
typedef unsigned short bf16_t;
typedef short bf16x8 __attribute__((ext_vector_type(8)));
typedef float f32x4 __attribute__((ext_vector_type(4)));
typedef unsigned u32x4 __attribute__((ext_vector_type(4)));
constexpr int BM = 256, BK = 64, HALF = 128, HTB = HALF * BK * 2  , STAGE_BYTES = 8 * HTB, NXCD = 8, WGM = 8;

__host__ __device__ __forceinline__ int lds_byte(int r, int c) { const int st = (r >> 4) * 2 + (c >> 5), rr = r & 15, cc = c & 31, ob = rr * 64 + cc * 2; return st * 1024 + (ob ^ (((ob >> 9) & 1) << 5)); }
__host__ __device__ __forceinline__ void stage_rc(int b, int& R, int& C) { const int st = b / 1024, sb = b % 1024, swz = sb ^ (((sb >> 9) & 1) << 5); R = (st >> 1) * 16 + swz / 64; C = (st & 1) * 32 + (swz % 64) / 2; }
__host__ __device__ __forceinline__ int perm32(int rho) { const int n = rho >> 4, i = rho & 15; return 8 * (i >> 2) + 4 * n + (i & 3); }

struct Unit { int pm, pn; };
struct Gemm { const bf16_t* A; const bf16_t* Bt; int M, N, K; const PG8_LAS unsigned short* rowtok = nullptr; int a_pitch = 0, a_kstep = 0; };

struct StaticOrder {
    int nM, nN, nwg, G, c;
    __host__ __device__ void init(int M, int N, int G_, int c_) { nM = M / BM; nN = N / BM; nwg = nM * nN; G = G_; c = c_; }
    __host__ __device__ bool next(int i, Unit& u) const {
        const long L = (long)i * G + c; if (L >= nwg) return false;
        int wgid = (int)L; { const int q = nwg / NXCD, r = nwg % NXCD, xcd = wgid % NXCD, off = wgid / NXCD; wgid = (xcd < r ? xcd * (q + 1) : r * (q + 1) + (xcd - r) * q) + off; }
        const int nig = WGM * nN, gid = wgid / nig, fm = gid * WGM, gsz = (nM - fm) < WGM ? (nM - fm) : WGM;
        u.pm = fm + ((wgid % nig) % gsz); u.pn = (wgid % nig) / gsz; return true;
    }
    __device__ __forceinline__ void a_ready(const Unit&) const {}
    __device__ __forceinline__ void done(const Unit&) const {}
};


__device__ __forceinline__ unsigned cvt_pk_bf16(float lo, float hi) { unsigned r; asm volatile("v_cvt_pk_bf16_f32 %0, %1, %2" : "=v"(r) : "v"(lo), "v"(hi)); return r; }
struct EpiBf16Plain {
    static constexpr bool PERM = true, AFTER_DRAIN = false, PERM64 = false; static constexpr int NVM = 0;
    bf16_t* O; int ldc;
    __device__ __forceinline__ void operator()(const f32x4 (&acc)[2][2][4][2], const Unit& u, int wr, int wc, int fr, int fq, int) const {
        const int row0 = u.pm * BM + wr * 64 + fr, col0 = u.pn * BM + wc * 32 + 8 * fq;
#pragma unroll
        for (int ai = 0; ai < 2; ++ai)
#pragma unroll
            for (int m = 0; m < 4; ++m) { bf16_t* rowp = O + (size_t)(row0 + ai * HALF + m * 16) * ldc + col0;
#pragma unroll
                for (int bj = 0; bj < 2; ++bj) { const f32x4 v0 = acc[ai][bj][m][0], v1 = acc[ai][bj][m][1];
                    u32x4 w; w.x = cvt_pk_bf16(v0[0], v0[1]); w.y = cvt_pk_bf16(v0[2], v0[3]); w.z = cvt_pk_bf16(v1[0], v1[1]); w.w = cvt_pk_bf16(v1[2], v1[3]);
                    *(u32x4*)(rowp + bj * HALF) = w; } }
    }
};
struct EpiSwiglu {
    static constexpr bool PERM = true, AFTER_DRAIN = false, PERM64 = false; static constexpr int NVM = 0;
    bf16_t* H1; const float* bgu;
    __device__ __forceinline__ void operator()(const f32x4 (&acc)[2][2][4][2], const Unit& u, int wr, int wc, int fr, int fq, int) const {
        const int j = u.pn & 7, row0 = u.pm * BM + wr * 64 + fr, lc0 = wc * 32 + 8 * fq;
        const float* bb = bgu + (size_t)(u.pn >> 3) * 2048 + j * 128 + lc0;
        const f32x4 bg0 = *(const f32x4*)(bb), bg1 = *(const f32x4*)(bb + 4), bu0 = *(const f32x4*)(bb + 1024), bu1 = *(const f32x4*)(bb + 1028);
#pragma unroll
        for (int ai = 0; ai < 2; ++ai)
#pragma unroll
            for (int m = 0; m < 4; ++m) { float o[8];
#pragma unroll
                for (int n = 0; n < 2; ++n) { const f32x4 g4 = acc[ai][0][m][n] + (n ? bg1 : bg0), u4 = acc[ai][1][m][n] + (n ? bu1 : bu0);
#pragma unroll
                    for (int q = 0; q < 4; ++q) { const float g = fminf(g4[q], 7.f), up = fminf(fmaxf(u4[q], -7.f), 7.f);
                        o[4 * n + q] = (up + 1.f) * g * __builtin_amdgcn_rcpf(1.f + __builtin_amdgcn_exp2f(-1.702f * 1.4426950408889634f * g)); } }
                u32x4 w; w.x = cvt_pk_bf16(o[0], o[1]); w.y = cvt_pk_bf16(o[2], o[3]); w.z = cvt_pk_bf16(o[4], o[5]); w.w = cvt_pk_bf16(o[6], o[7]);
                *(u32x4*)(H1 + (size_t)(row0 + ai * HALF + m * 16) * 1024 + j * 128 + lc0) = w; }
    }
};
__device__ __forceinline__ unsigned pk4_fp8(float a, float b, float c, float d) { int w = __builtin_amdgcn_cvt_pk_fp8_f32(a, b, 0, false); w = __builtin_amdgcn_cvt_pk_fp8_f32(c, d, w, true); return (unsigned)w; }
struct EpiSwiglu8 {
    static constexpr bool PERM = true, AFTER_DRAIN = false, PERM64 = false; static constexpr int NVM = 0;
    unsigned char* H1; const PG8_LAS float* bl;
    __device__ __forceinline__ void operator()(const f32x4 (&acc)[2][2][4][2], const Unit& u, int wr, int wc, int fr, int fq, int ui) const {
        const int j = u.pn & 7, row0 = u.pm * BM + wr * 64 + fr, lc0 = wc * 32 + 8 * fq;
        const PG8_LAS float* bb = bl + ui * 256 + lc0;
        const f32x4 bg0 = *(const PG8_LAS f32x4*)(bb), bg1 = *(const PG8_LAS f32x4*)(bb + 4), bu0 = *(const PG8_LAS f32x4*)(bb + 128), bu1 = *(const PG8_LAS f32x4*)(bb + 132);
#pragma unroll
        for (int ai = 0; ai < 2; ++ai)
#pragma unroll
            for (int m = 0; m < 4; ++m) { float o[8];
#pragma unroll
                for (int n = 0; n < 2; ++n) { const f32x4 ga = acc[ai][0][m][n], ua = acc[ai][1][m][n], gb = n ? bg1 : bg0, ub = n ? bu1 : bu0;
#pragma unroll
                    for (int hh = 0; hh < 2; ++hh) {
                        typedef float f2 __attribute__((ext_vector_type(2)));
                        f2 g = (f2){ga[2 * hh], ga[2 * hh + 1]} + (f2){gb[2 * hh], gb[2 * hh + 1]}, up = (f2){ua[2 * hh], ua[2 * hh + 1]} + (f2){ub[2 * hh], ub[2 * hh + 1]};
                        g.x = fminf(g.x, 7.f); g.y = fminf(g.y, 7.f); up.x = __builtin_amdgcn_fmed3f(up.x, -7.f, 7.f); up.y = __builtin_amdgcn_fmed3f(up.y, -7.f, 7.f);
                        const f2 t = g * (f2){-1.702f * 1.4426950408889634f, -1.702f * 1.4426950408889634f};
                        const f2 d = (f2){__builtin_amdgcn_exp2f(t.x), __builtin_amdgcn_exp2f(t.y)} + (f2){1.f, 1.f};
                        const f2 r = {__builtin_amdgcn_rcpf(d.x), __builtin_amdgcn_rcpf(d.y)};
                        const f2 a = __builtin_elementwise_fma(up, (f2){2.f, 2.f}, (f2){2.f, 2.f});
                        const f2 ov = (a * g) * r;
                        o[4 * n + 2 * hh] = ov.x; o[4 * n + 2 * hh + 1] = ov.y; } }
                typedef unsigned u32x2_ __attribute__((ext_vector_type(2))); u32x2_ w; w.x = pk4_fp8(o[0], o[1], o[2], o[3]); w.y = pk4_fp8(o[4], o[5], o[6], o[7]);
                *(u32x2_*)(H1 + ((size_t)(u.pm * 8 + j) * 256 + (wr * 64 + fr + ai * HALF + m * 16)) * 128 + lc0) = w; }
    }
};
struct EpiDown {
    static constexpr bool PERM = true, AFTER_DRAIN = false, PERM64 = false; static constexpr int NVM = 0;
    bf16_t* YR; const float* bdn;
    __device__ __forceinline__ void operator()(const f32x4 (&acc)[2][2][4][2], const Unit& u, int wr, int wc, int fr, int fq, int) const {
        const int jn = u.pn & 3, row0 = u.pm * BM + wr * 64 + fr, col0 = jn * BM + wc * 32 + 8 * fq;
        const float* bb = bdn + (size_t)(u.pn >> 2) * 1024 + col0;
        f32x4 bv[2][2]; bv[0][0] = *(const f32x4*)(bb); bv[0][1] = *(const f32x4*)(bb + 4); bv[1][0] = *(const f32x4*)(bb + HALF); bv[1][1] = *(const f32x4*)(bb + HALF + 4);
#pragma unroll
        for (int ai = 0; ai < 2; ++ai)
#pragma unroll
            for (int m = 0; m < 4; ++m) { bf16_t* rowp = YR + (size_t)(row0 + ai * HALF + m * 16) * 1024 + col0;
#pragma unroll
                for (int bj = 0; bj < 2; ++bj) { const f32x4 v0 = acc[ai][bj][m][0] + bv[bj][0], v1 = acc[ai][bj][m][1] + bv[bj][1];
                    u32x4 w; w.x = cvt_pk_bf16(v0[0], v0[1]); w.y = cvt_pk_bf16(v0[2], v0[3]); w.z = cvt_pk_bf16(v1[0], v1[1]); w.w = cvt_pk_bf16(v1[2], v1[3]);
                    *(u32x4*)(rowp + bj * HALF) = w; } }
    }
};
struct EpiDown8 {
    static constexpr bool PERM = true, AFTER_DRAIN = false, PERM64 = true; static constexpr int NVM = 0;
    unsigned char* YR; const PG8_LAS float* bl;
    __device__ __forceinline__ void operator()(const f32x4 (&acc)[2][2][4][2], const Unit& u, int wr, int wc, int fr, int fq, int ui) const {
        const int jn = u.pn & 3, row0 = u.pm * BM + wr * 64 + fr, col0 = jn * BM + wc * 32 + 8 * fq;
        const PG8_LAS float* bb = bl + ui * 256 + wc * 64 + 16 * fq;
        f32x4 bv[2][2]; bv[0][0] = *(const PG8_LAS f32x4*)(bb); bv[0][1] = *(const PG8_LAS f32x4*)(bb + 4); bv[1][0] = *(const PG8_LAS f32x4*)(bb + 8); bv[1][1] = *(const PG8_LAS f32x4*)(bb + 12);
#pragma unroll
        for (int ai = 0; ai < 2; ++ai)
#pragma unroll
            for (int m = 0; m < 4; ++m) { unsigned char* rowp = YR + ((size_t)(u.pm * 4 + jn) * 256 + (wr * 64 + fr + ai * HALF + m * 16)) * 256 + wc * 64 + 16 * fq;
                u32x4 w;
#pragma unroll
                for (int bj = 0; bj < 2; ++bj) { const f32x4 v0 = (acc[ai][bj][m][0] + bv[bj][0]) * 16.f, v1 = (acc[ai][bj][m][1] + bv[bj][1]) * 16.f;
                    w[2 * bj] = pk4_fp8(v0[0], v0[1], v0[2], v0[3]); w[2 * bj + 1] = pk4_fp8(v1[0], v1[1], v1[2], v1[3]); }
                *(u32x4*)rowp = w; }
    }
};
struct GroupOrder {
    int nt, nct, G, c; const PG8_LAS int* tile_e;
    __device__ __forceinline__ bool peek_pm(int i, int& rt) const { const int x = c & 7, j = c >> 3, rpg = 32 / nct, gi = i * 8 + x; rt = gi * rpg + j / nct; return G == 256 && rt < nt; }
    __device__ __forceinline__ bool next(int i, Unit& u) const {
        const int x = c & 7, j = c >> 3, rpg = 32 / nct, gi = i * 8 + x, rt = gi * rpg + j / nct, ct = j % nct;
        if (G != 256 || rt >= nt) return false;
        u.pm = rt; u.pn = tile_e[rt] * nct + ct; return true; }
    __device__ __forceinline__ void a_ready(const Unit&) const {}
    __device__ __forceinline__ void done(const Unit&) const {}
};

typedef int i32x8 __attribute__((ext_vector_type(8))); typedef int i32x4 __attribute__((ext_vector_type(4)));
__device__ __forceinline__ i32x8 cat8(bf16x8 lo, bf16x8 hi) { const i32x4 a = __builtin_bit_cast(i32x4, lo), b = __builtin_bit_cast(i32x4, hi); return __builtin_shufflevector(a, b, 0, 1, 2, 3, 4, 5, 6, 7); }
template <class Epi, class Sched, bool ALIGN_EPI = false, bool SP2 = false, int F8SCALE = 0, bool GATHER = false>
__device__ __forceinline__ void gemm_phase(PG8_LAS unsigned char* lds, const Gemm g, const Sched& S, const Epi& E) {
    const int tid = fresh_tid(), wid = __builtin_amdgcn_readfirstlane(tid >> 6), lane = tid & 63, wr = wid >> 2, wc = wid & 3, fr = lane & 15, fq = lane >> 4;
    const int K = g.K, nt = K / BK;
    unsigned voffA[2], voffB[2];
#pragma unroll
    for (int i = 0; i < 2; ++i) { int R, C; stage_rc(tid * 16 + i * 8192, R, C); const int Rb = Epi::PERM64 ? (64 * (R >> 5) + 16 * ((R & 15) >> 2) + 4 * ((R >> 4) & 1) + (R & 3)) : Epi::PERM ? ((R & ~31) + perm32(R & 31)) : R;
        voffA[i] = GATHER ? (unsigned)((R << 16) | (C * 2)) : (unsigned)(R * (g.a_pitch ? g.a_pitch : K * 2) + (g.a_pitch ? (C & 63) : C) * 2); voffB[i] = (unsigned)(Rb * K + C) * 2u; }
    static_assert(!GATHER || SP2, "the gathered form is written for the SP2 loop");
    unsigned gA[2][2] = {{0u, 0u}, {0u, 0u}}, gN[2][2] = {{0u, 0u}, {0u, 0u}};
#define PG8_GLOOK(dst, unit) do { _Pragma("unroll") for (int h_ = 0; h_ < 2; ++h_) _Pragma("unroll") for (int i_ = 0; i_ < 2; ++i_) \
        dst[h_][i_] = (unsigned)g.rowtok[(unit) * BM + h_ * HALF + (int)(voffA[i_] >> 16)]; } while (0)
#define PG8_GOFF(dst, src) do { _Pragma("unroll") for (int h_ = 0; h_ < 2; ++h_) _Pragma("unroll") for (int i_ = 0; i_ < 2; ++i_) dst[h_][i_] = src[h_][i_] * (unsigned)(K * 2) + (voffA[i_] & 0xffffu); } while (0)
#define PG8_STAGE_A(bufoff, gbase, half, OFFS) do { if constexpr (GATHER) { _Pragma("unroll") for (int _i = 0; _i < 2; ++_i) \
        __builtin_amdgcn_global_load_lds((const unsigned*)((const char*)(gbase) + OFFS[half][_i]), (PG8_LAS unsigned*)(lds + (bufoff) + ldsw + _i * 8192), 16, 0, 0); } \
        else { PG8_STAGE(bufoff, (gbase) + (half) * hstepA, voffA); } } while (0)
    const size_t kstep = (size_t)(BK * 2);
    const size_t hstep = (size_t)HALF * K * 2;
    const size_t kstepA = g.a_kstep ? (size_t)g.a_kstep : kstep, hstepA = g.a_pitch ? (size_t)HALF * g.a_pitch : hstep;
    const size_t tstep = 2 * hstep;
    const size_t hstepB = Epi::PERM64 ? (size_t)8 * K * 2 : hstep;
    static_assert(!Epi::PERM64 || SP2, "PERM64 is wired into the SP2 loop only");
    const unsigned ldsw = (unsigned)wid * 1024u;
    const int aoff = lds_byte(wr * 64 + fr, fq * 8), boff = lds_byte(wc * 32 + fr, fq * 8);
#define PG8_SA(b, h) (((b) * 2 + (h)) * HTB)
#define PG8_SB(b, h) ((4 + (b) * 2 + (h)) * HTB)
#define PG8_STAGE(bufoff, gbase, voff) do { _Pragma("unroll") for (int _i = 0; _i < 2; ++_i) \
        __builtin_amdgcn_global_load_lds((const unsigned*)((const char*)(gbase) + (voff)[_i]), (PG8_LAS unsigned*)(lds + (bufoff) + ldsw + _i * 8192), 16, 0, 0); } while (0)
#define PG8_LDA(dst, b, h) do { _Pragma("unroll") for (int m = 0; m < 4; ++m) { const bf16x8 l0_ = *(const PG8_LAS bf16x8*)(lds + PG8_SA(b, h) + aoff + m * 2048), l1_ = *(const PG8_LAS bf16x8*)(lds + PG8_SA(b, h) + aoff + m * 2048 + 1024); \
        if constexpr (F8SCALE != 0) dst##8[m] = cat8(l0_, l1_); else { dst[m][0] = l0_; dst[m][1] = l1_; } } } while (0)
#define PG8_LDB(dst, b, h) do { _Pragma("unroll") for (int n = 0; n < 2; ++n) { const bf16x8 l0_ = *(const PG8_LAS bf16x8*)(lds + PG8_SB(b, h) + boff + n * 2048), l1_ = *(const PG8_LAS bf16x8*)(lds + PG8_SB(b, h) + boff + n * 2048 + 1024); \
        if constexpr (F8SCALE != 0) dst##8[n] = cat8(l0_, l1_); else { dst[n][0] = l0_; dst[n][1] = l1_; } } } while (0)
#define PG8_MMA(ai, bj, At, Bt) do { __builtin_amdgcn_s_setprio(1); _Pragma("unroll") for (int m = 0; m < 4; ++m) _Pragma("unroll") for (int n = 0; n < 2; ++n) { \
        if constexpr (F8SCALE != 0) { if (F8_ALLV || ((ai) == 1 && (bj) == 1)) asm volatile("v_mfma_scale_f32_16x16x128_f8f6f4 %0, %1, %2, %0, %3, %4 op_sel_hi:[0,0,0]" : "+v"(acc[ai][bj][m][n]) : "v"(Bt##8[n]), "v"(At##8[m]), "v"(f8sa), "v"(f8sb)); \
            else asm volatile("v_mfma_scale_f32_16x16x128_f8f6f4 %0, %1, %2, %0, %3, %4 op_sel_hi:[0,0,0]" : "+a"(acc[ai][bj][m][n]) : "v"(Bt##8[n]), "v"(At##8[m]), "v"(f8sa), "v"(f8sb)); } \
        else { _Pragma("unroll") for (int k = 0; k < 2; ++k) acc[ai][bj][m][n] = __builtin_amdgcn_mfma_f32_16x16x32_bf16(Bt[n][k], At[m][k], acc[ai][bj][m][n], 0, 0, 0); } } __builtin_amdgcn_s_setprio(0); } while (0)
#define PG8_WAIT_V(n) asm volatile("s_waitcnt vmcnt(" #n ")" ::: "memory")
#define PG8_WAIT_V8F(first) asm volatile("v_cmp_ne_u32_e32 vcc, 0, %0\n\ts_nop 4\n\ts_cbranch_vccnz .Lpg8sk_%=\n\ts_waitcnt vmcnt(8)\n.Lpg8sk_%=:\n\ts_waitcnt vmcnt(%1)" :: "v"(first), "n"(8 + Epi::NVM) : "memory", "vcc")
#define PG8_WAIT_L(n) asm volatile("s_waitcnt lgkmcnt(" #n ")" ::: "memory")
#define PG8_BAR __builtin_amdgcn_s_barrier()
#define PG8_SCHED __builtin_amdgcn_sched_barrier(0)
    Unit cur, nxt; int ui = 0;
    if (!S.next(0, cur)) return;
    f32x4 acc[2][2][4][2];
#pragma unroll
    for (int a = 0; a < 2; ++a)
#pragma unroll
        for (int b = 0; b < 2; ++b)
#pragma unroll
            for (int m = 0; m < 4; ++m)
#pragma unroll
                for (int n = 0; n < 2; ++n) acc[a][b][m][n] = (f32x4){0.f, 0.f, 0.f, 0.f};
    bf16x8 At[4][2], B0[2][2], B1[2][2]; i32x8 At8[4], B08[2], B18[2];
    const int f8sa = F8SCALE * 0x01010101, f8sb = 0x7f7f7f7f;
    const char* cA = GATHER ? (const char*)g.A : (const char*)g.A + (size_t)cur.pm * tstep; const char* cB = (const char*)g.Bt + (size_t)cur.pn * tstep;
    if constexpr (GATHER) { PG8_GLOOK(gN, 0); PG8_GOFF(gA, gN); }
    S.a_ready(cur);
    if constexpr (SP2) {
        PG8_STAGE(PG8_SB(0, 0), cB, voffB); PG8_STAGE(PG8_SB(0, 1), cB + hstepB, voffB); PG8_STAGE_A(PG8_SA(0, 0), cA, 0, gA); PG8_STAGE_A(PG8_SA(0, 1), cA, 1, gA);
        if (wr == 1) PG8_BAR;
        PG8_WAIT_V(2); PG8_BAR;
        PG8_STAGE(PG8_SB(1, 0), cB + kstep, voffB); PG8_STAGE_A(PG8_SA(1, 0), cA + kstepA, 0, gA); PG8_STAGE(PG8_SB(1, 1), cB + hstepB + kstep, voffB);
        PG8_WAIT_V(6); PG8_BAR;
    } else {
        PG8_STAGE(PG8_SB(0, 0), cB, voffB); PG8_STAGE(PG8_SA(0, 0), cA, voffA); PG8_STAGE(PG8_SB(0, 1), cB + hstep, voffB); PG8_STAGE(PG8_SA(0, 1), cA + hstep, voffA);
        if (wr == 1) PG8_BAR;
        PG8_WAIT_V(4); PG8_BAR;
        PG8_STAGE(PG8_SB(1, 0), cB + kstep, voffB); PG8_STAGE(PG8_SA(1, 0), cA + kstep, voffA); PG8_STAGE(PG8_SB(1, 1), cB + hstep + kstep, voffB);
        PG8_WAIT_V(6); PG8_BAR;
    }
    for (;;) {
        if constexpr (GATHER) { int rt_; if (S.peek_pm(ui + 1, rt_)) PG8_GLOOK(gN, ui + 1); }
        const bool has_next = S.next(ui + 1, nxt);
        const char* nA = (has_next && !GATHER) ? (const char*)g.A + (size_t)nxt.pm * tstep : cA; const char* nB = has_next ? (const char*)g.Bt + (size_t)nxt.pn * tstep : cB;
        for (int t = 0; t < nt; t += 2) {
            const bool last = (t == nt - 2); const int ufirst = ((t == 0) && (ui > 0) && (Epi::NVM > 0)) ? 1 : 0;
            const char* a1 = cA + (size_t)(t + 1) * kstepA;
            const char* a2 = last ? nA : cA + (size_t)(t + 2) * kstepA; const char* b2 = last ? nB : cB + (size_t)(t + 2) * kstep;
            const char* a3 = a2 + kstepA; const char* b3 = b2 + kstep;
            if (last && has_next) S.a_ready(nxt);
            unsigned o2[2][2] = {{gA[0][0], gA[0][1]}, {gA[1][0], gA[1][1]}};
            if constexpr (GATHER) { if (last) { asm volatile("" : "+v"(gN[0][0]), "+v"(gN[0][1]), "+v"(gN[1][0]), "+v"(gN[1][1]) :: "memory"); PG8_GOFF(o2, gN); } }
            if constexpr (SP2) {
            PG8_LDB(B0, 0, 0); PG8_LDB(B1, 0, 1); PG8_SCHED; PG8_LDA(At, 0, 0); PG8_STAGE_A(PG8_SA(1, 1), a1, 1, gA);
            PG8_WAIT_V8F(ufirst); PG8_WAIT_L(0); PG8_BAR; PG8_MMA(0, 0, At, B0); PG8_MMA(0, 1, At, B1); PG8_BAR; PG8_SCHED;
            PG8_LDA(At, 0, 1); PG8_STAGE(PG8_SB(0, 0), b2, voffB); PG8_STAGE(PG8_SB(0, 1), b2 + hstepB, voffB); PG8_STAGE_A(PG8_SA(0, 0), a2, 0, o2);
            PG8_WAIT_V8F(ufirst); PG8_WAIT_L(0); PG8_BAR; PG8_MMA(1, 0, At, B0); PG8_MMA(1, 1, At, B1); PG8_BAR; PG8_SCHED;
            PG8_LDB(B0, 1, 0); PG8_LDB(B1, 1, 1); PG8_SCHED; PG8_LDA(At, 1, 0); PG8_STAGE_A(PG8_SA(0, 1), a2, 1, o2);
            PG8_WAIT_V(8); PG8_WAIT_L(0); PG8_BAR; PG8_MMA(0, 0, At, B0); PG8_MMA(0, 1, At, B1); PG8_BAR; PG8_SCHED;
            PG8_LDA(At, 1, 1); PG8_STAGE(PG8_SB(1, 0), b3, voffB); PG8_STAGE(PG8_SB(1, 1), b3 + hstepB, voffB); PG8_STAGE_A(PG8_SA(1, 0), a3, 0, o2);
            PG8_WAIT_V(8); PG8_WAIT_L(0); PG8_BAR; PG8_MMA(1, 0, At, B0); PG8_MMA(1, 1, At, B1); PG8_BAR; PG8_SCHED;
            } else {
            PG8_LDB(B0, 0, 0); PG8_SCHED; PG8_LDA(At, 0, 0); PG8_STAGE(PG8_SA(1, 1), a1 + hstep, voffA);
            PG8_WAIT_L(8); PG8_BAR; PG8_WAIT_L(0); PG8_MMA(0, 0, At, B0); PG8_BAR; PG8_SCHED;
            PG8_LDB(B1, 0, 1); PG8_STAGE(PG8_SB(0, 0), b2, voffB);
            PG8_BAR; PG8_WAIT_L(0); PG8_MMA(0, 1, At, B1); PG8_BAR;
            PG8_LDA(At, 0, 1); PG8_STAGE(PG8_SA(0, 0), a2, voffA);
            PG8_BAR; PG8_WAIT_L(0); PG8_MMA(1, 0, At, B0); PG8_BAR; PG8_SCHED;
            PG8_STAGE(PG8_SB(0, 1), b2 + hstep, voffB);
            PG8_WAIT_V(6); PG8_BAR; PG8_MMA(1, 1, At, B1); PG8_BAR;
            PG8_LDB(B0, 1, 0); PG8_SCHED; PG8_LDA(At, 1, 0); PG8_STAGE(PG8_SA(0, 1), a2 + hstep, voffA);
            PG8_WAIT_L(8); PG8_BAR; PG8_WAIT_L(0); PG8_MMA(0, 0, At, B0); PG8_BAR; PG8_SCHED;
            PG8_LDB(B1, 1, 1); PG8_STAGE(PG8_SB(1, 0), b3, voffB);
            PG8_BAR; PG8_WAIT_L(0); PG8_MMA(0, 1, At, B1); PG8_BAR;
            PG8_LDA(At, 1, 1); PG8_STAGE(PG8_SA(1, 0), a3, voffA);
            PG8_BAR; PG8_WAIT_L(0); PG8_MMA(1, 0, At, B0); PG8_BAR; PG8_SCHED;
            PG8_STAGE(PG8_SB(1, 1), b3 + hstep, voffB);
            PG8_WAIT_V(6); PG8_BAR; PG8_MMA(1, 1, At, B1); PG8_BAR;
            }
        }
        if constexpr (ALIGN_EPI) { if (wr == 0) PG8_BAR; }
        if constexpr (!Epi::AFTER_DRAIN) { E(acc, cur, wr, wc, fr, fq, ui); S.done(cur); }
        if (!has_next) break;
#pragma unroll
        for (int a = 0; a < 2; ++a)
#pragma unroll
            for (int b = 0; b < 2; ++b)
#pragma unroll
                for (int m = 0; m < 4; ++m)
#pragma unroll
                    for (int n = 0; n < 2; ++n) acc[a][b][m][n] = (f32x4){0.f, 0.f, 0.f, 0.f};
        cur = nxt; cA = nA; cB = nB; ++ui;
        if constexpr (GATHER) PG8_GOFF(gA, gN);
        if constexpr (ALIGN_EPI) { if (wr == 1) PG8_BAR; }
    }
    PG8_WAIT_V(0);
    if constexpr (!ALIGN_EPI) { if (wr == 0) PG8_BAR; }
    PG8_BAR;
    if constexpr (Epi::AFTER_DRAIN) { E.fused(acc, cur, wr, wc, fr, fq, lds, wid, lane); S.done(cur); }
#undef PG8_SA
#undef PG8_SB
#undef PG8_STAGE
#undef PG8_STAGE_A
#undef PG8_GLOOK
#undef PG8_GOFF
#undef PG8_LDA
#undef PG8_LDB
#undef PG8_MMA
#undef PG8_WAIT_V
#undef PG8_WAIT_V8F
#undef PG8_WAIT_L
#undef PG8_BAR
#undef PG8_SCHED
}
}

constexpr int GX_TILE = 133760, GX_ROWS = GX_TILE + 2240;
constexpr int GX_BIAS = GX_ROWS + 17 * 512;
static_assert(GX_BIAS + 17 * 1024 <= 163840 - 64, "grouped-GEMM LDS tables");
__device__ __forceinline__ void fg_gemm_in(PrmP p, int l, LAS unsigned char* lds, int wg, int nwg) {
    pg8::Gemm g{(const bf16_t*)(p->ws + WS_HB), (const bf16_t*)(p->ws + WS_WIN) + (size_t)l * NP * 1024, M, NP, 1024}; pg8::StaticOrder S; S.init(M, NP, nwg, wg);
    pg8::EpiBf16Plain E{(bf16_t*)(p->ws + WS_PB), NP};
    pg8::gemm_phase<pg8::EpiBf16Plain, pg8::StaticOrder, true, true>(lds, g, S, E);
}
__device__ __forceinline__ void fg_gemm_out(PrmP p, int l, LAS unsigned char* lds, int wg, int nwg) {
    pg8::StaticOrder S; S.init(M, 1024, nwg, wg);
    pg8::EpiBf16Plain E{(bf16_t*)(p->ws + WS_Y), 1024};
    if (OUT_FP8) {
        pg8::Gemm g{(const bf16_t*)(p->ws + WS_YC), (const bf16_t*)(p->ws + WS_WOUT + (size_t)l * 1024 * 1024), M, 1024, 512};
        pg8::gemm_phase<pg8::EpiBf16Plain, pg8::StaticOrder, true, true, 118>(lds, g, S, E);
    } else {
    pg8::Gemm g{(const bf16_t*)(p->ws + WS_YC), (const bf16_t*)(p->ws + WS_WOUT) + (size_t)l * 1024 * 1024, M, 1024, 1024};
    pg8::gemm_phase<pg8::EpiBf16Plain, pg8::StaticOrder, true, true>(lds, g, S, E); }
}
__device__ __forceinline__ void fg_gemm1(PrmP p, int l, LAS unsigned char* lds, int wg, int nwg) {
    const int nt = ((const int*)(p->ws + WS_CTL))[CW_NT];
    LAS int* tl = (LAS int*)(lds + GX_TILE); LAS unsigned short* rl = (LAS unsigned short*)(lds + GX_ROWS);
    pg8::GroupOrder S{nt, 8, nwg, wg, tl};
    { const int tid = fresh_tid(); const int* TE = (const int*)(p->ws + WS_MISC + MS_TILEE); const int* RT = (const int*)(p->ws + WS_MISC + MS_ROWTOK);
      __syncthreads();
      for (int i = tid; i < nt; i += NTHREADS) tl[i] = TE[i];
      { int rv[17];
#pragma unroll
        for (int ui = 0; ui < 17; ++ui) { int rt; rv[ui] = (S.peek_pm(ui, rt) && tid < 256) ? RT[rt * 256 + tid] : 0; }
#pragma unroll
        for (int ui = 0; ui < 17; ++ui) if (tid < 256) rl[ui * 256 + tid] = (unsigned short)rv[ui]; }
      __syncthreads();
      if (EXPERT_FP8) { LAS float* bl = (LAS float*)(lds + GX_BIAS); const float* bgu = p->in[I_BGU] + (size_t)l * NE * 2048; float bv[17];
#pragma unroll
        for (int ui = 0; ui < 17; ++ui) { pg8::Unit u; bv[ui] = (S.next(ui, u) && tid < 256) ? bgu[(size_t)(u.pn >> 3) * 2048 + (tid >> 7) * 1024 + (u.pn & 7) * 128 + (tid & 127)] : 0.f; }
#pragma unroll
        for (int ui = 0; ui < 17; ++ui) if (tid < 256) bl[ui * 256 + tid] = bv[ui];
        __syncthreads(); } }
    if (EXPERT_FP8) {
        pg8::Gemm g{(const bf16_t*)(p->ws + WS_HB), (const bf16_t*)(p->ws + WS_WGU + (size_t)l * NE * 2048 * 1024), RP, NE * 2048, 512, rl};
        pg8::EpiSwiglu8 E{p->ws + WS_H1, (const LAS float*)(lds + GX_BIAS)};
        pg8::gemm_phase<pg8::EpiSwiglu8, pg8::GroupOrder, true, true, 119, true>(lds, g, S, E);
    } else {
    pg8::Gemm g{(const bf16_t*)(p->ws + WS_XS), (const bf16_t*)(p->ws + WS_WGU) + (size_t)l * NE * 2048 * 1024, RP, NE * 2048, 1024};
    pg8::EpiSwiglu E{(bf16_t*)(p->ws + WS_H1), p->in[I_BGU] + (size_t)l * NE * 2048};
    pg8::gemm_phase<pg8::EpiSwiglu, pg8::GroupOrder, true, true>(lds, g, S, E);
    }
}
__device__ __forceinline__ void fg_gemm2(PrmP p, int l, LAS unsigned char* lds, int wg, int nwg) {
    const int nt = ((const int*)(p->ws + WS_CTL))[CW_NT];
    LAS int* tl = (LAS int*)(lds + GX_TILE);
    pg8::GroupOrder S{nt, 4, nwg, wg, tl};
    { const int tid = fresh_tid(); const int* TE = (const int*)(p->ws + WS_MISC + MS_TILEE); __syncthreads(); for (int i = tid; i < nt; i += NTHREADS) tl[i] = TE[i]; __syncthreads();
      if (EXPERT_FP8 && YR_FP8) { LAS float* bl = (LAS float*)(lds + GX_BIAS); const float* bdn = p->in[I_BDN] + (size_t)l * NE * 1024; float bv[9];
#pragma unroll
        for (int ui = 0; ui < 9; ++ui) { pg8::Unit u; bv[ui] = (S.next(ui, u) && tid < 256) ? bdn[(size_t)(u.pn >> 2) * 1024 + (u.pn & 3) * 256 + tid] : 0.f; }
#pragma unroll
        for (int ui = 0; ui < 9; ++ui) if (tid < 256) bl[ui * 256 + tid] = bv[ui];
        __syncthreads(); } }
    pg8::EpiDown E{(bf16_t*)(p->ws + WS_YR), p->in[I_BDN] + (size_t)l * NE * 1024};
    if (EXPERT_FP8) {
        pg8::Gemm g{(const bf16_t*)(p->ws + WS_H1), (const bf16_t*)(p->ws + WS_WDN + (size_t)l * NE * 1024 * 1024), RP, NE * 1024, 512}; g.a_pitch = 128; g.a_kstep = 256 * 128;
        if (YR_FP8) { pg8::EpiDown8 E8{p->ws + WS_YR, (const LAS float*)(lds + GX_BIAS)}; pg8::gemm_phase<pg8::EpiDown8, pg8::GroupOrder, true, true, 120>(lds, g, S, E8); }
        else pg8::gemm_phase<pg8::EpiDown, pg8::GroupOrder, true, true, 120>(lds, g, S, E);
    } else {
    pg8::Gemm g{(const bf16_t*)(p->ws + WS_H1), (const bf16_t*)(p->ws + WS_WDN) + (size_t)l * NE * 1024 * 1024, RP, NE * 1024, 1024};
    pg8::gemm_phase<pg8::EpiDown, pg8::GroupOrder, true, true>(lds, g, S, E);
    }
}

#include <hip/hip_bf16.h>
#include <cmath>
namespace attn_body {
using bf16=__hip_bfloat16;
using bf16x8=__attribute__((ext_vector_type(8)))short;
using s16x4=__attribute__((ext_vector_type(4)))short;
using f32x16=__attribute__((ext_vector_type(16)))float;
using u32x4=__attribute__((ext_vector_type(4)))unsigned;
constexpr int BATCH=4,NHEAD=8,SEQ=8192,D=64,DM=2560;
constexpr int NW=8,QBLK=32,QB=QBLK*NW,KVBLK=64,NQB=SEQ/QB;
constexpr int ATTN_PITCH=DM, ATTN_UNIT_ROWS=QB;
__device__ __forceinline__ int crow(int r,int hi){return (r&3)+8*(r>>2)+4*hi;}
#define SBAR() __builtin_amdgcn_sched_barrier(0)
__device__ __forceinline__ void cmask(f32x16&p0,f32x16&p1,int jb,int qrel,int hi){
  const float NEG=-INFINITY; int kb=64*jb+4*hi;
  #pragma unroll
  for(int r=0;r<16;++r){int kv=kb+(r&3)+8*(r>>2); if(kv>qrel)p0[r]=NEG; if(kv+32>qrel)p1[r]=NEG;}
}

constexpr int NSLOT=3, SLOTB=8192;
constexpr int LDS_K=0, LDS_V=NSLOT*SLOTB, LDS_WS=2*NSLOT*SLOTB, LDS_OST=LDS_WS+NW*64*4, LDS_BYTES=LDS_OST+NW*4096;
constexpr float C2=0.125f*1.4426950408889634f;
__device__ __forceinline__ void glds16(const void*gsrc,unsigned lds_dst){unsigned keep;
  asm volatile("s_mov_b32 %0, m0\n\ts_mov_b32 m0, %2\n\ts_nop 0\n\tglobal_load_lds_dwordx4 %1, off\n\ts_mov_b32 m0, %0":"=&s"(keep):"v"(gsrc),"s"(lds_dst):"memory");}
__device__ __forceinline__ float max3f(float a,float b,float c){float r;asm("v_max3_f32 %0, %1, %2, %3":"=v"(r):"v"(a),"v"(b),"v"(c));return r;}
__device__ __forceinline__ float max2f(float a,float b){float r;asm("v_max_f32_e32 %0, %1, %2":"=v"(r):"v"(a),"v"(b));return r;}
__device__ __forceinline__ float fadd_s(float a,float b){float r;asm("v_add_f32_e32 %0, %1, %2":"=v"(r):"v"(a),"v"(b));return r;}
__device__ __forceinline__ float fsub_s(float a,float b){float r;asm("v_sub_f32_e32 %0, %1, %2":"=v"(r):"v"(a),"v"(b));return r;}
typedef float f32x2_t __attribute__((ext_vector_type(2))); typedef __bf16 bf16x2_t __attribute__((ext_vector_type(2)));
__device__ __forceinline__ unsigned cvtpk_s(float lo,float hi){f32x2_t v={lo,hi};bf16x2_t b=__builtin_convertvector(v,bf16x2_t);return __builtin_bit_cast(unsigned,b);}
__device__ __forceinline__ unsigned f2bf(float f) { return pk2(f, 0.f) & 0xffffu; }
#define WAIT_BAR(N) asm volatile("s_waitcnt vmcnt(" #N ") lgkmcnt(0)\n\ts_barrier":::"memory")

typedef __attribute__((address_space(3))) const float* lds_fptr;
__device__ __forceinline__ void split3(float f,unsigned&hb,unsigned&mb,unsigned&lb){
  hb=__float_as_uint(f)&0xffff0000u; const float r1=f-__uint_as_float(hb); mb=__float_as_uint(r1)&0xffff0000u; const float r2=r1-__uint_as_float(mb); lb=__float_as_uint(r2)&0xffff0000u; }
__device__ __forceinline__ bf16x8 mk_kx(float fk,int hi){ unsigned hb,mb,lb; split3(-fk,hb,mb,lb);
  u32x4 w; w.x=0x3f803f80u; w.y=hi?0x00003f80u:(0x00003f80u|hb); w.z=hi?0u:((mb>>16)|lb); w.w=0u; return __builtin_bit_cast(bf16x8,w); }
__device__ __forceinline__ bf16x8 mk_qx(float fq,float mhat,int hi){ unsigned hb,mb,lb; split3(hi?-mhat:fq,hb,mb,lb);
  u32x4 w; w.x=(hb>>16)|mb; w.y=hi?(lb>>16):((lb>>16)|0x3f800000u); w.z=hi?0u:0x3f803f80u; w.w=0u; return __builtin_bit_cast(bf16x8,w); }
__device__ __forceinline__ void qkt(f32x16&p0,f32x16&p1,const char*Kslot,const bf16x8*qr,bf16x8 kxa,bf16x8 kxb,bf16x8 qx,int r32,int hi){
  const f32x16 zc=f32x16{};
  const char*kb=Kslot+hi*1024+r32*16;
  #pragma unroll
  for(int d0=0;d0<4;++d0){
    const bf16x8 b0=*reinterpret_cast<const bf16x8*>(kb+d0*2048);
    const bf16x8 b1=*reinterpret_cast<const bf16x8*>(kb+d0*2048+512);
    if(d0==0){p0=__builtin_amdgcn_mfma_f32_32x32x16_bf16(b0,qr[0],zc,0,0,0);p1=__builtin_amdgcn_mfma_f32_32x32x16_bf16(b1,qr[0],zc,0,0,0);}
    else{p0=__builtin_amdgcn_mfma_f32_32x32x16_bf16(b0,qr[d0],p0,0,0,0);p1=__builtin_amdgcn_mfma_f32_32x32x16_bf16(b1,qr[d0],p1,0,0,0);}}
  p0=__builtin_amdgcn_mfma_f32_32x32x16_bf16(kxa,qx,p0,0,0,0);p1=__builtin_amdgcn_mfma_f32_32x32x16_bf16(kxb,qx,p1,0,0,0);
}
typedef __attribute__((address_space(3))) const char* lds_cptr;
typedef short v4i16_t __attribute__((ext_vector_type(4)));
__device__ __forceinline__ void kload8(bf16x8*kf,lds_cptr kp){
  kf[0]=*(const __attribute__((address_space(3))) bf16x8*)(kp);      kf[1]=*(const __attribute__((address_space(3))) bf16x8*)(kp+512);
  kf[2]=*(const __attribute__((address_space(3))) bf16x8*)(kp+2048); kf[3]=*(const __attribute__((address_space(3))) bf16x8*)(kp+2560);
  kf[4]=*(const __attribute__((address_space(3))) bf16x8*)(kp+4096); kf[5]=*(const __attribute__((address_space(3))) bf16x8*)(kp+4608);
  kf[6]=*(const __attribute__((address_space(3))) bf16x8*)(kp+6144); kf[7]=*(const __attribute__((address_space(3))) bf16x8*)(kp+6656);
}
__device__ __forceinline__ void kload2(bf16x8*kf,lds_cptr kp,int j){ kf[2*j]=*(const __attribute__((address_space(3))) bf16x8*)(kp+j*2048); kf[2*j+1]=*(const __attribute__((address_space(3))) bf16x8*)(kp+j*2048+512); }
__device__ __forceinline__ s16x4 vtr(lds_cptr p){ return __builtin_bit_cast(s16x4,__builtin_amdgcn_ds_read_tr16_b64_v4i16((__attribute__((address_space(3))) v4i16_t*)p)); }
__device__ __forceinline__ float rowmax(const f32x16&p0,const f32x16&p1){
  float a=max3f(p0[0],p0[1],p1[0]),b=max3f(p0[2],p0[3],p1[1]);a=max3f(a,p1[2],p1[3]);
  #pragma unroll
  for(int r=4;r<16;r+=4){a=max3f(a,p0[r],p0[r+1]);b=max3f(b,p0[r+2],p0[r+3]);a=max3f(a,p1[r],p1[r+1]);b=max3f(b,p1[r+2],p1[r+3]);}
  const float m=max2f(a,b);
  auto rr=__builtin_amdgcn_permlane32_swap(__float_as_uint(m),__float_as_uint(m),false,false);
  return max2f(__uint_as_float(rr[0]),__uint_as_float(rr[1]));
}
__device__ __forceinline__ void pv(f32x16*o,int vb,bf16x8 pa0,bf16x8 pa1,bf16x8 pa2,bf16x8 pa3){
  #pragma unroll
  for(int d0=0;d0<2;++d0){s16x4 lo[4],hi[4];
    #pragma unroll
    for(int ks=0;ks<4;++ks){
      asm volatile("ds_read_b64_tr_b16 %0,%1 offset:%c2":"=&v"(lo[ks]):"v"(vb),"i"(d0*4096+ks*1024):"memory");
      asm volatile("ds_read_b64_tr_b16 %0,%1 offset:%c2":"=&v"(hi[ks]):"v"(vb),"i"(d0*4096+ks*1024+512):"memory");}
    asm volatile("s_waitcnt lgkmcnt(0)":::"memory");SBAR();
    #define PK(k) (bf16x8){lo[k][0],lo[k][1],lo[k][2],lo[k][3],hi[k][0],hi[k][1],hi[k][2],hi[k][3]}
    o[d0]=__builtin_amdgcn_mfma_f32_32x32x16_bf16(pa0,PK(0),o[d0],0,0,0);
    o[d0]=__builtin_amdgcn_mfma_f32_32x32x16_bf16(pa1,PK(1),o[d0],0,0,0);
    o[d0]=__builtin_amdgcn_mfma_f32_32x32x16_bf16(pa2,PK(2),o[d0],0,0,0);
    o[d0]=__builtin_amdgcn_mfma_f32_32x32x16_bf16(pa3,PK(3),o[d0],0,0,0);
    #undef PK
  }
}

#ifndef ATTN_STORE16
#define ATTN_STORE16(p,v) (*(u32x4*)(p)=(v))
#endif
template<int THRL> __device__ __forceinline__ void attn_unit(int b,int h,int qb,const bf16*Q,const bf16*__restrict__ K,const bf16*__restrict__ V,bf16*O,char*shm,lds_fptr F2s,int tstart,float kmx){
  const int tid=::fresh_tid(),lane=tid&63,r32=lane&31,hi=lane>>5; const int wid=__builtin_amdgcn_readfirstlane(tid>>6);
  const long rowbase=(long)b*SEQ; const int q0=qb*QB;
  const bf16*Qw=Q+(rowbase+q0+wid*QBLK)*DM+h*D;
  const bf16*Kh=K+(rowbase+(long)tstart*KVBLK)*DM+h*D,*Vh=V+(rowbase+(long)tstart*KVBLK)*DM+h*D; const lds_fptr F2k=F2s+tstart*KVBLK;
  const unsigned lds0=(unsigned)(uintptr_t)shm;
  float*wsf=(float*)(shm+LDS_WS)+wid*64;
  const bf16*ksrc=Kh+(long)lane*DM+wid*8;
  const bf16*vsrc=Vh+(long)(16*(wid&3)+(lane>>2))*DM+(wid>>2)*32+(lane&3)*8;
  const unsigned kdst=lds0+LDS_K+wid*1024, vdst=lds0+LDS_V+wid*1024;
  #define DMA_K(t,slot) glds16(ksrc+(long)(t)*KVBLK*DM,(unsigned)__builtin_amdgcn_readfirstlane(kdst+(slot)))
  #define DMA_V(t,slot) glds16(vsrc+(long)(t)*KVBLK*DM,(unsigned)__builtin_amdgcn_readfirstlane(vdst+(slot)))
  const int vb0=(int)(lds0+LDS_V)+((lane>>4)&1)*32+(lane&3)*8+(4*hi+((lane&15)>>2))*64;
  const char*Kbase=shm+LDS_K; bf16x8 kf[8];
  const lds_cptr shm3=(lds_cptr)shm; const lds_cptr kp0=shm3+LDS_K+hi*1024+r32*16; const lds_cptr vp0=shm3+LDS_V+((lane>>4)&1)*32+(lane&3)*8+(4*hi+((lane&15)>>2))*64;
  const int NT=(q0+QB)/KVBLK-tstart;
  DMA_K(0,0);DMA_V(0,0);DMA_K(1,SLOTB);
  bf16x8 qr[4];
  #pragma unroll
  for(int d0=0;d0<4;++d0)qr[d0]=*reinterpret_cast<const bf16x8*>(&Qw[(long)r32*DM+d0*16+hi*8]);
  float m0; { float qq=0.f;
    #pragma unroll
    for(int d0=0;d0<4;++d0){const u32x4 w_=__builtin_bit_cast(u32x4,qr[d0]);
      #pragma unroll
      for(int j_=0;j_<4;++j_){const float a_=__uint_as_float(w_[j_]<<16),b_=__uint_as_float(w_[j_]&0xffff0000u);qq+=a_*a_+b_*b_;}}
    qq+=__shfl_xor(qq,32); m0=sqrtf(qq)*kmx+1.f; }
  float l_reg=0.f;f32x16 o[2];o[0]=f32x16{};o[1]=f32x16{};const f32x16 zc=f32x16{};
  const float fq_=F2s[q0+wid*QBLK+r32]; const bf16x8 qx=mk_qx(fq_,m0,hi);
  const int qrel=wid*QBLK+r32;
  #define CMASK(P0,P1,t) do{int jb_=(t)-(NT-4); if(jb_>=0)cmask(P0,P1,jb_,qrel,hi);}while(0)
  #define START(P0,P1) do{ _Pragma("unroll") for(int r=0;r<16;++r)P0[r]=__builtin_amdgcn_exp2f(P0[r]); }while(0)
  #define RESC() do{}while(0)
  f32x16 pA0,pA1,pB0,pB1;
  int sl_prev=0,sl_cur=0,sl_next=SLOTB;
  #define ROT() do{sl_prev=sl_cur;sl_cur=sl_next;sl_next=(sl_next==(NSLOT-1)*SLOTB)?0:sl_next+SLOTB;}while(0)
  DMA_K(2,2*SLOTB);
  WAIT_BAR(3);
  qkt(pA0,pA1,Kbase,qr,mk_kx(F2k[r32],hi),mk_kx(F2k[32+r32],hi),qx,r32,hi);asm volatile("s_nop 15\n\ts_nop 7":"+v"(pA0),"+v"(pA1));CMASK(pA0,pA1,0);
  START(pA0,pA1);
  _Pragma("unroll") for(int r=0;r<16;++r)pA1[r]=__builtin_amdgcn_exp2f(pA1[r]);
  WAIT_BAR(0);
  DMA_K(3,0);DMA_V(1,SLOTB);
  ROT();
  kload8(kf,kp0+sl_cur);
  WAIT_BAR(2);
  s16x4 vlo[8],vhi[8]; u32x4 pw0,pw1,pw2,pw3;
  #define PKW(P,B) cvtpk_s(P[B],P[B+1])
  #define PAF(k) __builtin_bit_cast(bf16x8,pw##k)
  #define VFR(i) (bf16x8){vlo[i][0],vlo[i][1],vlo[i][2],vlo[i][3],vhi[i][0],vhi[i][1],vhi[i][2],vhi[i][3]}
  #define PIN(x) asm volatile("":"+v"(x))
  #define MX3(a,b,c) __builtin_fmaxf(__builtin_fmaxf((a),(b)),(c))
  #define GAPA(MF,A0,A1,A2,A3,W0,W1,PW) do{ MF; sacc+=A0; sacc+=A1; sacc+=A2; sacc+=A3; PIN(sacc); W0; W1; PIN(PW); SBAR(); }while(0)
  #define EX(v) __builtin_amdgcn_exp2f(v)
  #define GAPB(MF,X,B) do{ MF; X[B]=EX(X[B]); X[B+1]=EX(X[B+1]); X[B+2]=EX(X[B+2]); X[B+3]=EX(X[B+3]); PIN(X); SBAR(); }while(0)
  #define VRD(i) do{ vlo[i]=vtr(vp_+(((i)>>2)*4096+((i)&3)*1024)); vhi[i]=vtr(vp_+(((i)>>2)*4096+((i)&3)*1024+512)); }while(0)
  #define KRD(G,j) do{ if(G){ kload2(kf,kp0+sl_next,j); SBAR(); } }while(0)
  #define STEP(C0,C1,P0,P1,t,GK,GV,GL) do{ const float fka_=F2k[(t)*KVBLK+r32],fkb_=F2k[(t)*KVBLK+32+r32]; SBAR(); \
    const lds_cptr vp_=vp0+sl_prev; \
    VRD(0); SBAR(); float sacc=(P0[0]+P0[1]); \
    GAPA(C0=__builtin_amdgcn_mfma_f32_32x32x16_bf16(kf[0],qr[0],zc,0,0,0), P0[2],P0[3],P0[4],P0[5],     pw0[0]=PKW(P0,0), pw0[1]=PKW(P0,2), pw0); \
    VRD(4); SBAR(); GAPA(C1=__builtin_amdgcn_mfma_f32_32x32x16_bf16(kf[1],qr[0],zc,0,0,0), P0[6],P0[7],P0[8],P0[9],     pw0[2]=PKW(P0,4), pw0[3]=PKW(P0,6), pw0); \
    VRD(1); SBAR(); GAPA(C0=__builtin_amdgcn_mfma_f32_32x32x16_bf16(kf[2],qr[1],C0,0,0,0),   P0[10],P0[11],P0[12],P0[13], pw1[0]=PKW(P0,8), pw1[1]=PKW(P0,10), pw1); \
    VRD(5); SBAR(); GAPA(C1=__builtin_amdgcn_mfma_f32_32x32x16_bf16(kf[3],qr[1],C1,0,0,0),   P0[14],P0[15],P1[0],P1[1],   pw1[2]=PKW(P0,12),pw1[3]=PKW(P0,14), pw1); \
    VRD(2); SBAR(); GAPA(C0=__builtin_amdgcn_mfma_f32_32x32x16_bf16(kf[4],qr[2],C0,0,0,0),   P1[2],P1[3],P1[4],P1[5],     pw2[0]=PKW(P1,0), pw2[1]=PKW(P1,2), pw2); \
    VRD(6); SBAR(); GAPA(C1=__builtin_amdgcn_mfma_f32_32x32x16_bf16(kf[5],qr[2],C1,0,0,0),   P1[6],P1[7],P1[8],P1[9],     pw2[2]=PKW(P1,4), pw2[3]=PKW(P1,6), pw2); \
    VRD(3); SBAR(); GAPA(C0=__builtin_amdgcn_mfma_f32_32x32x16_bf16(kf[6],qr[3],C0,0,0,0),   P1[10],P1[11],P1[12],P1[13], pw3[0]=PKW(P1,8), pw3[1]=PKW(P1,10), pw3); \
    VRD(7); SBAR(); GAPA(C1=__builtin_amdgcn_mfma_f32_32x32x16_bf16(kf[7],qr[3],C1,0,0,0),   P1[14],P1[15],0.f,0.f,       pw3[2]=PKW(P1,12),pw3[3]=PKW(P1,14), pw3); \
    { C0=__builtin_amdgcn_mfma_f32_32x32x16_bf16(mk_kx(fka_,hi),qx,C0,0,0,0); SBAR(); C1=__builtin_amdgcn_mfma_f32_32x32x16_bf16(mk_kx(fkb_,hi),qx,C1,0,0,0); } \
    l_reg+=sacc; \
    if(GK){DMA_K((t)+3,sl_cur);} if(GV){DMA_V((t)+1,sl_next);} \
    CMASK(C0,C1,t); \
    SBAR(); \
    GAPB(o[0]=__builtin_amdgcn_mfma_f32_32x32x16_bf16(PAF(0),VFR(0),o[0],0,0,0), C0,0); \
    GAPB(o[1]=__builtin_amdgcn_mfma_f32_32x32x16_bf16(PAF(0),VFR(4),o[1],0,0,0), C0,4); \
    KRD(GL,0); GAPB(o[0]=__builtin_amdgcn_mfma_f32_32x32x16_bf16(PAF(1),VFR(1),o[0],0,0,0), C0,8); \
    KRD(GL,1); GAPB(o[1]=__builtin_amdgcn_mfma_f32_32x32x16_bf16(PAF(1),VFR(5),o[1],0,0,0), C0,12); \
    KRD(GL,2); GAPB(o[0]=__builtin_amdgcn_mfma_f32_32x32x16_bf16(PAF(2),VFR(2),o[0],0,0,0), C1,0); \
    KRD(GL,3); GAPB(o[1]=__builtin_amdgcn_mfma_f32_32x32x16_bf16(PAF(2),VFR(6),o[1],0,0,0), C1,4); \
    GAPB(o[0]=__builtin_amdgcn_mfma_f32_32x32x16_bf16(PAF(3),VFR(3),o[0],0,0,0), C1,8); \
    GAPB(o[1]=__builtin_amdgcn_mfma_f32_32x32x16_bf16(PAF(3),VFR(7),o[1],0,0,0), C1,12); \
    }while(0)
  int t=1;
  #undef CMASK
  #define CMASK(P0,P1,t) do{}while(0)
  for(;t+5<NT;t+=2){
    STEP(pB0,pB1,pA0,pA1,t,true,true,true);     WAIT_BAR(2); RESC(); ROT();
    STEP(pA0,pA1,pB0,pB1,t+1,true,true,true);   WAIT_BAR(2); RESC(); ROT();
  }
  #undef CMASK
  #define CMASK(P0,P1,t) do{int jb_=(t)-(NT-4); if(jb_>=0)cmask(P0,P1,jb_,qrel,hi);}while(0)
  #define ENDW(tt) do{ if((tt)+3<NT){WAIT_BAR(2);} else if((tt)+2<NT){WAIT_BAR(1);} else {WAIT_BAR(0);} }while(0)
  for(;t+1<NT;t+=2){
    STEP(pB0,pB1,pA0,pA1,t,(t+3<NT),(t+1<NT),(t+1<NT));       ENDW(t);   RESC(); ROT();
    STEP(pA0,pA1,pB0,pB1,t+1,(t+4<NT),(t+2<NT),(t+2<NT));     ENDW(t+1); RESC(); ROT();
  }
  STEP(pB0,pB1,pA0,pA1,NT-1,false,false,false); RESC();
  { float sacc=pB0[0]+pB0[1]; _Pragma("unroll") for(int r=2;r<16;++r)sacc+=pB0[r]; _Pragma("unroll") for(int r=0;r<16;++r)sacc+=pB1[r]; l_reg+=sacc;
    pw0=(u32x4){PKW(pB0,0),PKW(pB0,2),PKW(pB0,4),PKW(pB0,6)};pw1=(u32x4){PKW(pB0,8),PKW(pB0,10),PKW(pB0,12),PKW(pB0,14)};pw2=(u32x4){PKW(pB1,0),PKW(pB1,2),PKW(pB1,4),PKW(pB1,6)};pw3=(u32x4){PKW(pB1,8),PKW(pB1,10),PKW(pB1,12),PKW(pB1,14)};
    SBAR(); pv(o,vb0+sl_cur,PAF(0),PAF(1),PAF(2),PAF(3)); }
  #undef PKW
  #undef PAF
  #undef VFR
  #undef PIN
  #undef MX3
  #undef GAPA
  #undef GAPB
  #undef EX
  #undef VRD
  #undef KRD
  #undef STEP
  #undef ENDW
  {auto rr=__builtin_amdgcn_permlane32_swap(__float_as_uint(l_reg),__float_as_uint(l_reg),false,false);l_reg=__uint_as_float(rr[0])+__uint_as_float(rr[1]);}
  if(hi==0)wsf[32+r32]=l_reg;asm volatile("s_waitcnt lgkmcnt(0)":::"memory");
  float rli[16];
  #pragma unroll
  for(int r=0;r<16;++r)rli[r]=__builtin_amdgcn_rcpf(wsf[32+crow(r,hi)]);
  bf16*Ow=O+(rowbase+q0+wid*QBLK)*DM+h*D;
  { bf16*stg=(bf16*)(shm+LDS_OST)+wid*2048;
    #pragma unroll
    for(int r=0;r<16;++r){const int orow=crow(r,hi);
      #pragma unroll
      for(int d0=0;d0<2;++d0)stg[orow*64+d0*32+r32]=__float2bfloat16(o[d0][r]*rli[r]);}
    asm volatile("s_waitcnt lgkmcnt(0)":::"memory");
    #pragma unroll
    for(int i=0;i<4;++i){const int row=i*8+(lane>>3),ch=lane&7; const u32x4 v=*(const u32x4*)(stg+row*64+ch*8); ATTN_STORE16(Ow+(long)row*DM+ch*8,v);} }
  asm volatile("s_waitcnt lgkmcnt(0)\n\ts_barrier":::"memory");
  #undef DMA_K
  #undef DMA_V
  #undef CMASK
  #undef START
  #undef RESC
  #undef ROT
}
constexpr int ATTN_LDS_BYTES=LDS_BYTES;
#undef SBAR
#undef WAIT_BAR
}

constexpr float SKIP_MARGIN = 64.f;
constexpr int ATT_F2_OFF = 86016, ATT_SCN_OFF = ATT_F2_OFF + 32768;
static_assert(attn_body::ATTN_LDS_BYTES <= ATT_F2_OFF && ATT_SCN_OFF + 64 <= 131072, "attention LDS map");
__device__ __forceinline__ void f2_items(PrmP p, int l, LAS unsigned char* lds, int wg, int nwg) {
    const int tid = fresh_tid(), lane = tid & 63, wave = tid >> 6;
    LAS float* scn = (LAS float*)(lds + ATT_SCN_OFF);
    const bf16_t* PB = (const bf16_t*)(p->ws + WS_PB); float* F2G = (float*)(p->ws + WS_FC2);
    for (int bh = wg; bh < 32; bh += nwg) { const int b = bh >> 3, hh = bh & 7;
        const float fb = p->in[I_FOXFB][l * 8 + hh];
        float loc[16]; float run = 0.f;
#pragma unroll
        for (int i = 0; i < 16; ++i) { const float z = bf2f(PB[(size_t)(b * T + tid * 16 + i) * NP + C_F + hh]) + fb;
            run += -(fmaxf(-z, 0.f) + __logf(1.f + __expf(-fabsf(z)))) * LOG2E; loc[i] = run; }
        float incl = run;
#pragma unroll
        for (int o = 1; o < 64; o <<= 1) { const float v = __shfl_up(incl, o); if (lane >= o) incl += v; }
        __syncthreads();
        if (lane == 63) scn[wave] = incl;
        __syncthreads();
        float base = incl - run;
        for (int w = 0; w < wave; ++w) base += scn[w];
#pragma unroll
        for (int i = 0; i < 16; ++i) F2G[(size_t)bh * T + tid * 16 + i] = base + loc[i];
    }
}
__device__ __forceinline__ void fa_attn(PrmP p, int l, LAS unsigned char* lds, int wg, int nwg) {
    const int tid = fresh_tid();
    if (nwg != 256) return;
    LAS float* F2s = (LAS float*)(lds + ATT_F2_OFF);
    LAS int* work = (LAS int*)(lds + ATT_SCN_OFF); LAS int* tst = work + 1024; LAS int* mine = tst + 1024;
    const float* F2G = (const float*)(p->ws + WS_FC2);
    __syncthreads();
    const unsigned* CT = (const unsigned*)(p->ws + WS_CTL);
#pragma unroll
    for (int k = 0; k < 8; ++k) { const int i = tid + 512 * k; F2s[i] = F2G[(size_t)(i >> 7) * T + (i & 127) * 64 + 63];
        F2s[4096 + i] = sqrtf(__uint_as_float(__hip_atomic_load(CT + CW_KT + l * 4096 + i, __ATOMIC_RELAXED, __HIP_MEMORY_SCOPE_AGENT))); }
    __syncthreads();
#pragma unroll
    for (int k = 0; k < 2; ++k) { const int u = tid + 512 * k, bh = u >> 5, qb = u & 31;
        const unsigned* NRM = (const unsigned*)(p->ws + WS_CTL) + CW_NRM + (l * 32 + bh) * 2;
        const float qn = sqrtf(__uint_as_float(__hip_atomic_load(NRM, __ATOMIC_RELAXED, __HIP_MEMORY_SCOPE_AGENT))), kn = sqrtf(__uint_as_float(__hip_atomic_load(NRM + 1, __ATOMIC_RELAXED, __HIP_MEMORY_SCOPE_AGENT)));
        (void)qn; (void)kn;
        const float qI = sqrtf(__uint_as_float(__hip_atomic_load(CT + CW_QN + (l * 32 + bh) * 32 + qb, __ATOMIC_RELAXED, __HIP_MEMORY_SCOPE_AGENT)));
        const float kI = fmaxf(fmaxf(F2s[4096 + bh * 128 + 4 * qb], F2s[4096 + bh * 128 + 4 * qb + 1]), fmaxf(F2s[4096 + bh * 128 + 4 * qb + 2], F2s[4096 + bh * 128 + 4 * qb + 3]));
        const float base = F2G[(size_t)bh * T + qb * 256] + SKIP_MARGIN + qI * kI;
        int ts = 0; bool ok = true;
        for (int J = 0; J < 4 * qb; ++J) { ok = ok && (F2s[bh * 128 + J] > base + qI * F2s[4096 + bh * 128 + J]); ts = (ok && (J & 1)) ? J + 1 : ts; }
        tst[u] = ts; work[u] = 4 * (qb + 1) - ts; }
    if (tid < 4) mine[tid] = 0;
    __syncthreads();
    { const int ua = tid, ub = tid + 512; const int wa = work[ua], wb = work[ub]; int ra = 0, rb = 0;
      typedef int i32x4_ __attribute__((ext_vector_type(4)));
      const int ka = wa * 1024 + (1023 - ua), kb = wb * 1024 + (1023 - ub);
#pragma unroll 4
      for (int v = 0; v < 1024; v += 4) { const i32x4_ w4 = *(const LAS i32x4_*)(work + v);
#pragma unroll
          for (int q = 0; q < 4; ++q) { const int kv = w4[q] * 1024 + (1023 - (v + q)); ra += (kv > ka) ? 1 : 0; rb += (kv > kb) ? 1 : 0; } }
      const int t0 = wg, t1 = 511 - wg, t2 = 512 + wg, t3 = 1023 - wg;
      if (ra == t0) mine[0] = ua; if (ra == t1) mine[1] = ua; if (ra == t2) mine[2] = ua; if (ra == t3) mine[3] = ua;
      if (rb == t0) mine[0] = ub; if (rb == t1) mine[1] = ub; if (rb == t2) mine[2] = ub; if (rb == t3) mine[3] = ub; }
    __syncthreads();
    const unsigned* NRMB = (const unsigned*)(p->ws + WS_CTL) + CW_NRM + l * 64;
    attn_body::bf16* pb = (attn_body::bf16*)(p->ws + WS_PB);
#pragma unroll 1
    for (int k = 0; k < 4; ++k) { const int u = __builtin_amdgcn_readfirstlane(mine[k]), bh = u >> 5, qb = u & 31, ts_u = __builtin_amdgcn_readfirstlane(tst[u]);
        __syncthreads();
#pragma unroll
        for (int i = 0; i < 4; ++i) *(LAS f32x4*)(F2s + tid * 4 + 2048 * i) = *(const f32x4*)(F2G + (size_t)bh * T + tid * 4 + 2048 * i);
        __syncthreads();
        const float m0 = sqrtf(__uint_as_float(__hip_atomic_load(NRMB + bh * 2 + 1, __ATOMIC_RELAXED, __HIP_MEMORY_SCOPE_AGENT)));
        attn_body::attn_unit<8>(bh >> 3, bh & 7, qb, pb + C_Q, pb + C_K, pb + C_V, pb + C_Q, (char*)lds, (attn_body::lds_fptr)F2s, ts_u, m0);
    }
}

typedef float f32x16 __attribute__((ext_vector_type(16)));
struct S5M { float ar[2], ai[2], a16r[2], a16i[2]; bf16x8 bfr[4]; };
__device__ __forceinline__ int tau32(int i) { return 16 * ((i >> 2) & 1) + 4 * (i >> 3) + (i & 3); }
__device__ __forceinline__ void s5m_setup(PrmP p, int l, int g, int lane, S5M& c) {
    const int nl = lane & 31, hi = lane >> 5;
    const float dt = expf(p->in[I_S5LOGDT][l * 16 + g]);
    u32x4 fre[2], fim[2];
#pragma unroll
    for (int s = 0; s < 2; ++s) { const int pi = 32 * s + nl;
        const float are = p->in[I_S5ARE][(l * 16 + g) * 64 + pi], aim = p->in[I_S5AIM][(l * 16 + g) * 64 + pi];
        const float mag = expf(are * dt); const float th = aim * dt * 0.3183098861837907f; const float abr = mag * cospif(th), abi = mag * sinpif(th);
        const float den = are * are + aim * aim, nre = abr - 1.f;
        const float kre = (nre * are + abi * aim) / den, kim = (abi * are - nre * aim) / den;
        c.ar[s] = abr; c.ai[s] = abi;
        float pr = abr, pi_ = abi;
#pragma unroll
        for (int q = 0; q < 4; ++q) { const float nr = pr * pr - pi_ * pi_, ni = 2.f * pr * pi_; pr = nr; pi_ = ni; }
        c.a16r[s] = pr; c.a16i[s] = pi_;
        const float* brp = p->in[I_S5BRE] + ((size_t)(l * 16 + g) * 64 + pi) * 16 + 8 * hi; const float* bip = p->in[I_S5BIM] + ((size_t)(l * 16 + g) * 64 + pi) * 16 + 8 * hi;
        const f32x4 br0 = *(const f32x4*)brp, br1 = *(const f32x4*)(brp + 4), bi0 = *(const f32x4*)bip, bi1 = *(const f32x4*)(bip + 4);
        const f32x4 re0 = br0 * kre - bi0 * kim, re1 = br1 * kre - bi1 * kim, im0 = bi0 * kre + br0 * kim, im1 = bi1 * kre + br1 * kim;
        fre[s] = (u32x4){pk2(re0.x, re0.y), pk2(re0.z, re0.w), pk2(re1.x, re1.y), pk2(re1.z, re1.w)};
        fim[s] = (u32x4){pk2(im0.x, im0.y), pk2(im0.z, im0.w), pk2(im1.x, im1.y), pk2(im1.z, im1.w)}; }
    c.bfr[0] = __builtin_bit_cast(bf16x8, fre[0]); c.bfr[1] = __builtin_bit_cast(bf16x8, fre[1]); c.bfr[2] = __builtin_bit_cast(bf16x8, fim[0]); c.bfr[3] = __builtin_bit_cast(bf16x8, fim[1]);
}
__device__ __forceinline__ void s5m_cfrag(PrmP p, int l, int g, int lane, bf16x8 (&cmf)[8], bf16x8& dfr) {
    const int nl = lane & 31, hi = lane >> 5;
    const float* cre = p->in[I_S5CRE] + ((size_t)(l * 16 + g) * 16 + (nl & 15)) * 64; const float* cim = p->in[I_S5CIM] + ((size_t)(l * 16 + g) * 16 + (nl & 15)) * 64;
    const bool okc = nl < 16;
#pragma unroll
    for (int ks = 0; ks < 8; ++ks) { const int j0 = 4 * ks + 2 * hi; const float2 ra = *(const float2*)(cre + j0), rb2 = *(const float2*)(cre + 32 + j0), ia = *(const float2*)(cim + j0), ib = *(const float2*)(cim + 32 + j0);
        u32x4 w; w.x = pk2(ra.x, rb2.x); w.y = pk2(-ia.x, -ib.x); w.z = pk2(ra.y, rb2.y); w.w = pk2(-ia.y, -ib.y);
        if (!okc) w = (u32x4){0u, 0u, 0u, 0u}; cmf[ks] = __builtin_bit_cast(bf16x8, w); }
    const float dv = p->in[I_S5D][l * 256 + g * 16 + (nl & 15)]; const int jd = nl - 8 * hi;
    const unsigned db = f2bf(dv); u32x4 w = (u32x4){0u, 0u, 0u, 0u};
    if (okc && jd >= 0 && jd < 8) { const unsigned v = (jd & 1) ? (db << 16) : db; if ((jd >> 1) == 0) w.x = v; else if ((jd >> 1) == 1) w.y = v; else if ((jd >> 1) == 2) w.z = v; else w.w = v; }
    dfr = __builtin_bit_cast(bf16x8, w);
}
__device__ __forceinline__ void s5m_table_build(PrmP p, int l, int g, int lane) {
    S5M c; s5m_setup(p, l, g, lane, c); bf16x8 cmf[8]; bf16x8 dfr; s5m_cfrag(p, l, g, lane, cmf, dfr);
    u32x4* tb = (u32x4*)(p->ws + WS_S5T) + (size_t)(l * 16 + g) * 15 * 64 + lane;
    tb[0 * 64] = (u32x4){__float_as_uint(c.ar[0]), __float_as_uint(c.ar[1]), __float_as_uint(c.ai[0]), __float_as_uint(c.ai[1])};
    tb[1 * 64] = (u32x4){__float_as_uint(c.a16r[0]), __float_as_uint(c.a16r[1]), __float_as_uint(c.a16i[0]), __float_as_uint(c.a16i[1])};
#pragma unroll
    for (int q = 0; q < 4; ++q) tb[(2 + q) * 64] = __builtin_bit_cast(u32x4, c.bfr[q]);
#pragma unroll
    for (int q = 0; q < 8; ++q) tb[(6 + q) * 64] = __builtin_bit_cast(u32x4, cmf[q]);
    tb[14 * 64] = __builtin_bit_cast(u32x4, dfr);
}
__device__ __forceinline__ void s5m_load(PrmP p, int l, int g, int lane, S5M& c) {
    const u32x4* tb = (const u32x4*)(p->ws + WS_S5T) + (size_t)(l * 16 + g) * 15 * 64 + lane;
    const u32x4 a = tb[0], b = tb[64];
    c.ar[0] = __uint_as_float(a.x); c.ar[1] = __uint_as_float(a.y); c.ai[0] = __uint_as_float(a.z); c.ai[1] = __uint_as_float(a.w);
    c.a16r[0] = __uint_as_float(b.x); c.a16r[1] = __uint_as_float(b.y); c.a16i[0] = __uint_as_float(b.z); c.a16i[1] = __uint_as_float(b.w);
#pragma unroll
    for (int q = 0; q < 4; ++q) c.bfr[q] = __builtin_bit_cast(bf16x8, tb[(2 + q) * 64]);
}
__device__ __forceinline__ void s5m_load_c(PrmP p, int l, int g, int lane, bf16x8 (&cmf)[8], bf16x8& dfr) {
    const u32x4* tb = (const u32x4*)(p->ws + WS_S5T) + (size_t)(l * 16 + g) * 15 * 64 + lane;
#pragma unroll
    for (int q = 0; q < 8; ++q) cmf[q] = __builtin_bit_cast(bf16x8, tb[(6 + q) * 64]);
    dfr = __builtin_bit_cast(bf16x8, tb[14 * 64]);
}
__device__ __forceinline__ void s5m_bu(const bf16_t* PB, size_t rb, int tb, int g, int lane, const S5M& c, f32x16 (&bu)[4], bf16x8& ufrag) {
    const int i = lane & 31, hi = lane >> 5;
    ufrag = *(const bf16x8*)(PB + (rb + tb + tau32(i)) * NP + C_S5 + 16 * g + 8 * hi);
    const f32x16 z = f32x16{};
#pragma unroll
    for (int q = 0; q < 4; ++q) bu[q] = __builtin_amdgcn_mfma_f32_32x32x16_bf16(ufrag, c.bfr[q], z, 0, 0, 0);
}
__device__ __forceinline__ void s5m_tile_end(const S5M& c, const f32x16 (&bu)[4], float (&xr)[2], float (&xi)[2]) {
#pragma unroll
    for (int s = 0; s < 2; ++s) { float er = bu[s][0], ei = bu[2 + s][0];
#pragma unroll
        for (int r = 1; r < 16; ++r) { const float nr = c.ar[s] * er - c.ai[s] * ei + bu[s][r], ni = c.ar[s] * ei + c.ai[s] * er + bu[2 + s][r]; er = nr; ei = ni; }
        const auto swr_ = __builtin_amdgcn_permlane32_swap(__float_as_uint(er), __float_as_uint(er), false, false), swi_ = __builtin_amdgcn_permlane32_swap(__float_as_uint(ei), __float_as_uint(ei), false, false);
        const float elr = __uint_as_float(swr_[0]), eli = __uint_as_float(swi_[0]), ehr = __uint_as_float(swr_[1]), ehi = __uint_as_float(swi_[1]);
        const float t1r = c.a16r[s] * xr[s] - c.a16i[s] * xi[s] + elr, t1i = c.a16r[s] * xi[s] + c.a16i[s] * xr[s] + eli;
        xr[s] = c.a16r[s] * t1r - c.a16i[s] * t1i + ehr; xi[s] = c.a16r[s] * t1i + c.a16i[s] * t1r + ehi; }
}
__device__ __forceinline__ void fs_scan(PrmP p, int l, LAS unsigned char* lds, int wg, int nwg) {
    const int tid = fresh_tid(), lane = tid & 63, wave = tid >> 6;
    f2_items(p, l, lds, wg, nwg);
    const bf16_t* PB = (const bf16_t*)(p->ws + WS_PB);
    { bf16_t* HLOC = (bf16_t*)(p->ws + WS_YL); bf16_t* PCUM = (bf16_t*)(p->ws + WS_YS0); float* AGG = (float*)(p->ws + WS_AGG);
      LAS unsigned char* xa = lds + wave * 13312; LAS unsigned char* xf = xa + 4608;
      const int nl = lane & 31, hi = lane >> 5;
      for (int it = wave * nwg + wg; it < 2048; it += nwg * NWAVES) {
        const int b = it >> 9, c = (it >> 2) & 127, blk = it & 3; const size_t rb = (size_t)b * T; const int t0 = c * 64;
        const bf16_t* wt = (const bf16_t*)(p->ws + WS_LRUW) + (size_t)(l * 4 + blk) * 2 * 4096 + (size_t)nl * 64 + 8 * hi;
        const int chc = blk * 64 + lane;
        const float cw0 = p->in[I_CONVW][(l * 4 + 0) * 256 + chc], cw1 = p->in[I_CONVW][(l * 4 + 1) * 256 + chc], cw2 = p->in[I_CONVW][(l * 4 + 2) * 256 + chc], cw3 = p->in[I_CONVW][(l * 4 + 3) * 256 + chc], cb = p->in[I_CONVB][l * 256 + chc];
        float ba[2], bx[2], sp8[2];
#pragma unroll
        for (int s2 = 0; s2 < 2; ++s2) { const int ch = blk * 64 + 32 * s2 + nl; ba[s2] = p->in[I_LRUBA][l * 256 + ch]; bx[s2] = p->in[I_LRUBX][l * 256 + ch]; sp8[s2] = -8.f * log1pf(expf(-p->in[I_LAMBDA][l * 256 + ch])); }
        float x1 = (t0 >= 1) ? bf2f(PB[(rb + t0 - 1) * NP + C_LX + chc]) : 0.f, x2 = (t0 >= 2) ? bf2f(PB[(rb + t0 - 2) * NP + C_LX + chc]) : 0.f, x3 = (t0 >= 3) ? bf2f(PB[(rb + t0 - 3) * NP + C_LX + chc]) : 0.f;
        float hin[2] = {0.f, 0.f}, pin[2] = {1.f, 1.f};
#pragma unroll 1
        for (int mt = 0; mt < 2; ++mt) { const int tb = t0 + mt * 32;
#pragma unroll 1
            for (int th = 0; th < 32; th += 16) { float xin[16];
#pragma unroll
              for (int tt = 0; tt < 16; ++tt) xin[tt] = bf2f(PB[(rb + tb + th + tt) * NP + C_LX + chc]);
#pragma unroll
              for (int tt = 0; tt < 16; ++tt) { const float xr = cb + cw0 * x3 + cw1 * x2 + cw2 * x1 + cw3 * xin[tt]; x3 = x2; x2 = x1; x1 = xin[tt];
                  *(LAS bf16_t*)(xa + (th + tt) * 144 + lane * 2) = (bf16_t)f2bf(xr); *(LAS float*)(xf + (th + tt) * 272 + lane * 4) = xr; } }
            asm volatile("s_waitcnt lgkmcnt(0)" ::: "memory");
            f32x16 acc[4];
#pragma unroll
            for (int q = 0; q < 4; ++q) acc[q] = f32x16{};
#pragma unroll
            for (int ks = 0; ks < 4; ++ks) { const bf16x8 af = *(const LAS bf16x8*)(xa + tau32(nl) * 144 + (16 * ks + 8 * hi) * 2);
#pragma unroll
                for (int q = 0; q < 4; ++q) { const bf16x8 wfr = *(const bf16x8*)(wt + ((size_t)(q >> 1) * 64 + 32 * (q & 1)) * 64 + 16 * ks); acc[q] = __builtin_amdgcn_mfma_f32_32x32x16_bf16(af, wfr, acc[q], 0, 0, 0); } }
#pragma unroll
            for (int s2 = 0; s2 < 2; ++s2) { const int ch = blk * 64 + 32 * s2 + nl;
                float hl[16], pl[16]; float h = 0.f, P = 1.f;
#pragma unroll
                for (int r = 0; r < 16; ++r) { const float xr = *(const LAS float*)(xf + (16 * hi + r) * 272 + (32 * s2 + nl) * 4);
                    const float rg = sigmoidf_(acc[s2][r] + ba[s2]), ig = sigmoidf_(acc[2 + s2][r] + bx[s2]);
                    const float la = sp8[s2] * rg, a = __expf(la), x2a = 2.f * la;
                    const float om = (x2a > -0.125f) ? -x2a * (1.f + x2a * (0.5f + x2a * (0.16666667f + x2a * 0.041666668f))) : 1.f - a * a;
                    h = a * h + xr * ig * __builtin_amdgcn_sqrtf(om); P *= a; hl[r] = h; pl[r] = P; }
                const float h0e = __shfl(h, nl), p0e = __shfl(P, nl);
                const float hs = hi ? h0e + p0e * hin[s2] : hin[s2], ps = hi ? pin[s2] * p0e : pin[s2];
#pragma unroll
                for (int r = 0; r < 16; ++r) { const size_t m = rb + tb + 16 * hi + r; HLOC[m * 256 + ch] = (bf16_t)f2bf(hl[r] + pl[r] * hs); PCUM[m * 256 + ch] = (bf16_t)f2bf(pl[r] * ps); }
                const float he = hl[15] + pl[15] * hs, pe = pl[15] * ps;
                hin[s2] = __shfl(he, 32 + nl); pin[s2] = __shfl(pe, 32 + nl); }
            asm volatile("s_waitcnt lgkmcnt(0)" ::: "memory");
        }
        if (hi == 0) {
#pragma unroll
            for (int s2 = 0; s2 < 2; ++s2) { const int ch = blk * 64 + 32 * s2 + nl; AGG[((size_t)(b * 128 + c) * 2 + 0) * 256 + ch] = pin[s2]; AGG[((size_t)(b * 128 + c) * 2 + 1) * 256 + ch] = hin[s2]; } }
      }
    }
    { unsigned* NRM = (unsigned*)(p->ws + WS_CTL) + CW_NRM;
      for (int it = wg; it < M / 128; it += nwg) { const int b = it / (T / 128); float mq = 0.f, mk = 0.f;
#pragma unroll 1
        for (int r8 = 0; r8 < 2; ++r8) { u32x4 qwv[8], kwv[8];
#pragma unroll
          for (int q8 = 0; q8 < 8; ++q8) { const size_t m = (size_t)it * 128 + wave * 16 + r8 * 8 + q8; qwv[q8] = *(const u32x4*)(PB + m * NP + C_Q + 8 * lane); kwv[q8] = *(const u32x4*)(PB + m * NP + C_K + 8 * lane); }
#pragma unroll
          for (int q8 = 0; q8 < 8; ++q8) { const u32x4 qw = qwv[q8], kw = kwv[q8];
            float sq = bflo(qw.x) * bflo(qw.x) + bfhi(qw.x) * bfhi(qw.x) + bflo(qw.y) * bflo(qw.y) + bfhi(qw.y) * bfhi(qw.y) + bflo(qw.z) * bflo(qw.z) + bfhi(qw.z) * bfhi(qw.z) + bflo(qw.w) * bflo(qw.w) + bfhi(qw.w) * bfhi(qw.w);
            float sk = bflo(kw.x) * bflo(kw.x) + bfhi(kw.x) * bfhi(kw.x) + bflo(kw.y) * bflo(kw.y) + bfhi(kw.y) * bfhi(kw.y) + bflo(kw.z) * bflo(kw.z) + bfhi(kw.z) * bfhi(kw.z) + bflo(kw.w) * bflo(kw.w) + bfhi(kw.w) * bfhi(kw.w);
#pragma unroll
            for (int o = 0; o < 1; ++o) { sq += dppf<DPP_XOR1>(sq); sk += dppf<DPP_XOR1>(sk); sq += dppf<DPP_XOR2>(sq); sk += dppf<DPP_XOR2>(sk); sq += dppf<DPP_HMIRROR>(sq); sk += dppf<DPP_HMIRROR>(sk); }
            mq = fmaxf(mq, sq); mk = fmaxf(mk, sk); } }
        if ((lane & 7) == 0) { const int hh = lane >> 3, bh = b * 8 + hh, il = it % (T / 128); atomicMax(NRM + (l * 32 + bh) * 2, __float_as_uint(mq)); atomicMax(NRM + (l * 32 + bh) * 2 + 1, __float_as_uint(mk));
            unsigned* CT = (unsigned*)(p->ws + WS_CTL); atomicMax(CT + CW_QN + (l * 32 + bh) * 32 + (il >> 1), __float_as_uint(mq)); atomicMax(CT + CW_KT + (l * 32 + bh) * 128 + il * 2 + (wave >> 2), __float_as_uint(mk)); } }
    }
    { float* XEND = (float*)(p->ws + WS_XEND);
      for (int it = wave * nwg + wg; it < 2048; it += nwg * NWAVES) {
        const int b = it >> 9, g = (it >> 5) & 15, cq = it & 31;
        S5M cf; s5m_load(p, l, g, lane, cf);
        float a64r[2], a64i[2], x4r[2] = {0.f, 0.f}, x4i[2] = {0.f, 0.f};
#pragma unroll
        for (int s2 = 0; s2 < 2; ++s2) { float pr = cf.a16r[s2], pi_ = cf.a16i[s2];
#pragma unroll
            for (int q = 0; q < 2; ++q) { const float nr = pr * pr - pi_ * pi_, ni = 2.f * pr * pi_; pr = nr; pi_ = ni; }
            a64r[s2] = pr; a64i[s2] = pi_; }
        bf16x8 ufs[8];
#pragma unroll
        for (int t8 = 0; t8 < 8; ++t8) ufs[t8] = *(const bf16x8*)(PB + ((size_t)b * T + cq * 256 + t8 * 32 + tau32(lane & 31)) * NP + C_S5 + 16 * g + 8 * (lane >> 5));
#pragma unroll
        for (int k = 0; k < 4; ++k) { const int c = cq * 4 + k; float xr[2] = {0.f, 0.f}, xi[2] = {0.f, 0.f};
#pragma unroll
            for (int mt = 0; mt < 2; ++mt) { f32x16 bu[4]; const f32x16 z = f32x16{};
#pragma unroll
                for (int q = 0; q < 4; ++q) bu[q] = __builtin_amdgcn_mfma_f32_32x32x16_bf16(ufs[2 * k + mt], cf.bfr[q], z, 0, 0, 0);
                s5m_tile_end(cf, bu, xr, xi); }
#pragma unroll
            for (int s2 = 0; s2 < 2; ++s2) { const float nr = a64r[s2] * x4r[s2] - a64i[s2] * x4i[s2] + xr[s2], ni = a64r[s2] * x4i[s2] + a64i[s2] * x4r[s2] + xi[s2]; x4r[s2] = nr; x4i[s2] = ni; }
            if (lane < 32) { float* xe = XEND + ((size_t)((b * 16 + g) * 128 + c) * 64) * 2;
                *(float2*)(xe + lane * 2) = make_float2(xr[0], xi[0]); *(float2*)(xe + (32 + lane) * 2) = make_float2(xr[1], xi[1]); } }
        if (lane < 32) { float* xe = (float*)(p->ws + WS_X4END) + ((size_t)((b * 16 + g) * 32 + cq) * 64) * 2;
            *(float2*)(xe + lane * 2) = make_float2(x4r[0], x4i[0]); *(float2*)(xe + (32 + lane) * 2) = make_float2(x4r[1], x4i[1]); }
      }
    }
}

constexpr int FIN_YSB = 0, FIN_XST = 34816, FIN_CAR = FIN_XST + 8 * 8704;
static_assert(64 * 264 * 2 <= FIN_XST && FIN_CAR + 1024 <= 131072, "finalize LDS map");
__device__ __forceinline__ void fs_fin(PrmP p, int l, LAS unsigned char* lds, int wg, int nwg) {
    const int tid = fresh_tid(), lane = tid & 63, wave = tid >> 6, fr = lane & 15, fq = lane >> 4, nl = lane & 31, hi = lane >> 5;
    const bf16_t* PB = (const bf16_t*)(p->ws + WS_PB); bf16_t* YC = (bf16_t*)(p->ws + WS_YC);
    const bf16_t* HLOC = (const bf16_t*)(p->ws + WS_YL); const bf16_t* PCUM = (const bf16_t*)(p->ws + WS_YS0); const float* AGG = (const float*)(p->ws + WS_AGG); const float* XEND = (const float*)(p->ws + WS_XEND);
    LAS bf16_t* ysb = (LAS bf16_t*)(lds + FIN_YSB); LAS unsigned char* xst = lds + FIN_XST + wave * 8704; LAS float* car = (LAS float*)(lds + FIN_CAR);
    for (int it = wg; it < NB * 128; it += nwg) {
        const int b = it >> 7, c = (it & 256) ? 127 - (it & 127) : (it & 127), t0 = c * 64; const size_t rb = (size_t)b * T;
        __syncthreads();
        if (tid < 256) { float cr = 0.f; const float* ag = AGG + (size_t)(b * 128) * 512 + (fresh_tid() & 255); int cc = 0;
            for (; cc + 8 <= c; cc += 8) { float A[8], H[8];
#pragma unroll
                for (int q = 0; q < 8; ++q) { A[q] = ag[(size_t)(cc + q) * 512]; H[q] = ag[(size_t)(cc + q) * 512 + 256]; }
#pragma unroll
                for (int q = 0; q < 8; ++q) cr = A[q] * cr + H[q]; }
            for (; cc < c; ++cc) cr = ag[(size_t)cc * 512] * cr + ag[(size_t)cc * 512 + 256];
            car[tid] = cr; }
#pragma unroll 1
        for (int gi = 0; gi < 2; ++gi) { const int g = wave + 8 * gi;
            S5M cf; s5m_load(p, l, g, lane, cf);
            bf16x8 cmf[8]; bf16x8 dfr; s5m_load_c(p, l, g, lane, cmf, dfr);
            float xr[2] = {0.f, 0.f}, xi[2] = {0.f, 0.f};
            { float a64r[2], a64i[2];
#pragma unroll
              for (int s = 0; s < 2; ++s) { float pr = cf.a16r[s], pi_ = cf.a16i[s];
#pragma unroll
                  for (int q = 0; q < 2; ++q) { const float nr = pr * pr - pi_ * pi_, ni = 2.f * pr * pi_; pr = nr; pi_ = ni; }
                  a64r[s] = pr; a64i[s] = pi_; }
              float a256r[2], a256i[2];
#pragma unroll
              for (int s = 0; s < 2; ++s) { float pr = a64r[s], pi_ = a64i[s];
#pragma unroll
                  for (int q = 0; q < 2; ++q) { const float nr = pr * pr - pi_ * pi_, ni = 2.f * pr * pi_; pr = nr; pi_ = ni; }
                  a256r[s] = pr; a256i[s] = pi_; }
              const float* x4 = (const float*)(p->ws + WS_X4END) + ((size_t)((b * 16 + g) * 32) * 64) * 2 + nl * 2;
              const int nb4 = c >> 2; int cb = 0;
              for (; cb + 4 <= nb4; cb += 4) { float2 e0[4], e1[4];
#pragma unroll
                  for (int q = 0; q < 4; ++q) { e0[q] = *(const float2*)(x4 + (size_t)(cb + q) * 128); e1[q] = *(const float2*)(x4 + (size_t)(cb + q) * 128 + 64); }
#pragma unroll
                  for (int q = 0; q < 4; ++q) {
                      float nr = a256r[0] * xr[0] - a256i[0] * xi[0] + e0[q].x, ni = a256r[0] * xi[0] + a256i[0] * xr[0] + e0[q].y; xr[0] = nr; xi[0] = ni;
                      nr = a256r[1] * xr[1] - a256i[1] * xi[1] + e1[q].x; ni = a256r[1] * xi[1] + a256i[1] * xr[1] + e1[q].y; xr[1] = nr; xi[1] = ni; } }
              for (; cb < nb4; ++cb) { const float2 e0 = *(const float2*)(x4 + (size_t)cb * 128), e1 = *(const float2*)(x4 + (size_t)cb * 128 + 64);
                  float nr = a256r[0] * xr[0] - a256i[0] * xi[0] + e0.x, ni = a256r[0] * xi[0] + a256i[0] * xr[0] + e0.y; xr[0] = nr; xi[0] = ni;
                  nr = a256r[1] * xr[1] - a256i[1] * xi[1] + e1.x; ni = a256r[1] * xi[1] + a256i[1] * xr[1] + e1.y; xr[1] = nr; xi[1] = ni; }
              const float* xe = XEND + ((size_t)((b * 16 + g) * 128) * 64) * 2 + nl * 2;
              for (int cc = nb4 * 4; cc < c; ++cc) { const float2 e0 = *(const float2*)(xe + (size_t)cc * 128), e1 = *(const float2*)(xe + (size_t)cc * 128 + 64);
                  float nr = a64r[0] * xr[0] - a64i[0] * xi[0] + e0.x, ni = a64r[0] * xi[0] + a64i[0] * xr[0] + e0.y; xr[0] = nr; xi[0] = ni;
                  nr = a64r[1] * xr[1] - a64i[1] * xi[1] + e1.x; ni = a64r[1] * xi[1] + a64i[1] * xr[1] + e1.y; xr[1] = nr; xi[1] = ni; } }
#pragma unroll 1
            for (int mt = 0; mt < 2; ++mt) {
                f32x16 bu[4]; bf16x8 uf; s5m_bu(PB, rb, t0 + mt * 32, g, lane, cf, bu, uf);
#pragma unroll
                for (int s = 0; s < 2; ++s) {
#pragma unroll
                    for (int r = 1; r < 16; ++r) { const float pr = bu[s][r - 1], pi_ = bu[2 + s][r - 1]; bu[s][r] += cf.ar[s] * pr - cf.ai[s] * pi_; bu[2 + s][r] += cf.ar[s] * pi_ + cf.ai[s] * pr; }
                    const float er = bu[s][15], ei = bu[2 + s][15];
                    const auto swr_ = __builtin_amdgcn_permlane32_swap(__float_as_uint(er), __float_as_uint(er), false, false), swi_ = __builtin_amdgcn_permlane32_swap(__float_as_uint(ei), __float_as_uint(ei), false, false);
                    const float elr = __uint_as_float(swr_[0]), eli = __uint_as_float(swi_[0]), ehr = __uint_as_float(swr_[1]), ehi = __uint_as_float(swi_[1]);
                    const float t1r = cf.a16r[s] * xr[s] - cf.a16i[s] * xi[s] + elr, t1i = cf.a16r[s] * xi[s] + cf.a16i[s] * xr[s] + eli;
                    float wr = hi ? t1r : xr[s], wi = hi ? t1i : xi[s];
                    xr[s] = cf.a16r[s] * t1r - cf.a16i[s] * t1i + ehr; xi[s] = cf.a16r[s] * t1i + cf.a16i[s] * t1r + ehi;
#pragma unroll
                    for (int r = 0; r < 16; ++r) { const float nr = cf.ar[s] * wr - cf.ai[s] * wi, ni = cf.ar[s] * wi + cf.ai[s] * wr; wr = nr; wi = ni; bu[s][r] += wr; bu[2 + s][r] += wi; }
                }
#pragma unroll
                for (int r = 0; r < 16; ++r) { u32x2 w; w.x = pk2(bu[0][r], bu[1][r]); w.y = pk2(bu[2][r], bu[3][r]); *(LAS u32x2*)(xst + (16 * hi + r) * 272 + nl * 8) = w; }
                asm volatile("s_waitcnt lgkmcnt(0)" ::: "memory");
                f32x16 acc = __builtin_amdgcn_mfma_f32_32x32x16_bf16(uf, dfr, f32x16{}, 0, 0, 0);
#pragma unroll
                for (int ks = 0; ks < 8; ++ks) { const bf16x8 af = *(const LAS bf16x8*)(xst + tau32(nl) * 272 + (16 * ks + 8 * hi) * 2); acc = __builtin_amdgcn_mfma_f32_32x32x16_bf16(af, cmf[ks], acc, 0, 0, 0); }
                if (nl < 16) {
#pragma unroll
                    for (int r = 0; r < 16; ++r) ysb[(mt * 32 + 16 * hi + r) * 264 + g * 16 + nl] = (bf16_t)f2bf(gelu_tanh(acc[r])); }
                asm volatile("s_waitcnt lgkmcnt(0)" ::: "memory");
            }
        }
        __syncthreads();
        { const bf16_t* GW = (const bf16_t*)(p->ws + WS_GLUW) + (size_t)l * 65536;
          f32x4 acc[4][2];
#pragma unroll
          for (int m = 0; m < 4; ++m) { acc[m][0] = (f32x4){0.f, 0.f, 0.f, 0.f}; acc[m][1] = (f32x4){0.f, 0.f, 0.f, 0.f}; }
#pragma unroll 2
          for (int ks = 0; ks < 8; ++ks) { bf16x8 a[4], bb[2];
#pragma unroll
              for (int m = 0; m < 4; ++m) a[m] = *(const LAS bf16x8*)(ysb + (m * 16 + fr) * 264 + ks * 32 + 8 * fq);
#pragma unroll
              for (int n = 0; n < 2; ++n) bb[n] = *(const bf16x8*)(GW + (size_t)((2 * wave + n) * 16 + fr) * 256 + ks * 32 + 8 * fq);
#pragma unroll
              for (int m = 0; m < 4; ++m)
#pragma unroll
                  for (int n = 0; n < 2; ++n) acc[m][n] = __builtin_amdgcn_mfma_f32_16x16x32_bf16(a[m], bb[n], acc[m][n], 0, 0, 0); }
          __syncthreads();
#pragma unroll
          for (int n = 0; n < 2; ++n) { const int j = (2 * wave + n) * 16 + fr; const float gb = p->in[I_GLUB][l * 256 + j];
#pragma unroll
              for (int m = 0; m < 4; ++m)
#pragma unroll
                  for (int r = 0; r < 4; ++r) { const int tk = m * 16 + 4 * fq + r; const float y = bf2f(ysb[tk * 264 + j]); ysb[tk * 264 + j] = (bf16_t)f2bf(y * sigmoidf_(acc[m][n][r] + gb)); } }
        }
        __syncthreads();
        { const f32x4 ggl = *(const f32x4*)(p->in[I_GNLRU] + l * 256 + 4 * lane), ggs = *(const f32x4*)(p->in[I_GNS5] + l * 256 + 4 * lane);
          const f32x4 g0 = *(const f32x4*)(p->in[I_GNATT] + l * 512 + 8 * lane), g1 = *(const f32x4*)(p->in[I_GNATT] + l * 512 + 8 * lane + 4); const f32x4 cr = *(const LAS f32x4*)(car + 4 * lane);
#pragma unroll 1
          for (int rq = 0; rq < 2; ++rq) {
            u32x2 hw[4], pw[4], gw[4]; u32x4 ow[4];
#pragma unroll
            for (int q = 0; q < 4; ++q) { const size_t m = rb + t0 + wave + 8 * (4 * rq + q);
                hw[q] = *(const u32x2*)(HLOC + m * 256 + 4 * lane); pw[q] = *(const u32x2*)(PCUM + m * 256 + 4 * lane); gw[q] = *(const u32x2*)(PB + m * NP + C_LG + 4 * lane); ow[q] = *(const u32x4*)(PB + m * NP + C_Q + 8 * lane); }
#pragma unroll
            for (int q = 0; q < 4; ++q) { const int r = wave + 8 * (4 * rq + q); const size_t m = rb + t0 + r;
              { const f32x4 hl = (f32x4){bflo(hw[q].x), bfhi(hw[q].x), bflo(hw[q].y), bfhi(hw[q].y)}, pc = (f32x4){bflo(pw[q].x), bfhi(pw[q].x), bflo(pw[q].y), bfhi(pw[q].y)};
                f32x4 v; v.x = (hl.x + pc.x * cr.x) * gelu_tanh(bflo(gw[q].x)); v.y = (hl.y + pc.y * cr.y) * gelu_tanh(bfhi(gw[q].x)); v.z = (hl.z + pc.z * cr.z) * gelu_tanh(bflo(gw[q].y)); v.w = (hl.w + pc.w * cr.w) * gelu_tanh(bfhi(gw[q].y));
                const float rs = __builtin_amdgcn_rsqf(wave_sum(v.x * v.x + v.y * v.y + v.z * v.z + v.w * v.w) * (1.f / 256.f) + RMS_EPS);
                u32x2 o; o.x = pk2(v.x * rs * ggl.x, v.y * rs * ggl.y); o.y = pk2(v.z * rs * ggl.z, v.w * rs * ggl.w); if (OUT_FP8) *(unsigned*)((unsigned char*)YC + m * 1024 + 4 * lane) = pk4_fp8(8.f * v.x * rs * ggl.x, 8.f * v.y * rs * ggl.y, 8.f * v.z * rs * ggl.z, 8.f * v.w * rs * ggl.w); else *(u32x2*)(YC + m * 1024 + 4 * lane) = o; }
              { const u32x2 yw = *(const LAS u32x2*)(ysb + r * 264 + 4 * lane); const f32x4 v = (f32x4){bflo(yw.x), bfhi(yw.x), bflo(yw.y), bfhi(yw.y)};
                const float rs = __builtin_amdgcn_rsqf(wave_sum(v.x * v.x + v.y * v.y + v.z * v.z + v.w * v.w) * (1.f / 256.f) + RMS_EPS);
                u32x2 o; o.x = pk2(v.x * rs * ggs.x, v.y * rs * ggs.y); o.y = pk2(v.z * rs * ggs.z, v.w * rs * ggs.w); if (OUT_FP8) *(unsigned*)((unsigned char*)YC + m * 1024 + 256 + 4 * lane) = pk4_fp8(8.f * v.x * rs * ggs.x, 8.f * v.y * rs * ggs.y, 8.f * v.z * rs * ggs.z, 8.f * v.w * rs * ggs.w); else *(u32x2*)(YC + m * 1024 + 256 + 4 * lane) = o; }
              { const u32x4 w = ow[q];
                const float v[8] = {bflo(w.x), bfhi(w.x), bflo(w.y), bfhi(w.y), bflo(w.z), bfhi(w.z), bflo(w.w), bfhi(w.w)};
                float ss = 0.f;
#pragma unroll
                for (int i = 0; i < 8; ++i) ss += v[i] * v[i];
                const float rs = __builtin_amdgcn_rsqf(wave_sum(ss) * (1.f / 512.f) + RMS_EPS);
                u32x4 o; o.x = pk2(v[0] * rs * g0.x, v[1] * rs * g0.y); o.y = pk2(v[2] * rs * g0.z, v[3] * rs * g0.w); o.z = pk2(v[4] * rs * g1.x, v[5] * rs * g1.y); o.w = pk2(v[6] * rs * g1.z, v[7] * rs * g1.w);
                if (OUT_FP8) { u32x2 o8; const float r8 = 8.f * rs; o8.x = pk4_fp8(v[0] * r8 * g0.x, v[1] * r8 * g0.y, v[2] * r8 * g0.z, v[3] * r8 * g0.w); o8.y = pk4_fp8(v[4] * r8 * g1.x, v[5] * r8 * g1.y, v[6] * r8 * g1.z, v[7] * r8 * g1.w);
                    *(u32x2*)((unsigned char*)YC + m * 1024 + 512 + 8 * lane) = o8; }
                else *(u32x4*)(YC + m * 1024 + 512 + 8 * lane) = o; } } } }
    }
}

constexpr int ROW_WT = 0, ROW_WT_LD = 1028, ROW_ETAB = 131584 + 64;
__device__ __forceinline__ void ph_row(PrmP p, int l, LAS unsigned char* lds, int wg, int nwg) {
    const int tid = fresh_tid(), lane = tid & 63, wave = tid >> 6;
    const int R = M / nwg;
    const float* Xin = p->in[I_X]; bf16_t* XB = (bf16_t*)(p->ws + WS_XB); const bf16_t* Y = (const bf16_t*)(p->ws + WS_Y);
    const float* MOD = (const float*)(p->ws + WS_MOD); bf16_t* HB = (bf16_t*)(p->ws + WS_HB);
    int* TOPI = (int*)(p->ws + WS_MISC + MS_TOPI); float* TOPG = (float*)(p->ws + WS_MISC + MS_TOPG); int* RANK = (int*)(p->ws + WS_MISC + MS_RANK); int* HIST = (int*)(p->ws + WS_MISC + MS_HIST);
    LAS int* etab = (LAS int*)(lds + ROW_ETAB);
    LAS float* wt = (LAS float*)(lds + ROW_WT);
    const float* RW = p->in[I_ROUTW] + (size_t)l * 1024 * 32; const float* RB = p->in[I_ROUTB] + l * 32;
    __syncthreads();
    { f32x4 wv[16];
#pragma unroll
      for (int k = 0; k < 16; ++k) wv[k] = *(const f32x4*)(RW + tid * 4 + 2048 * k);
#pragma unroll
      for (int k = 0; k < 16; ++k) { const int i = tid * 4 + 2048 * k, e = i & 31, d = i >> 5; wt[e * ROW_WT_LD + d] = wv[k].x; wt[(e + 1) * ROW_WT_LD + d] = wv[k].y; wt[(e + 2) * ROW_WT_LD + d] = wv[k].z; wt[(e + 3) * ROW_WT_LD + d] = wv[k].w; } }
    __syncthreads();
    const float rbias = RB[(lane >> 1) & 31];
    const int RPW = R / NWAVES; constexpr int NR = 2;
    u32x2 ywn[NR][4]; f32x4 xfn[NR][4]; u32x2 xbn[NR][4];
#define ROW_LOAD(r0_) do { _Pragma("unroll") for (int q = 0; q < NR; ++q) _Pragma("unroll") for (int j = 0; j < 4; ++j) { const size_t mm_ = (size_t)wg * R + (r0_) + q; const int c_ = 4 * lane + 256 * j; \
        ywn[q][j] = *(const u32x2*)(Y + mm_ * 1024 + c_); if (l == 0) xfn[q][j] = *(const f32x4*)(Xin + mm_ * 1024 + c_); else xbn[q][j] = *(const u32x2*)(XB + mm_ * 1024 + c_); } } while (0)
    ROW_LOAD(wave * RPW);
    for (int r0 = wave * RPW; r0 < (wave + 1) * RPW; r0 += NR) {
        const size_t m0 = (size_t)wg * R + r0; const int b = (int)(m0 / T);
        const float* mod = MOD + (size_t)(l * 4 + b) * 6144;
        u32x2 ywc[NR][4]; f32x4 xfc[NR][4];
#pragma unroll
        for (int q = 0; q < NR; ++q)
#pragma unroll
            for (int j = 0; j < 4; ++j) { ywc[q][j] = ywn[q][j]; if (l == 0) xfc[q][j] = xfn[q][j]; else xfc[q][j] = (f32x4){bflo(xbn[q][j].x), bfhi(xbn[q][j].x), bflo(xbn[q][j].y), bfhi(xbn[q][j].y)}; }
        if (r0 + NR < (wave + 1) * RPW) ROW_LOAD(r0 + NR);
        f32x4 h[NR][4];
        { f32x4 y[NR][4]; float ss[NR] = {};
#pragma unroll
          for (int q = 0; q < NR; ++q)
#pragma unroll
              for (int j = 0; j < 4; ++j) { const u32x2 yw = ywc[q][j]; y[q][j] = (f32x4){bflo(yw.x), bfhi(yw.x), bflo(yw.y), bfhi(yw.y)}; ss[q] += (y[q][j].x * y[q][j].x + y[q][j].y * y[q][j].y) + (y[q][j].z * y[q][j].z + y[q][j].w * y[q][j].w); }
          float rstd[NR], s2[NR] = {};
#pragma unroll
          for (int q = 0; q < NR; ++q) rstd[q] = __builtin_amdgcn_rsqf(wave_sum(ss[q]) * (1.f / 1024.f) + RMS_EPS);
#pragma unroll
          for (int j = 0; j < 4; ++j) { const int c = 4 * lane + 256 * j; const f32x4 g = *(const f32x4*)(p->in[I_POSTMIXG] + l * 1024 + c), gate = *(const f32x4*)(mod + 2 * 1024 + c);
#pragma unroll
              for (int q = 0; q < NR; ++q) { const f32x4 x0 = xfc[q][j];
                  const f32x4 x = x0 + gate * (y[q][j] * rstd[q] * g); { u32x2 xo; xo.x = pk2(x.x, x.y); xo.y = pk2(x.z, x.w); *(u32x2*)(XB + (m0 + q) * 1024 + c) = xo; } h[q][j] = x;
                  s2[q] += (x.x * x.x + x.y * x.y) + (x.z * x.z + x.w * x.w); } }
          float rstd2[NR];
#pragma unroll
          for (int q = 0; q < NR; ++q) rstd2[q] = __builtin_amdgcn_rsqf(wave_sum(s2[q]) * (1.f / 1024.f) + RMS_EPS);
#pragma unroll
          for (int j = 0; j < 4; ++j) { const int c = 4 * lane + 256 * j; const f32x4 g = *(const f32x4*)(p->in[I_PREFFNG] + l * 1024 + c), sc = *(const f32x4*)(mod + 4 * 1024 + c), sh = *(const f32x4*)(mod + 3 * 1024 + c);
#pragma unroll
              for (int q = 0; q < NR; ++q) { h[q][j] = h[q][j] * rstd2[q] * g * (sc + 1.f) + sh;
                  if (EXPERT_FP8) *(unsigned*)((unsigned char*)HB + (m0 + q) * 1024 + c) = pk4_fp8(4.f * h[q][j].x, 4.f * h[q][j].y, 4.f * h[q][j].z, 4.f * h[q][j].w);
                  else { u32x2 o; o.x = pk2(h[q][j].x, h[q][j].y); o.y = pk2(h[q][j].z, h[q][j].w); *(u32x2*)(HB + (m0 + q) * 1024 + c) = o; } } } }
        float v16[NR][16];
        const bool b5 = lane & 32;
#pragma unroll
        for (int i = 0; i < 16; ++i) { float lo[NR], hi[NR]; f32x2h_ lo2[NR], hi2[NR];
#pragma unroll
            for (int q = 0; q < NR; ++q) { lo2[q] = (f32x2h_){0.f, 0.f}; hi2[q] = (f32x2h_){0.f, 0.f}; }
#pragma unroll
            for (int j = 0; j < 4; ++j) { const f32x4 wl = *(const LAS f32x4*)(wt + i * ROW_WT_LD + 4 * lane + 256 * j), wh = *(const LAS f32x4*)(wt + (i + 16) * ROW_WT_LD + 4 * lane + 256 * j);
                const f32x2h_ wl0 = {wl.x, wl.y}, wl1 = {wl.z, wl.w}, wh0 = {wh.x, wh.y}, wh1 = {wh.z, wh.w};
#pragma unroll
                for (int q = 0; q < NR; ++q) { const f32x2h_ h0 = {h[q][j].x, h[q][j].y}, h1 = {h[q][j].z, h[q][j].w};
                    lo2[q] = __builtin_elementwise_fma(h0, wl0, lo2[q]); lo2[q] = __builtin_elementwise_fma(h1, wl1, lo2[q]); hi2[q] = __builtin_elementwise_fma(h0, wh0, hi2[q]); hi2[q] = __builtin_elementwise_fma(h1, wh1, hi2[q]); } }
#pragma unroll
            for (int q = 0; q < NR; ++q) { lo[q] = lo2[q].x + lo2[q].y; hi[q] = hi2[q].x + hi2[q].y; }
#pragma unroll
            for (int q = 0; q < NR; ++q) { const auto sw = __builtin_amdgcn_permlane32_swap(__float_as_uint(lo[q]), __float_as_uint(hi[q]), false, false);
                v16[q][i] = __uint_as_float(sw[0]) + __uint_as_float(sw[1]); } }
#pragma unroll
        for (int q = 0; q < NR; ++q) { const int r = r0 + q; const size_t m = m0 + q;
            float v8[8], v4[4], v2[2], mine;
            { const bool b4 = lane & 16, b3 = lane & 8, b2 = lane & 4, b1 = lane & 2;
#pragma unroll
              for (int i = 0; i < 8; ++i) { const auto sw = __builtin_amdgcn_permlane16_swap(__float_as_uint(v16[q][i]), __float_as_uint(v16[q][i + 8]), false, false); v8[i] = __uint_as_float(sw[0]) + __uint_as_float(sw[1]); }
#pragma unroll
              for (int i = 0; i < 4; ++i) { const float rcv = dppf<DPP_ROR8>(b3 ? v8[i] : v8[i + 4]); v4[i] = (b3 ? v8[i + 4] : v8[i]) + rcv; }
#pragma unroll
              for (int i = 0; i < 2; ++i) { const float rcv = dppf<DPP_HMIRROR>(dppf<DPP_REV4>(b2 ? v4[i] : v4[i + 2])); v2[i] = (b2 ? v4[i + 2] : v4[i]) + rcv; }
              { const float rcv = dppf<DPP_XOR2>(b1 ? v2[0] : v2[1]); mine = (b1 ? v2[1] : v2[0]) + rcv; }
              mine += dppf<DPP_XOR1>(mine); (void)b4; }
            mine += rbias;
            if (lane & 1) mine = -3e38f;
            float tv[4]; int ti[4];
#pragma unroll
            for (int k = 0; k < 4; ++k) { const float mx = wave_max(mine);
                const unsigned long long bal = __ballot(mine == mx && !(lane & 1)); const int wl_ = __ffsll((long long)bal) - 1;
                tv[k] = mx; ti[k] = wl_ >> 1; if (lane == wl_) mine = -3e38f; }
            const float e1 = __expf(tv[1] - tv[0]), e2 = __expf(tv[2] - tv[0]), e3 = __expf(tv[3] - tv[0]); const float inv = __builtin_amdgcn_rcpf(1.f + e1 + e2 + e3);
            if (lane < 4) { const int id = (lane == 0) ? ti[0] : (lane == 1) ? ti[1] : (lane == 2) ? ti[2] : ti[3]; const float gv = ((lane == 0) ? 1.f : (lane == 1) ? e1 : (lane == 2) ? e2 : e3) * inv;
                TOPI[m * 4 + lane] = id; TOPG[m * 4 + lane] = gv; etab[r * 4 + lane] = id; } }
    }
    __syncthreads();
    const int NEn = R * 4;
    if (NEn == NTHREADS) {
        LAS int* wcnt = etab + NTHREADS;
        const int e = etab[tid]; int myrank = 0;
#pragma unroll 4
        for (int q = 0; q < 32; ++q) { const unsigned long long mk = __ballot(e == q); if (e == q) myrank = __popcll(mk & ((1ull << lane) - 1ull)); if (lane == q) wcnt[wave * 32 + q] = __popcll(mk); }
        __syncthreads();
        int pre = 0; for (int w = 0; w < wave; ++w) pre += wcnt[w * 32 + e];
        RANK[(size_t)wg * NEn + tid] = pre + myrank;
        if (tid < 32) { int c = 0;
#pragma unroll
            for (int w = 0; w < NWAVES; ++w) c += wcnt[w * 32 + tid];
            HIST[wg * 32 + tid] = c; }
    } else {
    if (tid < NEn) { const int e = etab[tid]; int rk = 0; for (int j = 0; j < tid; ++j) rk += (etab[j] == e) ? 1 : 0; RANK[(size_t)wg * NEn + tid] = rk; }
    if (tid < 32) { int c = 0; for (int j = 0; j < NEn; ++j) c += (etab[j] == tid) ? 1 : 0; HIST[wg * 32 + tid] = c; }
    }
    __syncthreads();
}

__device__ __forceinline__ void ph_offs(PrmP p, int l, LAS unsigned char* lds, int wg, int nwg) {
    const int tid = fresh_tid(), lane = tid & 63, wave = tid >> 6;
    const int R = M / nwg, NEn = R * 4;
    const int* TOPI = (const int*)(p->ws + WS_MISC + MS_TOPI); const int* RANK = (const int*)(p->ws + WS_MISC + MS_RANK); const int* HIST = (const int*)(p->ws + WS_MISC + MS_HIST);
    int* POS = (int*)(p->ws + WS_MISC + MS_POS); int* TILE_E = (int*)(p->ws + WS_MISC + MS_TILEE); int* CTL = (int*)(p->ws + WS_CTL);
    const bf16_t* HB = (const bf16_t*)(p->ws + WS_HB); bf16_t* XS = (bf16_t*)(p->ws + WS_XS);
    LAS int* tot = (LAS int*)lds; LAS int* mine = tot + 32; LAS int* base = mine + 32; LAS int* ptab = base + 32;
    __syncthreads();
    { LAS int* part = ptab + 512;
      const int e = tid & 31, pt = tid >> 5, per = (nwg + 15) / 16; int t = 0, mb = 0;
      for (int w = pt * per; w < (pt + 1) * per && w < nwg; ++w) { const int c = HIST[w * 32 + e]; t += c; mb += (w < wg) ? c : 0; }
      part[(pt * 2 + 0) * 32 + e] = t; part[(pt * 2 + 1) * 32 + e] = mb;
      __syncthreads();
      if (tid < 32) { int ts = 0, ms = 0;
#pragma unroll
          for (int q = 0; q < 16; ++q) { ts += part[(q * 2 + 0) * 32 + tid]; ms += part[(q * 2 + 1) * 32 + tid]; }
          tot[tid] = ts; mine[tid] = ms; } }
    __syncthreads();
    if (tid == 0) { int run = 0; for (int e = 0; e < 32; ++e) { const int pad = (tot[e] + 255) / 256 * 256; base[e] = run + mine[e];
            if (wg == 0) for (int t = run / 256; t < (run + pad) / 256; ++t) TILE_E[t] = e;
            run += pad; }
        if (wg == 0) CTL[CW_NT] = run / 256; }
    __syncthreads();
    int* ROWTOK = (int*)(p->ws + WS_MISC + MS_ROWTOK);
    if (tid < NEn) { const size_t idx = (size_t)wg * NEn + tid; const int pos = base[TOPI[idx]] + RANK[idx]; POS[idx] = pos; ptab[tid] = pos; ROWTOK[pos] = (int)(idx >> 2); }
    if (wg < 32) { const int e = wg, st = base[e] - mine[e] + tot[e], en = base[e] - mine[e] + (tot[e] + 255) / 256 * 256; for (int r = st + tid; r < en; r += NTHREADS) ROWTOK[r] = 0; }
    __syncthreads();
    if (EXPERT_FP8) return;
    for (int r0 = wave * (R / NWAVES); r0 < (wave + 1) * (R / NWAVES); r0 += 4) {
        u32x4 va[4], vb[4];
        if (EXPERT_FP8) {
#pragma unroll
            for (int q = 0; q < 4; ++q) va[q] = ((const u32x4*)((const unsigned char*)HB + ((size_t)wg * R + r0 + q) * 1024))[lane];
#pragma unroll
            for (int q = 0; q < 4; ++q)
#pragma unroll
                for (int k = 0; k < 4; ++k) ((u32x4*)((unsigned char*)XS + (size_t)ptab[(r0 + q) * 4 + k] * 1024))[lane] = va[q];
        } else {
#pragma unroll
        for (int q = 0; q < 4; ++q) { const u32x4* src = (const u32x4*)(HB + ((size_t)wg * R + r0 + q) * 1024); va[q] = src[lane]; vb[q] = src[lane + 64]; }
#pragma unroll
        for (int q = 0; q < 4; ++q)
#pragma unroll
            for (int k = 0; k < 4; ++k) { u32x4* dst = (u32x4*)(XS + (size_t)ptab[(r0 + q) * 4 + k] * 1024); dst[lane] = va[q]; dst[lane + 64] = vb[q]; }
        }
    }
}

__device__ __forceinline__ void ph_comb(PrmP p, int l, int wg, int nwg) {
    const int tid = fresh_tid(), lane = tid & 63, wave = tid >> 6;
    const bf16_t* YR = (const bf16_t*)(p->ws + WS_YR); const int* POS = (const int*)(p->ws + WS_MISC + MS_POS); const float* TOPG = (const float*)(p->ws + WS_MISC + MS_TOPG);
    const float* MOD = (const float*)(p->ws + WS_MOD); float* X = p->out; bf16_t* XB = (bf16_t*)(p->ws + WS_XB);
    int posv = POS[(size_t)(wg * NWAVES + wave) * 4 + (lane & 3)]; float gvv = TOPG[(size_t)(wg * NWAVES + wave) * 4 + (lane & 3)];
    for (int m = wg * NWAVES + wave; m < M; m += nwg * NWAVES) {
        const int b = m / T; const float* gate = MOD + (size_t)(l * 4 + b) * 6144 + 5 * 1024;
        const int posc = posv; const float gvc = gvv;
        { const int mn = m + nwg * NWAVES; if (mn < M) { posv = POS[(size_t)mn * 4 + (lane & 3)]; gvv = TOPG[(size_t)mn * 4 + (lane & 3)]; } }
        float y[16];
#pragma unroll
        for (int i = 0; i < 16; ++i) y[i] = 0.f;
#pragma unroll
        for (int k = 0; k < 4; ++k) { const int pos = __builtin_amdgcn_readlane(posc, k); const float gv = __builtin_bit_cast(float, __builtin_amdgcn_readlane(__builtin_bit_cast(int, gvc), k));
            if (YR_FP8) { typedef float f32x2_ __attribute__((ext_vector_type(2))); const float g16 = gv * 0.0625f;
                const unsigned char* yrow = (const unsigned char*)YR + ((size_t)(pos >> 8) * 1024 + (lane >> 5) * 256 + (pos & 255)) * 256 + 8 * (lane & 31);
                const u32x2 a8 = *(const u32x2*)(yrow), c8 = *(const u32x2*)(yrow + 2 * 65536);
                const unsigned wv[4] = {a8.x, a8.y, c8.x, c8.y};
#pragma unroll
                for (int q = 0; q < 4; ++q) { const f32x2_ lo = __builtin_amdgcn_cvt_pk_f32_fp8((int)wv[q], false), hi = __builtin_amdgcn_cvt_pk_f32_fp8((int)wv[q], true);
                    y[4 * q + 0] += g16 * lo.x; y[4 * q + 1] += g16 * lo.y; y[4 * q + 2] += g16 * hi.x; y[4 * q + 3] += g16 * hi.y; }
            } else {
            const u32x4 a = *(const u32x4*)(YR + (size_t)pos * 1024 + 8 * lane), c = *(const u32x4*)(YR + (size_t)pos * 1024 + 512 + 8 * lane);
            y[0] += gv * bflo(a.x); y[1] += gv * bfhi(a.x); y[2] += gv * bflo(a.y); y[3] += gv * bfhi(a.y); y[4] += gv * bflo(a.z); y[5] += gv * bfhi(a.z); y[6] += gv * bflo(a.w); y[7] += gv * bfhi(a.w);
            y[8] += gv * bflo(c.x); y[9] += gv * bfhi(c.x); y[10] += gv * bflo(c.y); y[11] += gv * bfhi(c.y); y[12] += gv * bflo(c.z); y[13] += gv * bfhi(c.z); y[14] += gv * bflo(c.w); y[15] += gv * bfhi(c.w); } }
        float ss = 0.f;
#pragma unroll
        for (int i = 0; i < 16; ++i) ss += y[i] * y[i];
        const float rstd = __builtin_amdgcn_rsqf(wave_sum(ss) * (1.f / 1024.f) + RMS_EPS);
        float xs[16]; float s2 = 0.f;
#pragma unroll
        for (int hf = 0; hf < 2; ++hf) { const int c0 = hf * 512 + 8 * lane;
#pragma unroll
            for (int q = 0; q < 2; ++q) { const int c = c0 + 4 * q; const f32x4 g = *(const f32x4*)(p->in[I_POSTFFNG] + l * 1024 + c), gt = *(const f32x4*)(gate + c); const u32x2 xw = *(const u32x2*)(XB + (size_t)m * 1024 + c); f32x4 xv = (f32x4){bflo(xw.x), bfhi(xw.x), bflo(xw.y), bfhi(xw.y)};
                xv.x += gt.x * (y[hf * 8 + 4 * q + 0] * rstd * g.x); xv.y += gt.y * (y[hf * 8 + 4 * q + 1] * rstd * g.y); xv.z += gt.z * (y[hf * 8 + 4 * q + 2] * rstd * g.z); xv.w += gt.w * (y[hf * 8 + 4 * q + 3] * rstd * g.w);
                if (l + 1 < NL) { u32x2 xo; xo.x = pk2(xv.x, xv.y); xo.y = pk2(xv.z, xv.w); *(u32x2*)(XB + (size_t)m * 1024 + c) = xo; } else *(f32x4*)(X + (size_t)m * 1024 + c) = xv;
                xs[hf * 8 + 4 * q + 0] = xv.x; xs[hf * 8 + 4 * q + 1] = xv.y; xs[hf * 8 + 4 * q + 2] = xv.z; xs[hf * 8 + 4 * q + 3] = xv.w; s2 += (xv.x * xv.x + xv.y * xv.y) + (xv.z * xv.z + xv.w * xv.w); } }
        if (l + 1 < NL) {
            const float rs2 = __builtin_amdgcn_rsqf(wave_sum(s2) * (1.f / 1024.f) + RMS_EPS);
            const float* shift = MOD + (size_t)((l + 1) * 4 + b) * 6144; const float* scale = shift + 1024; const float* g2 = p->in[I_PREMIXG] + (l + 1) * 1024;
            bf16_t* HB = (bf16_t*)(p->ws + WS_HB);
#pragma unroll
            for (int hf = 0; hf < 2; ++hf) { const int c0 = hf * 512 + 8 * lane; float hv[8];
#pragma unroll
                for (int q = 0; q < 2; ++q) { const f32x4 gg = *(const f32x4*)(g2 + c0 + 4 * q), sc = *(const f32x4*)(scale + c0 + 4 * q), sh = *(const f32x4*)(shift + c0 + 4 * q);
                    hv[4 * q + 0] = xs[hf * 8 + 4 * q + 0] * rs2 * gg.x * (sc.x + 1.f) + sh.x; hv[4 * q + 1] = xs[hf * 8 + 4 * q + 1] * rs2 * gg.y * (sc.y + 1.f) + sh.y;
                    hv[4 * q + 2] = xs[hf * 8 + 4 * q + 2] * rs2 * gg.z * (sc.z + 1.f) + sh.z; hv[4 * q + 3] = xs[hf * 8 + 4 * q + 3] * rs2 * gg.w * (sc.w + 1.f) + sh.w; }
                u32x4 o; o.x = pk2(hv[0], hv[1]); o.y = pk2(hv[2], hv[3]); o.z = pk2(hv[4], hv[5]); o.w = pk2(hv[6], hv[7]);
                *(u32x4*)(HB + (size_t)m * 1024 + c0) = o; } }
    }
}

__device__ __forceinline__ void ph_tables(PrmP p, int wg, int nwg) {
    const int tid = fresh_tid(), lane = tid & 63, wave = tid >> 6;
    for (int it = wave * nwg + wg; it < NL * 16; it += nwg * NWAVES) s5m_table_build(p, it >> 4, it & 15, lane);
}

#define XB_TMO      128
#define XB_XCNT(j)  (256  + 64 * (j))
#define XB_XSUB(j)  (1280 + 64 * (j))
#define XB_XGEN(j)  (2304 + 64 * (j))
#define XB_TOP      3328
#define XB_TOPGEN   3392
#define XCD_BAR_WORDS 3456
#define XB_SPIN_CAP (1u << 22)

__device__ __forceinline__ unsigned xb_ld(unsigned* p)              { return __hip_atomic_load(p, __ATOMIC_RELAXED, __HIP_MEMORY_SCOPE_AGENT); }
__device__ __forceinline__ unsigned xb_add(unsigned* p, unsigned v) { return __hip_atomic_fetch_add(p, v, __ATOMIC_RELAXED, __HIP_MEMORY_SCOPE_AGENT); }
__device__ __forceinline__ unsigned xb_xcc_id() { return (unsigned)__builtin_amdgcn_s_getreg((3 << 11) | 20) & 0xFu; }
#define XB_SPIN(cond, bar) do { unsigned _sp = 0; while (cond) { __builtin_amdgcn_s_sleep(1); \
    if ((++_sp & 255u) == 0u) { if (xb_ld(&(bar)[XB_TMO])) break; if (_sp > XB_SPIN_CAP) { atomicAdd(&(bar)[XB_TMO], 1u); break; } } } } while (0)

struct XcdBarrier { unsigned* bar; unsigned x; volatile LAS unsigned* st; };

__device__ __forceinline__ XcdBarrier xcd_barrier_post(unsigned* bar, volatile LAS unsigned* st) {
    XcdBarrier b; b.bar = bar; b.x = xb_xcc_id(); b.st = st;
    if (threadIdx.x == 0) (void)xb_add(&bar[XB_XCNT(b.x)], 1u);
    return b;
}
__device__ __forceinline__ void xcd_barrier_complete(unsigned* bar, unsigned x, unsigned& nloc, unsigned& nx) {
    const unsigned G = gridDim.x * gridDim.y * gridDim.z;
    unsigned sum, cnt, mine, sp = 0u;
    for (;;) {
        sum = 0u; cnt = 0u; mine = 0u;
#pragma unroll
        for (unsigned j = 0; j < 16; ++j) { const unsigned c = xb_ld(&bar[XB_XCNT(j)]); sum += c; cnt += (c > 0u) ? 1u : 0u; mine = (j == x) ? c : mine; }
        if (sum == G) break;
        __builtin_amdgcn_s_sleep(1);
        if ((++sp & 255u) == 0u) { if (xb_ld(&bar[XB_TMO])) break; if (sp > XB_SPIN_CAP) { atomicAdd(&bar[XB_TMO], 1u); break; } }
    }
    nloc = mine > 0u ? mine : 1u; nx = cnt > 0u ? cnt : 1u;
}
__device__ __forceinline__ void xcd_barrier(const XcdBarrier& b) {
    asm volatile("s_waitcnt vmcnt(0)" ::: "memory");
    __syncthreads();
    if (threadIdx.x == 0) {
        unsigned* bar = b.bar;
        __builtin_amdgcn_s_waitcnt(0);
        unsigned nloc = b.st[0], nx = b.st[1];
        if (nloc == 0u) { xcd_barrier_complete(bar, b.x, nloc, nx); b.st[0] = nloc; b.st[1] = nx; }
        const unsigned old = xb_add(&bar[XB_XSUB(b.x)], 1u);
        const unsigned gen = old / nloc;
        if (old + 1u == (gen + 1u) * nloc) {
            __builtin_amdgcn_fence(__ATOMIC_RELEASE, "agent");
            asm volatile("s_waitcnt vmcnt(0)" ::: "memory");
            const unsigned og = xb_add(&bar[XB_TOP], 1u);
            const unsigned tg = og / nx;
            if (og + 1u == (tg + 1u) * nx) xb_add(&bar[XB_TOPGEN], 1u);
            else XB_SPIN(xb_ld(&bar[XB_TOPGEN]) == tg, bar);
            __builtin_amdgcn_fence(__ATOMIC_ACQUIRE, "agent");
            xb_add(&bar[XB_XGEN(b.x)], 1u);
            asm volatile("s_waitcnt vmcnt(0)" ::: "memory");
        } else {
            XB_SPIN(xb_ld(&bar[XB_XGEN(b.x)]) == gen, bar);
            __builtin_amdgcn_fence(__ATOMIC_ACQUIRE, "agent");
            asm volatile("s_waitcnt vmcnt(0)" ::: "memory");
        }
    }
    __syncthreads();
}

constexpr int LDS_BYTES = 163840;
constexpr int LDS_BAR_OFF = LDS_BYTES - 64;
constexpr int CW_BAR = 4096;

__global__ void __launch_bounds__(NTHREADS, 2) mk_fwd(Prm p_unused) {
    extern __shared__ __attribute__((aligned(16))) unsigned char lds_raw[];
    LAS unsigned char* lds = (LAS unsigned char*)lds_raw;
    const int wg = blockIdx.x, nwg = gridDim.x;
    if (threadIdx.x < 4) ((LAS unsigned*)(lds + LDS_BAR_OFF))[threadIdx.x] = 0u;
    __syncthreads();
    (void)xcd_barrier_post((unsigned*)(prm_fresh()->ws + WS_CTL) + CW_BAR, (volatile LAS unsigned*)(lds + LDS_BAR_OFF));
#define GRID_BAR() do { XcdBarrier b_; b_.bar = (unsigned*)(prm_fresh()->ws + WS_CTL) + CW_BAR; b_.x = xb_xcc_id(); b_.st = (volatile LAS unsigned*)(lds + LDS_BAR_OFF); xcd_barrier(b_); } while (0)
#ifndef REP_PHASE
#define REP_PHASE -1
#endif
#define PHASE(id, call) do { call; GRID_BAR(); if (REP_PHASE == (id)) { call; GRID_BAR(); } } while (0)
    PHASE(0, (ph_prologue(prm_fresh(), lds, wg, nwg), ph_tables(prm_fresh(), wg, nwg)));
#define MK_LAYER(l) do { \
        if ((l) == 0) PHASE(1, ph_norm1(prm_fresh(), l, wg, nwg));     \
        PHASE(2, fg_gemm_in(prm_fresh(), l, lds, wg, nwg)); \
        PHASE(3, fs_scan(prm_fresh(), l, lds, wg, nwg)); \
        fa_attn(prm_fresh(), l, lds, wg, nwg); GRID_BAR(); \
        PHASE(5, fs_fin(prm_fresh(), l, lds, wg, nwg)); \
        PHASE(6, fg_gemm_out(prm_fresh(), l, lds, wg, nwg)); \
        ph_row(prm_fresh(), l, lds, wg, nwg); GRID_BAR(); \
        PHASE(8, ph_offs(prm_fresh(), l, lds, wg, nwg)); \
        PHASE(9, fg_gemm1(prm_fresh(), l, lds, wg, nwg)); \
        PHASE(10, fg_gemm2(prm_fresh(), l, lds, wg, nwg)); \
        ph_comb(prm_fresh(), l, wg, nwg); if ((l) + 1 < NL) GRID_BAR(); } while (0)
    MK_LAYER(0);
    MK_LAYER(1);
#undef MK_LAYER
}

extern "C" void kernel_launch(void* const* d_in, const int* in_sizes, int n_in, void* d_out, int out_size, void* d_ws, size_t ws_size, hipStream_t stream) {
    if (n_in != N_IN || out_size != M * D || ws_size < WS_END) { fprintf(stderr, "kernel_launch: unexpected shapes: n_in %d out %d ws %zu (need %zu)\n", n_in, out_size, ws_size, (size_t)WS_END); return; }
    Prm p{};
    for (int i = 0; i < N_IN; ++i) p.in[i] = (const float*)d_in[i];
    p.out = (float*)d_out; p.ws = (unsigned char*)d_ws;
    (void)hipMemsetAsync((char*)d_ws + WS_CTL, 0, 1 * MiB, stream);
    static int grid = 0;
    if (grid == 0) {
        int dev = 0, cus = 0, per_cu = 0;
        if (hipGetDevice(&dev) != hipSuccess || hipDeviceGetAttribute(&cus, hipDeviceAttributeMultiprocessorCount, dev) != hipSuccess) { fprintf(stderr, "kernel_launch: device query failed\n"); grid = -1; return; }
        if (hipFuncSetAttribute((const void*)mk_fwd, hipFuncAttributeMaxDynamicSharedMemorySize, LDS_BYTES) != hipSuccess) { fprintf(stderr, "kernel_launch: hipFuncSetAttribute failed\n"); grid = -1; return; }
        if (hipOccupancyMaxActiveBlocksPerMultiprocessor(&per_cu, (const void*)mk_fwd, NTHREADS, LDS_BYTES) != hipSuccess || per_cu < 1) fprintf(stderr, "kernel_launch: occupancy query reports %d\n", per_cu);
        (void)hipGetLastError();
        grid = 256;
        if (cus < 256) fprintf(stderr, "kernel_launch: %d CUs: 256 workgroups of 144 KiB LDS cannot all be resident\n", cus);
    }
    if (grid < 0) return;
    hipLaunchKernelGGL(mk_fwd, dim3(grid), dim3(NTHREADS), LDS_BYTES, stream, p);
}
```

```cpp
#include <hip/hip_runtime.h>
#include <stdint.h>
#include <stdio.h>

#define LAS __attribute__((address_space(3)))
typedef unsigned short bf16_t;
typedef short bf16x8 __attribute__((ext_vector_type(8)));
typedef float f32x4 __attribute__((ext_vector_type(4)));
typedef unsigned u32x4 __attribute__((ext_vector_type(4)));
typedef unsigned u32x2 __attribute__((ext_vector_type(2)));

constexpr int NB = 4, T = 8192, D = 1024, M = NB * T, NL = 2;
constexpr int INC = 2312, NP = 2560;
constexpr int C_LX = 0, C_LG = 256, C_S5 = 512, C_Q = 768, C_K = 1280, C_V = 1792, C_F = 2304;
constexpr int NH = 8, HD = 64, NE = 32, TOPK = 4, DFF = 1024;
constexpr int RP = M * TOPK + NE * 256;
constexpr float C2 = 0.125f * 1.4426950408889634f;
constexpr float LOG2E = 1.4426950408889634f;
constexpr float RMS_EPS = 1e-6f;
constexpr int NTHREADS = 512, NWAVES = 8;
#ifndef FAST_ATTN
#define FAST_ATTN 1
#endif
#ifndef YR_FP8
#define YR_FP8 1
#endif
#ifndef F8_ALLV
#define F8_ALLV 1
#endif
#ifndef EXPERT_FP8
#define OUT_FP8 1
#define EXPERT_FP8 1
#endif

enum { I_X = 0, I_C, I_ADAW, I_ADAB, I_PREMIXG, I_WIN, I_CONVW, I_CONVB, I_LRUWA, I_LRUBA, I_LRUWX, I_LRUBX, I_LAMBDA, I_S5ARE, I_S5AIM, I_S5BRE, I_S5BIM,
       I_S5CRE, I_S5CIM, I_S5D, I_S5LOGDT, I_GLUW, I_GLUB, I_FOXFB, I_GNLRU, I_GNS5, I_GNATT, I_WOUT, I_POSTMIXG, I_PREFFNG, I_ROUTW, I_ROUTB, I_WGU, I_BGU,
       I_WDN, I_BDN, I_POSTFFNG, N_IN };

constexpr size_t MiB = 1u << 20;
constexpr size_t WS_CTL = 0;
constexpr size_t WS_MOD = 1 * MiB;
constexpr size_t WS_MISC = 2 * MiB;
constexpr size_t WS_FC2 = 6 * MiB;
constexpr size_t WS_WIN = 8 * MiB;
constexpr size_t WS_WOUT = 18 * MiB;
constexpr size_t WS_WGU = 22 * MiB;
constexpr size_t WS_WDN = 278 * MiB;
constexpr size_t WS_HB = 406 * MiB;
constexpr size_t WS_PB = 470 * MiB;
constexpr size_t WS_YL = 630 * MiB;
constexpr size_t WS_YS0 = 662 * MiB;
constexpr size_t WS_OA = 694 * MiB;
constexpr size_t WS_AGG = WS_OA;
constexpr size_t WS_XEND = WS_OA + 2 * MiB;
constexpr size_t WS_GLUW = WS_OA + 8 * MiB;
constexpr size_t WS_X4END = WS_OA + 7 * MiB;
constexpr size_t WS_S5T = WS_OA + 10 * MiB;
constexpr size_t WS_LRUW = WS_OA + 9 * MiB;
constexpr size_t WS_YC = 758 * MiB;
constexpr size_t WS_Y = 822 * MiB;
constexpr size_t WS_XS = 950 * MiB;
constexpr size_t WS_XB = WS_XS;
constexpr size_t WS_H1 = 1222 * MiB;
constexpr size_t WS_YR = 1494 * MiB;
constexpr size_t WS_END = 1766 * MiB;
constexpr size_t MS_ROWTOK = 2560 * 1024;
constexpr size_t MS_TOPI = 0, MS_TOPG = 512 * 1024, MS_RANK = 1024 * 1024, MS_POS = 1536 * 1024, MS_HIST = 2048 * 1024, MS_TILEE = 2048 * 1024 + 64 * 1024;
constexpr int CW_NT = 8;
constexpr int CW_QN = 16384, CW_KT = 32768;
constexpr int CW_NRM = 8192;

struct Prm { const float* in[N_IN]; float* out; unsigned char* ws; };
__device__ __forceinline__ int fresh_tid() { int t = threadIdx.x; asm volatile("" : "+v"(t)); return t; }
typedef const __attribute__((address_space(4))) Prm* PrmP;
__device__ __forceinline__ PrmP prm_fresh() { PrmP q = (PrmP)__builtin_amdgcn_kernarg_segment_ptr(); asm volatile("" : "+s"(q)); return q; }

typedef float f32x2h_ __attribute__((ext_vector_type(2))); typedef __bf16 bf16x2h_ __attribute__((ext_vector_type(2)));
__device__ __forceinline__ unsigned pk2(float lo, float hi) { const f32x2h_ v = {lo, hi}; return __builtin_bit_cast(unsigned, __builtin_convertvector(v, bf16x2h_)); }
__device__ __forceinline__ unsigned f2bf(float f) { return pk2(f, 0.f) & 0xffffu; }
__device__ __forceinline__ float bf2f(unsigned v) { return __builtin_bit_cast(float, v << 16); }
__device__ __forceinline__ float bflo(unsigned w) { return __builtin_bit_cast(float, w << 16); }
__device__ __forceinline__ float bfhi(unsigned w) { return __builtin_bit_cast(float, w & 0xffff0000u); }
template <int CTRL> __device__ __forceinline__ float dppf(float x) { return __builtin_bit_cast(float, __builtin_amdgcn_update_dpp(0, __builtin_bit_cast(int, x), CTRL, 0xf, 0xf, true)); }
constexpr int DPP_XOR1 = 0xB1, DPP_XOR2 = 0x4E, DPP_REV4 = 0x1B, DPP_HMIRROR = 0x141, DPP_MIRROR = 0x140, DPP_ROR8 = 0x128;
__device__ __forceinline__ float wave_sum(float v) {
    v += dppf<DPP_XOR1>(v); v += dppf<DPP_XOR2>(v); v += dppf<DPP_HMIRROR>(v); v += dppf<DPP_MIRROR>(v);
    const auto s = __builtin_amdgcn_permlane16_swap(__float_as_uint(v), __float_as_uint(v), false, false); v = __uint_as_float(s[0]) + __uint_as_float(s[1]);
    const auto t = __builtin_amdgcn_permlane32_swap(__float_as_uint(v), __float_as_uint(v), false, false); return __uint_as_float(t[0]) + __uint_as_float(t[1]);
}
__device__ __forceinline__ float wave_max(float v) {
    v = fmaxf(v, dppf<DPP_XOR1>(v)); v = fmaxf(v, dppf<DPP_XOR2>(v)); v = fmaxf(v, dppf<DPP_HMIRROR>(v)); v = fmaxf(v, dppf<DPP_MIRROR>(v));
    const auto s = __builtin_amdgcn_permlane16_swap(__float_as_uint(v), __float_as_uint(v), false, false); v = fmaxf(__uint_as_float(s[0]), __uint_as_float(s[1]));
    const auto t = __builtin_amdgcn_permlane32_swap(__float_as_uint(v), __float_as_uint(v), false, false); return fmaxf(__uint_as_float(t[0]), __uint_as_float(t[1]));
}
__device__ __forceinline__ float sigmoidf_(float x) { return __builtin_amdgcn_rcpf(1.f + __expf(-x)); }
__device__ __forceinline__ float gelu_tanh(float x) { const float u = 0.7978845608028654f * (x + 0.044715f * x * x * x); return x * sigmoidf_(2.f * u); }

__device__ __forceinline__ void tr_item(const float* W, int ldw, int nvalid, int k0, int n0, bf16_t* dst, float scale, LAS float* scr, int lane, int ldd = 1024) {
    const int nn = n0 + (lane & 31); const bool ok = nn < nvalid;
    float wv[32];
#pragma unroll
    for (int i = 0; i < 32; ++i) { const int kk = 2 * i + (lane >> 5); wv[i] = ok ? W[(size_t)(k0 + kk) * ldw + nn] : 0.f; }
#pragma unroll
    for (int i = 0; i < 32; ++i) { const int kk = 2 * i + (lane >> 5); scr[kk * 33 + (lane & 31)] = wv[i] * scale; }
    asm volatile("s_waitcnt lgkmcnt(0)" ::: "memory");
    const int c = lane & 7;
#pragma unroll
    for (int j = 0; j < 4; ++j) { const int n = (lane >> 3) + 8 * j; const LAS float* s = scr + (8 * c) * 33 + n;
        u32x4 o; o.x = pk2(s[0 * 33], s[1 * 33]); o.y = pk2(s[2 * 33], s[3 * 33]); o.z = pk2(s[4 * 33], s[5 * 33]); o.w = pk2(s[6 * 33], s[7 * 33]);
        *(u32x4*)(dst + (size_t)n * ldd + k0 + 8 * c) = o; }
    asm volatile("s_waitcnt lgkmcnt(0)" ::: "memory");
}

__device__ __forceinline__ unsigned pk4_fp8(float a, float b, float c, float d) { int w = __builtin_amdgcn_cvt_pk_fp8_f32(a, b, 0, false); w = __builtin_amdgcn_cvt_pk_fp8_f32(c, d, w, true); return (unsigned)w; }
__device__ __forceinline__ void tr_item8w(const float* W, int ldw, int k0, int n0, unsigned char* dst, float scale, LAS float* scr, int lane) {
#pragma unroll 1
    for (int hh = 0; hh < 2; ++hh) { f32x4 v[8];
#pragma unroll
      for (int i = 0; i < 8; ++i) v[i] = *(const f32x4*)(W + (size_t)(k0 + hh * 32 + (lane >> 4) + 4 * i) * ldw + n0 + 4 * (lane & 15));
#pragma unroll
      for (int i = 0; i < 8; ++i) { LAS float* d = scr + (hh * 32 + (lane >> 4) + 4 * i) * 65 + 4 * (lane & 15); d[0] = v[i].x * scale; d[1] = v[i].y * scale; d[2] = v[i].z * scale; d[3] = v[i].w * scale; } }
    asm volatile("s_waitcnt lgkmcnt(0)" ::: "memory");
    const int kq = lane & 3;
#pragma unroll
    for (int j = 0; j < 4; ++j) { const int n = (lane >> 2) + 16 * j; const LAS float* s = scr + (16 * kq) * 65 + n;
        u32x4 o; o.x = pk4_fp8(s[0 * 65], s[1 * 65], s[2 * 65], s[3 * 65]); o.y = pk4_fp8(s[4 * 65], s[5 * 65], s[6 * 65], s[7 * 65]);
        o.z = pk4_fp8(s[8 * 65], s[9 * 65], s[10 * 65], s[11 * 65]); o.w = pk4_fp8(s[12 * 65], s[13 * 65], s[14 * 65], s[15 * 65]);
        *(u32x4*)(dst + (size_t)n * 1024 + k0 + 16 * kq) = o; }
    asm volatile("s_waitcnt lgkmcnt(0)" ::: "memory");
}
#ifndef PRO_PROBE
#define PRO_PROBE 0
#endif
template <int MODE> __device__ __forceinline__ void ex_convert(PrmP p, LAS float* scr, int gw, int NGW, int lane) {
    constexpr int I_GU = 16 * 32, I_DN = 16 * 16, NEX = 64 * I_GU + 64 * I_DN;
#define EX_ITEM(r_, src_, dst_, ldw_) do { int r2_ = (r_); if (r2_ < 64 * I_GU) { const int le = r2_ >> 9, q = r2_ & 511, kb = q >> 5, n0 = (q & 31) * 64; \
        const int sx = n0 >> 10, rr = n0 & 1023, j = rr >> 7, cc = rr & 127, drow = 256 * j + 128 * sx + cc; \
        ldw_ = 2048; src_ = p->in[I_WGU] + (size_t)le * 1024 * 2048 + (size_t)(kb * 64) * 2048 + n0; dst_ = p->ws + (MODE == 2 ? WS_YR : WS_WGU) + ((size_t)le * 2048 + drow) * 1024 + kb * 64; } \
      else { r2_ -= 64 * I_GU; const int le = r2_ >> 8, q = r2_ & 255, kb = q >> 4, n0 = (q & 15) * 64; \
        ldw_ = 1024; src_ = p->in[I_WDN] + (size_t)le * 1024 * 1024 + (size_t)(kb * 64) * 1024 + n0; dst_ = p->ws + (MODE == 2 ? WS_YR + 128 * MiB : WS_WDN) + ((size_t)le * 1024 + n0) * 1024 + kb * 64; } } while (0)
#define EX_LOAD(src_, ldw_) do { _Pragma("unroll") for (int i = 0; i < 16; ++i) { if (MODE == 2) v[i] = (f32x4){(float)i, (float)lane, 1.f, 2.f}; else v[i] = *(const f32x4*)((src_) + (size_t)((lane >> 4) + 4 * i) * (ldw_) + 4 * (lane & 15)); } } while (0)
    int r = gw;
    if (r < NEX) {
        const float* src; unsigned char* dst; int ldw; f32x4 v[16];
        EX_ITEM(r, src, dst, ldw); EX_LOAD(src, ldw);
#pragma unroll 1
        for (;;) {
#pragma unroll
            for (int i = 0; i < 16; ++i) { LAS float* d = scr + ((lane >> 4) + 4 * i) * 65 + 4 * (lane & 15); d[0] = v[i].x * 64.f; d[1] = v[i].y * 64.f; d[2] = v[i].z * 64.f; d[3] = v[i].w * 64.f; }
            const int rn = r + NGW; const bool more = rn < NEX; unsigned char* dcur = dst;
            if (more) { EX_ITEM(rn, src, dst, ldw); EX_LOAD(src, ldw); }
            asm volatile("s_waitcnt lgkmcnt(0)" ::: "memory");
            const int kq = lane & 3;
#pragma unroll
            for (int j = 0; j < 4; ++j) { const int n = (lane >> 2) + 16 * j; const LAS float* sp = scr + (16 * kq) * 65 + n;
                u32x4 o; o.x = pk4_fp8(sp[0 * 65], sp[1 * 65], sp[2 * 65], sp[3 * 65]); o.y = pk4_fp8(sp[4 * 65], sp[5 * 65], sp[6 * 65], sp[7 * 65]);
                o.z = pk4_fp8(sp[8 * 65], sp[9 * 65], sp[10 * 65], sp[11 * 65]); o.w = pk4_fp8(sp[12 * 65], sp[13 * 65], sp[14 * 65], sp[15 * 65]);
                if (MODE != 1 || (o.x == 0x12345678u && o.y == 0x9abcdef0u && o.z == 0x0fedcba9u)) *(u32x4*)(dcur + (size_t)n * 1024 + 16 * kq) = o; }
            asm volatile("s_waitcnt lgkmcnt(0)" ::: "memory");
            if (!more) break;
            r = rn;
        }
    }
#undef EX_ITEM
#undef EX_LOAD
}
constexpr int EXC_IMG = 256 * 128;
__device__ __forceinline__ void ex_convert_wg(PrmP p, LAS unsigned char* lds, int wg, int nwg) {
    const int tid = fresh_tid(), lane = tid & 63, wave = tid >> 6;
    constexpr int NGU = 64 * 8 * 8, NIT = NGU + 64 * 8 * 4;
#define EXW_ITEM(it_, src_, ldw_, dbase_, gu_, nb_) do { int r_ = (it_); if (r_ < NGU) { const int le = r_ >> 6, q = r_ & 63, kb = q >> 3; nb_ = q & 7; gu_ = 1; ldw_ = 2048; \
        src_ = p->in[I_WGU] + (size_t)le * 1024 * 2048 + (size_t)(kb * 128 + wave * 16) * 2048 + nb_ * 256 + 4 * lane; dbase_ = p->ws + WS_WGU + (size_t)le * 2048 * 1024 + kb * 128; } \
      else { r_ -= NGU; const int le = r_ >> 5, q = r_ & 31, kb = q >> 2; nb_ = q & 3; gu_ = 0; ldw_ = 1024; \
        src_ = p->in[I_WDN] + (size_t)le * 1024 * 1024 + (size_t)(kb * 128 + wave * 16) * 1024 + nb_ * 256 + 4 * lane; dbase_ = p->ws + WS_WDN + (size_t)le * 1024 * 1024 + kb * 128; } } while (0)
#define EXW_LOAD(src_, ldw_) do { _Pragma("unroll") for (int i = 0; i < 16; ++i) v[i] = *(const f32x4*)((src_) + (size_t)i * (ldw_)); } while (0)
    int it = wg; if (it >= NIT) return;
    const float* src; unsigned char* dbase; int ldw, gu, nb; f32x4 v[16];
    EXW_ITEM(it, src, ldw, dbase, gu, nb); EXW_LOAD(src, ldw);
    int buf = 0;
#pragma unroll 1
    for (;;) {
        LAS unsigned char* img = lds + buf * EXC_IMG;
#pragma unroll
        for (int q = 0; q < 4; ++q) { u32x4 o;
            o.x = pk4_fp8(v[0][q] * 64.f, v[1][q] * 64.f, v[2][q] * 64.f, v[3][q] * 64.f); o.y = pk4_fp8(v[4][q] * 64.f, v[5][q] * 64.f, v[6][q] * 64.f, v[7][q] * 64.f);
            o.z = pk4_fp8(v[8][q] * 64.f, v[9][q] * 64.f, v[10][q] * 64.f, v[11][q] * 64.f); o.w = pk4_fp8(v[12][q] * 64.f, v[13][q] * 64.f, v[14][q] * 64.f, v[15][q] * 64.f);
            *(LAS u32x4*)(img + (4 * lane + q) * 128 + ((wave ^ (lane & 7)) << 4)) = o; }
        const int itn = it + nwg; const bool more = itn < NIT; unsigned char* dcur = dbase; const int gucur = gu, nbcur = nb;
        if (more) { EXW_ITEM(itn, src, ldw, dbase, gu, nb); EXW_LOAD(src, ldw); }
        __syncthreads();
#pragma unroll
        for (int j = 0; j < 4; ++j) { const int pidx = tid + 512 * j, n = pidx >> 3, pc = pidx & 7;
            const u32x4 o = *(const LAS u32x4*)(img + n * 128 + ((pc ^ ((n >> 2) & 7)) << 4));
            const int ncol = nbcur * 256 + n; const int drow = gucur ? (256 * ((ncol & 1023) >> 7) + 128 * (ncol >> 10) + (ncol & 127)) : ncol;
            *(u32x4*)(dcur + (size_t)drow * 1024 + 16 * pc) = o; }
        if (!more) break;
        it = itn; buf ^= 1;
    }
#undef EXW_ITEM
#undef EXW_LOAD
}
__device__ __forceinline__ void ph_prologue(PrmP p, LAS unsigned char* lds, int wg, int nwg) {
    const int tid = fresh_tid(), lane = tid & 63, wave = tid >> 6;
    {
        LAS float* sc = (LAS float*)lds; LAS float* red = sc + 4096;
        const float* c = p->in[I_C];
        for (int i = tid; i < 4096; i += NTHREADS) { const float v = c[i]; sc[i] = v / (1.f + __expf(-v)); }
        __syncthreads();
        float* MOD = (float*)(p->ws + WS_MOD);
        for (int it = wg; it < 2 * 96; it += nwg) {
            const int l = it / 96, n0 = (it % 96) * 64, kg = tid >> 6, nl = tid & 63;
            const float* W = p->in[I_ADAW] + (size_t)l * 1024 * 6144 + n0 + nl;
            float a0 = 0.f, a1 = 0.f, a2 = 0.f, a3 = 0.f;
            for (int k0 = kg; k0 < 1024; k0 += 8 * 32) { float w[32];
#pragma unroll
                for (int q = 0; q < 32; ++q) w[q] = W[(size_t)(k0 + 8 * q) * 6144];
#pragma unroll
                for (int q = 0; q < 32; ++q) { const int k = k0 + 8 * q; a0 += sc[k] * w[q]; a1 += sc[1024 + k] * w[q]; a2 += sc[2048 + k] * w[q]; a3 += sc[3072 + k] * w[q]; } }
            red[(kg * 4 + 0) * 64 + nl] = a0; red[(kg * 4 + 1) * 64 + nl] = a1; red[(kg * 4 + 2) * 64 + nl] = a2; red[(kg * 4 + 3) * 64 + nl] = a3;
            __syncthreads();
            if (tid < 256) { const int b = tid >> 6; float s = 0.f;
#pragma unroll
                for (int g = 0; g < 8; ++g) s += red[(g * 4 + b) * 64 + nl];
                MOD[(size_t)(l * 4 + b) * 6144 + n0 + nl] = s + p->in[I_ADAB][l * 6144 + n0 + nl]; }
            __syncthreads();
        }
    }
    {
        LAS float* scr = (LAS float*)lds + wave * (64 * 65);
        const int gw = wave * nwg + wg, NGW = nwg * NWAVES;
        constexpr int I_IN = 16 * 80, I_OUT = OUT_FP8 ? 16 * 16 : 16 * 32, I_GU = EXPERT_FP8 ? 16 * 32 : 16 * 64, I_DN = EXPERT_FP8 ? 16 * 16 : 16 * 32;
        constexpr int I_GLU = 4 * 8;
        constexpr int I_LRU = 4 * 2 * 2;
        constexpr int NGU = EXPERT_FP8 ? 0 : 64 * I_GU, NDN = EXPERT_FP8 ? 0 : 64 * I_DN;
        constexpr int TOT = 2 * I_IN + 2 * I_OUT + NGU + NDN + 2 * I_GLU + 2 * I_LRU;
        for (int it = gw; it < TOT; it += NGW) {
            int r = it;
            if (r < 2 * I_IN) { const int l = r / I_IN, q = r % I_IN, kb = q / 80, nb = q % 80, n0 = nb * 32;
                const float sc = (n0 >= C_Q && n0 < C_K) ? C2 : 1.f;
                tr_item(p->in[I_WIN] + (size_t)l * 1024 * INC, INC, INC, kb * 64, n0, (bf16_t*)(p->ws + WS_WIN) + ((size_t)l * NP + n0) * 1024, sc, scr, lane); continue; }
            r -= 2 * I_IN;
            if (OUT_FP8 && r < 2 * I_OUT) { const int l = r / I_OUT, q = r % I_OUT, kb = q / 16, nb = q % 16;
                tr_item8w(p->in[I_WOUT] + (size_t)l * 1024 * 1024, 1024, kb * 64, nb * 64, p->ws + WS_WOUT + ((size_t)l * 1024 + nb * 64) * 1024, 64.f, scr, lane); continue; }
            if (r < 2 * I_OUT) { const int l = r / I_OUT, q = r % I_OUT, kb = q / 32, nb = q % 32, n0 = nb * 32;
                tr_item(p->in[I_WOUT] + (size_t)l * 1024 * 1024, 1024, 1024, kb * 64, n0, (bf16_t*)(p->ws + WS_WOUT) + ((size_t)l * 1024 + n0) * 1024, 1.f, scr, lane); continue; }
            r -= 2 * I_OUT;
            if (r < NGU) { const int le = r / I_GU, q = r % I_GU, NBK = EXPERT_FP8 ? 32 : 64, kb = q / NBK, nb = q % NBK, n0 = nb * (2048 / NBK);
                const int s = n0 / 1024, rr = n0 % 1024, j = rr / 128, cc = rr % 128, drow = 256 * j + 128 * s + cc;
                if (EXPERT_FP8) tr_item8w(p->in[I_WGU] + (size_t)le * 1024 * 2048, 2048, kb * 64, n0, p->ws + WS_WGU + ((size_t)le * 2048 + drow) * 1024, 64.f, scr, lane);
                else tr_item(p->in[I_WGU] + (size_t)le * 1024 * 2048, 2048, 2048, kb * 64, n0, (bf16_t*)(p->ws + WS_WGU) + ((size_t)le * 2048 + drow) * 1024, 1.f, scr, lane); continue; }
            r -= NGU;
            if (r < NDN) { const int le = r / I_DN, q = r % I_DN, NBK = EXPERT_FP8 ? 16 : 32, kb = q / NBK, nb = q % NBK, n0 = nb * (1024 / NBK);
                if (EXPERT_FP8) tr_item8w(p->in[I_WDN] + (size_t)le * 1024 * 1024, 1024, kb * 64, n0, p->ws + WS_WDN + ((size_t)le * 1024 + n0) * 1024, 64.f, scr, lane);
                else tr_item(p->in[I_WDN] + (size_t)le * 1024 * 1024, 1024, 1024, kb * 64, n0, (bf16_t*)(p->ws + WS_WDN) + ((size_t)le * 1024 + n0) * 1024, 1.f, scr, lane); continue; }
            r -= NDN;
            if (r < 2 * I_GLU) { const int l = r / I_GLU, q = r % I_GLU, kb = q / 8, nb = q % 8, n0 = nb * 32;
                tr_item(p->in[I_GLUW] + (size_t)l * 256 * 256, 256, 256, kb * 64, n0, (bf16_t*)(p->ws + WS_GLUW) + ((size_t)l * 256 + n0) * 256, 1.f, scr, lane, 256); continue; }
            r -= 2 * I_GLU;
            { const int l = r / I_LRU, q = r % I_LRU, blk = q >> 2, gate = (q >> 1) & 1, n0 = (q & 1) * 32;
                tr_item(p->in[gate ? I_LRUWX : I_LRUWA] + (size_t)(l * 4 + blk) * 4096, 64, 64, 0, n0, (bf16_t*)(p->ws + WS_LRUW) + ((size_t)((l * 4 + blk) * 2 + gate) * 64 + n0) * 64, 1.f, scr, lane, 64); }
        }
#if EXPERT_FP8
        __syncthreads();
        ex_convert_wg(p, lds, wg, nwg);
#endif
    }
}

__device__ __forceinline__ void ph_norm1(PrmP p, int l, int wg, int nwg) {
    const int tid = fresh_tid(), lane = tid & 63, wave = tid >> 6;
    const float* X = (l == 0) ? p->in[I_X] : p->out;
    const float* MOD = (const float*)(p->ws + WS_MOD);
    bf16_t* HB = (bf16_t*)(p->ws + WS_HB);
    const int R = M / nwg, RPW = R / NWAVES, mbeg = wg * R + wave * RPW, b = (wg * R) / T;
    f32x4 cg[4], csh[4];
    { const float* shift = MOD + (size_t)(l * 4 + b) * 6144 + 0 * 1024; const float* scale = shift + 1024; const float* g = p->in[I_PREMIXG] + l * 1024;
#pragma unroll
      for (int j = 0; j < 4; ++j) { const int c = 4 * lane + 256 * j; cg[j] = *(const f32x4*)(g + c) * (*(const f32x4*)(scale + c) + 1.f); csh[j] = *(const f32x4*)(shift + c); } }
    f32x4 vn[4];
#pragma unroll
    for (int j = 0; j < 4; ++j) vn[j] = *(const f32x4*)(X + (size_t)mbeg * 1024 + 4 * lane + 256 * j);
    for (int m = mbeg; m < mbeg + RPW; ++m) {
        f32x4 v[4]; float ss = 0.f;
#pragma unroll
        for (int j = 0; j < 4; ++j) { v[j] = vn[j]; ss += (v[j].x * v[j].x + v[j].y * v[j].y) + (v[j].z * v[j].z + v[j].w * v[j].w); }
        if (m + 1 < mbeg + RPW) {
#pragma unroll
            for (int j = 0; j < 4; ++j) vn[j] = *(const f32x4*)(X + (size_t)(m + 1) * 1024 + 4 * lane + 256 * j); }
        const float rstd = __builtin_amdgcn_rsqf(wave_sum(ss) * (1.f / 1024.f) + RMS_EPS);
#pragma unroll
        for (int j = 0; j < 4; ++j) { const int c = 4 * lane + 256 * j;
            const f32x4 h = v[j] * rstd * cg[j] + csh[j];
            u32x2 o; o.x = pk2(h.x, h.y); o.y = pk2(h.z, h.w); *(u32x2*)(HB + (size_t)m * 1024 + c) = o; }
    }
}

namespace pg8 {
#define PG8_LAS __attribute__((address_space(3)))
typedef unsigned short bf16_t;
typedef short bf16x8 __attribute__((ext_vector_type(8)));
typedef float f32x4 __attribute__((ext_vector_type(4)));
typedef unsigned u32x4 __attribute__((ext_vector_type(4)));
constexpr int BM = 256, BK = 64, HALF = 128, HTB = HALF * BK * 2  , STAGE_BYTES = 8 * HTB, NXCD = 8, WGM = 8;

__host__ __device__ __forceinline__ int lds_byte(int r, int c) { const int st = (r >> 4) * 2 + (c >> 5), rr = r & 15, cc = c & 31, ob = rr * 64 + cc * 2; return st * 1024 + (ob ^ (((ob >> 9) & 1) << 5)); }
__host__ __device__ __forceinline__ void stage_rc(int b, int& R, int& C) { const int st = b / 1024, sb = b % 1024, swz = sb ^ (((sb >> 9) & 1) << 5); R = (st >> 1) * 16 + swz / 64; C = (st & 1) * 32 + (swz % 64) / 2; }
__host__ __device__ __forceinline__ int perm32(int rho) { const int n = rho >> 4, i = rho & 15; return 8 * (i >> 2) + 4 * n + (i & 3); }

struct Unit { int pm, pn; };
struct Gemm { const bf16_t* A; const bf16_t* Bt; int M, N, K; const PG8_LAS unsigned short* rowtok = nullptr; int a_pitch = 0, a_kstep = 0; };

struct StaticOrder {
    int nM, nN, nwg, G, c;
    __host__ __device__ void init(int M, int N, int G_, int c_) { nM = M / BM; nN = N / BM; nwg = nM * nN; G = G_; c = c_; }
    __host__ __device__ bool next(int i, Unit& u) const {
        const long L = (long)i * G + c; if (L >= nwg) return false;
        int wgid = (int)L; { const int q = nwg / NXCD, r = nwg % NXCD, xcd = wgid % NXCD, off = wgid / NXCD; wgid = (xcd < r ? xcd * (q + 1) : r * (q + 1) + (xcd - r) * q) + off; }
        const int nig = WGM * nN, gid = wgid / nig, fm = gid * WGM, gsz = (nM - fm) < WGM ? (nM - fm) : WGM;
        u.pm = fm + ((wgid % nig) % gsz); u.pn = (wgid % nig) / gsz; return true;
    }
    __device__ __forceinline__ void a_ready(const Unit&) const {}
    __device__ __forceinline__ void done(const Unit&) const {}
};


__device__ __forceinline__ unsigned cvt_pk_bf16(float lo, float hi) { unsigned r; asm volatile("v_cvt_pk_bf16_f32 %0, %1, %2" : "=v"(r) : "v"(lo), "v"(hi)); return r; }
struct EpiBf16Plain {
    static constexpr bool PERM = true, AFTER_DRAIN = false, PERM64 = false; static constexpr int NVM = 0;
    bf16_t* O; int ldc;
    __device__ __forceinline__ void operator()(const f32x4 (&acc)[2][2][4][2], const Unit& u, int wr, int wc, int fr, int fq, int) const {
        const int row0 = u.pm * BM + wr * 64 + fr, col0 = u.pn * BM + wc * 32 + 8 * fq;
#pragma unroll
        for (int ai = 0; ai < 2; ++ai)
#pragma unroll
            for (int m = 0; m < 4; ++m) { bf16_t* rowp = O + (size_t)(row0 + ai * HALF + m * 16) * ldc + col0;
#pragma unroll
                for (int bj = 0; bj < 2; ++bj) { const f32x4 v0 = acc[ai][bj][m][0], v1 = acc[ai][bj][m][1];
                    u32x4 w; w.x = cvt_pk_bf16(v0[0], v0[1]); w.y = cvt_pk_bf16(v0[2], v0[3]); w.z = cvt_pk_bf16(v1[0], v1[1]); w.w = cvt_pk_bf16(v1[2], v1[3]);
                    *(u32x4*)(rowp + bj * HALF) = w; } }
    }
};
struct EpiSwiglu {
    static constexpr bool PERM = true, AFTER_DRAIN = false, PERM64 = false; static constexpr int NVM = 0;
    bf16_t* H1; const float* bgu;
    __device__ __forceinline__ void operator()(const f32x4 (&acc)[2][2][4][2], const Unit& u, int wr, int wc, int fr, int fq, int) const {
        const int j = u.pn & 7, row0 = u.pm * BM + wr * 64 + fr, lc0 = wc * 32 + 8 * fq;
        const float* bb = bgu + (size_t)(u.pn >> 3) * 2048 + j * 128 + lc0;
        const f32x4 bg0 = *(const f32x4*)(bb), bg1 = *(const f32x4*)(bb + 4), bu0 = *(const f32x4*)(bb + 1024), bu1 = *(const f32x4*)(bb + 1028);
#pragma unroll
        for (int ai = 0; ai < 2; ++ai)
#pragma unroll
            for (int m = 0; m < 4; ++m) { float o[8];
#pragma unroll
                for (int n = 0; n < 2; ++n) { const f32x4 g4 = acc[ai][0][m][n] + (n ? bg1 : bg0), u4 = acc[ai][1][m][n] + (n ? bu1 : bu0);
#pragma unroll
                    for (int q = 0; q < 4; ++q) { const float g = fminf(g4[q], 7.f), up = fminf(fmaxf(u4[q], -7.f), 7.f);
                        o[4 * n + q] = (up + 1.f) * g * __builtin_amdgcn_rcpf(1.f + __builtin_amdgcn_exp2f(-1.702f * 1.4426950408889634f * g)); } }
                u32x4 w; w.x = cvt_pk_bf16(o[0], o[1]); w.y = cvt_pk_bf16(o[2], o[3]); w.z = cvt_pk_bf16(o[4], o[5]); w.w = cvt_pk_bf16(o[6], o[7]);
                *(u32x4*)(H1 + (size_t)(row0 + ai * HALF + m * 16) * 1024 + j * 128 + lc0) = w; }
    }
};
__device__ __forceinline__ unsigned pk4_fp8(float a, float b, float c, float d) { int w = __builtin_amdgcn_cvt_pk_fp8_f32(a, b, 0, false); w = __builtin_amdgcn_cvt_pk_fp8_f32(c, d, w, true); return (unsigned)w; }
struct EpiSwiglu8 {
    static constexpr bool PERM = true, AFTER_DRAIN = false, PERM64 = false; static constexpr int NVM = 0;
    unsigned char* H1; const PG8_LAS float* bl;
    __device__ __forceinline__ void operator()(const f32x4 (&acc)[2][2][4][2], const Unit& u, int wr, int wc, int fr, int fq, int ui) const {
        const int j = u.pn & 7, row0 = u.pm * BM + wr * 64 + fr, lc0 = wc * 32 + 8 * fq;
        const PG8_LAS float* bb = bl + ui * 256 + lc0;
        const f32x4 bg0 = *(const PG8_LAS f32x4*)(bb), bg1 = *(const PG8_LAS f32x4*)(bb + 4), bu0 = *(const PG8_LAS f32x4*)(bb + 128), bu1 = *(const PG8_LAS f32x4*)(bb + 132);
#pragma unroll
        for (int ai = 0; ai < 2; ++ai)
#pragma unroll
            for (int m = 0; m < 4; ++m) { float o[8];
#pragma unroll
                for (int n = 0; n < 2; ++n) { const f32x4 ga = acc[ai][0][m][n], ua = acc[ai][1][m][n], gb = n ? bg1 : bg0, ub = n ? bu1 : bu0;
#pragma unroll
                    for (int hh = 0; hh < 2; ++hh) {
                        typedef float f2 __attribute__((ext_vector_type(2)));
                        f2 g = (f2){ga[2 * hh], ga[2 * hh + 1]} + (f2){gb[2 * hh], gb[2 * hh + 1]}, up = (f2){ua[2 * hh], ua[2 * hh + 1]} + (f2){ub[2 * hh], ub[2 * hh + 1]};
                        g.x = fminf(g.x, 7.f); g.y = fminf(g.y, 7.f); up.x = __builtin_amdgcn_fmed3f(up.x, -7.f, 7.f); up.y = __builtin_amdgcn_fmed3f(up.y, -7.f, 7.f);
                        const f2 t = g * (f2){-1.702f * 1.4426950408889634f, -1.702f * 1.4426950408889634f};
                        const f2 d = (f2){__builtin_amdgcn_exp2f(t.x), __builtin_amdgcn_exp2f(t.y)} + (f2){1.f, 1.f};
                        const f2 r = {__builtin_amdgcn_rcpf(d.x), __builtin_amdgcn_rcpf(d.y)};
                        const f2 a = __builtin_elementwise_fma(up, (f2){2.f, 2.f}, (f2){2.f, 2.f});
                        const f2 ov = (a * g) * r;
                        o[4 * n + 2 * hh] = ov.x; o[4 * n + 2 * hh + 1] = ov.y; } }
                typedef unsigned u32x2_ __attribute__((ext_vector_type(2))); u32x2_ w; w.x = pk4_fp8(o[0], o[1], o[2], o[3]); w.y = pk4_fp8(o[4], o[5], o[6], o[7]);
                *(u32x2_*)(H1 + ((size_t)(u.pm * 8 + j) * 256 + (wr * 64 + fr + ai * HALF + m * 16)) * 128 + lc0) = w; }
    }
};
struct EpiDown {
    static constexpr bool PERM = true, AFTER_DRAIN = false, PERM64 = false; static constexpr int NVM = 0;
    bf16_t* YR; const float* bdn;
    __device__ __forceinline__ void operator()(const f32x4 (&acc)[2][2][4][2], const Unit& u, int wr, int wc, int fr, int fq, int) const {
        const int jn = u.pn & 3, row0 = u.pm * BM + wr * 64 + fr, col0 = jn * BM + wc * 32 + 8 * fq;
        const float* bb = bdn + (size_t)(u.pn >> 2) * 1024 + col0;
        f32x4 bv[2][2]; bv[0][0] = *(const f32x4*)(bb); bv[0][1] = *(const f32x4*)(bb + 4); bv[1][0] = *(const f32x4*)(bb + HALF); bv[1][1] = *(const f32x4*)(bb + HALF + 4);
#pragma unroll
        for (int ai = 0; ai < 2; ++ai)
#pragma unroll
            for (int m = 0; m < 4; ++m) { bf16_t* rowp = YR + (size_t)(row0 + ai * HALF + m * 16) * 1024 + col0;
#pragma unroll
                for (int bj = 0; bj < 2; ++bj) { const f32x4 v0 = acc[ai][bj][m][0] + bv[bj][0], v1 = acc[ai][bj][m][1] + bv[bj][1];
                    u32x4 w; w.x = cvt_pk_bf16(v0[0], v0[1]); w.y = cvt_pk_bf16(v0[2], v0[3]); w.z = cvt_pk_bf16(v1[0], v1[1]); w.w = cvt_pk_bf16(v1[2], v1[3]);
                    *(u32x4*)(rowp + bj * HALF) = w; } }
    }
};
struct EpiDown8 {
    static constexpr bool PERM = true, AFTER_DRAIN = false, PERM64 = true; static constexpr int NVM = 0;
    unsigned char* YR; const PG8_LAS float* bl;
    __device__ __forceinline__ void operator()(const f32x4 (&acc)[2][2][4][2], const Unit& u, int wr, int wc, int fr, int fq, int ui) const {
        const int jn = u.pn & 3, row0 = u.pm * BM + wr * 64 + fr, col0 = jn * BM + wc * 32 + 8 * fq;
        const PG8_LAS float* bb = bl + ui * 256 + wc * 64 + 16 * fq;
        f32x4 bv[2][2]; bv[0][0] = *(const PG8_LAS f32x4*)(bb); bv[0][1] = *(const PG8_LAS f32x4*)(bb + 4); bv[1][0] = *(const PG8_LAS f32x4*)(bb + 8); bv[1][1] = *(const PG8_LAS f32x4*)(bb + 12);
#pragma unroll
        for (int ai = 0; ai < 2; ++ai)
#pragma unroll
            for (int m = 0; m < 4; ++m) { unsigned char* rowp = YR + ((size_t)(u.pm * 4 + jn) * 256 + (wr * 64 + fr + ai * HALF + m * 16)) * 256 + wc * 64 + 16 * fq;
                u32x4 w;
#pragma unroll
                for (int bj = 0; bj < 2; ++bj) { const f32x4 v0 = (acc[ai][bj][m][0] + bv[bj][0]) * 16.f, v1 = (acc[ai][bj][m][1] + bv[bj][1]) * 16.f;
                    w[2 * bj] = pk4_fp8(v0[0], v0[1], v0[2], v0[3]); w[2 * bj + 1] = pk4_fp8(v1[0], v1[1], v1[2], v1[3]); }
                *(u32x4*)rowp = w; }
    }
};
struct GroupOrder {
    int nt, nct, G, c; const PG8_LAS int* tile_e;
    __device__ __forceinline__ bool peek_pm(int i, int& rt) const { const int x = c & 7, j = c >> 3, rpg = 32 / nct, gi = i * 8 + x; rt = gi * rpg + j / nct; return G == 256 && rt < nt; }
    __device__ __forceinline__ bool next(int i, Unit& u) const {
        const int x = c & 7, j = c >> 3, rpg = 32 / nct, gi = i * 8 + x, rt = gi * rpg + j / nct, ct = j % nct;
        if (G != 256 || rt >= nt) return false;
        u.pm = rt; u.pn = tile_e[rt] * nct + ct; return true; }
    __device__ __forceinline__ void a_ready(const Unit&) const {}
    __device__ __forceinline__ void done(const Unit&) const {}
};

typedef int i32x8 __attribute__((ext_vector_type(8))); typedef int i32x4 __attribute__((ext_vector_type(4)));
__device__ __forceinline__ i32x8 cat8(bf16x8 lo, bf16x8 hi) { const i32x4 a = __builtin_bit_cast(i32x4, lo), b = __builtin_bit_cast(i32x4, hi); return __builtin_shufflevector(a, b, 0, 1, 2, 3, 4, 5, 6, 7); }
template <class Epi, class Sched, bool ALIGN_EPI = false, bool SP2 = false, int F8SCALE = 0, bool GATHER = false>
__device__ __forceinline__ void gemm_phase(PG8_LAS unsigned char* lds, const Gemm g, const Sched& S, const Epi& E) {
    const int tid = fresh_tid(), wid = __builtin_amdgcn_readfirstlane(tid >> 6), lane = tid & 63, wr = wid >> 2, wc = wid & 3, fr = lane & 15, fq = lane >> 4;
    const int K = g.K, nt = K / BK;
    unsigned voffA[2], voffB[2];
#pragma unroll
    for (int i = 0; i < 2; ++i) { int R, C; stage_rc(tid * 16 + i * 8192, R, C); const int Rb = Epi::PERM64 ? (64 * (R >> 5) + 16 * ((R & 15) >> 2) + 4 * ((R >> 4) & 1) + (R & 3)) : Epi::PERM ? ((R & ~31) + perm32(R & 31)) : R;
        voffA[i] = GATHER ? (unsigned)((R << 16) | (C * 2)) : (unsigned)(R * (g.a_pitch ? g.a_pitch : K * 2) + (g.a_pitch ? (C & 63) : C) * 2); voffB[i] = (unsigned)(Rb * K + C) * 2u; }
    static_assert(!GATHER || SP2, "the gathered form is written for the SP2 loop");
    unsigned gA[2][2] = {{0u, 0u}, {0u, 0u}}, gN[2][2] = {{0u, 0u}, {0u, 0u}};
#define PG8_GLOOK(dst, unit) do { _Pragma("unroll") for (int h_ = 0; h_ < 2; ++h_) _Pragma("unroll") for (int i_ = 0; i_ < 2; ++i_) \
        dst[h_][i_] = (unsigned)g.rowtok[(unit) * BM + h_ * HALF + (int)(voffA[i_] >> 16)]; } while (0)
#define PG8_GOFF(dst, src) do { _Pragma("unroll") for (int h_ = 0; h_ < 2; ++h_) _Pragma("unroll") for (int i_ = 0; i_ < 2; ++i_) dst[h_][i_] = src[h_][i_] * (unsigned)(K * 2) + (voffA[i_] & 0xffffu); } while (0)
#define PG8_STAGE_A(bufoff, gbase, half, OFFS) do { if constexpr (GATHER) { _Pragma("unroll") for (int _i = 0; _i < 2; ++_i) \
        __builtin_amdgcn_global_load_lds((const unsigned*)((const char*)(gbase) + OFFS[half][_i]), (PG8_LAS unsigned*)(lds + (bufoff) + ldsw + _i * 8192), 16, 0, 0); } \
        else { PG8_STAGE(bufoff, (gbase) + (half) * hstepA, voffA); } } while (0)
    const size_t kstep = (size_t)(BK * 2);
    const size_t hstep = (size_t)HALF * K * 2;
    const size_t kstepA = g.a_kstep ? (size_t)g.a_kstep : kstep, hstepA = g.a_pitch ? (size_t)HALF * g.a_pitch : hstep;
    const size_t tstep = 2 * hstep;
    const size_t hstepB = Epi::PERM64 ? (size_t)8 * K * 2 : hstep;
    static_assert(!Epi::PERM64 || SP2, "PERM64 is wired into the SP2 loop only");
    const unsigned ldsw = (unsigned)wid * 1024u;
    const int aoff = lds_byte(wr * 64 + fr, fq * 8), boff = lds_byte(wc * 32 + fr, fq * 8);
#define PG8_SA(b, h) (((b) * 2 + (h)) * HTB)
#define PG8_SB(b, h) ((4 + (b) * 2 + (h)) * HTB)
#define PG8_STAGE(bufoff, gbase, voff) do { _Pragma("unroll") for (int _i = 0; _i < 2; ++_i) \
        __builtin_amdgcn_global_load_lds((const unsigned*)((const char*)(gbase) + (voff)[_i]), (PG8_LAS unsigned*)(lds + (bufoff) + ldsw + _i * 8192), 16, 0, 0); } while (0)
#define PG8_LDA(dst, b, h) do { _Pragma("unroll") for (int m = 0; m < 4; ++m) { const bf16x8 l0_ = *(const PG8_LAS bf16x8*)(lds + PG8_SA(b, h) + aoff + m * 2048), l1_ = *(const PG8_LAS bf16x8*)(lds + PG8_SA(b, h) + aoff + m * 2048 + 1024); \
        if constexpr (F8SCALE != 0) dst##8[m] = cat8(l0_, l1_); else { dst[m][0] = l0_; dst[m][1] = l1_; } } } while (0)
#define PG8_LDB(dst, b, h) do { _Pragma("unroll") for (int n = 0; n < 2; ++n) { const bf16x8 l0_ = *(const PG8_LAS bf16x8*)(lds + PG8_SB(b, h) + boff + n * 2048), l1_ = *(const PG8_LAS bf16x8*)(lds + PG8_SB(b, h) + boff + n * 2048 + 1024); \
        if constexpr (F8SCALE != 0) dst##8[n] = cat8(l0_, l1_); else { dst[n][0] = l0_; dst[n][1] = l1_; } } } while (0)
#define PG8_MMA(ai, bj, At, Bt) do { __builtin_amdgcn_s_setprio(1); _Pragma("unroll") for (int m = 0; m < 4; ++m) _Pragma("unroll") for (int n = 0; n < 2; ++n) { \
        if constexpr (F8SCALE != 0) { if (F8_ALLV || ((ai) == 1 && (bj) == 1)) asm volatile("v_mfma_scale_f32_16x16x128_f8f6f4 %0, %1, %2, %0, %3, %4 op_sel_hi:[0,0,0]" : "+v"(acc[ai][bj][m][n]) : "v"(Bt##8[n]), "v"(At##8[m]), "v"(f8sa), "v"(f8sb)); \
            else asm volatile("v_mfma_scale_f32_16x16x128_f8f6f4 %0, %1, %2, %0, %3, %4 op_sel_hi:[0,0,0]" : "+a"(acc[ai][bj][m][n]) : "v"(Bt##8[n]), "v"(At##8[m]), "v"(f8sa), "v"(f8sb)); } \
        else { _Pragma("unroll") for (int k = 0; k < 2; ++k) acc[ai][bj][m][n] = __builtin_amdgcn_mfma_f32_16x16x32_bf16(Bt[n][k], At[m][k], acc[ai][bj][m][n], 0, 0, 0); } } __builtin_amdgcn_s_setprio(0); } while (0)
#define PG8_WAIT_V(n) asm volatile("s_waitcnt vmcnt(" #n ")" ::: "memory")
#define PG8_WAIT_V8F(first) asm volatile("v_cmp_ne_u32_e32 vcc, 0, %0\n\ts_nop 4\n\ts_cbranch_vccnz .Lpg8sk_%=\n\ts_waitcnt vmcnt(8)\n.Lpg8sk_%=:\n\ts_waitcnt vmcnt(%1)" :: "v"(first), "n"(8 + Epi::NVM) : "memory", "vcc")
#define PG8_WAIT_L(n) asm volatile("s_waitcnt lgkmcnt(" #n ")" ::: "memory")
#define PG8_BAR __builtin_amdgcn_s_barrier()
#define PG8_SCHED __builtin_amdgcn_sched_barrier(0)
    Unit cur, nxt; int ui = 0;
    if (!S.next(0, cur)) return;
    f32x4 acc[2][2][4][2];
#pragma unroll
    for (int a = 0; a < 2; ++a)
#pragma unroll
        for (int b = 0; b < 2; ++b)
#pragma unroll
            for (int m = 0; m < 4; ++m)
#pragma unroll
                for (int n = 0; n < 2; ++n) acc[a][b][m][n] = (f32x4){0.f, 0.f, 0.f, 0.f};
    bf16x8 At[4][2], B0[2][2], B1[2][2]; i32x8 At8[4], B08[2], B18[2];
    const int f8sa = F8SCALE * 0x01010101, f8sb = 0x7f7f7f7f;
    const char* cA = GATHER ? (const char*)g.A : (const char*)g.A + (size_t)cur.pm * tstep; const char* cB = (const char*)g.Bt + (size_t)cur.pn * tstep;
    if constexpr (GATHER) { PG8_GLOOK(gN, 0); PG8_GOFF(gA, gN); }
    S.a_ready(cur);
    if constexpr (SP2) {
        PG8_STAGE(PG8_SB(0, 0), cB, voffB); PG8_STAGE(PG8_SB(0, 1), cB + hstepB, voffB); PG8_STAGE_A(PG8_SA(0, 0), cA, 0, gA); PG8_STAGE_A(PG8_SA(0, 1), cA, 1, gA);
        if (wr == 1) PG8_BAR;
        PG8_WAIT_V(2); PG8_BAR;
        PG8_STAGE(PG8_SB(1, 0), cB + kstep, voffB); PG8_STAGE_A(PG8_SA(1, 0), cA + kstepA, 0, gA); PG8_STAGE(PG8_SB(1, 1), cB + hstepB + kstep, voffB);
        PG8_WAIT_V(6); PG8_BAR;
    } else {
        PG8_STAGE(PG8_SB(0, 0), cB, voffB); PG8_STAGE(PG8_SA(0, 0), cA, voffA); PG8_STAGE(PG8_SB(0, 1), cB + hstep, voffB); PG8_STAGE(PG8_SA(0, 1), cA + hstep, voffA);
        if (wr == 1) PG8_BAR;
        PG8_WAIT_V(4); PG8_BAR;
        PG8_STAGE(PG8_SB(1, 0), cB + kstep, voffB); PG8_STAGE(PG8_SA(1, 0), cA + kstep, voffA); PG8_STAGE(PG8_SB(1, 1), cB + hstep + kstep, voffB);
        PG8_WAIT_V(6); PG8_BAR;
    }
    for (;;) {
        if constexpr (GATHER) { int rt_; if (S.peek_pm(ui + 1, rt_)) PG8_GLOOK(gN, ui + 1); }
        const bool has_next = S.next(ui + 1, nxt);
        const char* nA = (has_next && !GATHER) ? (const char*)g.A + (size_t)nxt.pm * tstep : cA; const char* nB = has_next ? (const char*)g.Bt + (size_t)nxt.pn * tstep : cB;
        for (int t = 0; t < nt; t += 2) {
            const bool last = (t == nt - 2); const int ufirst = ((t == 0) && (ui > 0) && (Epi::NVM > 0)) ? 1 : 0;
            const char* a1 = cA + (size_t)(t + 1) * kstepA;
            const char* a2 = last ? nA : cA + (size_t)(t + 2) * kstepA; const char* b2 = last ? nB : cB + (size_t)(t + 2) * kstep;
            const char* a3 = a2 + kstepA; const char* b3 = b2 + kstep;
            if (last && has_next) S.a_ready(nxt);
            unsigned o2[2][2] = {{gA[0][0], gA[0][1]}, {gA[1][0], gA[1][1]}};
            if constexpr (GATHER) { if (last) { asm volatile("" : "+v"(gN[0][0]), "+v"(gN[0][1]), "+v"(gN[1][0]), "+v"(gN[1][1]) :: "memory"); PG8_GOFF(o2, gN); } }
            if constexpr (SP2) {
            PG8_LDB(B0, 0, 0); PG8_LDB(B1, 0, 1); PG8_SCHED; PG8_LDA(At, 0, 0); PG8_STAGE_A(PG8_SA(1, 1), a1, 1, gA);
            PG8_WAIT_V8F(ufirst); PG8_WAIT_L(0); PG8_BAR; PG8_MMA(0, 0, At, B0); PG8_MMA(0, 1, At, B1); PG8_BAR; PG8_SCHED;
            PG8_LDA(At, 0, 1); PG8_STAGE(PG8_SB(0, 0), b2, voffB); PG8_STAGE(PG8_SB(0, 1), b2 + hstepB, voffB); PG8_STAGE_A(PG8_SA(0, 0), a2, 0, o2);
            PG8_WAIT_V8F(ufirst); PG8_WAIT_L(0); PG8_BAR; PG8_MMA(1, 0, At, B0); PG8_MMA(1, 1, At, B1); PG8_BAR; PG8_SCHED;
            PG8_LDB(B0, 1, 0); PG8_LDB(B1, 1, 1); PG8_SCHED; PG8_LDA(At, 1, 0); PG8_STAGE_A(PG8_SA(0, 1), a2, 1, o2);
            PG8_WAIT_V(8); PG8_WAIT_L(0); PG8_BAR; PG8_MMA(0, 0, At, B0); PG8_MMA(0, 1, At, B1); PG8_BAR; PG8_SCHED;
            PG8_LDA(At, 1, 1); PG8_STAGE(PG8_SB(1, 0), b3, voffB); PG8_STAGE(PG8_SB(1, 1), b3 + hstepB, voffB); PG8_STAGE_A(PG8_SA(1, 0), a3, 0, o2);
            PG8_WAIT_V(8); PG8_WAIT_L(0); PG8_BAR; PG8_MMA(1, 0, At, B0); PG8_MMA(1, 1, At, B1); PG8_BAR; PG8_SCHED;
            } else {
            PG8_LDB(B0, 0, 0); PG8_SCHED; PG8_LDA(At, 0, 0); PG8_STAGE(PG8_SA(1, 1), a1 + hstep, voffA);
            PG8_WAIT_L(8); PG8_BAR; PG8_WAIT_L(0); PG8_MMA(0, 0, At, B0); PG8_BAR; PG8_SCHED;
            PG8_LDB(B1, 0, 1); PG8_STAGE(PG8_SB(0, 0), b2, voffB);
            PG8_BAR; PG8_WAIT_L(0); PG8_MMA(0, 1, At, B1); PG8_BAR;
            PG8_LDA(At, 0, 1); PG8_STAGE(PG8_SA(0, 0), a2, voffA);
            PG8_BAR; PG8_WAIT_L(0); PG8_MMA(1, 0, At, B0); PG8_BAR; PG8_SCHED;
            PG8_STAGE(PG8_SB(0, 1), b2 + hstep, voffB);
            PG8_WAIT_V(6); PG8_BAR; PG8_MMA(1, 1, At, B1); PG8_BAR;
            PG8_LDB(B0, 1, 0); PG8_SCHED; PG8_LDA(At, 1, 0); PG8_STAGE(PG8_SA(0, 1), a2 + hstep, voffA);
            PG8_WAIT_L(8); PG8_BAR; PG8_WAIT_L(0); PG8_MMA(0, 0, At, B0); PG8_BAR; PG8_SCHED;
            PG8_LDB(B1, 1, 1); PG8_STAGE(PG8_SB(1, 0), b3, voffB);
            PG8_BAR; PG8_WAIT_L(0); PG8_MMA(0, 1, At, B1); PG8_BAR;
            PG8_LDA(At, 1, 1); PG8_STAGE(PG8_SA(1, 0), a3, voffA);
            PG8_BAR; PG8_WAIT_L(0); PG8_MMA(1, 0, At, B0); PG8_BAR; PG8_SCHED;
            PG8_STAGE(PG8_SB(1, 1), b3 + hstep, voffB);
            PG8_WAIT_V(6); PG8_BAR; PG8_MMA(1, 1, At, B1); PG8_BAR;
            }
        }
        if constexpr (ALIGN_EPI) { if (wr == 0) PG8_BAR; }
        if constexpr (!Epi::AFTER_DRAIN) { E(acc, cur, wr, wc, fr, fq, ui); S.done(cur); }
        if (!has_next) break;
#pragma unroll
        for (int a = 0; a < 2; ++a)
#pragma unroll
            for (int b = 0; b < 2; ++b)
#pragma unroll
                for (int m = 0; m < 4; ++m)
#pragma unroll
                    for (int n = 0; n < 2; ++n) acc[a][b][m][n] = (f32x4){0.f, 0.f, 0.f, 0.f};
        cur = nxt; cA = nA; cB = nB; ++ui;
        if constexpr (GATHER) PG8_GOFF(gA, gN);
        if constexpr (ALIGN_EPI) { if (wr == 1) PG8_BAR; }
    }
    PG8_WAIT_V(0);
    if constexpr (!ALIGN_EPI) { if (wr == 0) PG8_BAR; }
    PG8_BAR;
    if constexpr (Epi::AFTER_DRAIN) { E.fused(acc, cur, wr, wc, fr, fq, lds, wid, lane); S.done(cur); }
#undef PG8_SA
#undef PG8_SB
#undef PG8_STAGE
#undef PG8_STAGE_A
#undef PG8_GLOOK
#undef PG8_GOFF
#undef PG8_LDA
#undef PG8_LDB
#undef PG8_MMA
#undef PG8_WAIT_V
#undef PG8_WAIT_V8F
#undef PG8_WAIT_L
#undef PG8_BAR
#undef PG8_SCHED
}
}

constexpr int GX_TILE = 133760, GX_ROWS = GX_TILE + 2240;
constexpr int GX_BIAS = GX_ROWS + 17 * 512;
static_assert(GX_BIAS + 17 * 1024 <= 163840 - 64, "grouped-GEMM LDS tables");
__device__ __forceinline__ void fg_gemm_in(PrmP p, int l, LAS unsigned char* lds, int wg, int nwg) {
    pg8::Gemm g{(const bf16_t*)(p->ws + WS_HB), (const bf16_t*)(p->ws + WS_WIN) + (size_t)l * NP * 1024, M, NP, 1024}; pg8::StaticOrder S; S.init(M, NP, nwg, wg);
    pg8::EpiBf16Plain E{(bf16_t*)(p->ws + WS_PB), NP};
    pg8::gemm_phase<pg8::EpiBf16Plain, pg8::StaticOrder, true, true>(lds, g, S, E);
}
__device__ __forceinline__ void fg_gemm_out(PrmP p, int l, LAS unsigned char* lds, int wg, int nwg) {
    pg8::StaticOrder S; S.init(M, 1024, nwg, wg);
    pg8::EpiBf16Plain E{(bf16_t*)(p->ws + WS_Y), 1024};
    if (OUT_FP8) {
        pg8::Gemm g{(const bf16_t*)(p->ws + WS_YC), (const bf16_t*)(p->ws + WS_WOUT + (size_t)l * 1024 * 1024), M, 1024, 512};
        pg8::gemm_phase<pg8::EpiBf16Plain, pg8::StaticOrder, true, true, 118>(lds, g, S, E);
    } else {
    pg8::Gemm g{(const bf16_t*)(p->ws + WS_YC), (const bf16_t*)(p->ws + WS_WOUT) + (size_t)l * 1024 * 1024, M, 1024, 1024};
    pg8::gemm_phase<pg8::EpiBf16Plain, pg8::StaticOrder, true, true>(lds, g, S, E); }
}
__device__ __forceinline__ void fg_gemm1(PrmP p, int l, LAS unsigned char* lds, int wg, int nwg) {
    const int nt = ((const int*)(p->ws + WS_CTL))[CW_NT];
    LAS int* tl = (LAS int*)(lds + GX_TILE); LAS unsigned short* rl = (LAS unsigned short*)(lds + GX_ROWS);
    pg8::GroupOrder S{nt, 8, nwg, wg, tl};
    { const int tid = fresh_tid(); const int* TE = (const int*)(p->ws + WS_MISC + MS_TILEE); const int* RT = (const int*)(p->ws + WS_MISC + MS_ROWTOK);
      __syncthreads();
      for (int i = tid; i < nt; i += NTHREADS) tl[i] = TE[i];
      { int rv[17];
#pragma unroll
        for (int ui = 0; ui < 17; ++ui) { int rt; rv[ui] = (S.peek_pm(ui, rt) && tid < 256) ? RT[rt * 256 + tid] : 0; }
#pragma unroll
        for (int ui = 0; ui < 17; ++ui) if (tid < 256) rl[ui * 256 + tid] = (unsigned short)rv[ui]; }
      __syncthreads();
      if (EXPERT_FP8) { LAS float* bl = (LAS float*)(lds + GX_BIAS); const float* bgu = p->in[I_BGU] + (size_t)l * NE * 2048; float bv[17];
#pragma unroll
        for (int ui = 0; ui < 17; ++ui) { pg8::Unit u; bv[ui] = (S.next(ui, u) && tid < 256) ? bgu[(size_t)(u.pn >> 3) * 2048 + (tid >> 7) * 1024 + (u.pn & 7) * 128 + (tid & 127)] : 0.f; }
#pragma unroll
        for (int ui = 0; ui < 17; ++ui) if (tid < 256) bl[ui * 256 + tid] = bv[ui];
        __syncthreads(); } }
    if (EXPERT_FP8) {
        pg8::Gemm g{(const bf16_t*)(p->ws + WS_HB), (const bf16_t*)(p->ws + WS_WGU + (size_t)l * NE * 2048 * 1024), RP, NE * 2048, 512, rl};
        pg8::EpiSwiglu8 E{p->ws + WS_H1, (const LAS float*)(lds + GX_BIAS)};
        pg8::gemm_phase<pg8::EpiSwiglu8, pg8::GroupOrder, true, true, 119, true>(lds, g, S, E);
    } else {
    pg8::Gemm g{(const bf16_t*)(p->ws + WS_XS), (const bf16_t*)(p->ws + WS_WGU) + (size_t)l * NE * 2048 * 1024, RP, NE * 2048, 1024};
    pg8::EpiSwiglu E{(bf16_t*)(p->ws + WS_H1), p->in[I_BGU] + (size_t)l * NE * 2048};
    pg8::gemm_phase<pg8::EpiSwiglu, pg8::GroupOrder, true, true>(lds, g, S, E);
    }
}
__device__ __forceinline__ void fg_gemm2(PrmP p, int l, LAS unsigned char* lds, int wg, int nwg) {
    const int nt = ((const int*)(p->ws + WS_CTL))[CW_NT];
    LAS int* tl = (LAS int*)(lds + GX_TILE);
    pg8::GroupOrder S{nt, 4, nwg, wg, tl};
    { const int tid = fresh_tid(); const int* TE = (const int*)(p->ws + WS_MISC + MS_TILEE); __syncthreads(); for (int i = tid; i < nt; i += NTHREADS) tl[i] = TE[i]; __syncthreads();
      if (EXPERT_FP8 && YR_FP8) { LAS float* bl = (LAS float*)(lds + GX_BIAS); const float* bdn = p->in[I_BDN] + (size_t)l * NE * 1024; float bv[9];
#pragma unroll
        for (int ui = 0; ui < 9; ++ui) { pg8::Unit u; bv[ui] = (S.next(ui, u) && tid < 256) ? bdn[(size_t)(u.pn >> 2) * 1024 + (u.pn & 3) * 256 + tid] : 0.f; }
#pragma unroll
        for (int ui = 0; ui < 9; ++ui) if (tid < 256) bl[ui * 256 + tid] = bv[ui];
        __syncthreads(); } }
    pg8::EpiDown E{(bf16_t*)(p->ws + WS_YR), p->in[I_BDN] + (size_t)l * NE * 1024};
    if (EXPERT_FP8) {
        pg8::Gemm g{(const bf16_t*)(p->ws + WS_H1), (const bf16_t*)(p->ws + WS_WDN + (size_t)l * NE * 1024 * 1024), RP, NE * 1024, 512}; g.a_pitch = 128; g.a_kstep = 256 * 128;
        if (YR_FP8) { pg8::EpiDown8 E8{p->ws + WS_YR, (const LAS float*)(lds + GX_BIAS)}; pg8::gemm_phase<pg8::EpiDown8, pg8::GroupOrder, true, true, 120>(lds, g, S, E8); }
        else pg8::gemm_phase<pg8::EpiDown, pg8::GroupOrder, true, true, 120>(lds, g, S, E);
    } else {
    pg8::Gemm g{(const bf16_t*)(p->ws + WS_H1), (const bf16_t*)(p->ws + WS_WDN) + (size_t)l * NE * 1024 * 1024, RP, NE * 1024, 1024};
    pg8::gemm_phase<pg8::EpiDown, pg8::GroupOrder, true, true>(lds, g, S, E);
    }
}

#include <hip/hip_bf16.h>
#include <cmath>
namespace attn_body {
using bf16=__hip_bfloat16;
using bf16x8=__attribute__((ext_vector_type(8)))short;
using s16x4=__attribute__((ext_vector_type(4)))short;
using f32x16=__attribute__((ext_vector_type(16)))float;
using u32x4=__attribute__((ext_vector_type(4)))unsigned;
constexpr int BATCH=4,NHEAD=8,SEQ=8192,D=64,DM=2560;
constexpr int NW=8,QBLK=32,QB=QBLK*NW,KVBLK=64,NQB=SEQ/QB;
constexpr int ATTN_PITCH=DM, ATTN_UNIT_ROWS=QB;
__device__ __forceinline__ int crow(int r,int hi){return (r&3)+8*(r>>2)+4*hi;}
#define SBAR() __builtin_amdgcn_sched_barrier(0)
__device__ __forceinline__ void cmask(f32x16&p0,f32x16&p1,int jb,int qrel,int hi){
  const float NEG=-INFINITY; int kb=64*jb+4*hi;
  #pragma unroll
  for(int r=0;r<16;++r){int kv=kb+(r&3)+8*(r>>2); if(kv>qrel)p0[r]=NEG; if(kv+32>qrel)p1[r]=NEG;}
}

constexpr int NSLOT=3, SLOTB=8192;
constexpr int LDS_K=0, LDS_V=NSLOT*SLOTB, LDS_WS=2*NSLOT*SLOTB, LDS_OST=LDS_WS+NW*64*4, LDS_BYTES=LDS_OST+NW*4096;
constexpr float C2=0.125f*1.4426950408889634f;
__device__ __forceinline__ void glds16(const void*gsrc,unsigned lds_dst){unsigned keep;
  asm volatile("s_mov_b32 %0, m0\n\ts_mov_b32 m0, %2\n\ts_nop 0\n\tglobal_load_lds_dwordx4 %1, off\n\ts_mov_b32 m0, %0":"=&s"(keep):"v"(gsrc),"s"(lds_dst):"memory");}
__device__ __forceinline__ float max3f(float a,float b,float c){float r;asm("v_max3_f32 %0, %1, %2, %3":"=v"(r):"v"(a),"v"(b),"v"(c));return r;}
__device__ __forceinline__ float max2f(float a,float b){float r;asm("v_max_f32_e32 %0, %1, %2":"=v"(r):"v"(a),"v"(b));return r;}
__device__ __forceinline__ float fadd_s(float a,float b){float r;asm("v_add_f32_e32 %0, %1, %2":"=v"(r):"v"(a),"v"(b));return r;}
__device__ __forceinline__ float fsub_s(float a,float b){float r;asm("v_sub_f32_e32 %0, %1, %2":"=v"(r):"v"(a),"v"(b));return r;}
typedef float f32x2_t __attribute__((ext_vector_type(2))); typedef __bf16 bf16x2_t __attribute__((ext_vector_type(2)));
__device__ __forceinline__ unsigned cvtpk_s(float lo,float hi){f32x2_t v={lo,hi};bf16x2_t b=__builtin_convertvector(v,bf16x2_t);return __builtin_bit_cast(unsigned,b);}
__device__ __forceinline__ unsigned f2bf(float f) { return pk2(f, 0.f) & 0xffffu; }
#define WAIT_BAR(N) asm volatile("s_waitcnt vmcnt(" #N ") lgkmcnt(0)\n\ts_barrier":::"memory")

typedef __attribute__((address_space(3))) const float* lds_fptr;
__device__ __forceinline__ void split3(float f,unsigned&hb,unsigned&mb,unsigned&lb){
  hb=__float_as_uint(f)&0xffff0000u; const float r1=f-__uint_as_float(hb); mb=__float_as_uint(r1)&0xffff0000u; const float r2=r1-__uint_as_float(mb); lb=__float_as_uint(r2)&0xffff0000u; }
__device__ __forceinline__ bf16x8 mk_kx(float fk,int hi){ unsigned hb,mb,lb; split3(-fk,hb,mb,lb);
  u32x4 w; w.x=0x3f803f80u; w.y=hi?0x00003f80u:(0x00003f80u|hb); w.z=hi?0u:((mb>>16)|lb); w.w=0u; return __builtin_bit_cast(bf16x8,w); }
__device__ __forceinline__ bf16x8 mk_qx(float fq,float mhat,int hi){ unsigned hb,mb,lb; split3(hi?-mhat:fq,hb,mb,lb);
  u32x4 w; w.x=(hb>>16)|mb; w.y=hi?(lb>>16):((lb>>16)|0x3f800000u); w.z=hi?0u:0x3f803f80u; w.w=0u; return __builtin_bit_cast(bf16x8,w); }
__device__ __forceinline__ void qkt(f32x16&p0,f32x16&p1,const char*Kslot,const bf16x8*qr,bf16x8 kxa,bf16x8 kxb,bf16x8 qx,int r32,int hi){
  const f32x16 zc=f32x16{};
  const char*kb=Kslot+hi*1024+r32*16;
  #pragma unroll
  for(int d0=0;d0<4;++d0){
    const bf16x8 b0=*reinterpret_cast<const bf16x8*>(kb+d0*2048);
    const bf16x8 b1=*reinterpret_cast<const bf16x8*>(kb+d0*2048+512);
    if(d0==0){p0=__builtin_amdgcn_mfma_f32_32x32x16_bf16(b0,qr[0],zc,0,0,0);p1=__builtin_amdgcn_mfma_f32_32x32x16_bf16(b1,qr[0],zc,0,0,0);}
    else{p0=__builtin_amdgcn_mfma_f32_32x32x16_bf16(b0,qr[d0],p0,0,0,0);p1=__builtin_amdgcn_mfma_f32_32x32x16_bf16(b1,qr[d0],p1,0,0,0);}}
  p0=__builtin_amdgcn_mfma_f32_32x32x16_bf16(kxa,qx,p0,0,0,0);p1=__builtin_amdgcn_mfma_f32_32x32x16_bf16(kxb,qx,p1,0,0,0);
}
typedef __attribute__((address_space(3))) const char* lds_cptr;
typedef short v4i16_t __attribute__((ext_vector_type(4)));
__device__ __forceinline__ void kload8(bf16x8*kf,lds_cptr kp){
  kf[0]=*(const __attribute__((address_space(3))) bf16x8*)(kp);      kf[1]=*(const __attribute__((address_space(3))) bf16x8*)(kp+512);
  kf[2]=*(const __attribute__((address_space(3))) bf16x8*)(kp+2048); kf[3]=*(const __attribute__((address_space(3))) bf16x8*)(kp+2560);
  kf[4]=*(const __attribute__((address_space(3))) bf16x8*)(kp+4096); kf[5]=*(const __attribute__((address_space(3))) bf16x8*)(kp+4608);
  kf[6]=*(const __attribute__((address_space(3))) bf16x8*)(kp+6144); kf[7]=*(const __attribute__((address_space(3))) bf16x8*)(kp+6656);
}
__device__ __forceinline__ void kload2(bf16x8*kf,lds_cptr kp,int j){ kf[2*j]=*(const __attribute__((address_space(3))) bf16x8*)(kp+j*2048); kf[2*j+1]=*(const __attribute__((address_space(3))) bf16x8*)(kp+j*2048+512); }
__device__ __forceinline__ s16x4 vtr(lds_cptr p){ return __builtin_bit_cast(s16x4,__builtin_amdgcn_ds_read_tr16_b64_v4i16((__attribute__((address_space(3))) v4i16_t*)p)); }
__device__ __forceinline__ float rowmax(const f32x16&p0,const f32x16&p1){
  float a=max3f(p0[0],p0[1],p1[0]),b=max3f(p0[2],p0[3],p1[1]);a=max3f(a,p1[2],p1[3]);
  #pragma unroll
  for(int r=4;r<16;r+=4){a=max3f(a,p0[r],p0[r+1]);b=max3f(b,p0[r+2],p0[r+3]);a=max3f(a,p1[r],p1[r+1]);b=max3f(b,p1[r+2],p1[r+3]);}
  const float m=max2f(a,b);
  auto rr=__builtin_amdgcn_permlane32_swap(__float_as_uint(m),__float_as_uint(m),false,false);
  return max2f(__uint_as_float(rr[0]),__uint_as_float(rr[1]));
}
__device__ __forceinline__ void pv(f32x16*o,int vb,bf16x8 pa0,bf16x8 pa1,bf16x8 pa2,bf16x8 pa3){
  #pragma unroll
  for(int d0=0;d0<2;++d0){s16x4 lo[4],hi[4];
    #pragma unroll
    for(int ks=0;ks<4;++ks){
      asm volatile("ds_read_b64_tr_b16 %0,%1 offset:%c2":"=&v"(lo[ks]):"v"(vb),"i"(d0*4096+ks*1024):"memory");
      asm volatile("ds_read_b64_tr_b16 %0,%1 offset:%c2":"=&v"(hi[ks]):"v"(vb),"i"(d0*4096+ks*1024+512):"memory");}
    asm volatile("s_waitcnt lgkmcnt(0)":::"memory");SBAR();
    #define PK(k) (bf16x8){lo[k][0],lo[k][1],lo[k][2],lo[k][3],hi[k][0],hi[k][1],hi[k][2],hi[k][3]}
    o[d0]=__builtin_amdgcn_mfma_f32_32x32x16_bf16(pa0,PK(0),o[d0],0,0,0);
    o[d0]=__builtin_amdgcn_mfma_f32_32x32x16_bf16(pa1,PK(1),o[d0],0,0,0);
    o[d0]=__builtin_amdgcn_mfma_f32_32x32x16_bf16(pa2,PK(2),o[d0],0,0,0);
    o[d0]=__builtin_amdgcn_mfma_f32_32x32x16_bf16(pa3,PK(3),o[d0],0,0,0);
    #undef PK
  }
}

#ifndef ATTN_STORE16
#define ATTN_STORE16(p,v) (*(u32x4*)(p)=(v))
#endif
template<int THRL> __device__ __forceinline__ void attn_unit(int b,int h,int qb,const bf16*Q,const bf16*__restrict__ K,const bf16*__restrict__ V,bf16*O,char*shm,lds_fptr F2s,int tstart,float kmx){
  const int tid=::fresh_tid(),lane=tid&63,r32=lane&31,hi=lane>>5; const int wid=__builtin_amdgcn_readfirstlane(tid>>6);
  const long rowbase=(long)b*SEQ; const int q0=qb*QB;
  const bf16*Qw=Q+(rowbase+q0+wid*QBLK)*DM+h*D;
  const bf16*Kh=K+(rowbase+(long)tstart*KVBLK)*DM+h*D,*Vh=V+(rowbase+(long)tstart*KVBLK)*DM+h*D; const lds_fptr F2k=F2s+tstart*KVBLK;
  const unsigned lds0=(unsigned)(uintptr_t)shm;
  float*wsf=(float*)(shm+LDS_WS)+wid*64;
  const bf16*ksrc=Kh+(long)lane*DM+wid*8;
  const bf16*vsrc=Vh+(long)(16*(wid&3)+(lane>>2))*DM+(wid>>2)*32+(lane&3)*8;
  const unsigned kdst=lds0+LDS_K+wid*1024, vdst=lds0+LDS_V+wid*1024;
  #define DMA_K(t,slot) glds16(ksrc+(long)(t)*KVBLK*DM,(unsigned)__builtin_amdgcn_readfirstlane(kdst+(slot)))
  #define DMA_V(t,slot) glds16(vsrc+(long)(t)*KVBLK*DM,(unsigned)__builtin_amdgcn_readfirstlane(vdst+(slot)))
  const int vb0=(int)(lds0+LDS_V)+((lane>>4)&1)*32+(lane&3)*8+(4*hi+((lane&15)>>2))*64;
  const char*Kbase=shm+LDS_K; bf16x8 kf[8];
  const lds_cptr shm3=(lds_cptr)shm; const lds_cptr kp0=shm3+LDS_K+hi*1024+r32*16; const lds_cptr vp0=shm3+LDS_V+((lane>>4)&1)*32+(lane&3)*8+(4*hi+((lane&15)>>2))*64;
  const int NT=(q0+QB)/KVBLK-tstart;
  DMA_K(0,0);DMA_V(0,0);DMA_K(1,SLOTB);
  bf16x8 qr[4];
  #pragma unroll
  for(int d0=0;d0<4;++d0)qr[d0]=*reinterpret_cast<const bf16x8*>(&Qw[(long)r32*DM+d0*16+hi*8]);
  float m0; { float qq=0.f;
    #pragma unroll
    for(int d0=0;d0<4;++d0){const u32x4 w_=__builtin_bit_cast(u32x4,qr[d0]);
      #pragma unroll
      for(int j_=0;j_<4;++j_){const float a_=__uint_as_float(w_[j_]<<16),b_=__uint_as_float(w_[j_]&0xffff0000u);qq+=a_*a_+b_*b_;}}
    qq+=__shfl_xor(qq,32); m0=sqrtf(qq)*kmx+1.f; }
  float l_reg=0.f;f32x16 o[2];o[0]=f32x16{};o[1]=f32x16{};const f32x16 zc=f32x16{};
  const float fq_=F2s[q0+wid*QBLK+r32]; const bf16x8 qx=mk_qx(fq_,m0,hi);
  const int qrel=wid*QBLK+r32;
  #define CMASK(P0,P1,t) do{int jb_=(t)-(NT-4); if(jb_>=0)cmask(P0,P1,jb_,qrel,hi);}while(0)
  #define START(P0,P1) do{ _Pragma("unroll") for(int r=0;r<16;++r)P0[r]=__builtin_amdgcn_exp2f(P0[r]); }while(0)
  #define RESC() do{}while(0)
  f32x16 pA0,pA1,pB0,pB1;
  int sl_prev=0,sl_cur=0,sl_next=SLOTB;
  #define ROT() do{sl_prev=sl_cur;sl_cur=sl_next;sl_next=(sl_next==(NSLOT-1)*SLOTB)?0:sl_next+SLOTB;}while(0)
  DMA_K(2,2*SLOTB);
  WAIT_BAR(3);
  qkt(pA0,pA1,Kbase,qr,mk_kx(F2k[r32],hi),mk_kx(F2k[32+r32],hi),qx,r32,hi);asm volatile("s_nop 15\n\ts_nop 7":"+v"(pA0),"+v"(pA1));CMASK(pA0,pA1,0);
  START(pA0,pA1);
  _Pragma("unroll") for(int r=0;r<16;++r)pA1[r]=__builtin_amdgcn_exp2f(pA1[r]);
  WAIT_BAR(0);
  DMA_K(3,0);DMA_V(1,SLOTB);
  ROT();
  kload8(kf,kp0+sl_cur);
  WAIT_BAR(2);
  s16x4 vlo[8],vhi[8]; u32x4 pw0,pw1,pw2,pw3;
  #define PKW(P,B) cvtpk_s(P[B],P[B+1])
  #define PAF(k) __builtin_bit_cast(bf16x8,pw##k)
  #define VFR(i) (bf16x8){vlo[i][0],vlo[i][1],vlo[i][2],vlo[i][3],vhi[i][0],vhi[i][1],vhi[i][2],vhi[i][3]}
  #define PIN(x) asm volatile("":"+v"(x))
  #define MX3(a,b,c) __builtin_fmaxf(__builtin_fmaxf((a),(b)),(c))
  #define GAPA(MF,A0,A1,A2,A3,W0,W1,PW) do{ MF; sacc+=A0; sacc+=A1; sacc+=A2; sacc+=A3; PIN(sacc); W0; W1; PIN(PW); SBAR(); }while(0)
  #define EX(v) __builtin_amdgcn_exp2f(v)
  #define GAPB(MF,X,B) do{ MF; X[B]=EX(X[B]); X[B+1]=EX(X[B+1]); X[B+2]=EX(X[B+2]); X[B+3]=EX(X[B+3]); PIN(X); SBAR(); }while(0)
  #define VRD(i) do{ vlo[i]=vtr(vp_+(((i)>>2)*4096+((i)&3)*1024)); vhi[i]=vtr(vp_+(((i)>>2)*4096+((i)&3)*1024+512)); }while(0)
  #define KRD(G,j) do{ if(G){ kload2(kf,kp0+sl_next,j); SBAR(); } }while(0)
  #define STEP(C0,C1,P0,P1,t,GK,GV,GL) do{ const float fka_=F2k[(t)*KVBLK+r32],fkb_=F2k[(t)*KVBLK+32+r32]; SBAR(); \
    const lds_cptr vp_=vp0+sl_prev; \
    VRD(0); SBAR(); float sacc=(P0[0]+P0[1]); \
    GAPA(C0=__builtin_amdgcn_mfma_f32_32x32x16_bf16(kf[0],qr[0],zc,0,0,0), P0[2],P0[3],P0[4],P0[5],     pw0[0]=PKW(P0,0), pw0[1]=PKW(P0,2), pw0); \
    VRD(4); SBAR(); GAPA(C1=__builtin_amdgcn_mfma_f32_32x32x16_bf16(kf[1],qr[0],zc,0,0,0), P0[6],P0[7],P0[8],P0[9],     pw0[2]=PKW(P0,4), pw0[3]=PKW(P0,6), pw0); \
    VRD(1); SBAR(); GAPA(C0=__builtin_amdgcn_mfma_f32_32x32x16_bf16(kf[2],qr[1],C0,0,0,0),   P0[10],P0[11],P0[12],P0[13], pw1[0]=PKW(P0,8), pw1[1]=PKW(P0,10), pw1); \
    VRD(5); SBAR(); GAPA(C1=__builtin_amdgcn_mfma_f32_32x32x16_bf16(kf[3],qr[1],C1,0,0,0),   P0[14],P0[15],P1[0],P1[1],   pw1[2]=PKW(P0,12),pw1[3]=PKW(P0,14), pw1); \
    VRD(2); SBAR(); GAPA(C0=__builtin_amdgcn_mfma_f32_32x32x16_bf16(kf[4],qr[2],C0,0,0,0),   P1[2],P1[3],P1[4],P1[5],     pw2[0]=PKW(P1,0), pw2[1]=PKW(P1,2), pw2); \
    VRD(6); SBAR(); GAPA(C1=__builtin_amdgcn_mfma_f32_32x32x16_bf16(kf[5],qr[2],C1,0,0,0),   P1[6],P1[7],P1[8],P1[9],     pw2[2]=PKW(P1,4), pw2[3]=PKW(P1,6), pw2); \
    VRD(3); SBAR(); GAPA(C0=__builtin_amdgcn_mfma_f32_32x32x16_bf16(kf[6],qr[3],C0,0,0,0),   P1[10],P1[11],P1[12],P1[13], pw3[0]=PKW(P1,8), pw3[1]=PKW(P1,10), pw3); \
    VRD(7); SBAR(); GAPA(C1=__builtin_amdgcn_mfma_f32_32x32x16_bf16(kf[7],qr[3],C1,0,0,0),   P1[14],P1[15],0.f,0.f,       pw3[2]=PKW(P1,12),pw3[3]=PKW(P1,14), pw3); \
    { C0=__builtin_amdgcn_mfma_f32_32x32x16_bf16(mk_kx(fka_,hi),qx,C0,0,0,0); SBAR(); C1=__builtin_amdgcn_mfma_f32_32x32x16_bf16(mk_kx(fkb_,hi),qx,C1,0,0,0); } \
    l_reg+=sacc; \
    if(GK){DMA_K((t)+3,sl_cur);} if(GV){DMA_V((t)+1,sl_next);} \
    CMASK(C0,C1,t); \
    SBAR(); \
    GAPB(o[0]=__builtin_amdgcn_mfma_f32_32x32x16_bf16(PAF(0),VFR(0),o[0],0,0,0), C0,0); \
    GAPB(o[1]=__builtin_amdgcn_mfma_f32_32x32x16_bf16(PAF(0),VFR(4),o[1],0,0,0), C0,4); \
    KRD(GL,0); GAPB(o[0]=__builtin_amdgcn_mfma_f32_32x32x16_bf16(PAF(1),VFR(1),o[0],0,0,0), C0,8); \
    KRD(GL,1); GAPB(o[1]=__builtin_amdgcn_mfma_f32_32x32x16_bf16(PAF(1),VFR(5),o[1],0,0,0), C0,12); \
    KRD(GL,2); GAPB(o[0]=__builtin_amdgcn_mfma_f32_32x32x16_bf16(PAF(2),VFR(2),o[0],0,0,0), C1,0); \
    KRD(GL,3); GAPB(o[1]=__builtin_amdgcn_mfma_f32_32x32x16_bf16(PAF(2),VFR(6),o[1],0,0,0), C1,4); \
    GAPB(o[0]=__builtin_amdgcn_mfma_f32_32x32x16_bf16(PAF(3),VFR(3),o[0],0,0,0), C1,8); \
    GAPB(o[1]=__builtin_amdgcn_mfma_f32_32x32x16_bf16(PAF(3),VFR(7),o[1],0,0,0), C1,12); \
    }while(0)
  int t=1;
  #undef CMASK
  #define CMASK(P0,P1,t) do{}while(0)
  for(;t+5<NT;t+=2){
    STEP(pB0,pB1,pA0,pA1,t,true,true,true);     WAIT_BAR(2); RESC(); ROT();
    STEP(pA0,pA1,pB0,pB1,t+1,true,true,true);   WAIT_BAR(2); RESC(); ROT();
  }
  #undef CMASK
  #define CMASK(P0,P1,t) do{int jb_=(t)-(NT-4); if(jb_>=0)cmask(P0,P1,jb_,qrel,hi);}while(0)
  #define ENDW(tt) do{ if((tt)+3<NT){WAIT_BAR(2);} else if((tt)+2<NT){WAIT_BAR(1);} else {WAIT_BAR(0);} }while(0)
  for(;t+1<NT;t+=2){
    STEP(pB0,pB1,pA0,pA1,t,(t+3<NT),(t+1<NT),(t+1<NT));       ENDW(t);   RESC(); ROT();
    STEP(pA0,pA1,pB0,pB1,t+1,(t+4<NT),(t+2<NT),(t+2<NT));     ENDW(t+1); RESC(); ROT();
  }
  STEP(pB0,pB1,pA0,pA1,NT-1,false,false,false); RESC();
  { float sacc=pB0[0]+pB0[1]; _Pragma("unroll") for(int r=2;r<16;++r)sacc+=pB0[r]; _Pragma("unroll") for(int r=0;r<16;++r)sacc+=pB1[r]; l_reg+=sacc;
    pw0=(u32x4){PKW(pB0,0),PKW(pB0,2),PKW(pB0,4),PKW(pB0,6)};pw1=(u32x4){PKW(pB0,8),PKW(pB0,10),PKW(pB0,12),PKW(pB0,14)};pw2=(u32x4){PKW(pB1,0),PKW(pB1,2),PKW(pB1,4),PKW(pB1,6)};pw3=(u32x4){PKW(pB1,8),PKW(pB1,10),PKW(pB1,12),PKW(pB1,14)};
    SBAR(); pv(o,vb0+sl_cur,PAF(0),PAF(1),PAF(2),PAF(3)); }
  #undef PKW
  #undef PAF
  #undef VFR
  #undef PIN
  #undef MX3
  #undef GAPA
  #undef GAPB
  #undef EX
  #undef VRD
  #undef KRD
  #undef STEP
  #undef ENDW
  {auto rr=__builtin_amdgcn_permlane32_swap(__float_as_uint(l_reg),__float_as_uint(l_reg),false,false);l_reg=__uint_as_float(rr[0])+__uint_as_float(rr[1]);}
  if(hi==0)wsf[32+r32]=l_reg;asm volatile("s_waitcnt lgkmcnt(0)":::"memory");
  float rli[16];
  #pragma unroll
  for(int r=0;r<16;++r)rli[r]=__builtin_amdgcn_rcpf(wsf[32+crow(r,hi)]);
  bf16*Ow=O+(rowbase+q0+wid*QBLK)*DM+h*D;
  { bf16*stg=(bf16*)(shm+LDS_OST)+wid*2048;
    #pragma unroll
    for(int r=0;r<16;++r){const int orow=crow(r,hi);
      #pragma unroll
      for(int d0=0;d0<2;++d0)stg[orow*64+d0*32+r32]=__float2bfloat16(o[d0][r]*rli[r]);}
    asm volatile("s_waitcnt lgkmcnt(0)":::"memory");
    #pragma unroll
    for(int i=0;i<4;++i){const int row=i*8+(lane>>3),ch=lane&7; const u32x4 v=*(const u32x4*)(stg+row*64+ch*8); ATTN_STORE16(Ow+(long)row*DM+ch*8,v);} }
  asm volatile("s_waitcnt lgkmcnt(0)\n\ts_barrier":::"memory");
  #undef DMA_K
  #undef DMA_V
  #undef CMASK
  #undef START
  #undef RESC
  #undef ROT
}
constexpr int ATTN_LDS_BYTES=LDS_BYTES;
#undef SBAR
#undef WAIT_BAR
}

constexpr float SKIP_MARGIN = 64.f;
constexpr int ATT_F2_OFF = 86016, ATT_SCN_OFF = ATT_F2_OFF + 32768;
static_assert(attn_body::ATTN_LDS_BYTES <= ATT_F2_OFF && ATT_SCN_OFF + 64 <= 131072, "attention LDS map");
__device__ __forceinline__ void f2_items(PrmP p, int l, LAS unsigned char* lds, int wg, int nwg) {
    const int tid = fresh_tid(), lane = tid & 63, wave = tid >> 6;
    LAS float* scn = (LAS float*)(lds + ATT_SCN_OFF);
    const bf16_t* PB = (const bf16_t*)(p->ws + WS_PB); float* F2G = (float*)(p->ws + WS_FC2);
    for (int bh = wg; bh < 32; bh += nwg) { const int b = bh >> 3, hh = bh & 7;
        const float fb = p->in[I_FOXFB][l * 8 + hh];
        float loc[16]; float run = 0.f;
#pragma unroll
        for (int i = 0; i < 16; ++i) { const float z = bf2f(PB[(size_t)(b * T + tid * 16 + i) * NP + C_F + hh]) + fb;
            run += -(fmaxf(-z, 0.f) + __logf(1.f + __expf(-fabsf(z)))) * LOG2E; loc[i] = run; }
        float incl = run;
#pragma unroll
        for (int o = 1; o < 64; o <<= 1) { const float v = __shfl_up(incl, o); if (lane >= o) incl += v; }
        __syncthreads();
        if (lane == 63) scn[wave] = incl;
        __syncthreads();
        float base = incl - run;
        for (int w = 0; w < wave; ++w) base += scn[w];
#pragma unroll
        for (int i = 0; i < 16; ++i) F2G[(size_t)bh * T + tid * 16 + i] = base + loc[i];
    }
}
__device__ __forceinline__ void fa_attn(PrmP p, int l, LAS unsigned char* lds, int wg, int nwg) {
    const int tid = fresh_tid();
    if (nwg != 256) return;
    LAS float* F2s = (LAS float*)(lds + ATT_F2_OFF);
    LAS int* work = (LAS int*)(lds + ATT_SCN_OFF); LAS int* tst = work + 1024; LAS int* mine = tst + 1024;
    const float* F2G = (const float*)(p->ws + WS_FC2);
    __syncthreads();
    const unsigned* CT = (const unsigned*)(p->ws + WS_CTL);
#pragma unroll
    for (int k = 0; k < 8; ++k) { const int i = tid + 512 * k; F2s[i] = F2G[(size_t)(i >> 7) * T + (i & 127) * 64 + 63];
        F2s[4096 + i] = sqrtf(__uint_as_float(__hip_atomic_load(CT + CW_KT + l * 4096 + i, __ATOMIC_RELAXED, __HIP_MEMORY_SCOPE_AGENT))); }
    __syncthreads();
#pragma unroll
    for (int k = 0; k < 2; ++k) { const int u = tid + 512 * k, bh = u >> 5, qb = u & 31;
        const unsigned* NRM = (const unsigned*)(p->ws + WS_CTL) + CW_NRM + (l * 32 + bh) * 2;
        const float qn = sqrtf(__uint_as_float(__hip_atomic_load(NRM, __ATOMIC_RELAXED, __HIP_MEMORY_SCOPE_AGENT))), kn = sqrtf(__uint_as_float(__hip_atomic_load(NRM + 1, __ATOMIC_RELAXED, __HIP_MEMORY_SCOPE_AGENT)));
        (void)qn; (void)kn;
        const float qI = sqrtf(__uint_as_float(__hip_atomic_load(CT + CW_QN + (l * 32 + bh) * 32 + qb, __ATOMIC_RELAXED, __HIP_MEMORY_SCOPE_AGENT)));
        const float kI = fmaxf(fmaxf(F2s[4096 + bh * 128 + 4 * qb], F2s[4096 + bh * 128 + 4 * qb + 1]), fmaxf(F2s[4096 + bh * 128 + 4 * qb + 2], F2s[4096 + bh * 128 + 4 * qb + 3]));
        const float base = F2G[(size_t)bh * T + qb * 256] + SKIP_MARGIN + qI * kI;
        int ts = 0; bool ok = true;
        for (int J = 0; J < 4 * qb; ++J) { ok = ok && (F2s[bh * 128 + J] > base + qI * F2s[4096 + bh * 128 + J]); ts = (ok && (J & 1)) ? J + 1 : ts; }
        tst[u] = ts; work[u] = 4 * (qb + 1) - ts; }
    if (tid < 4) mine[tid] = 0;
    __syncthreads();
    { const int ua = tid, ub = tid + 512; const int wa = work[ua], wb = work[ub]; int ra = 0, rb = 0;
      typedef int i32x4_ __attribute__((ext_vector_type(4)));
      const int ka = wa * 1024 + (1023 - ua), kb = wb * 1024 + (1023 - ub);
#pragma unroll 4
      for (int v = 0; v < 1024; v += 4) { const i32x4_ w4 = *(const LAS i32x4_*)(work + v);
#pragma unroll
          for (int q = 0; q < 4; ++q) { const int kv = w4[q] * 1024 + (1023 - (v + q)); ra += (kv > ka) ? 1 : 0; rb += (kv > kb) ? 1 : 0; } }
      const int t0 = wg, t1 = 511 - wg, t2 = 512 + wg, t3 = 1023 - wg;
      if (ra == t0) mine[0] = ua; if (ra == t1) mine[1] = ua; if (ra == t2) mine[2] = ua; if (ra == t3) mine[3] = ua;
      if (rb == t0) mine[0] = ub; if (rb == t1) mine[1] = ub; if (rb == t2) mine[2] = ub; if (rb == t3) mine[3] = ub; }
    __syncthreads();
    const unsigned* NRMB = (const unsigned*)(p->ws + WS_CTL) + CW_NRM + l * 64;
    attn_body::bf16* pb = (attn_body::bf16*)(p->ws + WS_PB);
#pragma unroll 1
    for (int k = 0; k < 4; ++k) { const int u = __builtin_amdgcn_readfirstlane(mine[k]), bh = u >> 5, qb = u & 31, ts_u = __builtin_amdgcn_readfirstlane(tst[u]);
        __syncthreads();
#pragma unroll
        for (int i = 0; i < 4; ++i) *(LAS f32x4*)(F2s + tid * 4 + 2048 * i) = *(const f32x4*)(F2G + (size_t)bh * T + tid * 4 + 2048 * i);
        __syncthreads();
        const float m0 = sqrtf(__uint_as_float(__hip_atomic_load(NRMB + bh * 2 + 1, __ATOMIC_RELAXED, __HIP_MEMORY_SCOPE_AGENT)));
        attn_body::attn_unit<8>(bh >> 3, bh & 7, qb, pb + C_Q, pb + C_K, pb + C_V, pb + C_Q, (char*)lds, (attn_body::lds_fptr)F2s, ts_u, m0);
    }
}

typedef float f32x16 __attribute__((ext_vector_type(16)));
struct S5M { float ar[2], ai[2], a16r[2], a16i[2]; bf16x8 bfr[4]; };
__device__ __forceinline__ int tau32(int i) { return 16 * ((i >> 2) & 1) + 4 * (i >> 3) + (i & 3); }
__device__ __forceinline__ void s5m_setup(PrmP p, int l, int g, int lane, S5M& c) {
    const int nl = lane & 31, hi = lane >> 5;
    const float dt = expf(p->in[I_S5LOGDT][l * 16 + g]);
    u32x4 fre[2], fim[2];
#pragma unroll
    for (int s = 0; s < 2; ++s) { const int pi = 32 * s + nl;
        const float are = p->in[I_S5ARE][(l * 16 + g) * 64 + pi], aim = p->in[I_S5AIM][(l * 16 + g) * 64 + pi];
        const float mag = expf(are * dt); const float th = aim * dt * 0.3183098861837907f; const float abr = mag * cospif(th), abi = mag * sinpif(th);
        const float den = are * are + aim * aim, nre = abr - 1.f;
        const float kre = (nre * are + abi * aim) / den, kim = (abi * are - nre * aim) / den;
        c.ar[s] = abr; c.ai[s] = abi;
        float pr = abr, pi_ = abi;
#pragma unroll
        for (int q = 0; q < 4; ++q) { const float nr = pr * pr - pi_ * pi_, ni = 2.f * pr * pi_; pr = nr; pi_ = ni; }
        c.a16r[s] = pr; c.a16i[s] = pi_;
        const float* brp = p->in[I_S5BRE] + ((size_t)(l * 16 + g) * 64 + pi) * 16 + 8 * hi; const float* bip = p->in[I_S5BIM] + ((size_t)(l * 16 + g) * 64 + pi) * 16 + 8 * hi;
        const f32x4 br0 = *(const f32x4*)brp, br1 = *(const f32x4*)(brp + 4), bi0 = *(const f32x4*)bip, bi1 = *(const f32x4*)(bip + 4);
        const f32x4 re0 = br0 * kre - bi0 * kim, re1 = br1 * kre - bi1 * kim, im0 = bi0 * kre + br0 * kim, im1 = bi1 * kre + br1 * kim;
        fre[s] = (u32x4){pk2(re0.x, re0.y), pk2(re0.z, re0.w), pk2(re1.x, re1.y), pk2(re1.z, re1.w)};
        fim[s] = (u32x4){pk2(im0.x, im0.y), pk2(im0.z, im0.w), pk2(im1.x, im1.y), pk2(im1.z, im1.w)}; }
    c.bfr[0] = __builtin_bit_cast(bf16x8, fre[0]); c.bfr[1] = __builtin_bit_cast(bf16x8, fre[1]); c.bfr[2] = __builtin_bit_cast(bf16x8, fim[0]); c.bfr[3] = __builtin_bit_cast(bf16x8, fim[1]);
}
__device__ __forceinline__ void s5m_cfrag(PrmP p, int l, int g, int lane, bf16x8 (&cmf)[8], bf16x8& dfr) {
    const int nl = lane & 31, hi = lane >> 5;
    const float* cre = p->in[I_S5CRE] + ((size_t)(l * 16 + g) * 16 + (nl & 15)) * 64; const float* cim = p->in[I_S5CIM] + ((size_t)(l * 16 + g) * 16 + (nl & 15)) * 64;
    const bool okc = nl < 16;
#pragma unroll
    for (int ks = 0; ks < 8; ++ks) { const int j0 = 4 * ks + 2 * hi; const float2 ra = *(const float2*)(cre + j0), rb2 = *(const float2*)(cre + 32 + j0), ia = *(const float2*)(cim + j0), ib = *(const float2*)(cim + 32 + j0);
        u32x4 w; w.x = pk2(ra.x, rb2.x); w.y = pk2(-ia.x, -ib.x); w.z = pk2(ra.y, rb2.y); w.w = pk2(-ia.y, -ib.y);
        if (!okc) w = (u32x4){0u, 0u, 0u, 0u}; cmf[ks] = __builtin_bit_cast(bf16x8, w); }
    const float dv = p->in[I_S5D][l * 256 + g * 16 + (nl & 15)]; const int jd = nl - 8 * hi;
    const unsigned db = f2bf(dv); u32x4 w = (u32x4){0u, 0u, 0u, 0u};
    if (okc && jd >= 0 && jd < 8) { const unsigned v = (jd & 1) ? (db << 16) : db; if ((jd >> 1) == 0) w.x = v; else if ((jd >> 1) == 1) w.y = v; else if ((jd >> 1) == 2) w.z = v; else w.w = v; }
    dfr = __builtin_bit_cast(bf16x8, w);
}
__device__ __forceinline__ void s5m_table_build(PrmP p, int l, int g, int lane) {
    S5M c; s5m_setup(p, l, g, lane, c); bf16x8 cmf[8]; bf16x8 dfr; s5m_cfrag(p, l, g, lane, cmf, dfr);
    u32x4* tb = (u32x4*)(p->ws + WS_S5T) + (size_t)(l * 16 + g) * 15 * 64 + lane;
    tb[0 * 64] = (u32x4){__float_as_uint(c.ar[0]), __float_as_uint(c.ar[1]), __float_as_uint(c.ai[0]), __float_as_uint(c.ai[1])};
    tb[1 * 64] = (u32x4){__float_as_uint(c.a16r[0]), __float_as_uint(c.a16r[1]), __float_as_uint(c.a16i[0]), __float_as_uint(c.a16i[1])};
#pragma unroll
    for (int q = 0; q < 4; ++q) tb[(2 + q) * 64] = __builtin_bit_cast(u32x4, c.bfr[q]);
#pragma unroll
    for (int q = 0; q < 8; ++q) tb[(6 + q) * 64] = __builtin_bit_cast(u32x4, cmf[q]);
    tb[14 * 64] = __builtin_bit_cast(u32x4, dfr);
}
__device__ __forceinline__ void s5m_load(PrmP p, int l, int g, int lane, S5M& c) {
    const u32x4* tb = (const u32x4*)(p->ws + WS_S5T) + (size_t)(l * 16 + g) * 15 * 64 + lane;
    const u32x4 a = tb[0], b = tb[64];
    c.ar[0] = __uint_as_float(a.x); c.ar[1] = __uint_as_float(a.y); c.ai[0] = __uint_as_float(a.z); c.ai[1] = __uint_as_float(a.w);
    c.a16r[0] = __uint_as_float(b.x); c.a16r[1] = __uint_as_float(b.y); c.a16i[0] = __uint_as_float(b.z); c.a16i[1] = __uint_as_float(b.w);
#pragma unroll
    for (int q = 0; q < 4; ++q) c.bfr[q] = __builtin_bit_cast(bf16x8, tb[(2 + q) * 64]);
}
__device__ __forceinline__ void s5m_load_c(PrmP p, int l, int g, int lane, bf16x8 (&cmf)[8], bf16x8& dfr) {
    const u32x4* tb = (const u32x4*)(p->ws + WS_S5T) + (size_t)(l * 16 + g) * 15 * 64 + lane;
#pragma unroll
    for (int q = 0; q < 8; ++q) cmf[q] = __builtin_bit_cast(bf16x8, tb[(6 + q) * 64]);
    dfr = __builtin_bit_cast(bf16x8, tb[14 * 64]);
}
__device__ __forceinline__ void s5m_bu(const bf16_t* PB, size_t rb, int tb, int g, int lane, const S5M& c, f32x16 (&bu)[4], bf16x8& ufrag) {
    const int i = lane & 31, hi = lane >> 5;
    ufrag = *(const bf16x8*)(PB + (rb + tb + tau32(i)) * NP + C_S5 + 16 * g + 8 * hi);
    const f32x16 z = f32x16{};
#pragma unroll
    for (int q = 0; q < 4; ++q) bu[q] = __builtin_amdgcn_mfma_f32_32x32x16_bf16(ufrag, c.bfr[q], z, 0, 0, 0);
}
__device__ __forceinline__ void s5m_tile_end(const S5M& c, const f32x16 (&bu)[4], float (&xr)[2], float (&xi)[2]) {
#pragma unroll
    for (int s = 0; s < 2; ++s) { float er = bu[s][0], ei = bu[2 + s][0];
#pragma unroll
        for (int r = 1; r < 16; ++r) { const float nr = c.ar[s] * er - c.ai[s] * ei + bu[s][r], ni = c.ar[s] * ei + c.ai[s] * er + bu[2 + s][r]; er = nr; ei = ni; }
        const auto swr_ = __builtin_amdgcn_permlane32_swap(__float_as_uint(er), __float_as_uint(er), false, false), swi_ = __builtin_amdgcn_permlane32_swap(__float_as_uint(ei), __float_as_uint(ei), false, false);
        const float elr = __uint_as_float(swr_[0]), eli = __uint_as_float(swi_[0]), ehr = __uint_as_float(swr_[1]), ehi = __uint_as_float(swi_[1]);
        const float t1r = c.a16r[s] * xr[s] - c.a16i[s] * xi[s] + elr, t1i = c.a16r[s] * xi[s] + c.a16i[s] * xr[s] + eli;
        xr[s] = c.a16r[s] * t1r - c.a16i[s] * t1i + ehr; xi[s] = c.a16r[s] * t1i + c.a16i[s] * t1r + ehi; }
}
__device__ __forceinline__ void fs_scan(PrmP p, int l, LAS unsigned char* lds, int wg, int nwg) {
    const int tid = fresh_tid(), lane = tid & 63, wave = tid >> 6;
    f2_items(p, l, lds, wg, nwg);
    const bf16_t* PB = (const bf16_t*)(p->ws + WS_PB);
    { bf16_t* HLOC = (bf16_t*)(p->ws + WS_YL); bf16_t* PCUM = (bf16_t*)(p->ws + WS_YS0); float* AGG = (float*)(p->ws + WS_AGG);
      LAS unsigned char* xa = lds + wave * 13312; LAS unsigned char* xf = xa + 4608;
      const int nl = lane & 31, hi = lane >> 5;
      for (int it = wave * nwg + wg; it < 2048; it += nwg * NWAVES) {
        const int b = it >> 9, c = (it >> 2) & 127, blk = it & 3; const size_t rb = (size_t)b * T; const int t0 = c * 64;
        const bf16_t* wt = (const bf16_t*)(p->ws + WS_LRUW) + (size_t)(l * 4 + blk) * 2 * 4096 + (size_t)nl * 64 + 8 * hi;
        const int chc = blk * 64 + lane;
        const float cw0 = p->in[I_CONVW][(l * 4 + 0) * 256 + chc], cw1 = p->in[I_CONVW][(l * 4 + 1) * 256 + chc], cw2 = p->in[I_CONVW][(l * 4 + 2) * 256 + chc], cw3 = p->in[I_CONVW][(l * 4 + 3) * 256 + chc], cb = p->in[I_CONVB][l * 256 + chc];
        float ba[2], bx[2], sp8[2];
#pragma unroll
        for (int s2 = 0; s2 < 2; ++s2) { const int ch = blk * 64 + 32 * s2 + nl; ba[s2] = p->in[I_LRUBA][l * 256 + ch]; bx[s2] = p->in[I_LRUBX][l * 256 + ch]; sp8[s2] = -8.f * log1pf(expf(-p->in[I_LAMBDA][l * 256 + ch])); }
        float x1 = (t0 >= 1) ? bf2f(PB[(rb + t0 - 1) * NP + C_LX + chc]) : 0.f, x2 = (t0 >= 2) ? bf2f(PB[(rb + t0 - 2) * NP + C_LX + chc]) : 0.f, x3 = (t0 >= 3) ? bf2f(PB[(rb + t0 - 3) * NP + C_LX + chc]) : 0.f;
        float hin[2] = {0.f, 0.f}, pin[2] = {1.f, 1.f};
#pragma unroll 1
        for (int mt = 0; mt < 2; ++mt) { const int tb = t0 + mt * 32;
#pragma unroll 1
            for (int th = 0; th < 32; th += 16) { float xin[16];
#pragma unroll
              for (int tt = 0; tt < 16; ++tt) xin[tt] = bf2f(PB[(rb + tb + th + tt) * NP + C_LX + chc]);
#pragma unroll
              for (int tt = 0; tt < 16; ++tt) { const float xr = cb + cw0 * x3 + cw1 * x2 + cw2 * x1 + cw3 * xin[tt]; x3 = x2; x2 = x1; x1 = xin[tt];
                  *(LAS bf16_t*)(xa + (th + tt) * 144 + lane * 2) = (bf16_t)f2bf(xr); *(LAS float*)(xf + (th + tt) * 272 + lane * 4) = xr; } }
            asm volatile("s_waitcnt lgkmcnt(0)" ::: "memory");
            f32x16 acc[4];
#pragma unroll
            for (int q = 0; q < 4; ++q) acc[q] = f32x16{};
#pragma unroll
            for (int ks = 0; ks < 4; ++ks) { const bf16x8 af = *(const LAS bf16x8*)(xa + tau32(nl) * 144 + (16 * ks + 8 * hi) * 2);
#pragma unroll
                for (int q = 0; q < 4; ++q) { const bf16x8 wfr = *(const bf16x8*)(wt + ((size_t)(q >> 1) * 64 + 32 * (q & 1)) * 64 + 16 * ks); acc[q] = __builtin_amdgcn_mfma_f32_32x32x16_bf16(af, wfr, acc[q], 0, 0, 0); } }
#pragma unroll
            for (int s2 = 0; s2 < 2; ++s2) { const int ch = blk * 64 + 32 * s2 + nl;
                float hl[16], pl[16]; float h = 0.f, P = 1.f;
#pragma unroll
                for (int r = 0; r < 16; ++r) { const float xr = *(const LAS float*)(xf + (16 * hi + r) * 272 + (32 * s2 + nl) * 4);
                    const float rg = sigmoidf_(acc[s2][r] + ba[s2]), ig = sigmoidf_(acc[2 + s2][r] + bx[s2]);
                    const float la = sp8[s2] * rg, a = __expf(la), x2a = 2.f * la;
                    const float om = (x2a > -0.125f) ? -x2a * (1.f + x2a * (0.5f + x2a * (0.16666667f + x2a * 0.041666668f))) : 1.f - a * a;
                    h = a * h + xr * ig * __builtin_amdgcn_sqrtf(om); P *= a; hl[r] = h; pl[r] = P; }
                const float h0e = __shfl(h, nl), p0e = __shfl(P, nl);
                const float hs = hi ? h0e + p0e * hin[s2] : hin[s2], ps = hi ? pin[s2] * p0e : pin[s2];
#pragma unroll
                for (int r = 0; r < 16; ++r) { const size_t m = rb + tb + 16 * hi + r; HLOC[m * 256 + ch] = (bf16_t)f2bf(hl[r] + pl[r] * hs); PCUM[m * 256 + ch] = (bf16_t)f2bf(pl[r] * ps); }
                const float he = hl[15] + pl[15] * hs, pe = pl[15] * ps;
                hin[s2] = __shfl(he, 32 + nl); pin[s2] = __shfl(pe, 32 + nl); }
            asm volatile("s_waitcnt lgkmcnt(0)" ::: "memory");
        }
        if (hi == 0) {
#pragma unroll
            for (int s2 = 0; s2 < 2; ++s2) { const int ch = blk * 64 + 32 * s2 + nl; AGG[((size_t)(b * 128 + c) * 2 + 0) * 256 + ch] = pin[s2]; AGG[((size_t)(b * 128 + c) * 2 + 1) * 256 + ch] = hin[s2]; } }
      }
    }
    { unsigned* NRM = (unsigned*)(p->ws + WS_CTL) + CW_NRM;
      for (int it = wg; it < M / 128; it += nwg) { const int b = it / (T / 128); float mq = 0.f, mk = 0.f;
#pragma unroll 1
        for (int r8 = 0; r8 < 2; ++r8) { u32x4 qwv[8], kwv[8];
#pragma unroll
          for (int q8 = 0; q8 < 8; ++q8) { const size_t m = (size_t)it * 128 + wave * 16 + r8 * 8 + q8; qwv[q8] = *(const u32x4*)(PB + m * NP + C_Q + 8 * lane); kwv[q8] = *(const u32x4*)(PB + m * NP + C_K + 8 * lane); }
#pragma unroll
          for (int q8 = 0; q8 < 8; ++q8) { const u32x4 qw = qwv[q8], kw = kwv[q8];
            float sq = bflo(qw.x) * bflo(qw.x) + bfhi(qw.x) * bfhi(qw.x) + bflo(qw.y) * bflo(qw.y) + bfhi(qw.y) * bfhi(qw.y) + bflo(qw.z) * bflo(qw.z) + bfhi(qw.z) * bfhi(qw.z) + bflo(qw.w) * bflo(qw.w) + bfhi(qw.w) * bfhi(qw.w);
            float sk = bflo(kw.x) * bflo(kw.x) + bfhi(kw.x) * bfhi(kw.x) + bflo(kw.y) * bflo(kw.y) + bfhi(kw.y) * bfhi(kw.y) + bflo(kw.z) * bflo(kw.z) + bfhi(kw.z) * bfhi(kw.z) + bflo(kw.w) * bflo(kw.w) + bfhi(kw.w) * bfhi(kw.w);
#pragma unroll
            for (int o = 0; o < 1; ++o) { sq += dppf<DPP_XOR1>(sq); sk += dppf<DPP_XOR1>(sk); sq += dppf<DPP_XOR2>(sq); sk += dppf<DPP_XOR2>(sk); sq += dppf<DPP_HMIRROR>(sq); sk += dppf<DPP_HMIRROR>(sk); }
            mq = fmaxf(mq, sq); mk = fmaxf(mk, sk); } }
        if ((lane & 7) == 0) { const int hh = lane >> 3, bh = b * 8 + hh, il = it % (T / 128); atomicMax(NRM + (l * 32 + bh) * 2, __float_as_uint(mq)); atomicMax(NRM + (l * 32 + bh) * 2 + 1, __float_as_uint(mk));
            unsigned* CT = (unsigned*)(p->ws + WS_CTL); atomicMax(CT + CW_QN + (l * 32 + bh) * 32 + (il >> 1), __float_as_uint(mq)); atomicMax(CT + CW_KT + (l * 32 + bh) * 128 + il * 2 + (wave >> 2), __float_as_uint(mk)); } }
    }
    { float* XEND = (float*)(p->ws + WS_XEND);
      for (int it = wave * nwg + wg; it < 2048; it += nwg * NWAVES) {
        const int b = it >> 9, g = (it >> 5) & 15, cq = it & 31;
        S5M cf; s5m_load(p, l, g, lane, cf);
        float a64r[2], a64i[2], x4r[2] = {0.f, 0.f}, x4i[2] = {0.f, 0.f};
#pragma unroll
        for (int s2 = 0; s2 < 2; ++s2) { float pr = cf.a16r[s2], pi_ = cf.a16i[s2];
#pragma unroll
            for (int q = 0; q < 2; ++q) { const float nr = pr * pr - pi_ * pi_, ni = 2.f * pr * pi_; pr = nr; pi_ = ni; }
            a64r[s2] = pr; a64i[s2] = pi_; }
        bf16x8 ufs[8];
#pragma unroll
        for (int t8 = 0; t8 < 8; ++t8) ufs[t8] = *(const bf16x8*)(PB + ((size_t)b * T + cq * 256 + t8 * 32 + tau32(lane & 31)) * NP + C_S5 + 16 * g + 8 * (lane >> 5));
#pragma unroll
        for (int k = 0; k < 4; ++k) { const int c = cq * 4 + k; float xr[2] = {0.f, 0.f}, xi[2] = {0.f, 0.f};
#pragma unroll
            for (int mt = 0; mt < 2; ++mt) { f32x16 bu[4]; const f32x16 z = f32x16{};
#pragma unroll
                for (int q = 0; q < 4; ++q) bu[q] = __builtin_amdgcn_mfma_f32_32x32x16_bf16(ufs[2 * k + mt], cf.bfr[q], z, 0, 0, 0);
                s5m_tile_end(cf, bu, xr, xi); }
#pragma unroll
            for (int s2 = 0; s2 < 2; ++s2) { const float nr = a64r[s2] * x4r[s2] - a64i[s2] * x4i[s2] + xr[s2], ni = a64r[s2] * x4i[s2] + a64i[s2] * x4r[s2] + xi[s2]; x4r[s2] = nr; x4i[s2] = ni; }
            if (lane < 32) { float* xe = XEND + ((size_t)((b * 16 + g) * 128 + c) * 64) * 2;
                *(float2*)(xe + lane * 2) = make_float2(xr[0], xi[0]); *(float2*)(xe + (32 + lane) * 2) = make_float2(xr[1], xi[1]); } }
        if (lane < 32) { float* xe = (float*)(p->ws + WS_X4END) + ((size_t)((b * 16 + g) * 32 + cq) * 64) * 2;
            *(float2*)(xe + lane * 2) = make_float2(x4r[0], x4i[0]); *(float2*)(xe + (32 + lane) * 2) = make_float2(x4r[1], x4i[1]); }
      }
    }
}

constexpr int FIN_YSB = 0, FIN_XST = 34816, FIN_CAR = FIN_XST + 8 * 8704;
static_assert(64 * 264 * 2 <= FIN_XST && FIN_CAR + 1024 <= 131072, "finalize LDS map");
__device__ __forceinline__ void fs_fin(PrmP p, int l, LAS unsigned char* lds, int wg, int nwg) {
    const int tid = fresh_tid(), lane = tid & 63, wave = tid >> 6, fr = lane & 15, fq = lane >> 4, nl = lane & 31, hi = lane >> 5;
    const bf16_t* PB = (const bf16_t*)(p->ws + WS_PB); bf16_t* YC = (bf16_t*)(p->ws + WS_YC);
    const bf16_t* HLOC = (const bf16_t*)(p->ws + WS_YL); const bf16_t* PCUM = (const bf16_t*)(p->ws + WS_YS0); const float* AGG = (const float*)(p->ws + WS_AGG); const float* XEND = (const float*)(p->ws + WS_XEND);
    LAS bf16_t* ysb = (LAS bf16_t*)(lds + FIN_YSB); LAS unsigned char* xst = lds + FIN_XST + wave * 8704; LAS float* car = (LAS float*)(lds + FIN_CAR);
    for (int it = wg; it < NB * 128; it += nwg) {
        const int b = it >> 7, c = (it & 256) ? 127 - (it & 127) : (it & 127), t0 = c * 64; const size_t rb = (size_t)b * T;
        __syncthreads();
        if (tid < 256) { float cr = 0.f; const float* ag = AGG + (size_t)(b * 128) * 512 + (fresh_tid() & 255); int cc = 0;
            for (; cc + 8 <= c; cc += 8) { float A[8], H[8];
#pragma unroll
                for (int q = 0; q < 8; ++q) { A[q] = ag[(size_t)(cc + q) * 512]; H[q] = ag[(size_t)(cc + q) * 512 + 256]; }
#pragma unroll
                for (int q = 0; q < 8; ++q) cr = A[q] * cr + H[q]; }
            for (; cc < c; ++cc) cr = ag[(size_t)cc * 512] * cr + ag[(size_t)cc * 512 + 256];
            car[tid] = cr; }
#pragma unroll 1
        for (int gi = 0; gi < 2; ++gi) { const int g = wave + 8 * gi;
            S5M cf; s5m_load(p, l, g, lane, cf);
            bf16x8 cmf[8]; bf16x8 dfr; s5m_load_c(p, l, g, lane, cmf, dfr);
            float xr[2] = {0.f, 0.f}, xi[2] = {0.f, 0.f};
            { float a64r[2], a64i[2];
#pragma unroll
              for (int s = 0; s < 2; ++s) { float pr = cf.a16r[s], pi_ = cf.a16i[s];
#pragma unroll
                  for (int q = 0; q < 2; ++q) { const float nr = pr * pr - pi_ * pi_, ni = 2.f * pr * pi_; pr = nr; pi_ = ni; }
                  a64r[s] = pr; a64i[s] = pi_; }
              float a256r[2], a256i[2];
#pragma unroll
              for (int s = 0; s < 2; ++s) { float pr = a64r[s], pi_ = a64i[s];
#pragma unroll
                  for (int q = 0; q < 2; ++q) { const float nr = pr * pr - pi_ * pi_, ni = 2.f * pr * pi_; pr = nr; pi_ = ni; }
                  a256r[s] = pr; a256i[s] = pi_; }
              const float* x4 = (const float*)(p->ws + WS_X4END) + ((size_t)((b * 16 + g) * 32) * 64) * 2 + nl * 2;
              const int nb4 = c >> 2; int cb = 0;
              for (; cb + 4 <= nb4; cb += 4) { float2 e0[4], e1[4];
#pragma unroll
                  for (int q = 0; q < 4; ++q) { e0[q] = *(const float2*)(x4 + (size_t)(cb + q) * 128); e1[q] = *(const float2*)(x4 + (size_t)(cb + q) * 128 + 64); }
#pragma unroll
                  for (int q = 0; q < 4; ++q) {
                      float nr = a256r[0] * xr[0] - a256i[0] * xi[0] + e0[q].x, ni = a256r[0] * xi[0] + a256i[0] * xr[0] + e0[q].y; xr[0] = nr; xi[0] = ni;
                      nr = a256r[1] * xr[1] - a256i[1] * xi[1] + e1[q].x; ni = a256r[1] * xi[1] + a256i[1] * xr[1] + e1[q].y; xr[1] = nr; xi[1] = ni; } }
              for (; cb < nb4; ++cb) { const float2 e0 = *(const float2*)(x4 + (size_t)cb * 128), e1 = *(const float2*)(x4 + (size_t)cb * 128 + 64);
                  float nr = a256r[0] * xr[0] - a256i[0] * xi[0] + e0.x, ni = a256r[0] * xi[0] + a256i[0] * xr[0] + e0.y; xr[0] = nr; xi[0] = ni;
                  nr = a256r[1] * xr[1] - a256i[1] * xi[1] + e1.x; ni = a256r[1] * xi[1] + a256i[1] * xr[1] + e1.y; xr[1] = nr; xi[1] = ni; }
              const float* xe = XEND + ((size_t)((b * 16 + g) * 128) * 64) * 2 + nl * 2;
              for (int cc = nb4 * 4; cc < c; ++cc) { const float2 e0 = *(const float2*)(xe + (size_t)cc * 128), e1 = *(const float2*)(xe + (size_t)cc * 128 + 64);
                  float nr = a64r[0] * xr[0] - a64i[0] * xi[0] + e0.x, ni = a64r[0] * xi[0] + a64i[0] * xr[0] + e0.y; xr[0] = nr; xi[0] = ni;
                  nr = a64r[1] * xr[1] - a64i[1] * xi[1] + e1.x; ni = a64r[1] * xi[1] + a64i[1] * xr[1] + e1.y; xr[1] = nr; xi[1] = ni; } }
#pragma unroll 1
            for (int mt = 0; mt < 2; ++mt) {
                f32x16 bu[4]; bf16x8 uf; s5m_bu(PB, rb, t0 + mt * 32, g, lane, cf, bu, uf);
#pragma unroll
                for (int s = 0; s < 2; ++s) {
#pragma unroll
                    for (int r = 1; r < 16; ++r) { const float pr = bu[s][r - 1], pi_ = bu[2 + s][r - 1]; bu[s][r] += cf.ar[s] * pr - cf.ai[s] * pi_; bu[2 + s][r] += cf.ar[s] * pi_ + cf.ai[s] * pr; }
                    const float er = bu[s][15], ei = bu[2 + s][15];
                    const auto swr_ = __builtin_amdgcn_permlane32_swap(__float_as_uint(er), __float_as_uint(er), false, false), swi_ = __builtin_amdgcn_permlane32_swap(__float_as_uint(ei), __float_as_uint(ei), false, false);
                    const float elr = __uint_as_float(swr_[0]), eli = __uint_as_float(swi_[0]), ehr = __uint_as_float(swr_[1]), ehi = __uint_as_float(swi_[1]);
                    const float t1r = cf.a16r[s] * xr[s] - cf.a16i[s] * xi[s] + elr, t1i = cf.a16r[s] * xi[s] + cf.a16i[s] * xr[s] + eli;
                    float wr = hi ? t1r : xr[s], wi = hi ? t1i : xi[s];
                    xr[s] = cf.a16r[s] * t1r - cf.a16i[s] * t1i + ehr; xi[s] = cf.a16r[s] * t1i + cf.a16i[s] * t1r + ehi;
#pragma unroll
                    for (int r = 0; r < 16; ++r) { const float nr = cf.ar[s] * wr - cf.ai[s] * wi, ni = cf.ar[s] * wi + cf.ai[s] * wr; wr = nr; wi = ni; bu[s][r] += wr; bu[2 + s][r] += wi; }
                }
#pragma unroll
                for (int r = 0; r < 16; ++r) { u32x2 w; w.x = pk2(bu[0][r], bu[1][r]); w.y = pk2(bu[2][r], bu[3][r]); *(LAS u32x2*)(xst + (16 * hi + r) * 272 + nl * 8) = w; }
                asm volatile("s_waitcnt lgkmcnt(0)" ::: "memory");
                f32x16 acc = __builtin_amdgcn_mfma_f32_32x32x16_bf16(uf, dfr, f32x16{}, 0, 0, 0);
#pragma unroll
                for (int ks = 0; ks < 8; ++ks) { const bf16x8 af = *(const LAS bf16x8*)(xst + tau32(nl) * 272 + (16 * ks + 8 * hi) * 2); acc = __builtin_amdgcn_mfma_f32_32x32x16_bf16(af, cmf[ks], acc, 0, 0, 0); }
                if (nl < 16) {
#pragma unroll
                    for (int r = 0; r < 16; ++r) ysb[(mt * 32 + 16 * hi + r) * 264 + g * 16 + nl] = (bf16_t)f2bf(gelu_tanh(acc[r])); }
                asm volatile("s_waitcnt lgkmcnt(0)" ::: "memory");
            }
        }
        __syncthreads();
        { const bf16_t* GW = (const bf16_t*)(p->ws + WS_GLUW) + (size_t)l * 65536;
          f32x4 acc[4][2];
#pragma unroll
          for (int m = 0; m < 4; ++m) { acc[m][0] = (f32x4){0.f, 0.f, 0.f, 0.f}; acc[m][1] = (f32x4){0.f, 0.f, 0.f, 0.f}; }
#pragma unroll 2
          for (int ks = 0; ks < 8; ++ks) { bf16x8 a[4], bb[2];
#pragma unroll
              for (int m = 0; m < 4; ++m) a[m] = *(const LAS bf16x8*)(ysb + (m * 16 + fr) * 264 + ks * 32 + 8 * fq);
#pragma unroll
              for (int n = 0; n < 2; ++n) bb[n] = *(const bf16x8*)(GW + (size_t)((2 * wave + n) * 16 + fr) * 256 + ks * 32 + 8 * fq);
#pragma unroll
              for (int m = 0; m < 4; ++m)
#pragma unroll
                  for (int n = 0; n < 2; ++n) acc[m][n] = __builtin_amdgcn_mfma_f32_16x16x32_bf16(a[m], bb[n], acc[m][n], 0, 0, 0); }
          __syncthreads();
#pragma unroll
          for (int n = 0; n < 2; ++n) { const int j = (2 * wave + n) * 16 + fr; const float gb = p->in[I_GLUB][l * 256 + j];
#pragma unroll
              for (int m = 0; m < 4; ++m)
#pragma unroll
                  for (int r = 0; r < 4; ++r) { const int tk = m * 16 + 4 * fq + r; const float y = bf2f(ysb[tk * 264 + j]); ysb[tk * 264 + j] = (bf16_t)f2bf(y * sigmoidf_(acc[m][n][r] + gb)); } }
        }
        __syncthreads();
        { const f32x4 ggl = *(const f32x4*)(p->in[I_GNLRU] + l * 256 + 4 * lane), ggs = *(const f32x4*)(p->in[I_GNS5] + l * 256 + 4 * lane);
          const f32x4 g0 = *(const f32x4*)(p->in[I_GNATT] + l * 512 + 8 * lane), g1 = *(const f32x4*)(p->in[I_GNATT] + l * 512 + 8 * lane + 4); const f32x4 cr = *(const LAS f32x4*)(car + 4 * lane);
#pragma unroll 1
          for (int rq = 0; rq < 2; ++rq) {
            u32x2 hw[4], pw[4], gw[4]; u32x4 ow[4];
#pragma unroll
            for (int q = 0; q < 4; ++q) { const size_t m = rb + t0 + wave + 8 * (4 * rq + q);
                hw[q] = *(const u32x2*)(HLOC + m * 256 + 4 * lane); pw[q] = *(const u32x2*)(PCUM + m * 256 + 4 * lane); gw[q] = *(const u32x2*)(PB + m * NP + C_LG + 4 * lane); ow[q] = *(const u32x4*)(PB + m * NP + C_Q + 8 * lane); }
#pragma unroll
            for (int q = 0; q < 4; ++q) { const int r = wave + 8 * (4 * rq + q); const size_t m = rb + t0 + r;
              { const f32x4 hl = (f32x4){bflo(hw[q].x), bfhi(hw[q].x), bflo(hw[q].y), bfhi(hw[q].y)}, pc = (f32x4){bflo(pw[q].x), bfhi(pw[q].x), bflo(pw[q].y), bfhi(pw[q].y)};
                f32x4 v; v.x = (hl.x + pc.x * cr.x) * gelu_tanh(bflo(gw[q].x)); v.y = (hl.y + pc.y * cr.y) * gelu_tanh(bfhi(gw[q].x)); v.z = (hl.z + pc.z * cr.z) * gelu_tanh(bflo(gw[q].y)); v.w = (hl.w + pc.w * cr.w) * gelu_tanh(bfhi(gw[q].y));
                const float rs = __builtin_amdgcn_rsqf(wave_sum(v.x * v.x + v.y * v.y + v.z * v.z + v.w * v.w) * (1.f / 256.f) + RMS_EPS);
                u32x2 o; o.x = pk2(v.x * rs * ggl.x, v.y * rs * ggl.y); o.y = pk2(v.z * rs * ggl.z, v.w * rs * ggl.w); if (OUT_FP8) *(unsigned*)((unsigned char*)YC + m * 1024 + 4 * lane) = pk4_fp8(8.f * v.x * rs * ggl.x, 8.f * v.y * rs * ggl.y, 8.f * v.z * rs * ggl.z, 8.f * v.w * rs * ggl.w); else *(u32x2*)(YC + m * 1024 + 4 * lane) = o; }
              { const u32x2 yw = *(const LAS u32x2*)(ysb + r * 264 + 4 * lane); const f32x4 v = (f32x4){bflo(yw.x), bfhi(yw.x), bflo(yw.y), bfhi(yw.y)};
                const float rs = __builtin_amdgcn_rsqf(wave_sum(v.x * v.x + v.y * v.y + v.z * v.z + v.w * v.w) * (1.f / 256.f) + RMS_EPS);
                u32x2 o; o.x = pk2(v.x * rs * ggs.x, v.y * rs * ggs.y); o.y = pk2(v.z * rs * ggs.z, v.w * rs * ggs.w); if (OUT_FP8) *(unsigned*)((unsigned char*)YC + m * 1024 + 256 + 4 * lane) = pk4_fp8(8.f * v.x * rs * ggs.x, 8.f * v.y * rs * ggs.y, 8.f * v.z * rs * ggs.z, 8.f * v.w * rs * ggs.w); else *(u32x2*)(YC + m * 1024 + 256 + 4 * lane) = o; }
              { const u32x4 w = ow[q];
                const float v[8] = {bflo(w.x), bfhi(w.x), bflo(w.y), bfhi(w.y), bflo(w.z), bfhi(w.z), bflo(w.w), bfhi(w.w)};
                float ss = 0.f;
#pragma unroll
                for (int i = 0; i < 8; ++i) ss += v[i] * v[i];
                const float rs = __builtin_amdgcn_rsqf(wave_sum(ss) * (1.f / 512.f) + RMS_EPS);
                u32x4 o; o.x = pk2(v[0] * rs * g0.x, v[1] * rs * g0.y); o.y = pk2(v[2] * rs * g0.z, v[3] * rs * g0.w); o.z = pk2(v[4] * rs * g1.x, v[5] * rs * g1.y); o.w = pk2(v[6] * rs * g1.z, v[7] * rs * g1.w);
                if (OUT_FP8) { u32x2 o8; const float r8 = 8.f * rs; o8.x = pk4_fp8(v[0] * r8 * g0.x, v[1] * r8 * g0.y, v[2] * r8 * g0.z, v[3] * r8 * g0.w); o8.y = pk4_fp8(v[4] * r8 * g1.x, v[5] * r8 * g1.y, v[6] * r8 * g1.z, v[7] * r8 * g1.w);
                    *(u32x2*)((unsigned char*)YC + m * 1024 + 512 + 8 * lane) = o8; }
                else *(u32x4*)(YC + m * 1024 + 512 + 8 * lane) = o; } } } }
    }
}

constexpr int ROW_WT = 0, ROW_WT_LD = 1028, ROW_ETAB = 131584 + 64;
__device__ __forceinline__ void ph_row(PrmP p, int l, LAS unsigned char* lds, int wg, int nwg) {
    const int tid = fresh_tid(), lane = tid & 63, wave = tid >> 6;
    const int R = M / nwg;
    const float* Xin = p->in[I_X]; bf16_t* XB = (bf16_t*)(p->ws + WS_XB); const bf16_t* Y = (const bf16_t*)(p->ws + WS_Y);
    const float* MOD = (const float*)(p->ws + WS_MOD); bf16_t* HB = (bf16_t*)(p->ws + WS_HB);
    int* TOPI = (int*)(p->ws + WS_MISC + MS_TOPI); float* TOPG = (float*)(p->ws + WS_MISC + MS_TOPG); int* RANK = (int*)(p->ws + WS_MISC + MS_RANK); int* HIST = (int*)(p->ws + WS_MISC + MS_HIST);
    LAS int* etab = (LAS int*)(lds + ROW_ETAB);
    LAS float* wt = (LAS float*)(lds + ROW_WT);
    const float* RW = p->in[I_ROUTW] + (size_t)l * 1024 * 32; const float* RB = p->in[I_ROUTB] + l * 32;
    __syncthreads();
    { f32x4 wv[16];
#pragma unroll
      for (int k = 0; k < 16; ++k) wv[k] = *(const f32x4*)(RW + tid * 4 + 2048 * k);
#pragma unroll
      for (int k = 0; k < 16; ++k) { const int i = tid * 4 + 2048 * k, e = i & 31, d = i >> 5; wt[e * ROW_WT_LD + d] = wv[k].x; wt[(e + 1) * ROW_WT_LD + d] = wv[k].y; wt[(e + 2) * ROW_WT_LD + d] = wv[k].z; wt[(e + 3) * ROW_WT_LD + d] = wv[k].w; } }
    __syncthreads();
    const float rbias = RB[(lane >> 1) & 31];
    const int RPW = R / NWAVES; constexpr int NR = 2;
    u32x2 ywn[NR][4]; f32x4 xfn[NR][4]; u32x2 xbn[NR][4];
#define ROW_LOAD(r0_) do { _Pragma("unroll") for (int q = 0; q < NR; ++q) _Pragma("unroll") for (int j = 0; j < 4; ++j) { const size_t mm_ = (size_t)wg * R + (r0_) + q; const int c_ = 4 * lane + 256 * j; \
        ywn[q][j] = *(const u32x2*)(Y + mm_ * 1024 + c_); if (l == 0) xfn[q][j] = *(const f32x4*)(Xin + mm_ * 1024 + c_); else xbn[q][j] = *(const u32x2*)(XB + mm_ * 1024 + c_); } } while (0)
    ROW_LOAD(wave * RPW);
    f32x4 ca1[4], cb1[4], csh[4];
    { const int b = (int)(((size_t)wg * R) / T); const float* mod = MOD + (size_t)(l * 4 + b) * 6144;
#pragma unroll
      for (int j = 0; j < 4; ++j) { const int c = 4 * lane + 256 * j; ca1[j] = *(const f32x4*)(p->in[I_POSTMIXG] + l * 1024 + c) * *(const f32x4*)(mod + 2 * 1024 + c);
          cb1[j] = *(const f32x4*)(p->in[I_PREFFNG] + l * 1024 + c) * (*(const f32x4*)(mod + 4 * 1024 + c) + 1.f); csh[j] = *(const f32x4*)(mod + 3 * 1024 + c); } }
    for (int r0 = wave * RPW; r0 < (wave + 1) * RPW; r0 += NR) {
        const size_t m0 = (size_t)wg * R + r0;
        u32x2 ywc[NR][4]; f32x4 xfc[NR][4];
#pragma unroll
        for (int q = 0; q < NR; ++q)
#pragma unroll
            for (int j = 0; j < 4; ++j) { ywc[q][j] = ywn[q][j]; if (l == 0) xfc[q][j] = xfn[q][j]; else xfc[q][j] = (f32x4){bflo(xbn[q][j].x), bfhi(xbn[q][j].x), bflo(xbn[q][j].y), bfhi(xbn[q][j].y)}; }
        if (r0 + NR < (wave + 1) * RPW) ROW_LOAD(r0 + NR);
        f32x4 h[NR][4];
        { f32x4 y[NR][4]; float ss[NR] = {};
#pragma unroll
          for (int q = 0; q < NR; ++q)
#pragma unroll
              for (int j = 0; j < 4; ++j) { const u32x2 yw = ywc[q][j]; y[q][j] = (f32x4){bflo(yw.x), bfhi(yw.x), bflo(yw.y), bfhi(yw.y)}; ss[q] += (y[q][j].x * y[q][j].x + y[q][j].y * y[q][j].y) + (y[q][j].z * y[q][j].z + y[q][j].w * y[q][j].w); }
          float rstd[NR], s2[NR] = {};
#pragma unroll
          for (int q = 0; q < NR; ++q) rstd[q] = __builtin_amdgcn_rsqf(wave_sum(ss[q]) * (1.f / 1024.f) + RMS_EPS);
#pragma unroll
          for (int j = 0; j < 4; ++j) { const int c = 4 * lane + 256 * j;
#pragma unroll
              for (int q = 0; q < NR; ++q) { const f32x4 x0 = xfc[q][j];
                  const f32x4 x = x0 + ca1[j] * (y[q][j] * rstd[q]); { u32x2 xo; xo.x = pk2(x.x, x.y); xo.y = pk2(x.z, x.w); *(u32x2*)(XB + (m0 + q) * 1024 + c) = xo; } h[q][j] = x;
                  s2[q] += (x.x * x.x + x.y * x.y) + (x.z * x.z + x.w * x.w); } }
          float rstd2[NR];
#pragma unroll
          for (int q = 0; q < NR; ++q) rstd2[q] = __builtin_amdgcn_rsqf(wave_sum(s2[q]) * (1.f / 1024.f) + RMS_EPS);
#pragma unroll
          for (int j = 0; j < 4; ++j) { const int c = 4 * lane + 256 * j;
#pragma unroll
              for (int q = 0; q < NR; ++q) { h[q][j] = h[q][j] * rstd2[q] * cb1[j] + csh[j];
                  if (EXPERT_FP8) *(unsigned*)((unsigned char*)HB + (m0 + q) * 1024 + c) = pk4_fp8(4.f * h[q][j].x, 4.f * h[q][j].y, 4.f * h[q][j].z, 4.f * h[q][j].w);
                  else { u32x2 o; o.x = pk2(h[q][j].x, h[q][j].y); o.y = pk2(h[q][j].z, h[q][j].w); *(u32x2*)(HB + (m0 + q) * 1024 + c) = o; } } } }
        float v16[NR][16];
        const bool b5 = lane & 32;
#pragma unroll
        for (int i = 0; i < 16; ++i) { float lo[NR], hi[NR]; f32x2h_ lo2[NR], hi2[NR];
#pragma unroll
            for (int q = 0; q < NR; ++q) { lo2[q] = (f32x2h_){0.f, 0.f}; hi2[q] = (f32x2h_){0.f, 0.f}; }
#pragma unroll
            for (int j = 0; j < 4; ++j) { const f32x4 wl = *(const LAS f32x4*)(wt + i * ROW_WT_LD + 4 * lane + 256 * j), wh = *(const LAS f32x4*)(wt + (i + 16) * ROW_WT_LD + 4 * lane + 256 * j);
                const f32x2h_ wl0 = {wl.x, wl.y}, wl1 = {wl.z, wl.w}, wh0 = {wh.x, wh.y}, wh1 = {wh.z, wh.w};
#pragma unroll
                for (int q = 0; q < NR; ++q) { const f32x2h_ h0 = {h[q][j].x, h[q][j].y}, h1 = {h[q][j].z, h[q][j].w};
                    lo2[q] = __builtin_elementwise_fma(h0, wl0, lo2[q]); lo2[q] = __builtin_elementwise_fma(h1, wl1, lo2[q]); hi2[q] = __builtin_elementwise_fma(h0, wh0, hi2[q]); hi2[q] = __builtin_elementwise_fma(h1, wh1, hi2[q]); } }
#pragma unroll
            for (int q = 0; q < NR; ++q) { lo[q] = lo2[q].x + lo2[q].y; hi[q] = hi2[q].x + hi2[q].y; }
#pragma unroll
            for (int q = 0; q < NR; ++q) { const auto sw = __builtin_amdgcn_permlane32_swap(__float_as_uint(lo[q]), __float_as_uint(hi[q]), false, false);
                v16[q][i] = __uint_as_float(sw[0]) + __uint_as_float(sw[1]); } }
#pragma unroll
        for (int q = 0; q < NR; ++q) { const int r = r0 + q; const size_t m = m0 + q;
            float v8[8], v4[4], v2[2], mine;
            { const bool b4 = lane & 16, b3 = lane & 8, b2 = lane & 4, b1 = lane & 2;
#pragma unroll
              for (int i = 0; i < 8; ++i) { const auto sw = __builtin_amdgcn_permlane16_swap(__float_as_uint(v16[q][i]), __float_as_uint(v16[q][i + 8]), false, false); v8[i] = __uint_as_float(sw[0]) + __uint_as_float(sw[1]); }
#pragma unroll
              for (int i = 0; i < 4; ++i) { const float rcv = dppf<DPP_ROR8>(b3 ? v8[i] : v8[i + 4]); v4[i] = (b3 ? v8[i + 4] : v8[i]) + rcv; }
#pragma unroll
              for (int i = 0; i < 2; ++i) { const float rcv = dppf<DPP_HMIRROR>(dppf<DPP_REV4>(b2 ? v4[i] : v4[i + 2])); v2[i] = (b2 ? v4[i + 2] : v4[i]) + rcv; }
              { const float rcv = dppf<DPP_XOR2>(b1 ? v2[0] : v2[1]); mine = (b1 ? v2[1] : v2[0]) + rcv; }
              mine += dppf<DPP_XOR1>(mine); (void)b4; }
            mine += rbias;
            if (lane & 1) mine = -3e38f;
            float tv[4]; int ti[4];
#pragma unroll
            for (int k = 0; k < 4; ++k) { const float mx = wave_max(mine);
                const unsigned long long bal = __ballot(mine == mx && !(lane & 1)); const int wl_ = __ffsll((long long)bal) - 1;
                tv[k] = mx; ti[k] = wl_ >> 1; if (lane == wl_) mine = -3e38f; }
            const float e1 = __expf(tv[1] - tv[0]), e2 = __expf(tv[2] - tv[0]), e3 = __expf(tv[3] - tv[0]); const float inv = __builtin_amdgcn_rcpf(1.f + e1 + e2 + e3);
            if (lane < 4) { const int id = (lane == 0) ? ti[0] : (lane == 1) ? ti[1] : (lane == 2) ? ti[2] : ti[3]; const float gv = ((lane == 0) ? 1.f : (lane == 1) ? e1 : (lane == 2) ? e2 : e3) * inv;
                TOPI[m * 4 + lane] = id; TOPG[m * 4 + lane] = gv; etab[r * 4 + lane] = id; } }
    }
    __syncthreads();
    const int NEn = R * 4;
    if (NEn == NTHREADS) {
        LAS int* wcnt = etab + NTHREADS;
        const int e = etab[tid]; int myrank = 0;
#pragma unroll 4
        for (int q = 0; q < 32; ++q) { const unsigned long long mk = __ballot(e == q); if (e == q) myrank = __popcll(mk & ((1ull << lane) - 1ull)); if (lane == q) wcnt[wave * 32 + q] = __popcll(mk); }
        __syncthreads();
        int pre = 0; for (int w = 0; w < wave; ++w) pre += wcnt[w * 32 + e];
        RANK[(size_t)wg * NEn + tid] = pre + myrank;
        if (tid < 32) { int c = 0;
#pragma unroll
            for (int w = 0; w < NWAVES; ++w) c += wcnt[w * 32 + tid];
            HIST[wg * 32 + tid] = c; }
    } else {
    if (tid < NEn) { const int e = etab[tid]; int rk = 0; for (int j = 0; j < tid; ++j) rk += (etab[j] == e) ? 1 : 0; RANK[(size_t)wg * NEn + tid] = rk; }
    if (tid < 32) { int c = 0; for (int j = 0; j < NEn; ++j) c += (etab[j] == tid) ? 1 : 0; HIST[wg * 32 + tid] = c; }
    }
    __syncthreads();
}

__device__ __forceinline__ void ph_offs(PrmP p, int l, LAS unsigned char* lds, int wg, int nwg) {
    const int tid = fresh_tid(), lane = tid & 63, wave = tid >> 6;
    const int R = M / nwg, NEn = R * 4;
    const int* TOPI = (const int*)(p->ws + WS_MISC + MS_TOPI); const int* RANK = (const int*)(p->ws + WS_MISC + MS_RANK); const int* HIST = (const int*)(p->ws + WS_MISC + MS_HIST);
    int* POS = (int*)(p->ws + WS_MISC + MS_POS); int* TILE_E = (int*)(p->ws + WS_MISC + MS_TILEE); int* CTL = (int*)(p->ws + WS_CTL);
    const bf16_t* HB = (const bf16_t*)(p->ws + WS_HB); bf16_t* XS = (bf16_t*)(p->ws + WS_XS);
    LAS int* tot = (LAS int*)lds; LAS int* mine = tot + 32; LAS int* base = mine + 32; LAS int* ptab = base + 32;
    __syncthreads();
    { LAS int* part = ptab + 512;
      const int e = tid & 31, pt = tid >> 5, per = (nwg + 15) / 16; int t = 0, mb = 0;
      for (int w = pt * per; w < (pt + 1) * per && w < nwg; ++w) { const int c = HIST[w * 32 + e]; t += c; mb += (w < wg) ? c : 0; }
      part[(pt * 2 + 0) * 32 + e] = t; part[(pt * 2 + 1) * 32 + e] = mb;
      __syncthreads();
      if (tid < 32) { int ts = 0, ms = 0;
#pragma unroll
          for (int q = 0; q < 16; ++q) { ts += part[(q * 2 + 0) * 32 + tid]; ms += part[(q * 2 + 1) * 32 + tid]; }
          tot[tid] = ts; mine[tid] = ms; } }
    __syncthreads();
    if (tid == 0) { int run = 0; for (int e = 0; e < 32; ++e) { const int pad = (tot[e] + 255) / 256 * 256; base[e] = run + mine[e];
            if (wg == 0) for (int t = run / 256; t < (run + pad) / 256; ++t) TILE_E[t] = e;
            run += pad; }
        if (wg == 0) CTL[CW_NT] = run / 256; }
    __syncthreads();
    int* ROWTOK = (int*)(p->ws + WS_MISC + MS_ROWTOK);
    if (tid < NEn) { const size_t idx = (size_t)wg * NEn + tid; const int pos = base[TOPI[idx]] + RANK[idx]; POS[idx] = pos; ptab[tid] = pos; ROWTOK[pos] = (int)(idx >> 2); }
    if (wg < 32) { const int e = wg, st = base[e] - mine[e] + tot[e], en = base[e] - mine[e] + (tot[e] + 255) / 256 * 256; for (int r = st + tid; r < en; r += NTHREADS) ROWTOK[r] = 0; }
    __syncthreads();
    if (EXPERT_FP8) return;
    for (int r0 = wave * (R / NWAVES); r0 < (wave + 1) * (R / NWAVES); r0 += 4) {
        u32x4 va[4], vb[4];
        if (EXPERT_FP8) {
#pragma unroll
            for (int q = 0; q < 4; ++q) va[q] = ((const u32x4*)((const unsigned char*)HB + ((size_t)wg * R + r0 + q) * 1024))[lane];
#pragma unroll
            for (int q = 0; q < 4; ++q)
#pragma unroll
                for (int k = 0; k < 4; ++k) ((u32x4*)((unsigned char*)XS + (size_t)ptab[(r0 + q) * 4 + k] * 1024))[lane] = va[q];
        } else {
#pragma unroll
        for (int q = 0; q < 4; ++q) { const u32x4* src = (const u32x4*)(HB + ((size_t)wg * R + r0 + q) * 1024); va[q] = src[lane]; vb[q] = src[lane + 64]; }
#pragma unroll
        for (int q = 0; q < 4; ++q)
#pragma unroll
            for (int k = 0; k < 4; ++k) { u32x4* dst = (u32x4*)(XS + (size_t)ptab[(r0 + q) * 4 + k] * 1024); dst[lane] = va[q]; dst[lane + 64] = vb[q]; }
        }
    }
}

__device__ __forceinline__ void ph_comb(PrmP p, int l, int wg, int nwg) {
    const int tid = fresh_tid(), lane = tid & 63, wave = tid >> 6;
    const bf16_t* YR = (const bf16_t*)(p->ws + WS_YR); const int* POS = (const int*)(p->ws + WS_MISC + MS_POS); const float* TOPG = (const float*)(p->ws + WS_MISC + MS_TOPG);
    const float* MOD = (const float*)(p->ws + WS_MOD); float* X = p->out; bf16_t* XB = (bf16_t*)(p->ws + WS_XB);
    static_assert(YR_FP8, "the combine is written for the fp8 expert-output rows");
    const int R = M / nwg, RPW = R / NWAVES, mbeg = wg * R + wave * RPW, b = (wg * R) / T;
    float a1[16], b1[16], shv[16];
    { const float* gate = MOD + (size_t)(l * 4 + b) * 6144 + 5 * 1024; const float* shift = MOD + (size_t)((l + 1 < NL ? l + 1 : l) * 4 + b) * 6144; const float* scale = shift + 1024; const float* g2 = p->in[I_PREMIXG] + (l + 1 < NL ? l + 1 : l) * 1024;
#pragma unroll
      for (int hq = 0; hq < 4; ++hq) { const int c = (hq >> 1) * 512 + 8 * lane + 4 * (hq & 1); const f32x4 g = *(const f32x4*)(p->in[I_POSTFFNG] + l * 1024 + c), gt = *(const f32x4*)(gate + c);
          const f32x4 gg = *(const f32x4*)(g2 + c), sc = *(const f32x4*)(scale + c), sh = *(const f32x4*)(shift + c);
#pragma unroll
          for (int e = 0; e < 4; ++e) { a1[hq * 4 + e] = gt[e] * g[e]; b1[hq * 4 + e] = gg[e] * (sc[e] + 1.f); shv[hq * 4 + e] = sh[e]; } } }
    int posv = POS[(size_t)mbeg * 4 + (lane & 3)]; float gvv = TOPG[(size_t)mbeg * 4 + (lane & 3)];
    for (int m = mbeg; m < mbeg + RPW; ++m) {
        const int posc = posv; const float gvc = gvv;
        if (m + 1 < mbeg + RPW) { posv = POS[(size_t)(m + 1) * 4 + (lane & 3)]; gvv = TOPG[(size_t)(m + 1) * 4 + (lane & 3)]; }
        float y[16];
#pragma unroll
        for (int i = 0; i < 16; ++i) y[i] = 0.f;
#pragma unroll
        for (int k = 0; k < 4; ++k) { const int pos = __builtin_amdgcn_readlane(posc, k); const float gv = __builtin_bit_cast(float, __builtin_amdgcn_readlane(__builtin_bit_cast(int, gvc), k));
            typedef float f32x2_ __attribute__((ext_vector_type(2))); const float g16 = gv * 0.0625f;
            const unsigned char* yrow = (const unsigned char*)YR + ((size_t)(pos >> 8) * 1024 + (lane >> 5) * 256 + (pos & 255)) * 256 + 8 * (lane & 31);
            const u32x2 a8 = *(const u32x2*)(yrow), c8 = *(const u32x2*)(yrow + 2 * 65536);
            const unsigned wv[4] = {a8.x, a8.y, c8.x, c8.y};
#pragma unroll
            for (int q = 0; q < 4; ++q) { const f32x2_ lo = __builtin_amdgcn_cvt_pk_f32_fp8((int)wv[q], false), hi = __builtin_amdgcn_cvt_pk_f32_fp8((int)wv[q], true);
                y[4 * q + 0] += g16 * lo.x; y[4 * q + 1] += g16 * lo.y; y[4 * q + 2] += g16 * hi.x; y[4 * q + 3] += g16 * hi.y; } }
        float ss = 0.f;
#pragma unroll
        for (int i = 0; i < 16; ++i) ss += y[i] * y[i];
        const float rstd = __builtin_amdgcn_rsqf(wave_sum(ss) * (1.f / 1024.f) + RMS_EPS);
        float xs[16]; float s2 = 0.f;
#pragma unroll
        for (int hf = 0; hf < 2; ++hf) { const int c0 = hf * 512 + 8 * lane;
#pragma unroll
            for (int q = 0; q < 2; ++q) { const int c = c0 + 4 * q, i0 = hf * 8 + 4 * q; const u32x2 xw = *(const u32x2*)(XB + (size_t)m * 1024 + c); f32x4 xv = (f32x4){bflo(xw.x), bfhi(xw.x), bflo(xw.y), bfhi(xw.y)};
                xv.x += a1[i0 + 0] * (y[i0 + 0] * rstd); xv.y += a1[i0 + 1] * (y[i0 + 1] * rstd); xv.z += a1[i0 + 2] * (y[i0 + 2] * rstd); xv.w += a1[i0 + 3] * (y[i0 + 3] * rstd);
                if (l + 1 < NL) { u32x2 xo; xo.x = pk2(xv.x, xv.y); xo.y = pk2(xv.z, xv.w); *(u32x2*)(XB + (size_t)m * 1024 + c) = xo; } else *(f32x4*)(X + (size_t)m * 1024 + c) = xv;
                xs[i0 + 0] = xv.x; xs[i0 + 1] = xv.y; xs[i0 + 2] = xv.z; xs[i0 + 3] = xv.w; s2 += (xv.x * xv.x + xv.y * xv.y) + (xv.z * xv.z + xv.w * xv.w); } }
        if (l + 1 < NL) {
            const float rs2 = __builtin_amdgcn_rsqf(wave_sum(s2) * (1.f / 1024.f) + RMS_EPS);
            bf16_t* HB = (bf16_t*)(p->ws + WS_HB);
#pragma unroll
            for (int hf = 0; hf < 2; ++hf) { const int c0 = hf * 512 + 8 * lane; float hv[8];
#pragma unroll
                for (int i = 0; i < 8; ++i) hv[i] = xs[hf * 8 + i] * rs2 * b1[hf * 8 + i] + shv[hf * 8 + i];
                u32x4 o; o.x = pk2(hv[0], hv[1]); o.y = pk2(hv[2], hv[3]); o.z = pk2(hv[4], hv[5]); o.w = pk2(hv[6], hv[7]);
                *(u32x4*)(HB + (size_t)m * 1024 + c0) = o; } }
    }
}

__device__ __forceinline__ void ph_tables(PrmP p, int wg, int nwg) {
    const int tid = fresh_tid(), lane = tid & 63, wave = tid >> 6;
    for (int it = wave * nwg + wg; it < NL * 16; it += nwg * NWAVES) s5m_table_build(p, it >> 4, it & 15, lane);
}

#define XB_TMO      128
#define XB_XCNT(j)  (256  + 64 * (j))
#define XB_XSUB(j)  (1280 + 64 * (j))
#define XB_XGEN(j)  (2304 + 64 * (j))
#define XB_TOP      3328
#define XB_TOPGEN   3392
#define XCD_BAR_WORDS 3456
#define XB_SPIN_CAP (1u << 22)

__device__ __forceinline__ unsigned xb_ld(unsigned* p)              { return __hip_atomic_load(p, __ATOMIC_RELAXED, __HIP_MEMORY_SCOPE_AGENT); }
__device__ __forceinline__ unsigned xb_add(unsigned* p, unsigned v) { return __hip_atomic_fetch_add(p, v, __ATOMIC_RELAXED, __HIP_MEMORY_SCOPE_AGENT); }
__device__ __forceinline__ unsigned xb_xcc_id() { return (unsigned)__builtin_amdgcn_s_getreg((3 << 11) | 20) & 0xFu; }
#define XB_SPIN(cond, bar) do { unsigned _sp = 0; while (cond) { __builtin_amdgcn_s_sleep(1); \
    if ((++_sp & 255u) == 0u) { if (xb_ld(&(bar)[XB_TMO])) break; if (_sp > XB_SPIN_CAP) { atomicAdd(&(bar)[XB_TMO], 1u); break; } } } } while (0)

struct XcdBarrier { unsigned* bar; unsigned x; volatile LAS unsigned* st; };

__device__ __forceinline__ XcdBarrier xcd_barrier_post(unsigned* bar, volatile LAS unsigned* st) {
    XcdBarrier b; b.bar = bar; b.x = xb_xcc_id(); b.st = st;
    if (threadIdx.x == 0) (void)xb_add(&bar[XB_XCNT(b.x)], 1u);
    return b;
}
__device__ __forceinline__ void xcd_barrier_complete(unsigned* bar, unsigned x, unsigned& nloc, unsigned& nx) {
    const unsigned G = gridDim.x * gridDim.y * gridDim.z;
    unsigned sum, cnt, mine, sp = 0u;
    for (;;) {
        sum = 0u; cnt = 0u; mine = 0u;
#pragma unroll
        for (unsigned j = 0; j < 16; ++j) { const unsigned c = xb_ld(&bar[XB_XCNT(j)]); sum += c; cnt += (c > 0u) ? 1u : 0u; mine = (j == x) ? c : mine; }
        if (sum == G) break;
        __builtin_amdgcn_s_sleep(1);
        if ((++sp & 255u) == 0u) { if (xb_ld(&bar[XB_TMO])) break; if (sp > XB_SPIN_CAP) { atomicAdd(&bar[XB_TMO], 1u); break; } }
    }
    nloc = mine > 0u ? mine : 1u; nx = cnt > 0u ? cnt : 1u;
}
__device__ __forceinline__ void xcd_barrier(const XcdBarrier& b) {
    asm volatile("s_waitcnt vmcnt(0)" ::: "memory");
    __syncthreads();
    if (threadIdx.x == 0) {
        unsigned* bar = b.bar;
        __builtin_amdgcn_s_waitcnt(0);
        unsigned nloc = b.st[0], nx = b.st[1];
        if (nloc == 0u) { xcd_barrier_complete(bar, b.x, nloc, nx); b.st[0] = nloc; b.st[1] = nx; }
        const unsigned old = xb_add(&bar[XB_XSUB(b.x)], 1u);
        const unsigned gen = old / nloc;
        if (old + 1u == (gen + 1u) * nloc) {
            __builtin_amdgcn_fence(__ATOMIC_RELEASE, "agent");
            asm volatile("s_waitcnt vmcnt(0)" ::: "memory");
            const unsigned og = xb_add(&bar[XB_TOP], 1u);
            const unsigned tg = og / nx;
            if (og + 1u == (tg + 1u) * nx) xb_add(&bar[XB_TOPGEN], 1u);
            else XB_SPIN(xb_ld(&bar[XB_TOPGEN]) == tg, bar);
            __builtin_amdgcn_fence(__ATOMIC_ACQUIRE, "agent");
            xb_add(&bar[XB_XGEN(b.x)], 1u);
            asm volatile("s_waitcnt vmcnt(0)" ::: "memory");
        } else {
            XB_SPIN(xb_ld(&bar[XB_XGEN(b.x)]) == gen, bar);
            __builtin_amdgcn_fence(__ATOMIC_ACQUIRE, "agent");
            asm volatile("s_waitcnt vmcnt(0)" ::: "memory");
        }
    }
    __syncthreads();
}

constexpr int LDS_BYTES = 163840;
constexpr int LDS_BAR_OFF = LDS_BYTES - 64;
constexpr int CW_BAR = 4096;

__global__ void __launch_bounds__(NTHREADS, 2) mk_fwd(Prm p_unused) {
    extern __shared__ __attribute__((aligned(16))) unsigned char lds_raw[];
    LAS unsigned char* lds = (LAS unsigned char*)lds_raw;
    const int wg = blockIdx.x, nwg = gridDim.x;
    if (threadIdx.x < 4) ((LAS unsigned*)(lds + LDS_BAR_OFF))[threadIdx.x] = 0u;
    __syncthreads();
    (void)xcd_barrier_post((unsigned*)(prm_fresh()->ws + WS_CTL) + CW_BAR, (volatile LAS unsigned*)(lds + LDS_BAR_OFF));
#define GRID_BAR() do { XcdBarrier b_; b_.bar = (unsigned*)(prm_fresh()->ws + WS_CTL) + CW_BAR; b_.x = xb_xcc_id(); b_.st = (volatile LAS unsigned*)(lds + LDS_BAR_OFF); xcd_barrier(b_); } while (0)
#ifndef REP_PHASE
#define REP_PHASE -1
#endif
#define PHASE(id, call) do { call; GRID_BAR(); if (REP_PHASE == (id)) { call; GRID_BAR(); } } while (0)
    PHASE(0, (ph_prologue(prm_fresh(), lds, wg, nwg), ph_tables(prm_fresh(), wg, nwg)));
#define MK_LAYER(l) do { \
        if ((l) == 0) PHASE(1, ph_norm1(prm_fresh(), l, wg, nwg));     \
        PHASE(2, fg_gemm_in(prm_fresh(), l, lds, wg, nwg)); \
        PHASE(3, fs_scan(prm_fresh(), l, lds, wg, nwg)); \
        fa_attn(prm_fresh(), l, lds, wg, nwg); GRID_BAR(); \
        PHASE(5, fs_fin(prm_fresh(), l, lds, wg, nwg)); \
        PHASE(6, fg_gemm_out(prm_fresh(), l, lds, wg, nwg)); \
        ph_row(prm_fresh(), l, lds, wg, nwg); GRID_BAR(); \
        PHASE(8, ph_offs(prm_fresh(), l, lds, wg, nwg)); \
        PHASE(9, fg_gemm1(prm_fresh(), l, lds, wg, nwg)); \
        PHASE(10, fg_gemm2(prm_fresh(), l, lds, wg, nwg)); \
        ph_comb(prm_fresh(), l, wg, nwg); if ((l) + 1 < NL) GRID_BAR(); } while (0)
    MK_LAYER(0);
    MK_LAYER(1);
#undef MK_LAYER
}

extern "C" void kernel_launch(void* const* d_in, const int* in_sizes, int n_in, void* d_out, int out_size, void* d_ws, size_t ws_size, hipStream_t stream) {
    if (n_in != N_IN || out_size != M * D || ws_size < WS_END) { fprintf(stderr, "kernel_launch: unexpected shapes: n_in %d out %d ws %zu (need %zu)\n", n_in, out_size, ws_size, (size_t)WS_END); return; }
    Prm p{};
    for (int i = 0; i < N_IN; ++i) p.in[i] = (const float*)d_in[i];
    p.out = (float*)d_out; p.ws = (unsigned char*)d_ws;
    (void)hipMemsetAsync((char*)d_ws + WS_CTL, 0, 1 * MiB, stream);
    static int grid = 0;
    if (grid == 0) {
        int dev = 0, cus = 0, per_cu = 0;
        if (hipGetDevice(&dev) != hipSuccess || hipDeviceGetAttribute(&cus, hipDeviceAttributeMultiprocessorCount, dev) != hipSuccess) { fprintf(stderr, "kernel_launch: device query failed\n"); grid = -1; return; }
        if (hipFuncSetAttribute((const void*)mk_fwd, hipFuncAttributeMaxDynamicSharedMemorySize, LDS_BYTES) != hipSuccess) { fprintf(stderr, "kernel_launch: hipFuncSetAttribute failed\n"); grid = -1; return; }
        if (hipOccupancyMaxActiveBlocksPerMultiprocessor(&per_cu, (const void*)mk_fwd, NTHREADS, LDS_BYTES) != hipSuccess || per_cu < 1) fprintf(stderr, "kernel_launch: occupancy query reports %d\n", per_cu);
        (void)hipGetLastError();
        grid = 256;
        if (cus < 256) fprintf(stderr, "kernel_launch: %d CUs: 256 workgroups of 144 KiB LDS cannot all be resident\n", cus);
    }
    if (grid < 0) return;
    hipLaunchKernelGGL(mk_fwd, dim3(grid), dim3(NTHREADS), LDS_BYTES, stream, p);
}
```
